# Optimizing an MI355X kernel written in HIP

```python
import math
import jax, jax.numpy as jnp
from jax import lax
import numpy as np

D_MODEL = 1024
BATCH = 8
SEQ = 4096
DEPTH = 1

EPS = 1e-6
Q_BLOCK = 128
H_A = 8
QK_NOPE = 128
QK_ROPE = 64
V_DIM = 128
Q_LORA = 256
KV_LORA = 128
ROPE_THETA = 10000.0
H_B = 16
KV_B = 4
GROUP = H_B // KV_B
HD_B = 64
WINDOW = 128
NUM_BUCKETS = 32
MAX_DISTANCE = 128
D_FF = 2816
CONV_W = 3

W_IN_SIZES = (Q_LORA, KV_LORA + QK_ROPE, H_B * HD_B, KV_B * HD_B, KV_B * HD_B, D_MODEL, D_MODEL)
W_IN_COLS = sum(W_IN_SIZES)
W_IN_SPLITS = tuple(int(s) for s in np.cumsum(W_IN_SIZES)[:-1])

kernel_name = "hybrid_mla_swa_gated_convffn_encoder"


def rms_norm(x, g):
    xf = x.astype(jnp.float32)
    y = xf * lax.rsqrt(jnp.mean(xf * xf, axis=-1, keepdims=True) + EPS)
    return (y * g.astype(jnp.float32)).astype(x.dtype)


def apply_rope(x, positions):
    half = QK_ROPE // 2
    inv_freq = ROPE_THETA ** (-jnp.arange(half, dtype=jnp.float32) / half)
    ang = positions.astype(jnp.float32)[:, None] * inv_freq[None, :]
    cos = jnp.cos(ang)[None, :, None, :]
    sin = jnp.sin(ang)[None, :, None, :]
    xf = x.astype(jnp.float32)
    x1, x2 = xf[..., :half], xf[..., half:]
    out = jnp.concatenate([x1 * cos - x2 * sin, x2 * cos + x1 * sin], axis=-1)
    return out.astype(x.dtype)


def t5_bucket(rel):
    nb = NUM_BUCKETS // 2
    max_exact = nb // 2
    base = (rel > 0).astype(jnp.int32) * nb
    n = jnp.abs(rel)
    nf = jnp.maximum(n, 1).astype(jnp.float32)
    large = max_exact + (jnp.log(nf / max_exact) / math.log(MAX_DISTANCE / max_exact)
                         * (nb - max_exact)).astype(jnp.int32)
    large = jnp.minimum(large, nb - 1)
    return base + jnp.where(n < max_exact, n, large)


def mla_branch(q_lat, kv_lat, positions, q_a_norm_g, w_q_b, kv_a_norm_g, w_kv_b):
    B, S, _ = q_lat.shape
    q = (rms_norm(q_lat, q_a_norm_g) @ w_q_b).reshape(B, S, H_A, QK_NOPE + QK_ROPE)
    q = jnp.concatenate([q[..., :QK_NOPE], apply_rope(q[..., QK_NOPE:], positions)], axis=-1)
    c_kv, k_rope = kv_lat[..., :KV_LORA], kv_lat[..., KV_LORA:]
    kv = (rms_norm(c_kv, kv_a_norm_g) @ w_kv_b).reshape(B, S, H_A, QK_NOPE + V_DIM)
    k_nope, v = kv[..., :QK_NOPE], kv[..., QK_NOPE:]
    k_rope = apply_rope(k_rope[:, :, None, :], positions)
    k = jnp.concatenate([k_nope, jnp.broadcast_to(k_rope, (B, S, H_A, QK_ROPE))], axis=-1)
    scale = 1.0 / math.sqrt(QK_NOPE + QK_ROPE)
    nblk = S // Q_BLOCK
    qb = q.reshape(B, nblk, Q_BLOCK, H_A, QK_NOPE + QK_ROPE).transpose(1, 0, 2, 3, 4)

    def attend(q_blk):
        s = jnp.einsum('bqhd,bkhd->bhqk', q_blk, k, preferred_element_type=jnp.float32) * scale
        p = jax.nn.softmax(s, axis=-1).astype(v.dtype)
        return jnp.einsum('bhqk,bkhd->bqhd', p, v)

    o = lax.map(attend, qb)
    return o.transpose(1, 0, 2, 3, 4).reshape(B, S, H_A * V_DIM)


def window_branch(q, k, v, rel_bias, sinks):
    B, S, _ = q.shape
    q = q.reshape(B, S, KV_B, GROUP, HD_B)
    k = k.reshape(B, S, KV_B, HD_B)
    v = v.reshape(B, S, KV_B, HD_B)
    pad = ((0, 0), (WINDOW, WINDOW), (0, 0), (0, 0))
    kp = jnp.pad(k, pad)
    vp = jnp.pad(v, pad)
    span = Q_BLOCK + 2 * WINDOW
    a = jnp.arange(Q_BLOCK, dtype=jnp.int32)[:, None]
    c = jnp.arange(span, dtype=jnp.int32)[None, :]
    rel = c - WINDOW - a
    in_band = jnp.abs(rel) <= WINDOW
    bias = rel_bias[t5_bucket(rel)].astype(jnp.float32)
    bias = bias.transpose(2, 0, 1).reshape(KV_B, GROUP, Q_BLOCK, span)
    sink = sinks.astype(jnp.float32).reshape(1, KV_B, GROUP, 1, 1)
    scale = 1.0 / math.sqrt(HD_B)
    nblk = S // Q_BLOCK
    qb = q.reshape(B, nblk, Q_BLOCK, KV_B, GROUP, HD_B).transpose(1, 0, 2, 3, 4, 5)

    def attend(args):
        q_blk, n = args
        start = n * Q_BLOCK
        k_blk = lax.dynamic_slice_in_dim(kp, start, span, axis=1)
        v_blk = lax.dynamic_slice_in_dim(vp, start, span, axis=1)
        key_pos = start - WINDOW + c
        valid = in_band & (key_pos >= 0) & (key_pos < S)
        s = jnp.einsum('bqhgd,bkhd->bhgqk', q_blk, k_blk,
                       preferred_element_type=jnp.float32) * scale + bias
        s = jnp.where(valid, s, -1e30)
        sink_col = jnp.broadcast_to(sink, (B, KV_B, GROUP, Q_BLOCK, 1))
        p = jax.nn.softmax(jnp.concatenate([s, sink_col], axis=-1), axis=-1)[..., :span]
        return jnp.einsum('bhgqk,bkhd->bqhgd', p.astype(v_blk.dtype), v_blk)

    o = lax.map(attend, (qb, jnp.arange(nblk, dtype=jnp.int32)))
    return o.transpose(1, 0, 2, 3, 4, 5).reshape(B, S, H_B * HD_B)


def conv_ffn(h, w_up, conv_w, conv_b, w_down):
    u = h @ w_up
    up = jnp.pad(u, ((0, 0), (1, 1), (0, 0)))
    u = up[:, :-2] * conv_w[0] + up[:, 1:-1] * conv_w[1] + up[:, 2:] * conv_w[2] + conv_b
    g, val = u[..., :D_FF], u[..., D_FF:]
    return (jax.nn.silu(g) * val) @ w_down


def setup_inputs(seed: int = 0) -> dict:
    key = jax.random.key(seed)
    ks = jax.random.split(key, 20)
    f32 = jnp.float32
    L = DEPTH

    def nrm(k, shape, scale):
        return jax.random.normal(k, shape, f32) * scale

    def gain(k, shape):
        return 1.0 + 0.05 * jax.random.normal(k, shape, f32)

    return {
        "x": jax.random.normal(ks[0], (BATCH, SEQ, D_MODEL), f32),
        "positions": jnp.arange(SEQ, dtype=jnp.int32),
        "norm1_g": gain(ks[1], (L, D_MODEL)),
        "w_in": nrm(ks[2], (L, D_MODEL, W_IN_COLS), D_MODEL ** -0.5),
        "q_a_norm_g": gain(ks[3], (L, Q_LORA)),
        "w_q_b": nrm(ks[4], (L, Q_LORA, H_A * (QK_NOPE + QK_ROPE)), Q_LORA ** -0.5),
        "kv_a_norm_g": gain(ks[5], (L, KV_LORA)),
        "w_kv_b": nrm(ks[6], (L, KV_LORA, H_A * (QK_NOPE + V_DIM)), KV_LORA ** -0.5),
        "rel_bias": nrm(ks[7], (NUM_BUCKETS, H_B), 0.5),
        "sinks": nrm(ks[8], (L, H_B), 0.5),
        "w_out": nrm(ks[9], (L, D_MODEL, D_MODEL), D_MODEL ** -0.5),
        "norm2_g": gain(ks[10], (L, D_MODEL)),
        "w_up": nrm(ks[11], (L, D_MODEL, 2 * D_FF), D_MODEL ** -0.5),
        "conv_w": nrm(ks[12], (L, CONV_W, 2 * D_FF), CONV_W ** -0.5),
        "conv_b": nrm(ks[13], (L, 2 * D_FF), 0.02),
        "w_down": nrm(ks[14], (L, D_FF, D_MODEL), D_FF ** -0.5),
        "final_norm_g": gain(ks[15], (D_MODEL,)),
    }


def reference(x, positions, norm1_g, w_in, q_a_norm_g, w_q_b, kv_a_norm_g, w_kv_b, rel_bias,
              sinks, w_out, norm2_g, w_up, conv_w, conv_b, w_down, final_norm_g):
    for l in range(DEPTH):
        h = rms_norm(x, norm1_g[l])
        proj = h @ w_in[l]
        q_lat, kv_lat, q_b, k_b, v_b, gate_a, gate_b = jnp.split(proj, W_IN_SPLITS, axis=-1)
        o_a = mla_branch(q_lat, kv_lat, positions, q_a_norm_g[l], w_q_b[l],
                         kv_a_norm_g[l], w_kv_b[l])
        o_b = window_branch(q_b, k_b, v_b, rel_bias, sinks[l])
        mixed = jax.nn.sigmoid(gate_a) * o_a + jax.nn.sigmoid(gate_b) * o_b
        x = x + mixed @ w_out[l]
        x = x + conv_ffn(rms_norm(x, norm2_g[l]), w_up[l], conv_w[l], conv_b[l], w_down[l])
    return rms_norm(x, final_norm_g)
```

```cpp
#include <hip/hip_runtime.h>
#include <cstdio>
#include <cstdint>
namespace pg8 {
#define PG8_LAS __attribute__((address_space(3)))
typedef unsigned short bf16_t;
typedef short bf16x8 __attribute__((ext_vector_type(8)));
typedef float f32x4 __attribute__((ext_vector_type(4)));
typedef unsigned u32x4 __attribute__((ext_vector_type(4)));
constexpr int BM = 256, BK = 64, HALF = 128, HTB = HALF * BK * 2  , STAGE_BYTES = 8 * HTB, NXCD = 8, WGM = 8;

__host__ __device__ __forceinline__ int lds_byte(int r, int c) { const int st = (r >> 4) * 2 + (c >> 5), rr = r & 15, cc = c & 31, ob = rr * 64 + cc * 2; return st * 1024 + (ob ^ (((ob >> 9) & 1) << 5)); }
__host__ __device__ __forceinline__ void stage_rc(int b, int& R, int& C) { const int st = b / 1024, sb = b % 1024, swz = sb ^ (((sb >> 9) & 1) << 5); R = (st >> 1) * 16 + swz / 64; C = (st & 1) * 32 + (swz % 64) / 2; }
__host__ __device__ __forceinline__ int perm32(int rho) { const int n = rho >> 4, i = rho & 15; return 8 * (i >> 2) + 4 * n + (i & 3); }

struct Unit { int pm, pn; };
struct Gemm { const bf16_t* A; const bf16_t* Bt; int M, N, K; };

struct StaticOrder {
    int nM, nN, nwg, G, c;
    __host__ __device__ void init(int M, int N, int G_, int c_) { nM = M / BM; nN = N / BM; nwg = nM * nN; G = G_; c = c_; }
    __host__ __device__ bool next(int i, Unit& u) const {
        const long L = (long)i * G + c; if (L >= nwg) return false;
        int wgid = (int)L; { const int q = nwg / NXCD, r = nwg % NXCD, xcd = wgid % NXCD, off = wgid / NXCD; wgid = (xcd < r ? xcd * (q + 1) : r * (q + 1) + (xcd - r) * q) + off; }
        const int nig = WGM * nN, gid = wgid / nig, fm = gid * WGM, gsz = (nM - fm) < WGM ? (nM - fm) : WGM;
        u.pm = fm + ((wgid % nig) % gsz); u.pn = (wgid % nig) / gsz; return true;
    }
    __device__ __forceinline__ void a_ready(const Unit&) const {}
    __device__ __forceinline__ void done(const Unit&) const {}
};

__device__ __forceinline__ unsigned cvt_pk_bf16(float lo, float hi) { unsigned r; asm volatile("v_cvt_pk_bf16_f32 %0, %1, %2" : "=v"(r) : "v"(lo), "v"(hi)); return r; }
constexpr int SEQ = 4096, NBATCH = 8, MTOK = NBATCH * SEQ, DM = 1024;
constexpr int DFF = 2816;
constexpr float RMS_EPS = 1e-6f;
constexpr float LOG2E = 1.4426950408889634f;
constexpr float C_MLA = 0.07216878364870322f * LOG2E;
constexpr float C_SWA = 0.125f * LOG2E;

typedef unsigned u32x2 __attribute__((ext_vector_type(2)));
__device__ __forceinline__ int lane_id_fresh() { int l; asm volatile("v_mbcnt_lo_u32_b32 %0, -1, 0\n\tv_mbcnt_hi_u32_b32 %0, -1, %0" : "=v"(l)); return l; }
__device__ __forceinline__ float fast_sigmoid(float v) { return __builtin_amdgcn_rcpf(1.0f + __builtin_amdgcn_exp2f(-LOG2E * v)); }
__device__ __forceinline__ void st8(bf16_t* p, f32x4 v0, f32x4 v1) {
    u32x4 w; w.x = cvt_pk_bf16(v0[0], v0[1]); w.y = cvt_pk_bf16(v0[2], v0[3]); w.z = cvt_pk_bf16(v1[0], v1[1]); w.w = cvt_pk_bf16(v1[2], v1[3]); *(u32x4*)p = w; }
__device__ __forceinline__ void st4(bf16_t* p, f32x4 v) { u32x2 w; w.x = cvt_pk_bf16(v[0], v[1]); w.y = cvt_pk_bf16(v[2], v[3]); *(u32x2*)p = w; }
__device__ __forceinline__ float sq4(f32x4 x) { return (x[0] * x[0] + x[1] * x[1]) + (x[2] * x[2] + x[3] * x[3]); }
__device__ __forceinline__ float fq_sum(float s) { s += __shfl_xor(s, 16); s += __shfl_xor(s, 32); return s; }

__device__ __forceinline__ void rope_store(bf16_t* dst  , int d, int srow, const float* cosT, const float* sinT, f32x4 a, f32x4 b, float sc) {
    const f32x4 c4 = *(const f32x4*)(cosT + srow * 32 + d), s4 = *(const f32x4*)(sinT + srow * 32 + d);
    const f32x4 x1 = {a[0] * sc, a[2] * sc, b[0] * sc, b[2] * sc}, x2 = {a[1] * sc, a[3] * sc, b[1] * sc, b[3] * sc};
    st4(dst + d, x1 * c4 - x2 * s4); st4(dst + 32 + d, x2 * c4 + x1 * s4);
}

struct EpiInProj {
    static constexpr bool PERM = true, AFTER_DRAIN = false;
    bf16_t *qlat, *ckv, *kr, *qb, *kb, *vb, *ga, *gb; float *ssq_q, *ssq_kv; const float *cosT, *sinT;
    __device__ __forceinline__ void operator()(f32x4 (&acc)[2][2][4][2], const Unit& u, int wr, int wc, int fr, int fq) const {
        asm volatile("" : "+v"(fr), "+v"(fq));
        const int pn = u.pn, row0 = u.pm * BM + wr * 64 + fr, cw = wc * 32 + 8 * fq;
        if (pn == 0) {
#pragma unroll
            for (int ai = 0; ai < 2; ++ai)
#pragma unroll
                for (int m = 0; m < 4; ++m) { const int row = row0 + ai * HALF + m * 16;
                    float s = (sq4(acc[ai][0][m][0]) + sq4(acc[ai][0][m][1])) + (sq4(acc[ai][1][m][0]) + sq4(acc[ai][1][m][1]));
                    s = fq_sum(s); if (fq == 0) ssq_q[(size_t)row * 4 + wc] = s;
                    st8(qlat + (size_t)row * 256 + cw, acc[ai][0][m][0], acc[ai][0][m][1]); st8(qlat + (size_t)row * 256 + HALF + cw, acc[ai][1][m][0], acc[ai][1][m][1]);
                    asm volatile("" ::: "memory"); }
        } else if (pn == 1) {
#pragma unroll
            for (int ai = 0; ai < 2; ++ai)
#pragma unroll
                for (int m = 0; m < 4; ++m) { const int row = row0 + ai * HALF + m * 16;
                    float s = sq4(acc[ai][0][m][0]) + sq4(acc[ai][0][m][1]);
                    s = fq_sum(s); if (fq == 0) ssq_kv[(size_t)row * 4 + wc] = s;
                    st8(ckv + (size_t)row * 128 + cw, acc[ai][0][m][0], acc[ai][0][m][1]);
                    if (wc < 2) rope_store(kr + (size_t)row * 64, 16 * wc + 4 * fq, row & (SEQ - 1), cosT, sinT, acc[ai][1][m][0], acc[ai][1][m][1], 1.0f);
                    asm volatile("" ::: "memory"); }
        } else {
            bf16_t* base; int ld, col0; float sc = 1.0f; bool sig = false;
            if (pn < 6) { base = qb; ld = 1024; col0 = (pn - 2) * 256; sc = C_SWA; }
            else if (pn == 6) { base = kb; ld = 256; col0 = 0; }
            else if (pn == 7) { base = vb; ld = 256; col0 = 0; }
            else if (pn < 12) { base = ga; ld = 1024; col0 = (pn - 8) * 256; sig = true; }
            else { base = gb; ld = 1024; col0 = (pn - 12) * 256; sig = true; }
            bf16_t* rowp = base + (size_t)row0 * ld + col0 + cw; const size_t rstep = (size_t)16 * ld;
#pragma unroll
            for (int ai = 0; ai < 2; ++ai)
#pragma unroll
                for (int m = 0; m < 4; ++m) { bf16_t* rp = rowp + (size_t)(ai * 8 + m) * rstep;
#pragma unroll
                    for (int bj = 0; bj < 2; ++bj) { f32x4 v0 = acc[ai][bj][m][0], v1 = acc[ai][bj][m][1];
                        if (sig) {
#pragma unroll
                            for (int e = 0; e < 4; ++e) { v0[e] = fast_sigmoid(v0[e]); v1[e] = fast_sigmoid(v1[e]); } }
                        else { v0 = v0 * sc; v1 = v1 * sc; }
                        st8(rp + bj * HALF, v0, v1); }
                    asm volatile("" ::: "memory"); }
        }
    }
};

struct EpiQProj {
    static constexpr bool PERM = true, AFTER_DRAIN = false;
    bf16_t* qa; const float* ssq; const float *cosT, *sinT;
    __device__ __forceinline__ void operator()(f32x4 (&acc)[2][2][4][2], const Unit& u, int wr, int wc, int fr, int fq) const {
        asm volatile("" : "+v"(fr), "+v"(fq));
        const int pn = u.pn, row0 = u.pm * BM + wr * 64 + fr, cw = wc * 32 + 8 * fq;
#pragma unroll
        for (int ai = 0; ai < 2; ++ai)
#pragma unroll
            for (int m = 0; m < 4; ++m) { const int row = row0 + ai * HALF + m * 16;
                const f32x4 s4 = *(const f32x4*)(ssq + (size_t)row * 4);
                const float rs = C_MLA * __builtin_amdgcn_rsqf(((s4[0] + s4[1]) + (s4[2] + s4[3])) * (1.0f / 256.0f) + RMS_EPS);
                bf16_t* qrow = qa + (size_t)row * 1536;
                if (pn < 4) {
#pragma unroll
                    for (int bj = 0; bj < 2; ++bj) st8(qrow + (2 * pn + bj) * 192 + cw, acc[ai][bj][m][0] * rs, acc[ai][bj][m][1] * rs);
                } else {
#pragma unroll
                    for (int bj = 0; bj < 2; ++bj) { const int head = 4 * (pn - 4) + 2 * bj + (wc >> 1);
                        rope_store(qrow + head * 192 + 128, 16 * (wc & 1) + 4 * fq, row & (SEQ - 1), cosT, sinT, acc[ai][bj][m][0], acc[ai][bj][m][1], rs); }
                }
                asm volatile("" ::: "memory");
            }
    }
};

struct EpiKVProj {
    static constexpr bool PERM = true, AFTER_DRAIN = false;
    bf16_t *kn, *va; const float* ssq;
    __device__ __forceinline__ void operator()(f32x4 (&acc)[2][2][4][2], const Unit& u, int wr, int wc, int fr, int fq) const {
        asm volatile("" : "+v"(fr), "+v"(fq));
        const int pn = u.pn, row0 = u.pm * BM + wr * 64 + fr, cw = wc * 32 + 8 * fq;
#pragma unroll
        for (int ai = 0; ai < 2; ++ai)
#pragma unroll
            for (int m = 0; m < 4; ++m) { const int row = row0 + ai * HALF + m * 16;
                const f32x4 s4 = *(const f32x4*)(ssq + (size_t)row * 4);
                const float rs = __builtin_amdgcn_rsqf(((s4[0] + s4[1]) + (s4[2] + s4[3])) * (1.0f / 128.0f) + RMS_EPS);
                st8(kn + (size_t)row * 1024 + pn * 128 + cw, acc[ai][0][m][0] * rs, acc[ai][0][m][1] * rs);
                st8(va + (size_t)row * 1024 + pn * 128 + cw, acc[ai][1][m][0] * rs, acc[ai][1][m][1] * rs); asm volatile("" ::: "memory"); }
    }
};

struct EpiResidual {
    static constexpr bool PERM = true, AFTER_DRAIN = false;
    const float* base; float* y; bf16_t* yb; float* ssq;
    __device__ __forceinline__ void operator()(f32x4 (&acc)[2][2][4][2], const Unit& u, int wr, int wc, int fr, int fq) const {
        asm volatile("" : "+v"(fr), "+v"(fq));
        const int pn = u.pn, row0 = u.pm * BM + wr * 64 + fr, cw = wc * 32 + 8 * fq;
#pragma unroll
        for (int ai = 0; ai < 2; ++ai)
#pragma unroll
            for (int m = 0; m < 4; ++m) { const int row = row0 + ai * HALF + m * 16; float s = 0.f;
#pragma unroll
                for (int bj = 0; bj < 2; ++bj) { const size_t off = (size_t)row * DM + pn * 256 + bj * HALF + cw;
                    const f32x4 v0 = *(const f32x4*)(base + off) + acc[ai][bj][m][0], v1 = *(const f32x4*)(base + off + 4) + acc[ai][bj][m][1];
                    *(f32x4*)(y + off) = v0; *(f32x4*)(y + off + 4) = v1; if (yb) st8(yb + off, v0, v1);
                    s += sq4(v0) + sq4(v1); }
                s = fq_sum(s); if (fq == 0) ssq[(size_t)row * 16 + pn * 4 + wc] = s; asm volatile("" ::: "memory"); }
    }
};

struct EpiUp {
    static constexpr bool PERM = true, AFTER_DRAIN = false;
    bf16_t* U; int ldu; const float* ssq;
    __device__ __forceinline__ void operator()(f32x4 (&acc)[2][2][4][2], const Unit& u, int wr, int wc, int fr, int fq) const {
        asm volatile("" : "+v"(fr), "+v"(fq));
        const int pn = u.pn, row0 = u.pm * BM + wr * 64 + fr, cw = wc * 32 + 8 * fq;
#pragma unroll
        for (int ai = 0; ai < 2; ++ai)
#pragma unroll
            for (int m = 0; m < 4; ++m) { const int row = row0 + ai * HALF + m * 16;
                const f32x4* sp = (const f32x4*)(ssq + (size_t)row * 16); const f32x4 t = (sp[0] + sp[1]) + (sp[2] + sp[3]);
                const float rs = __builtin_amdgcn_rsqf(((t[0] + t[1]) + (t[2] + t[3])) * (1.0f / 1024.0f) + RMS_EPS);
#pragma unroll
                for (int bj = 0; bj < 2; ++bj) st8(U + (size_t)row * ldu + pn * 256 + bj * HALF + cw, acc[ai][bj][m][0] * rs, acc[ai][bj][m][1] * rs);
                asm volatile("" ::: "memory"); }
    }
};
template <class Epi, class Sched, bool ALIGN_EPI = false, bool SP2 = false>
__device__ __forceinline__ void gemm_phase(PG8_LAS unsigned char* lds, const Gemm g, const Sched& S, const Epi& E, const int wave_id  ) {
    const int lane = lane_id_fresh(), wid = wave_id, tid = wid * 64 + lane,
              wr = wid >> 2, wc = wid & 3, fr = lane & 15, fq = lane >> 4;
    const int K = g.K, nt = K / BK;
    unsigned voffA[2], voffB[2];
#pragma unroll
    for (int i = 0; i < 2; ++i) { int R, C; stage_rc(tid * 16 + i * 8192, R, C); const int Rb = Epi::PERM ? ((R & ~31) + perm32(R & 31)) : R;
        voffA[i] = (unsigned)(R * K + C) * 2u; voffB[i] = (unsigned)(Rb * K + C) * 2u; }
    const size_t kstep = (size_t)(BK * 2);
    const size_t hstep = (size_t)HALF * K * 2;
    const size_t tstep = 2 * hstep;
    const unsigned ldsw = (unsigned)wid * 1024u;
    const int aoff = lds_byte(wr * 64 + fr, fq * 8), boff = lds_byte(wc * 32 + fr, fq * 8);
#define PG8_SA(b, h) (((b) * 2 + (h)) * HTB)
#define PG8_SB(b, h) ((4 + (b) * 2 + (h)) * HTB)
#define PG8_STAGE(bufoff, gbase, voff) do { _Pragma("unroll") for (int _i = 0; _i < 2; ++_i) \
        __builtin_amdgcn_global_load_lds((const unsigned*)((const char*)(gbase) + (voff)[_i]), (PG8_LAS unsigned*)(lds + (bufoff) + ldsw + _i * 8192), 16, 0, 0); } while (0)
#define PG8_LDA(dst, b, h) do { _Pragma("unroll") for (int m = 0; m < 4; ++m) _Pragma("unroll") for (int k = 0; k < 2; ++k) dst[m][k] = *(const PG8_LAS bf16x8*)(lds + PG8_SA(b, h) + aoff + m * 2048 + k * 1024); } while (0)
#define PG8_LDB(dst, b, h) do { _Pragma("unroll") for (int n = 0; n < 2; ++n) _Pragma("unroll") for (int k = 0; k < 2; ++k) dst[n][k] = *(const PG8_LAS bf16x8*)(lds + PG8_SB(b, h) + boff + n * 2048 + k * 1024); } while (0)
#define PG8_MMA(ai, bj, At, Bt) do { __builtin_amdgcn_s_setprio(1); _Pragma("unroll") for (int m = 0; m < 4; ++m) _Pragma("unroll") for (int n = 0; n < 2; ++n) _Pragma("unroll") for (int k = 0; k < 2; ++k) \
        acc[ai][bj][m][n] = __builtin_amdgcn_mfma_f32_16x16x32_bf16(Bt[n][k], At[m][k], acc[ai][bj][m][n], 0, 0, 0); __builtin_amdgcn_s_setprio(0); } while (0)
#define PG8_WAIT_V(n) asm volatile("s_waitcnt vmcnt(" #n ")" ::: "memory")
#define PG8_WAIT_L(n) asm volatile("s_waitcnt lgkmcnt(" #n ")" ::: "memory")
#define PG8_BAR __builtin_amdgcn_s_barrier()
#define PG8_SCHED __builtin_amdgcn_sched_barrier(0)
    Unit cur, nxt; int ui = 0;
    if (!S.next(0, cur)) return;
    f32x4 acc[2][2][4][2];
#pragma unroll
    for (int a = 0; a < 2; ++a)
#pragma unroll
        for (int b = 0; b < 2; ++b)
#pragma unroll
            for (int m = 0; m < 4; ++m)
#pragma unroll
                for (int n = 0; n < 2; ++n) acc[a][b][m][n] = (f32x4){0.f, 0.f, 0.f, 0.f};
    bf16x8 At[4][2], B0[2][2], B1[2][2];
    const char* cA = (const char*)g.A + (size_t)cur.pm * tstep; const char* cB = (const char*)g.Bt + (size_t)cur.pn * tstep;
    S.a_ready(cur);
    if constexpr (SP2) {
        PG8_STAGE(PG8_SB(0, 0), cB, voffB); PG8_STAGE(PG8_SB(0, 1), cB + hstep, voffB); PG8_STAGE(PG8_SA(0, 0), cA, voffA); PG8_STAGE(PG8_SA(0, 1), cA + hstep, voffA);
        if (wr == 1) PG8_BAR;
        PG8_WAIT_V(2); PG8_BAR;
        PG8_STAGE(PG8_SB(1, 0), cB + kstep, voffB); PG8_STAGE(PG8_SA(1, 0), cA + kstep, voffA); PG8_STAGE(PG8_SB(1, 1), cB + hstep + kstep, voffB);
        PG8_WAIT_V(6); PG8_BAR;
    } else {
        PG8_STAGE(PG8_SB(0, 0), cB, voffB); PG8_STAGE(PG8_SA(0, 0), cA, voffA); PG8_STAGE(PG8_SB(0, 1), cB + hstep, voffB); PG8_STAGE(PG8_SA(0, 1), cA + hstep, voffA);
        if (wr == 1) PG8_BAR;
        PG8_WAIT_V(4); PG8_BAR;
        PG8_STAGE(PG8_SB(1, 0), cB + kstep, voffB); PG8_STAGE(PG8_SA(1, 0), cA + kstep, voffA); PG8_STAGE(PG8_SB(1, 1), cB + hstep + kstep, voffB);
        PG8_WAIT_V(6); PG8_BAR;
    }
    for (;;) {
        const bool has_next = S.next(ui + 1, nxt);
        const char* nA = has_next ? (const char*)g.A + (size_t)nxt.pm * tstep : cA; const char* nB = has_next ? (const char*)g.Bt + (size_t)nxt.pn * tstep : cB;
        for (int t = 0; t < nt; t += 2) {
            const bool last = (t == nt - 2);
            const char* a1 = cA + (size_t)(t + 1) * kstep;
            const char* a2 = last ? nA : cA + (size_t)(t + 2) * kstep; const char* b2 = last ? nB : cB + (size_t)(t + 2) * kstep;
            const char* a3 = a2 + kstep; const char* b3 = b2 + kstep;
            if (last && has_next) S.a_ready(nxt);
            if constexpr (SP2) {
            PG8_LDB(B0, 0, 0); PG8_LDB(B1, 0, 1); PG8_SCHED; PG8_LDA(At, 0, 0); PG8_STAGE(PG8_SA(1, 1), a1 + hstep, voffA);
            PG8_WAIT_V(8); PG8_WAIT_L(0); PG8_BAR; PG8_MMA(0, 0, At, B0); PG8_MMA(0, 1, At, B1); PG8_BAR; PG8_SCHED;
            PG8_LDA(At, 0, 1); PG8_STAGE(PG8_SB(0, 0), b2, voffB); PG8_STAGE(PG8_SB(0, 1), b2 + hstep, voffB); PG8_STAGE(PG8_SA(0, 0), a2, voffA);
            PG8_WAIT_V(8); PG8_WAIT_L(0); PG8_BAR; PG8_MMA(1, 0, At, B0); PG8_MMA(1, 1, At, B1); PG8_BAR; PG8_SCHED;
            PG8_LDB(B0, 1, 0); PG8_LDB(B1, 1, 1); PG8_SCHED; PG8_LDA(At, 1, 0); PG8_STAGE(PG8_SA(0, 1), a2 + hstep, voffA);
            PG8_WAIT_V(8); PG8_WAIT_L(0); PG8_BAR; PG8_MMA(0, 0, At, B0); PG8_MMA(0, 1, At, B1); PG8_BAR; PG8_SCHED;
            PG8_LDA(At, 1, 1); PG8_STAGE(PG8_SB(1, 0), b3, voffB); PG8_STAGE(PG8_SB(1, 1), b3 + hstep, voffB); PG8_STAGE(PG8_SA(1, 0), a3, voffA);
            PG8_WAIT_V(8); PG8_WAIT_L(0); PG8_BAR; PG8_MMA(1, 0, At, B0); PG8_MMA(1, 1, At, B1); PG8_BAR; PG8_SCHED;
            } else {
            PG8_LDB(B0, 0, 0); PG8_SCHED; PG8_LDA(At, 0, 0); PG8_STAGE(PG8_SA(1, 1), a1 + hstep, voffA);
            PG8_WAIT_L(8); PG8_BAR; PG8_WAIT_L(0); PG8_MMA(0, 0, At, B0); PG8_BAR; PG8_SCHED;
            PG8_LDB(B1, 0, 1); PG8_STAGE(PG8_SB(0, 0), b2, voffB);
            PG8_BAR; PG8_WAIT_L(0); PG8_MMA(0, 1, At, B1); PG8_BAR;
            PG8_LDA(At, 0, 1); PG8_STAGE(PG8_SA(0, 0), a2, voffA);
            PG8_BAR; PG8_WAIT_L(0); PG8_MMA(1, 0, At, B0); PG8_BAR; PG8_SCHED;
            PG8_STAGE(PG8_SB(0, 1), b2 + hstep, voffB);
            PG8_WAIT_V(6); PG8_BAR; PG8_MMA(1, 1, At, B1); PG8_BAR;
            PG8_LDB(B0, 1, 0); PG8_SCHED; PG8_LDA(At, 1, 0); PG8_STAGE(PG8_SA(0, 1), a2 + hstep, voffA);
            PG8_WAIT_L(8); PG8_BAR; PG8_WAIT_L(0); PG8_MMA(0, 0, At, B0); PG8_BAR; PG8_SCHED;
            PG8_LDB(B1, 1, 1); PG8_STAGE(PG8_SB(1, 0), b3, voffB);
            PG8_BAR; PG8_WAIT_L(0); PG8_MMA(0, 1, At, B1); PG8_BAR;
            PG8_LDA(At, 1, 1); PG8_STAGE(PG8_SA(1, 0), a3, voffA);
            PG8_BAR; PG8_WAIT_L(0); PG8_MMA(1, 0, At, B0); PG8_BAR; PG8_SCHED;
            PG8_STAGE(PG8_SB(1, 1), b3 + hstep, voffB);
            PG8_WAIT_V(6); PG8_BAR; PG8_MMA(1, 1, At, B1); PG8_BAR;
            }
        }
        if constexpr (ALIGN_EPI) { if (wr == 0) PG8_BAR; }
        if constexpr (!Epi::AFTER_DRAIN) { E(acc, cur, wr, wc, fr, fq); S.done(cur); }
        if (!has_next) break;
#pragma unroll
        for (int a = 0; a < 2; ++a)
#pragma unroll
            for (int b = 0; b < 2; ++b)
#pragma unroll
                for (int m = 0; m < 4; ++m)
#pragma unroll
                    for (int n = 0; n < 2; ++n) acc[a][b][m][n] = (f32x4){0.f, 0.f, 0.f, 0.f};
        cur = nxt; cA = nA; cB = nB; ++ui;
        if constexpr (ALIGN_EPI) { if (wr == 1) PG8_BAR; }
    }
    PG8_WAIT_V(0);
    if constexpr (!ALIGN_EPI) { if (wr == 0) PG8_BAR; }
    PG8_BAR;
    if constexpr (Epi::AFTER_DRAIN) { E.fused(acc, cur, wr, wc, fr, fq, lds, wid, lane); S.done(cur); }
#undef PG8_SA
#undef PG8_SB
#undef PG8_STAGE
#undef PG8_LDA
#undef PG8_LDB
#undef PG8_MMA
#undef PG8_WAIT_V
#undef PG8_WAIT_L
#undef PG8_BAR
#undef PG8_SCHED
}
}
using pg8::SEQ; using pg8::NBATCH; using pg8::MTOK; using pg8::DM; using pg8::DFF; using pg8::RMS_EPS; using pg8::LOG2E;
#ifndef PG8_SP2
#define PG8_SP2 true
#endif
#ifndef PG8_ALIGN
#define PG8_ALIGN true
#endif
namespace att {
using bf16x8 = __attribute__((ext_vector_type(8))) short;
using s16x4  = __attribute__((ext_vector_type(4))) short;
using f32x16 = __attribute__((ext_vector_type(16))) float;
using u32x4  = __attribute__((ext_vector_type(4))) unsigned;
typedef unsigned short bf16_t;
#define SBAR() __builtin_amdgcn_sched_barrier(0)
#define ATT_WAIT_BAR(N) asm volatile("s_waitcnt vmcnt(" #N ") lgkmcnt(0)\n\ts_barrier" ::: "memory")
__device__ __forceinline__ int crow(int r, int hi) { return (r & 3) + 8 * (r >> 2) + 4 * hi; }
__device__ __forceinline__ unsigned cvtpk(float lo, float hi) { unsigned r; asm volatile("v_cvt_pk_bf16_f32 %0, %1, %2" : "=v"(r) : "v"(lo), "v"(hi)); return r; }
__device__ __forceinline__ float bf2f(bf16_t b) { return __uint_as_float((unsigned)b << 16); }
__device__ __forceinline__ bf16_t f2bf(float f) { return (bf16_t)(cvtpk(f, f) & 0xffffu); }
__device__ __forceinline__ void glds16(const void* gsrc, unsigned lds_dst) { unsigned keep;
    asm volatile("s_mov_b32 %0, m0\n\ts_mov_b32 m0, %2\n\ts_nop 0\n\tglobal_load_lds_dwordx4 %1, off\n\ts_mov_b32 m0, %0" : "=&s"(keep) : "v"(gsrc), "s"(lds_dst) : "memory"); }
template <int IMM> __device__ __forceinline__ void glds16s(const void* sbase, unsigned voff, unsigned lds_dst) { unsigned keep;
    asm volatile("s_mov_b32 %0, m0\n\ts_mov_b32 m0, %3\n\ts_nop 4\n\tglobal_load_lds_dwordx4 %1, %2 offset:%4\n\ts_mov_b32 m0, %0" : "=&s"(keep) : "v"(voff), "s"(sbase), "s"(lds_dst), "i"(IMM) : "memory"); }
__device__ __forceinline__ int swap23(int k) { return (k & ~0xC) | ((k & 4) << 1) | ((k & 8) >> 1); }
__device__ __forceinline__ int v_rd_base(int lane) { return ((lane & 3) << 3) | (((lane >> 2) & 3) << 6) | (((lane >> 4) & 1) << 5) | (((lane >> 5) & 1) << 8); }
template <int OFF> __device__ __forceinline__ s16x4 tr_read(int vb) { s16x4 r; asm volatile("ds_read_b64_tr_b16 %0, %1 offset:%2" : "=&v"(r) : "v"(vb), "i"(OFF) : "memory"); return r; }
__device__ __forceinline__ void pack_p(const f32x16& p0, const f32x16& p1, bf16x8& pa0, bf16x8& pa1, bf16x8& pa2, bf16x8& pa3) {
#define PK4(P, BASE, OUT) do { unsigned a0 = cvtpk(P[BASE + 0], P[BASE + 1]), a1 = cvtpk(P[BASE + 2], P[BASE + 3]);   \
    unsigned b0 = cvtpk(P[BASE + 4], P[BASE + 5]), b1 = cvtpk(P[BASE + 6], P[BASE + 7]);                              \
    auto r0 = __builtin_amdgcn_permlane32_swap(a0, b0, false, false); auto r1 = __builtin_amdgcn_permlane32_swap(a1, b1, false, false); \
    u32x4 w = {r0[0], r1[0], r0[1], r1[1]}; OUT = *reinterpret_cast<bf16x8*>(&w); } while (0)
    PK4(p0, 0, pa0); PK4(p0, 8, pa1); PK4(p1, 0, pa2); PK4(p1, 8, pa3);
#undef PK4
}
__device__ __forceinline__ float half_max(float v) { auto rr = __builtin_amdgcn_permlane32_swap(__float_as_uint(v), __float_as_uint(v), false, false); return fmaxf(__uint_as_float(rr[0]), __uint_as_float(rr[1])); }
__device__ __forceinline__ float half_sum(float v) { auto rr = __builtin_amdgcn_permlane32_swap(__float_as_uint(v), __float_as_uint(v), false, false); return __uint_as_float(rr[0]) + __uint_as_float(rr[1]); }
template <int ND0, int D0> __device__ __forceinline__ void pv_one(f32x16& od, int vb, bf16x8 pa0, bf16x8 pa1, bf16x8 pa2, bf16x8 pa3) {
    constexpr int KS = 1024 * ND0, HF = 512 * ND0;
    const s16x4 l0 = tr_read<D0 * 512 + 0 * KS>(vb), h0 = tr_read<D0 * 512 + 0 * KS + HF>(vb), l1 = tr_read<D0 * 512 + 1 * KS>(vb), h1 = tr_read<D0 * 512 + 1 * KS + HF>(vb);
    const s16x4 l2 = tr_read<D0 * 512 + 2 * KS>(vb), h2 = tr_read<D0 * 512 + 2 * KS + HF>(vb), l3 = tr_read<D0 * 512 + 3 * KS>(vb), h3 = tr_read<D0 * 512 + 3 * KS + HF>(vb);
    asm volatile("s_waitcnt lgkmcnt(0)" ::: "memory"); SBAR();
#define PK(L, H) (bf16x8){L[0], L[1], L[2], L[3], H[0], H[1], H[2], H[3]}
    od = __builtin_amdgcn_mfma_f32_32x32x16_bf16(pa0, PK(l0, h0), od, 0, 0, 0);
    od = __builtin_amdgcn_mfma_f32_32x32x16_bf16(pa1, PK(l1, h1), od, 0, 0, 0);
    od = __builtin_amdgcn_mfma_f32_32x32x16_bf16(pa2, PK(l2, h2), od, 0, 0, 0);
    od = __builtin_amdgcn_mfma_f32_32x32x16_bf16(pa3, PK(l3, h3), od, 0, 0, 0);
#undef PK
}
template <int NK16> __device__ __forceinline__ void qkt(f32x16& p0, f32x16& p1, const char* Ks, const bf16x8* qr, int r32, int hi) {
    p0 = f32x16{}; p1 = f32x16{};
    const char* kb = Ks + hi * 1024 + r32 * 16;
#pragma unroll
    for (int d0 = 0; d0 < NK16; ++d0) {
        const bf16x8 b0 = *reinterpret_cast<const bf16x8*>(kb + d0 * 2048), b1 = *reinterpret_cast<const bf16x8*>(kb + d0 * 2048 + 512);
        p0 = __builtin_amdgcn_mfma_f32_32x32x16_bf16(b0, qr[d0], p0, 0, 0, 0);
        p1 = __builtin_amdgcn_mfma_f32_32x32x16_bf16(b1, qr[d0], p1, 0, 0, 0); }
}

namespace mla {
constexpr int NTILE = SEQ / 64;
constexpr int KSLOT = 24576, VSLOT = 16384;
constexpr int LDS_K = 0, LDS_V = 3 * KSLOT, LDS_WS = LDS_V + 3 * VSLOT, LDS_BYTES = LDS_WS + 8 * 256;
constexpr float THR = 8.f;
__device__ __forceinline__ void partialSM(f32x16& p0, f32x16& p1, float& m_reg, float& alpha) {
    float pmax = p0[0];
#pragma unroll
    for (int r = 1; r < 16; ++r) pmax = fmaxf(pmax, p0[r]);
#pragma unroll
    for (int r = 0; r < 16; ++r) pmax = fmaxf(pmax, p1[r]);
    pmax = half_max(pmax);
    float mn;
    if (__builtin_expect(__all(pmax - m_reg <= THR), 1)) { mn = m_reg; alpha = 1.f; }
    else { mn = fmaxf(m_reg, pmax); alpha = __builtin_amdgcn_exp2f(m_reg - mn); m_reg = mn; }
#pragma unroll
    for (int r = 0; r < 16; ++r) { p0[r] -= mn; p1[r] -= mn; }
#pragma unroll
    for (int r = 0; r < 16; ++r) p0[r] = __builtin_amdgcn_exp2f(p0[r]);
}
__device__ __forceinline__ void finishSM(f32x16& p0, f32x16& p1, float alpha, float& l_reg, bf16x8& pa0, bf16x8& pa1, bf16x8& pa2, bf16x8& pa3) {
#pragma unroll
    for (int r = 0; r < 16; ++r) p1[r] = __builtin_amdgcn_exp2f(p1[r]);
    float ps = 0;
#pragma unroll
    for (int r = 0; r < 16; ++r) ps += p0[r];
#pragma unroll
    for (int r = 0; r < 16; ++r) ps += p1[r];
    ps = half_sum(ps);
    l_reg = l_reg * alpha + ps;
    pack_p(p0, p1, pa0, pa1, pa2, pa3);
}
__device__ __forceinline__ void pv_d0(f32x16* o, int vb, bf16x8 pa0, bf16x8 pa1, bf16x8 pa2, bf16x8 pa3) {
    pv_one<4, 0>(o[0], vb, pa0, pa1, pa2, pa3); pv_one<4, 1>(o[1], vb, pa0, pa1, pa2, pa3); pv_one<4, 2>(o[2], vb, pa0, pa1, pa2, pa3); pv_one<4, 3>(o[3], vb, pa0, pa1, pa2, pa3);
}
struct Tensors { const bf16_t* QA; const bf16_t* KN; const bf16_t* KR; const bf16_t* VA; const bf16_t* GA; const bf16_t* OB; bf16_t* MIX; };
__device__ __forceinline__ void unit(int b, int h, int qb, const Tensors& T, char* shm, const int wave_id) {
    const int lane = pg8::lane_id_fresh(), wid = wave_id, tid = wid * 64 + lane, r32 = lane & 31, hi = lane >> 5;
    const long rowbase = (long)b * SEQ; const int q0 = qb * 256;
    const unsigned lds0 = (unsigned)(uintptr_t)shm;
    float* wsf = (float*)(shm + LDS_WS) + wid * 64; float* al_l = wsf; float* li_l = wsf + 32;
    const char* knb = (const char*)(T.KN + rowbase * 1024 + h * 128);
    const char* krb = (const char*)(T.KR + rowbase * 64);
    const char* vab = (const char*)(T.VA + rowbase * 1024 + h * 128);
    const unsigned kvoff = (unsigned)(lane * 2048 + wid * 16), kroff = (unsigned)(lane * 128 + wid * 16);
    unsigned vvoff; { const int st = 2 * wid + (lane >> 5), kk = (st >> 2) * 8 + ((lane & 31) >> 2), k = swap23(kk), c = (st & 3) * 32 + (lane & 3) * 8; vvoff = (unsigned)((k * 1024 + c) * 2); }
#define MLA_DMA_K(t, slot) do { const unsigned kd_ = (unsigned)__builtin_amdgcn_readfirstlane(lds0 + LDS_K + (slot) * KSLOT + wid * 1024); const char* kb_ = knb + (size_t)(t) * 131072; \
        glds16s<0>(kb_, kvoff, kd_); glds16s<0>(kb_ + 128, kvoff, kd_ + 8192); glds16s<0>(krb + (size_t)(t) * 8192, kroff, kd_ + 16384); } while (0)
#define MLA_DMA_V(t, slot) do { const unsigned vd_ = (unsigned)__builtin_amdgcn_readfirstlane(lds0 + LDS_V + (slot) * VSLOT + wid * 1024); const char* vb_ = vab + (size_t)(t) * 131072; \
        glds16s<0>(vb_, vvoff, vd_); glds16s<0>(vb_ + 65536, vvoff, vd_ + 8192); } while (0)
    MLA_DMA_K(0, 0); MLA_DMA_V(0, 0); MLA_DMA_K(1, 1);
    bf16x8 qr[12];
    { const bf16_t* Qw = T.QA + (rowbase + q0 + wid * 32 + r32) * 1536 + h * 192 + hi * 8;
#pragma unroll
      for (int d0 = 0; d0 < 12; ++d0) qr[d0] = *reinterpret_cast<const bf16x8*>(Qw + d0 * 16); }
    const int vb0 = (int)(lds0 + LDS_V) + v_rd_base(lane);
    float m_reg = -1e30f, l_reg = 0.f; f32x16 o[4] = {};
    f32x16 pA0, pA1, pB0, pB1; float alA, alB; bf16x8 pa0, pa1, pa2, pa3;
#define MLA_RESC(a) do { if (__any((a) < 1.f)) { if (hi == 0) al_l[r32] = (a); asm volatile("s_waitcnt lgkmcnt(0)" ::: "memory"); \
        _Pragma("unroll") for (int d = 0; d < 4; ++d) _Pragma("unroll") for (int r = 0; r < 16; ++r) o[d][r] *= al_l[crow(r, hi)]; } } while (0)
    int kc = 0;
#define MLA_KP() (kc == 0 ? 2 : kc - 1)
#define MLA_KN() (kc == 2 ? 0 : kc + 1)
    ATT_WAIT_BAR(0);
    MLA_DMA_K(2, 2); MLA_DMA_V(1, 1);
    SBAR(); qkt<12>(pA0, pA1, shm + LDS_K, qr, r32, hi); partialSM(pA0, pA1, m_reg, alA);
    ATT_WAIT_BAR(5); kc = 1;
#define MLA_STEP(C0, C1, P0, P1, alC, alP, t) do { const int kp_ = MLA_KP(), kn_ = MLA_KN(); \
        { const int tk_ = ((t) + 2 < NTILE) ? (t) + 2 : NTILE - 1; MLA_DMA_K(tk_, kp_); MLA_DMA_V((t) + 1, kn_); } \
        SBAR(); qkt<12>(C0, C1, shm + LDS_K + kc * KSLOT, qr, r32, hi); \
        finishSM(P0, P1, alP, l_reg, pa0, pa1, pa2, pa3); SBAR(); \
        pv_d0(o, vb0 + kp_ * VSLOT, pa0, pa1, pa2, pa3); partialSM(C0, C1, m_reg, alC); \
        ATT_WAIT_BAR(5); MLA_RESC(alC); kc = kn_; } while (0)
    for (int t = 1; t + 1 < NTILE; t += 2) {
        MLA_STEP(pB0, pB1, pA0, pA1, alB, alA, t);
        MLA_STEP(pA0, pA1, pB0, pB1, alA, alB, t + 1);
    }
    { const int kp_ = MLA_KP();
      SBAR(); qkt<12>(pB0, pB1, shm + LDS_K + kc * KSLOT, qr, r32, hi);
      finishSM(pA0, pA1, alA, l_reg, pa0, pa1, pa2, pa3); SBAR();
      pv_d0(o, vb0 + kp_ * VSLOT, pa0, pa1, pa2, pa3); partialSM(pB0, pB1, m_reg, alB);
      ATT_WAIT_BAR(0); MLA_RESC(alB);
      finishSM(pB0, pB1, alB, l_reg, pa0, pa1, pa2, pa3); SBAR();
      pv_d0(o, vb0 + kc * VSLOT, pa0, pa1, pa2, pa3); }
    if (hi == 0) li_l[r32] = l_reg; asm volatile("s_waitcnt lgkmcnt(0)" ::: "memory");
    float rli[16];
#pragma unroll
    for (int r = 0; r < 16; ++r) rli[r] = __builtin_amdgcn_rcpf(li_l[crow(r, hi)]);
    const long orow0 = rowbase + q0 + wid * 32;
#pragma unroll
    for (int r = 0; r < 16; ++r) { const long off = (orow0 + crow(r, hi)) * 1024 + h * 128 + r32;
#pragma unroll
        for (int d0 = 0; d0 < 4; ++d0) { const float v = o[d0][r] * rli[r] * bf2f(T.GA[off + d0 * 32]) + bf2f(T.OB[off + d0 * 32]); T.MIX[off + d0 * 32] = f2bf(v); } }
    asm volatile("s_waitcnt lgkmcnt(0)\n\ts_barrier" ::: "memory");
#undef MLA_DMA_K
#undef MLA_DMA_V
#undef MLA_RESC
#undef MLA_KP
#undef MLA_KN
#undef MLA_STEP
}
}

namespace swa {
constexpr int LDS_K = 0, LDS_V = 5 * 8192, LDS_TAB = 10 * 8192, LDS_WS = LDS_TAB + 4 * 384 * 4, LDS_BYTES = LDS_WS + 8 * 256;
struct Tensors { const bf16_t* QB; const bf16_t* KB; const bf16_t* VB; bf16_t* GOB; const float* BT2; const float* SINK2; };
__device__ __forceinline__ void unit(int b, int kvh, int qblk, const Tensors& T, char* shm, const int wave_id) {
    const int lane = pg8::lane_id_fresh(), wid = wave_id, tid = wid * 64 + lane, r32 = lane & 31, hi = lane >> 5;
    const int g = wid >> 1, rh = wid & 1, head = kvh * 4 + g;
    const long rowbase = (long)b * SEQ; const int q0 = qblk * 64;
    const unsigned lds0 = (unsigned)(uintptr_t)shm;
    float* wsf = (float*)(shm + LDS_WS) + wid * 64; float* al_l = wsf; float* li_l = wsf + 32;
    const int t_lo = (q0 < 128) ? (128 - q0) / 64 : 0, t_hi = (SEQ - (q0 - 128)) / 64 < 5 ? (SEQ - (q0 - 128)) / 64 : 5;
    { const int st = 2 * wid + (lane >> 5), kk = (st >> 1) * 8 + ((lane & 31) >> 2), k = swap23(kk), c = (st & 1) * 32 + (lane & 3) * 8;
      const unsigned kvoff = (unsigned)(lane * 512 + wid * 16), vvoff = (unsigned)((k * 256 + c) * 2);
      for (int t = t_lo; t < t_hi; ++t) { const long kb = rowbase + q0 - 128 + 64 * t;
          glds16s<0>((const char*)(T.KB + kb * 256 + kvh * 64), kvoff, (unsigned)__builtin_amdgcn_readfirstlane(lds0 + LDS_K + t * 8192 + wid * 1024));
          glds16s<0>((const char*)(T.VB + kb * 256 + kvh * 64), vvoff, (unsigned)__builtin_amdgcn_readfirstlane(lds0 + LDS_V + t * 8192 + wid * 1024)); } }
    { float* tab = (float*)(shm + LDS_TAB);
      for (int i = tid; i < 4 * 384; i += 512) { const int gg = i / 384, rel = i % 384 - 192;
          tab[i] = (rel >= -128 && rel <= 128) ? T.BT2[(kvh * 4 + gg) * 264 + rel + 128] : -1e30f; } }
    bf16x8 qr[4];
    { const bf16_t* Qw = T.QB + (rowbase + q0 + rh * 32 + r32) * 1024 + head * 64 + hi * 8;
#pragma unroll
      for (int d0 = 0; d0 < 4; ++d0) qr[d0] = *reinterpret_cast<const bf16x8*>(Qw + d0 * 16); }
    float m_reg = T.SINK2[head], l_reg = 1.0f; f32x16 o[2] = {};
    const int vb0 = (int)(lds0 + LDS_V) + v_rd_base(lane);
    const float* tabg = (const float*)(shm + LDS_TAB) + g * 384;
    ATT_WAIT_BAR(0);
    for (int t = t_lo; t < t_hi; ++t) {
        f32x16 p0, p1; bf16x8 pa0, pa1, pa2, pa3;
        qkt<4>(p0, p1, shm + LDS_K + t * 8192, qr, r32, hi);
        const float* tb = tabg + (64 * t + 64 - 32 * rh - r32 + 4 * hi);
#pragma unroll
        for (int r = 0; r < 16; ++r) { p0[r] += tb[(r & 3) + 8 * (r >> 2)]; p1[r] += tb[32 + (r & 3) + 8 * (r >> 2)]; }
        float pmax = p0[0];
#pragma unroll
        for (int r = 1; r < 16; ++r) pmax = fmaxf(pmax, p0[r]);
#pragma unroll
        for (int r = 0; r < 16; ++r) pmax = fmaxf(pmax, p1[r]);
        pmax = half_max(pmax);
        const float mn = fmaxf(m_reg, pmax), alpha = __builtin_amdgcn_exp2f(m_reg - mn); m_reg = mn;
        float ps = 0.f;
#pragma unroll
        for (int r = 0; r < 16; ++r) { p0[r] = __builtin_amdgcn_exp2f(p0[r] - mn); p1[r] = __builtin_amdgcn_exp2f(p1[r] - mn); ps += p0[r] + p1[r]; }
        ps = half_sum(ps); l_reg = l_reg * alpha + ps;
        pack_p(p0, p1, pa0, pa1, pa2, pa3);
        if (__any(alpha < 1.f)) { if (hi == 0) al_l[r32] = alpha; asm volatile("s_waitcnt lgkmcnt(0)" ::: "memory");
#pragma unroll
            for (int d = 0; d < 2; ++d)
#pragma unroll
                for (int r = 0; r < 16; ++r) o[d][r] *= al_l[crow(r, hi)]; }
        SBAR();
        pv_one<2, 0>(o[0], vb0 + t * 8192, pa0, pa1, pa2, pa3); pv_one<2, 1>(o[1], vb0 + t * 8192, pa0, pa1, pa2, pa3);
    }
    if (hi == 0) li_l[r32] = l_reg; asm volatile("s_waitcnt lgkmcnt(0)" ::: "memory");
    float rli[16];
#pragma unroll
    for (int r = 0; r < 16; ++r) rli[r] = __builtin_amdgcn_rcpf(li_l[crow(r, hi)]);
    const long orow0 = rowbase + q0 + rh * 32;
#pragma unroll
    for (int r = 0; r < 16; ++r) { const long off = (orow0 + crow(r, hi)) * 1024 + head * 64 + r32;
#pragma unroll
        for (int d0 = 0; d0 < 2; ++d0) { const float v = o[d0][r] * rli[r] * bf2f(T.GOB[off + d0 * 32]); T.GOB[off + d0 * 32] = f2bf(v); } }
    asm volatile("s_waitcnt lgkmcnt(0)\n\ts_barrier" ::: "memory");
}
}
#undef SBAR
#undef ATT_WAIT_BAR
}
constexpr int NWAVES = 8;
#ifndef MK_PER_PHASE
#define MK_PER_PHASE 1
#endif
constexpr int N_PHASES = 11;

constexpr size_t MiB = 1u << 20;
constexpr size_t WS_CTL = 0, CTL_ZERO_BYTES = 1 * MiB;
constexpr size_t WS_COS = 1 * MiB, WS_SIN = WS_COS + 512 * 1024;
constexpr size_t WS_BT2 = 2 * MiB, WS_SINK2 = WS_BT2 + 16 * 264 * 4;
constexpr size_t WS_SSQQ = 3 * MiB, WS_SSQKV = WS_SSQQ + 512 * 1024;
constexpr size_t WS_SSQ2 = 4 * MiB, WS_SSQ3 = 6 * MiB;
constexpr size_t WS_WIN = 8 * MiB, WS_WQB = 16 * MiB, WS_WKVB = 17 * MiB, WS_WOUT = 18 * MiB, WS_WUP = 20 * MiB, WS_WDN = 31 * MiB;
constexpr size_t WS_A0 = 40 * MiB;
constexpr size_t WS_XN = WS_A0;
constexpr size_t WS_KN = WS_A0;
constexpr size_t WS_X1B = WS_A0;
constexpr size_t WS_QLAT = 104 * MiB, WS_CKV = 120 * MiB, WS_KR = 128 * MiB, WS_QB = 132 * MiB, WS_KB = 196 * MiB, WS_VB = 212 * MiB, WS_GA = 228 * MiB, WS_GB = 292 * MiB;
constexpr size_t WS_VA = 356 * MiB;
constexpr size_t WS_MIX = WS_QB;
constexpr size_t WS_U = 104 * MiB;
constexpr size_t WS_ACT = 296 * MiB;
constexpr size_t WS_END = 472 * MiB;
constexpr int UP_TILES_A = 12, UP_TILES_B = 10;
static_assert(WS_ACT + (size_t)MTOK * DFF * 2 <= WS_END && WS_U + (size_t)MTOK * UP_TILES_A * 256 * 2 <= WS_ACT && WS_VA + (size_t)MTOK * 1024 * 2 <= WS_END, "d_ws map");
constexpr int CW_BAR = 4096;

constexpr int RING_OFF = 0, RING_BYTES = 131072;
constexpr int LDSCTL_OFF = RING_BYTES, MISC_OFF = LDSCTL_OFF + 320;
constexpr int LDS_BYTES = 147456;
static_assert(att::mla::LDS_BYTES <= RING_BYTES && att::swa::LDS_BYTES <= RING_BYTES && pg8::STAGE_BYTES <= RING_BYTES, "LDS map");

#define GAS __attribute__((address_space(1)))
#define LAS __attribute__((address_space(3)))
typedef unsigned short bf16;
typedef unsigned v4u __attribute__((ext_vector_type(4)));
typedef float f32x4 __attribute__((ext_vector_type(4)));
typedef short bf16x8 __attribute__((ext_vector_type(8)));
typedef GAS unsigned gu32;
typedef GAS unsigned long long gu64;
#define RLX_AGENT __ATOMIC_RELAXED, __HIP_MEMORY_SCOPE_AGENT
#define LDS_WAIT() asm volatile("s_waitcnt lgkmcnt(0)" ::: "memory")
#define VM_WAIT() asm volatile("s_waitcnt vmcnt(0)" ::: "memory")
__device__ __forceinline__ unsigned long long rt() { return __builtin_amdgcn_s_memrealtime(); }
__device__ __forceinline__ unsigned f2bf(float f) { unsigned u = __builtin_bit_cast(unsigned, f); return (u + 0x7fffu + ((u >> 16) & 1u)) >> 16; }
__device__ __forceinline__ unsigned pk2(float lo, float hi) { return f2bf(lo) | (f2bf(hi) << 16); }

#define XB_TMO      128
#define XB_XCNT(j)  (256  + 64 * (j))
#define XB_XSUB(j)  (1280 + 64 * (j))
#define XB_XGEN(j)  (2304 + 64 * (j))
#define XB_TOP      3328
#define XB_TOPGEN   3392
#define XCD_BAR_WORDS 3456
#define XB_SPIN_CAP (1u << 18)

__device__ __forceinline__ unsigned xb_ld(unsigned* p)              { return __hip_atomic_load(p, __ATOMIC_RELAXED, __HIP_MEMORY_SCOPE_AGENT); }
__device__ __forceinline__ unsigned xb_add(unsigned* p, unsigned v) { return __hip_atomic_fetch_add(p, v, __ATOMIC_RELAXED, __HIP_MEMORY_SCOPE_AGENT); }
__device__ __forceinline__ unsigned xb_xcc_id() { return (unsigned)__builtin_amdgcn_s_getreg((3 << 11) | 20) & 0xFu; }
#define XB_SPIN(cond, bar) do { unsigned _sp = 0; while (cond) { __builtin_amdgcn_s_sleep(1); \
    if ((++_sp & 255u) == 0u) { if (xb_ld(&(bar)[XB_TMO])) break; if (_sp > XB_SPIN_CAP) { atomicAdd(&(bar)[XB_TMO], 1u); break; } } } } while (0)

struct XcdBarrier {
    unsigned* bar; unsigned x; int w;
    volatile LAS unsigned* st;
};

__device__ __forceinline__ XcdBarrier xcd_barrier_post(unsigned* bar, volatile LAS unsigned* st) {
    XcdBarrier b; b.bar = bar; b.x = xb_xcc_id(); b.st = st;
    if (threadIdx.x == 0) (void)xb_add(&bar[XB_XCNT(b.x)], 1u);
    return b;
}
__device__ __forceinline__ void xcd_barrier_complete(unsigned* bar, unsigned x, unsigned& nloc, unsigned& nx) {
    const unsigned G = gridDim.x * gridDim.y * gridDim.z;
    unsigned sum, cnt, mine, sp = 0u;
    for (;;) {
        sum = 0u; cnt = 0u; mine = 0u;
#pragma unroll
        for (unsigned j = 0; j < 16; ++j) { const unsigned c = xb_ld(&bar[XB_XCNT(j)]); sum += c; cnt += (c > 0u) ? 1u : 0u; mine = (j == x) ? c : mine; }
        if (sum == G) break;
        __builtin_amdgcn_s_sleep(1);
        if ((++sp & 255u) == 0u) { if (xb_ld(&bar[XB_TMO])) break; if (sp > XB_SPIN_CAP) { atomicAdd(&bar[XB_TMO], 1u); break; } }
    }
    nloc = mine > 0u ? mine : 1u; nx = cnt > 0u ? cnt : 1u;
}

__device__ __forceinline__ void xcd_barrier(const XcdBarrier& b) {
    asm volatile("s_waitcnt vmcnt(0)" ::: "memory");
    __syncthreads();
    if (b.w == 0 && pg8::lane_id_fresh() == 0) {
        unsigned* bar = b.bar;
        __builtin_amdgcn_s_waitcnt(0);
        unsigned nloc = b.st[0], nx = b.st[1];
        if (nloc == 0u) { xcd_barrier_complete(bar, b.x, nloc, nx); b.st[0] = nloc; b.st[1] = nx; }
        const unsigned old = xb_add(&bar[XB_XSUB(b.x)], 1u);
        const unsigned gen = old / nloc;
        if (old + 1u == (gen + 1u) * nloc) {
            __builtin_amdgcn_fence(__ATOMIC_RELEASE, "agent");
            asm volatile("s_waitcnt vmcnt(0)" ::: "memory");
            const unsigned og = xb_add(&bar[XB_TOP], 1u);
            const unsigned tg = og / nx;
            if (og + 1u == (tg + 1u) * nx) xb_add(&bar[XB_TOPGEN], 1u);
            else XB_SPIN(xb_ld(&bar[XB_TOPGEN]) == tg, bar);
            __builtin_amdgcn_fence(__ATOMIC_ACQUIRE, "agent");
            xb_add(&bar[XB_XGEN(b.x)], 1u);
            asm volatile("s_waitcnt vmcnt(0)" ::: "memory");
        } else {
            XB_SPIN(xb_ld(&bar[XB_XGEN(b.x)]) == gen, bar);
            __builtin_amdgcn_fence(__ATOMIC_ACQUIRE, "agent");
            asm volatile("s_waitcnt vmcnt(0)" ::: "memory");
        }
    }
    __syncthreads();
}

struct Frame {
    LAS unsigned char* lds; volatile LAS unsigned* MISC; gu32* ctl;
    int wave, vcu, G;
};
__device__ __forceinline__ float wave_sum(float v) {
#pragma unroll
    for (int o = 1; o < 64; o <<= 1) v += __shfl_xor(v, o);
    return v;
}
template <class RowMap>
__device__ __forceinline__ void p0_transpose_item(const float* W, int K, int N, bf16* WT, const float* kscale, const RowMap& rm, LAS float* scr, int item, int lane) {
    const int nblk = N / 32, kb = item / nblk, nb = item % nblk, k0 = 64 * kb, n0 = 32 * nb;
#pragma unroll 8
    for (int i = 0; i < 32; ++i) { const int kk = 2 * i + (lane >> 5); const float sc = kscale ? kscale[k0 + kk] : 1.0f; scr[kk * 33 + (lane & 31)] = W[(size_t)(k0 + kk) * N + n0 + (lane & 31)] * sc; }
    LDS_WAIT(); asm volatile("" ::: "memory");
    const int c = lane & 7;
#pragma unroll
    for (int j = 0; j < 4; ++j) { const int n = (lane >> 3) + 8 * j; const LAS float* s = scr + (8 * c) * 33 + n;
        v4u o; o.x = pk2(s[0 * 33], s[1 * 33]); o.y = pk2(s[2 * 33], s[3 * 33]); o.z = pk2(s[4 * 33], s[5 * 33]); o.w = pk2(s[6 * 33], s[7 * 33]);
        *(GAS v4u*)(WT + (size_t)rm(n0 + n) * K + k0 + 8 * c) = o; }
    LDS_WAIT(); asm volatile("" ::: "memory");
}
struct MapIdent { __device__ __forceinline__ int operator()(int n) const { return n; } };
struct MapWin { __device__ __forceinline__ int operator()(int n) const {
    if (n < 256) return n; if (n >= 448) return n + 64; const int j = n - 256; if (j < 128) return 256 + j; const int d = j - 128; return 384 + (d < 32 ? 2 * d : 2 * (d - 32) + 1); } };
struct MapWqb { __device__ __forceinline__ int operator()(int n) const {
    const int h = n / 192, d = n % 192; if (d < 128) return h * 128 + d; const int r = d - 128; return 1024 + h * 64 + (r < 32 ? 2 * r : 2 * (r - 32) + 1); } };
struct MapWup { __device__ __forceinline__ int operator()(int n) const {
    const int v = n >= DFF, c = v ? n - DFF : n; return 256 * (c >> 7) + 128 * v + (c & 127); } };

__device__ __forceinline__ int t5_bucket(int rel) {
    const int n = rel < 0 ? -rel : rel; int bk;
    if (n < 8) bk = n; else { const int e = (31 - __builtin_clz((unsigned)(n * n))) - 6; bk = 8 + e; if (bk > 15) bk = 15; }
    return (rel > 0 ? 16 : 0) + bk;
}
struct Args {
    const float* x; const int* positions; const float* norm1_g; const float* w_in; const float* q_a_norm_g; const float* w_q_b; const float* kv_a_norm_g; const float* w_kv_b;
    const float* rel_bias; const float* sinks; const float* w_out; const float* norm2_g; const float* w_up; const float* conv_w; const float* conv_b; const float* w_down; const float* final_norm_g;
    float* out; unsigned char* ws; int ph_lo, ph_hi;
};

__device__ __forceinline__ void p0_prologue(Frame& F, const Args& a) {
    unsigned char* ws = a.ws;
    LAS float* scr = (LAS float*)(F.lds + RING_OFF + F.wave * 16384);
    const int lane = pg8::lane_id_fresh();
    const int gw = F.vcu * NWAVES + F.wave, NGW = F.G * NWAVES;
    constexpr int I_IN = (1024 / 64) * (4032 / 32), I_QB = (256 / 64) * (1536 / 32), I_KVB = (128 / 64) * (2048 / 32), I_OUT = (1024 / 64) * (1024 / 32), I_UP = (1024 / 64) * (5632 / 32), I_DN = (DFF / 64) * (1024 / 32);
    constexpr int NITEMS = I_IN + I_QB + I_KVB + I_OUT + I_UP + I_DN;
    for (int it = gw; it < NITEMS; it += NGW) {
        int r = it;
        if (r < I_IN) { p0_transpose_item(a.w_in, 1024, 4032, (bf16*)(ws + WS_WIN), nullptr, MapWin(), scr, r, lane); continue; } r -= I_IN;
        if (r < I_QB) { p0_transpose_item(a.w_q_b, 256, 1536, (bf16*)(ws + WS_WQB), a.q_a_norm_g, MapWqb(), scr, r, lane); continue; } r -= I_QB;
        if (r < I_KVB) { p0_transpose_item(a.w_kv_b, 128, 2048, (bf16*)(ws + WS_WKVB), a.kv_a_norm_g, MapIdent(), scr, r, lane); continue; } r -= I_KVB;
        if (r < I_OUT) { p0_transpose_item(a.w_out, 1024, 1024, (bf16*)(ws + WS_WOUT), nullptr, MapIdent(), scr, r, lane); continue; } r -= I_OUT;
        if (r < I_UP) { p0_transpose_item(a.w_up, 1024, 5632, (bf16*)(ws + WS_WUP), a.norm2_g, MapWup(), scr, r, lane); continue; } r -= I_UP;
        p0_transpose_item(a.w_down, DFF, 1024, (bf16*)(ws + WS_WDN), nullptr, MapIdent(), scr, r, lane);
    }
    const int gt = gw * 64 + lane, NGT = NGW * 64;
    for (int i = gt; i < 64 * 1024 / 8; i += NGT) *(GAS v4u*)((bf16*)(ws + WS_WIN) + (size_t)448 * 1024 + (size_t)i * 8) = (v4u){0u, 0u, 0u, 0u};
    for (int i = gt; i < SEQ * 32; i += NGT) { const int s = i >> 5, d = i & 31;
        const float invf = __builtin_amdgcn_exp2f(-(float)d * (13.287712379549449f / 32.0f));
        const float ang = (float)a.positions[s] * invf;
        const double rev = (double)ang * 0.15915494309189535; const float fr = (float)(rev - __builtin_rint(rev));
        ((float*)(ws + WS_COS))[i] = __builtin_amdgcn_cosf(fr); ((float*)(ws + WS_SIN))[i] = __builtin_amdgcn_sinf(fr); }
    for (int i = gt; i < 16 * 264; i += NGT) { const int h = i / 264, j = i % 264; float v = 0.f; if (j <= 256) v = a.rel_bias[t5_bucket(j - 128) * 16 + h] * LOG2E; ((float*)(ws + WS_BT2))[i] = v; }
    if (gt < 16) ((float*)(ws + WS_SINK2))[gt] = a.sinks[gt] * LOG2E;
    for (int m = gw; m < MTOK; m += NGW) {
        const GAS f32x4* xr = (const GAS f32x4*)(a.x + (size_t)m * DM) + lane; const GAS f32x4* gr = (const GAS f32x4*)a.norm1_g + lane;
        f32x4 v[4]; float s = 0.f;
#pragma unroll
        for (int j = 0; j < 4; ++j) { v[j] = xr[64 * j]; s += (v[j].x * v[j].x + v[j].y * v[j].y) + (v[j].z * v[j].z + v[j].w * v[j].w); }
        const float rs = 1.0f / sqrtf(wave_sum(s) * (1.0f / DM) + RMS_EPS);
        GAS unsigned long long* o8 = (GAS unsigned long long*)((bf16*)(ws + WS_XN) + (size_t)m * DM) + lane;
#pragma unroll
        for (int j = 0; j < 4; ++j) { const f32x4 g = gr[64 * j]; o8[64 * j] = (unsigned long long)pk2(v[j].x * rs * g.x, v[j].y * rs * g.y) | ((unsigned long long)pk2(v[j].z * rs * g.z, v[j].w * rs * g.w) << 32); }
    }
}

__device__ __forceinline__ float bfl(unsigned w) { return __uint_as_float(w << 16); }
__device__ __forceinline__ float bfh(unsigned w) { return __uint_as_float(w & 0xffff0000u); }
__device__ __forceinline__ void p6_conv(Frame& F, const Args& a, const bf16* U, int ldu, int ntile, int tile0, bf16* ACT) {
    const int gw = F.vcu * NWAVES + F.wave, NGW = F.G * NWAVES;
    const int npair = ntile / 2, nitems = (MTOK / 16) * npair;
    const int lane = pg8::lane_id_fresh();
    const int rsel = lane >> 5, tsel = (lane >> 4) & 1, l = lane & 15;
    for (int it = gw; it < nitems; it += NGW) {
        const int rb = it / npair, tp = it % npair, j = tp * 2 + tsel, c0 = (tile0 + j) * 128 + l * 8, t0 = rb * 16 + rsel * 8;
        float wg[3][8], wv[3][8], bg[8], bv[8];
#pragma unroll
        for (int k = 0; k < 3; ++k) { const f32x4 g0 = *(const f32x4*)(a.conv_w + k * 5632 + c0), g1 = *(const f32x4*)(a.conv_w + k * 5632 + c0 + 4), v0 = *(const f32x4*)(a.conv_w + k * 5632 + DFF + c0), v1 = *(const f32x4*)(a.conv_w + k * 5632 + DFF + c0 + 4);
#pragma unroll
            for (int e = 0; e < 4; ++e) { wg[k][e] = g0[e]; wg[k][4 + e] = g1[e]; wv[k][e] = v0[e]; wv[k][4 + e] = v1[e]; } }
        { const f32x4 g0 = *(const f32x4*)(a.conv_b + c0), g1 = *(const f32x4*)(a.conv_b + c0 + 4), v0 = *(const f32x4*)(a.conv_b + DFF + c0), v1 = *(const f32x4*)(a.conv_b + DFF + c0 + 4);
#pragma unroll
          for (int e = 0; e < 4; ++e) { bg[e] = g0[e]; bg[4 + e] = g1[e]; bv[e] = v0[e]; bv[4 + e] = v1[e]; } }
        const bf16* ug = U + (size_t)t0 * ldu + j * 256 + l * 8;
        const bool hasp = (t0 & (SEQ - 1)) != 0, hasn = ((t0 + 8) & (SEQ - 1)) != 0;
        v4u zg = {0u, 0u, 0u, 0u};
        v4u pg = zg, pv = zg, cg, cv, ng, nv;
        if (hasp) { pg = *(const v4u*)(ug - ldu); pv = *(const v4u*)(ug - ldu + 128); }
        cg = *(const v4u*)(ug); cv = *(const v4u*)(ug + 128);
#pragma unroll
        for (int i = 0; i < 8; ++i) {
            if (i < 7 || hasn) { ng = *(const v4u*)(ug + (size_t)(i + 1) * ldu); nv = *(const v4u*)(ug + (size_t)(i + 1) * ldu + 128); } else { ng = zg; nv = zg; }
            float og[8];
#pragma unroll
            for (int e = 0; e < 4; ++e) {
                const unsigned pw = pg[e], cw_ = cg[e], nw = ng[e], pw2 = pv[e], cw2 = cv[e], nw2 = nv[e];
                const float G0 = wg[0][2 * e] * bfl(pw) + wg[1][2 * e] * bfl(cw_) + wg[2][2 * e] * bfl(nw) + bg[2 * e];
                const float G1 = wg[0][2 * e + 1] * bfh(pw) + wg[1][2 * e + 1] * bfh(cw_) + wg[2][2 * e + 1] * bfh(nw) + bg[2 * e + 1];
                const float V0 = wv[0][2 * e] * bfl(pw2) + wv[1][2 * e] * bfl(cw2) + wv[2][2 * e] * bfl(nw2) + bv[2 * e];
                const float V1 = wv[0][2 * e + 1] * bfh(pw2) + wv[1][2 * e + 1] * bfh(cw2) + wv[2][2 * e + 1] * bfh(nw2) + bv[2 * e + 1];
                og[2 * e] = G0 * pg8::fast_sigmoid(G0) * V0; og[2 * e + 1] = G1 * pg8::fast_sigmoid(G1) * V1; }
            v4u o; o.x = pk2(og[0], og[1]); o.y = pk2(og[2], og[3]); o.z = pk2(og[4], og[5]); o.w = pk2(og[6], og[7]);
            *(v4u*)(ACT + (size_t)(t0 + i) * DFF + c0) = o;
            pg = cg; pv = cv; cg = ng; cv = nv;
        }
    }
}

__device__ __forceinline__ void p8_final_norm(Frame& F, const Args& a) {
    const int gw = F.vcu * NWAVES + F.wave, NGW = F.G * NWAVES;
    const int lane = pg8::lane_id_fresh();
    const float* ssq = (const float*)(a.ws + WS_SSQ3);
    for (int m = gw; m < MTOK; m += NGW) {
        const f32x4* sp = (const f32x4*)(ssq + (size_t)m * 16); const f32x4 t = (sp[0] + sp[1]) + (sp[2] + sp[3]);
        const float rs = 1.0f / sqrtf(((t[0] + t[1]) + (t[2] + t[3])) * (1.0f / DM) + RMS_EPS);
        GAS f32x4* xr = (GAS f32x4*)(a.out + (size_t)m * DM) + lane; const GAS f32x4* gr = (const GAS f32x4*)a.final_norm_g + lane;
#pragma unroll
        for (int j = 0; j < 4; ++j) { const f32x4 v = xr[64 * j], g = gr[64 * j]; xr[64 * j] = v * rs * g; }
    }
}

__global__ void __launch_bounds__(NWAVES * 64, 2) enc_fwd(Args args) {
    extern __shared__ __attribute__((aligned(16))) unsigned char lds[];
    Frame F;
    F.lds = (LAS unsigned char*)lds; F.MISC = (volatile LAS unsigned*)(F.lds + MISC_OFF);
    F.wave = __builtin_amdgcn_readfirstlane(threadIdx.x >> 6);
    F.G = gridDim.x; { const int bx = blockIdx.x; F.vcu = (F.G % 8 == 0) ? (bx % 8) * (F.G / 8) + bx / 8 : bx; }
    unsigned char* ws = args.ws;
    F.ctl = (gu32*)(ws + WS_CTL);
    for (int u = threadIdx.x; u < (LDS_BYTES - LDSCTL_OFF) / 4; u += NWAVES * 64) ((LAS unsigned*)(F.lds + LDSCTL_OFF))[u] = 0u;
    __syncthreads();
    XcdBarrier bar; bar.bar = (unsigned*)(F.ctl + CW_BAR); bar.x = 0; bar.st = nullptr;
    if (!MK_PER_PHASE) bar = xcd_barrier_post((unsigned*)(F.ctl + CW_BAR), F.MISC + 8);
    bar.w = F.wave;
    const int lo = args.ph_lo, hi = args.ph_hi;
#ifndef PHMASK
#define PHMASK 0x7ff
#endif
#define IN(k) (((PHMASK >> (k)) & 1) && lo <= (k) && (k) < hi)
#define SEAM(k) do { if (IN(k) && IN((k) + 1)) xcd_barrier(bar); } while (0)
    bf16* const WIN = (bf16*)(ws + WS_WIN); bf16* const WQB = (bf16*)(ws + WS_WQB); bf16* const WKVB = (bf16*)(ws + WS_WKVB); bf16* const WOUT = (bf16*)(ws + WS_WOUT);
    bf16* const WUP = (bf16*)(ws + WS_WUP); bf16* const WDN = (bf16*)(ws + WS_WDN);
    const float* const COS = (const float*)(ws + WS_COS); const float* const SIN = (const float*)(ws + WS_SIN);
    bf16* const QA = (bf16*)args.out;

    if (IN(0)) { p0_prologue(F, args); } SEAM(0);

    if (IN(1)) {
        pg8::Gemm g{(bf16*)(ws + WS_XN), WIN, MTOK, 4096, 1024}; pg8::StaticOrder S; S.init(MTOK, 4096, F.G, (int)blockIdx.x);
        pg8::EpiInProj E{(bf16*)(ws + WS_QLAT), (bf16*)(ws + WS_CKV), (bf16*)(ws + WS_KR), (bf16*)(ws + WS_QB), (bf16*)(ws + WS_KB), (bf16*)(ws + WS_VB), (bf16*)(ws + WS_GA), (bf16*)(ws + WS_GB),
                         (float*)(ws + WS_SSQQ), (float*)(ws + WS_SSQKV), COS, SIN};
        pg8::gemm_phase<pg8::EpiInProj, pg8::StaticOrder, PG8_ALIGN, PG8_SP2>(F.lds + RING_OFF, g, S, E, F.wave);
    } SEAM(1);

    if (IN(2)) {
#ifndef P2SUB
#define P2SUB 7
#endif
        if (P2SUB & 1) { pg8::Gemm g{(bf16*)(ws + WS_QLAT), WQB, MTOK, 1536, 256}; pg8::StaticOrder S; S.init(MTOK, 1536, F.G, (int)blockIdx.x);
          pg8::EpiQProj E{QA, (const float*)(ws + WS_SSQQ), COS, SIN};
          pg8::gemm_phase<pg8::EpiQProj, pg8::StaticOrder, PG8_ALIGN, PG8_SP2>(F.lds + RING_OFF, g, S, E, F.wave); }
        if (P2SUB & 2) { pg8::Gemm g{(bf16*)(ws + WS_CKV), WKVB, MTOK, 2048, 128}; pg8::StaticOrder S; S.init(MTOK, 2048, F.G, (int)blockIdx.x);
          pg8::EpiKVProj E{(bf16*)(ws + WS_KN), (bf16*)(ws + WS_VA), (const float*)(ws + WS_SSQKV)};
          pg8::gemm_phase<pg8::EpiKVProj, pg8::StaticOrder, PG8_ALIGN, PG8_SP2>(F.lds + RING_OFF, g, S, E, F.wave); }
        if (P2SUB & 4) { const att::swa::Tensors T{(const bf16*)(ws + WS_QB), (const bf16*)(ws + WS_KB), (const bf16*)(ws + WS_VB), (bf16*)(ws + WS_GB), (const float*)(ws + WS_BT2), (const float*)(ws + WS_SINK2)};
          for (int u = F.vcu; u < NBATCH * 4 * (SEQ / 64); u += F.G) { const int qblk = u % (SEQ / 64), bk = u / (SEQ / 64); att::swa::unit(bk >> 2, bk & 3, qblk, T, (char*)lds + RING_OFF, F.wave); } }
    } SEAM(2);

    if (IN(3)) {
        const att::mla::Tensors T{QA, (const bf16*)(ws + WS_KN), (const bf16*)(ws + WS_KR), (const bf16*)(ws + WS_VA), (const bf16*)(ws + WS_GA), (const bf16*)(ws + WS_GB), (bf16*)(ws + WS_MIX)};
        for (int u = F.vcu; u < NBATCH * 8 * (SEQ / 256); u += F.G) { const int qb = u & 15, bh = u >> 4; att::mla::unit(bh >> 3, bh & 7, qb, T, (char*)lds + RING_OFF, F.wave); }
    } SEAM(3);

    if (IN(4)) {
        pg8::Gemm g{(bf16*)(ws + WS_MIX), WOUT, MTOK, 1024, 1024}; pg8::StaticOrder S; S.init(MTOK, 1024, F.G, (int)blockIdx.x);
        pg8::EpiResidual E{args.x, args.out, (bf16*)(ws + WS_X1B), (float*)(ws + WS_SSQ2)};
        pg8::gemm_phase<pg8::EpiResidual, pg8::StaticOrder, PG8_ALIGN, PG8_SP2>(F.lds + RING_OFF, g, S, E, F.wave);
    } SEAM(4);

    if (IN(5)) {
        pg8::Gemm g{(bf16*)(ws + WS_X1B), WUP, MTOK, UP_TILES_A * 256, 1024}; pg8::StaticOrder S; S.init(MTOK, UP_TILES_A * 256, F.G, (int)blockIdx.x);
        pg8::EpiUp E{(bf16*)(ws + WS_U), UP_TILES_A * 256, (const float*)(ws + WS_SSQ2)};
        pg8::gemm_phase<pg8::EpiUp, pg8::StaticOrder, PG8_ALIGN, PG8_SP2>(F.lds + RING_OFF, g, S, E, F.wave);
    } SEAM(5);
    if (IN(6)) { p6_conv(F, args, (const bf16*)(ws + WS_U), UP_TILES_A * 256, UP_TILES_A, 0, (bf16*)(ws + WS_ACT)); } SEAM(6);
    if (IN(7)) {
        pg8::Gemm g{(bf16*)(ws + WS_X1B), WUP + (size_t)UP_TILES_A * 256 * 1024, MTOK, UP_TILES_B * 256, 1024}; pg8::StaticOrder S; S.init(MTOK, UP_TILES_B * 256, F.G, (int)blockIdx.x);
        pg8::EpiUp E{(bf16*)(ws + WS_U), UP_TILES_B * 256, (const float*)(ws + WS_SSQ2)};
        pg8::gemm_phase<pg8::EpiUp, pg8::StaticOrder, PG8_ALIGN, PG8_SP2>(F.lds + RING_OFF, g, S, E, F.wave);
    } SEAM(7);
    if (IN(8)) { p6_conv(F, args, (const bf16*)(ws + WS_U), UP_TILES_B * 256, UP_TILES_B, UP_TILES_A, (bf16*)(ws + WS_ACT)); } SEAM(8);

    if (IN(9)) {
        pg8::Gemm g{(bf16*)(ws + WS_ACT), WDN, MTOK, 1024, DFF}; pg8::StaticOrder S; S.init(MTOK, 1024, F.G, (int)blockIdx.x);
        pg8::EpiResidual E{args.out, args.out, nullptr, (float*)(ws + WS_SSQ3)};
        pg8::gemm_phase<pg8::EpiResidual, pg8::StaticOrder, PG8_ALIGN, PG8_SP2>(F.lds + RING_OFF, g, S, E, F.wave);
    } SEAM(9);

    if (IN(10)) { p8_final_norm(F, args); }
#undef IN
#undef SEAM
}

extern "C" void kernel_launch(void* const* d_in, const int* in_sizes, int n_in, void* d_out, int out_size, void* d_ws, size_t ws_size, hipStream_t stream) {
    static int grid = 0;
    if (grid == 0) {
        if (n_in != 17 || in_sizes[0] != MTOK * DM || out_size != MTOK * DM || ws_size < WS_END) { fprintf(stderr, "kernel_launch: unexpected shapes (n_in %d, in0 %d, out %d, ws %zu; need ws >= %zu); nothing launched\n", n_in, n_in > 0 ? in_sizes[0] : -1, out_size, ws_size, (size_t)WS_END); grid = -1; return; }
        int dev = 0, cus = 0, per_cu = 0;
        if (hipGetDevice(&dev) != hipSuccess || hipDeviceGetAttribute(&cus, hipDeviceAttributeMultiprocessorCount, dev) != hipSuccess) { fprintf(stderr, "kernel_launch: device query failed\n"); grid = -1; return; }
        if (hipFuncSetAttribute((const void*)enc_fwd, hipFuncAttributeMaxDynamicSharedMemorySize, LDS_BYTES) != hipSuccess) { fprintf(stderr, "kernel_launch: hipFuncSetAttribute failed\n"); grid = -1; return; }
        if (hipOccupancyMaxActiveBlocksPerMultiprocessor(&per_cu, (const void*)enc_fwd, NWAVES * 64, LDS_BYTES) != hipSuccess || per_cu < 1) { fprintf(stderr, "kernel_launch: occupancy query reports %d workgroups per CU\n", per_cu); }
        (void)hipGetLastError();
        grid = cus;
    }
    if (grid < 0) return;
    if (hipMemsetAsync((char*)d_ws + WS_CTL, 0, CTL_ZERO_BYTES, stream) != hipSuccess) { fprintf(stderr, "kernel_launch: hipMemsetAsync failed\n"); return; }
    Args a{};
    a.x = (const float*)d_in[0]; a.positions = (const int*)d_in[1]; a.norm1_g = (const float*)d_in[2]; a.w_in = (const float*)d_in[3]; a.q_a_norm_g = (const float*)d_in[4]; a.w_q_b = (const float*)d_in[5];
    a.kv_a_norm_g = (const float*)d_in[6]; a.w_kv_b = (const float*)d_in[7]; a.rel_bias = (const float*)d_in[8]; a.sinks = (const float*)d_in[9]; a.w_out = (const float*)d_in[10]; a.norm2_g = (const float*)d_in[11];
    a.w_up = (const float*)d_in[12]; a.conv_w = (const float*)d_in[13]; a.conv_b = (const float*)d_in[14]; a.w_down = (const float*)d_in[15]; a.final_norm_g = (const float*)d_in[16];
    a.out = (float*)d_out; a.ws = (unsigned char*)d_ws;
#if MK_PER_PHASE
    for (int p = 0; p < N_PHASES; ++p) { a.ph_lo = p; a.ph_hi = p + 1; hipLaunchKernelGGL(enc_fwd, dim3(grid), dim3(NWAVES * 64), LDS_BYTES, stream, a); }
#else
    a.ph_lo = 0; a.ph_hi = N_PHASES; hipLaunchKernelGGL(enc_fwd, dim3(grid), dim3(NWAVES * 64), LDS_BYTES, stream, a);
#endif
    const hipError_t le = hipPeekAtLastError();
    if (le != hipSuccess) fprintf(stderr, "kernel_launch: launch failed: %s (grid %d)\n", hipGetErrorName(le), grid);
}
```

```cpp
#include <hip/hip_runtime.h>
#include <cstdio>
#include <cstdint>
namespace pg8 {
#define PG8_LAS __attribute__((address_space(3)))
typedef unsigned short bf16_t;
typedef short bf16x8 __attribute__((ext_vector_type(8)));
typedef float f32x4 __attribute__((ext_vector_type(4)));
typedef unsigned u32x4 __attribute__((ext_vector_type(4)));
constexpr int BM = 256, BK = 64, HALF = 128, HTB = HALF * BK * 2  , STAGE_BYTES = 8 * HTB, NXCD = 8, WGM = 8;

__host__ __device__ __forceinline__ int lds_byte(int r, int c) { const int st = (r >> 4) * 2 + (c >> 5), rr = r & 15, cc = c & 31, ob = rr * 64 + cc * 2; return st * 1024 + (ob ^ (((ob >> 9) & 1) << 5)); }
__host__ __device__ __forceinline__ void stage_rc(int b, int& R, int& C) { const int st = b / 1024, sb = b % 1024, swz = sb ^ (((sb >> 9) & 1) << 5); R = (st >> 1) * 16 + swz / 64; C = (st & 1) * 32 + (swz % 64) / 2; }
__host__ __device__ __forceinline__ int perm32(int rho) { const int n = rho >> 4, i = rho & 15; return 8 * (i >> 2) + 4 * n + (i & 3); }

struct Unit { int pm, pn; };
struct Gemm { const bf16_t* A; const bf16_t* Bt; int M, N, K; };

struct StaticOrder {
    int nM, nN, nwg, G, c;
    __host__ __device__ void init(int M, int N, int G_, int c_) { nM = M / BM; nN = N / BM; nwg = nM * nN; G = G_; c = c_; }
    __host__ __device__ bool next(int i, Unit& u) const {
        const long L = (long)i * G + c; if (L >= nwg) return false;
        int wgid = (int)L; { const int q = nwg / NXCD, r = nwg % NXCD, xcd = wgid % NXCD, off = wgid / NXCD; wgid = (xcd < r ? xcd * (q + 1) : r * (q + 1) + (xcd - r) * q) + off; }
        const int nig = WGM * nN, gid = wgid / nig, fm = gid * WGM, gsz = (nM - fm) < WGM ? (nM - fm) : WGM;
        u.pm = fm + ((wgid % nig) % gsz); u.pn = (wgid % nig) / gsz; return true;
    }
    __device__ __forceinline__ void a_ready(const Unit&) const {}
    __device__ __forceinline__ void done(const Unit&) const {}
};

__device__ __forceinline__ unsigned cvt_pk_bf16(float lo, float hi) { unsigned r; asm volatile("v_cvt_pk_bf16_f32 %0, %1, %2" : "=v"(r) : "v"(lo), "v"(hi)); return r; }
constexpr int SEQ = 4096, NBATCH = 8, MTOK = NBATCH * SEQ, DM = 1024;
constexpr int DFF = 2816;
constexpr float RMS_EPS = 1e-6f;
constexpr float LOG2E = 1.4426950408889634f;
constexpr float C_MLA = 0.07216878364870322f * LOG2E;
constexpr float C_SWA = 0.125f * LOG2E;

typedef unsigned u32x2 __attribute__((ext_vector_type(2)));
__device__ __forceinline__ int lane_id_fresh() { int l; asm volatile("v_mbcnt_lo_u32_b32 %0, -1, 0\n\tv_mbcnt_hi_u32_b32 %0, -1, %0" : "=v"(l)); return l; }
__device__ __forceinline__ float fast_sigmoid(float v) { return __builtin_amdgcn_rcpf(1.0f + __builtin_amdgcn_exp2f(-LOG2E * v)); }
__device__ __forceinline__ void st8(bf16_t* p, f32x4 v0, f32x4 v1) {
    u32x4 w; w.x = cvt_pk_bf16(v0[0], v0[1]); w.y = cvt_pk_bf16(v0[2], v0[3]); w.z = cvt_pk_bf16(v1[0], v1[1]); w.w = cvt_pk_bf16(v1[2], v1[3]); *(u32x4*)p = w; }
__device__ __forceinline__ void st4(bf16_t* p, f32x4 v) { u32x2 w; w.x = cvt_pk_bf16(v[0], v[1]); w.y = cvt_pk_bf16(v[2], v[3]); *(u32x2*)p = w; }
__device__ __forceinline__ float sq4(f32x4 x) { return (x[0] * x[0] + x[1] * x[1]) + (x[2] * x[2] + x[3] * x[3]); }
__device__ __forceinline__ float fq_sum(float s) { s += __shfl_xor(s, 16); s += __shfl_xor(s, 32); return s; }

__device__ __forceinline__ void rope_store(bf16_t* dst  , int d, int srow, const float* cosT, const float* sinT, f32x4 a, f32x4 b, float sc) {
    const f32x4 c4 = *(const f32x4*)(cosT + srow * 32 + d), s4 = *(const f32x4*)(sinT + srow * 32 + d);
    const f32x4 x1 = {a[0] * sc, a[2] * sc, b[0] * sc, b[2] * sc}, x2 = {a[1] * sc, a[3] * sc, b[1] * sc, b[3] * sc};
    st4(dst + d, x1 * c4 - x2 * s4); st4(dst + 32 + d, x2 * c4 + x1 * s4);
}

struct EpiInProj {
    static constexpr bool PERM = true, AFTER_DRAIN = false;
    bf16_t *qlat, *kl, *qb, *kb, *vb, *ga, *gb; float *ssq_q, *ssq_kv; const float *cosT, *sinT;
    __device__ __forceinline__ void operator()(f32x4 (&acc)[2][2][4][2], const Unit& u, int wr, int wc, int fr, int fq) const {
        { const int l_ = lane_id_fresh(); fr = l_ & 15; fq = l_ >> 4; }
        const int pn = u.pn, row0 = u.pm * BM + wr * 64 + fr, cw = wc * 32 + 8 * fq;
        if (pn == 0) {
#pragma unroll
            for (int ai = 0; ai < 2; ++ai)
#pragma unroll
                for (int m = 0; m < 4; ++m) { const int row = row0 + ai * HALF + m * 16;
                    float s = (sq4(acc[ai][0][m][0]) + sq4(acc[ai][0][m][1])) + (sq4(acc[ai][1][m][0]) + sq4(acc[ai][1][m][1]));
                    s = fq_sum(s); if (fq == 0) ssq_q[(size_t)row * 4 + wc] = s;
                    st8(qlat + (size_t)row * 256 + cw, acc[ai][0][m][0], acc[ai][0][m][1]); st8(qlat + (size_t)row * 256 + HALF + cw, acc[ai][1][m][0], acc[ai][1][m][1]);
                    asm volatile("" ::: "memory"); }
        } else if (pn == 1) {
#pragma unroll
            for (int ai = 0; ai < 2; ++ai)
#pragma unroll
                for (int m = 0; m < 4; ++m) { const int row = row0 + ai * HALF + m * 16;
                    float s = sq4(acc[ai][0][m][0]) + sq4(acc[ai][0][m][1]);
                    s = fq_sum(s); if (fq == 0) __hip_atomic_store(ssq_kv + (unsigned)row * 4 + wc, s, __ATOMIC_RELAXED, __HIP_MEMORY_SCOPE_AGENT); }
            asm volatile("s_waitcnt vmcnt(0)" ::: "memory");
            __builtin_amdgcn_s_barrier(); asm volatile("" ::: "memory");
#pragma unroll
            for (int ai = 0; ai < 2; ++ai)
#pragma unroll
                for (int m = 0; m < 4; ++m) { const int row = row0 + ai * HALF + m * 16; const float* sp = ssq_kv + (unsigned)row * 4;
                    const float t = (__hip_atomic_load(sp, __ATOMIC_RELAXED, __HIP_MEMORY_SCOPE_AGENT) + __hip_atomic_load(sp + 1, __ATOMIC_RELAXED, __HIP_MEMORY_SCOPE_AGENT))
                                  + (__hip_atomic_load(sp + 2, __ATOMIC_RELAXED, __HIP_MEMORY_SCOPE_AGENT) + __hip_atomic_load(sp + 3, __ATOMIC_RELAXED, __HIP_MEMORY_SCOPE_AGENT));
                    const float rs = __builtin_amdgcn_rsqf(t * (1.0f / 128.0f) + RMS_EPS);
                    bf16_t* krow = kl + (size_t)row * 192;
                    st8(krow + cw, acc[ai][0][m][0] * rs, acc[ai][0][m][1] * rs);
                    if (wc < 2) rope_store(krow + 128, 16 * wc + 4 * fq, row & (SEQ - 1), cosT, sinT, acc[ai][1][m][0], acc[ai][1][m][1], 1.0f);
                    if (m == 1 || m == 3) asm volatile("" ::: "memory"); }
        } else {
            bf16_t* base; int ld, col0; float sc = 1.0f; bool sig = false;
            if (pn < 6) { base = qb; ld = 1024; col0 = (pn - 2) * 256; sc = C_SWA; }
            else if (pn == 6) { base = kb; ld = 256; col0 = 0; }
            else if (pn == 7) { base = vb; ld = 256; col0 = 0; }
            else if (pn < 12) { base = ga; ld = 1024; col0 = (pn - 8) * 256; sig = true; }
            else { base = gb; ld = 1024; col0 = (pn - 12) * 256; sig = true; }
            bf16_t* rowp = base + (size_t)row0 * ld + col0 + cw; const size_t rstep = (size_t)16 * ld;
#pragma unroll
            for (int ai = 0; ai < 2; ++ai)
#pragma unroll
                for (int m = 0; m < 4; ++m) { bf16_t* rp = rowp + (size_t)(ai * 8 + m) * rstep;
#pragma unroll
                    for (int bj = 0; bj < 2; ++bj) { f32x4 v0 = acc[ai][bj][m][0], v1 = acc[ai][bj][m][1];
                        if (sig) {
#pragma unroll
                            for (int e = 0; e < 4; ++e) { v0[e] = fast_sigmoid(v0[e]); v1[e] = fast_sigmoid(v1[e]); } }
                        else { v0 = v0 * sc; v1 = v1 * sc; }
                        st8(rp + bj * HALF, v0, v1); }
                    asm volatile("" ::: "memory"); }
        }
    }
};

struct EpiQProj {
    static constexpr bool PERM = true, AFTER_DRAIN = false;
    bf16_t* qa; const float* ssq; const float *cosT, *sinT;
    __device__ __forceinline__ void operator()(f32x4 (&acc)[2][2][4][2], const Unit& u, int wr, int wc, int fr, int fq) const {
        { const int l_ = lane_id_fresh(); fr = l_ & 15; fq = l_ >> 4; }
        const int pn = u.pn, row0 = u.pm * BM + wr * 64 + fr, cw = wc * 32 + 8 * fq;
        f32x4 sv[2][4];
#pragma unroll
        for (int ai = 0; ai < 2; ++ai)
#pragma unroll
            for (int m = 0; m < 4; ++m) sv[ai][m] = *(const f32x4*)(ssq + (unsigned)(row0 + ai * HALF + m * 16) * 4);
        asm volatile("" ::: "memory");
#pragma unroll
        for (int ai = 0; ai < 2; ++ai)
#pragma unroll
            for (int m = 0; m < 4; ++m) { const int row = row0 + ai * HALF + m * 16;
                const f32x4 s4 = sv[ai][m];
                const float rs = C_MLA * __builtin_amdgcn_rsqf(((s4[0] + s4[1]) + (s4[2] + s4[3])) * (1.0f / 256.0f) + RMS_EPS);
                bf16_t* qrow = qa + (size_t)row * 1536;
                if (pn < 4) {
#pragma unroll
                    for (int bj = 0; bj < 2; ++bj) st8(qrow + (2 * pn + bj) * 192 + cw, acc[ai][bj][m][0] * rs, acc[ai][bj][m][1] * rs);
                } else {
#pragma unroll
                    for (int bj = 0; bj < 2; ++bj) { const int head = 4 * (pn - 4) + 2 * bj + (wc >> 1);
                        rope_store(qrow + head * 192 + 128, 16 * (wc & 1) + 4 * fq, row & (SEQ - 1), cosT, sinT, acc[ai][bj][m][0], acc[ai][bj][m][1], rs); }
                }
                if (m == 1 || m == 3) asm volatile("" ::: "memory");
            }
    }
};

struct EpiResidual {
    static constexpr bool PERM = true, AFTER_DRAIN = false;
    const float* base; float* y; bf16_t* yb; float* ssq;
    __device__ __forceinline__ void operator()(f32x4 (&acc)[2][2][4][2], const Unit& u, int wr, int wc, int fr, int fq) const {
        { const int l_ = lane_id_fresh(); fr = l_ & 15; fq = l_ >> 4; }
        const int pn = u.pn, row0 = u.pm * BM + wr * 64 + fr, cw = wc * 32 + 8 * fq;
        const unsigned off0 = (unsigned)row0 * DM + pn * 256 + cw;
#pragma unroll
        for (int ai = 0; ai < 2; ++ai) {
            f32x4 xv[4][2][2];
#pragma unroll
            for (int m = 0; m < 4; ++m)
#pragma unroll
                for (int bj = 0; bj < 2; ++bj) { const unsigned off = off0 + (unsigned)((ai * HALF + m * 16) * DM + bj * HALF);
                    xv[m][bj][0] = *(const f32x4*)(base + off); xv[m][bj][1] = *(const f32x4*)(base + off + 4); }
            asm volatile("" ::: "memory");
#pragma unroll
            for (int m = 0; m < 4; ++m) { const int row = row0 + ai * HALF + m * 16; float s = 0.f;
#pragma unroll
                for (int bj = 0; bj < 2; ++bj) { const unsigned off = off0 + (unsigned)((ai * HALF + m * 16) * DM + bj * HALF);
                    const f32x4 v0 = xv[m][bj][0] + acc[ai][bj][m][0], v1 = xv[m][bj][1] + acc[ai][bj][m][1];
                    if (y) { *(f32x4*)(y + off) = v0; *(f32x4*)(y + off + 4) = v1; } if (yb) st8(yb + off, v0, v1);
                    s += sq4(v0) + sq4(v1); }
                s = fq_sum(s); if (fq == 0) ssq[(unsigned)row * 16 + pn * 4 + wc] = s; }
            asm volatile("" ::: "memory");
        }
    }
};

struct EpiUp {
    static constexpr bool PERM = true, AFTER_DRAIN = false;
    bf16_t* U; int ldu; const float* ssq;
    __device__ __forceinline__ void operator()(f32x4 (&acc)[2][2][4][2], const Unit& u, int wr, int wc, int fr, int fq) const {
        { const int l_ = lane_id_fresh(); fr = l_ & 15; fq = l_ >> 4; }
        const int pn = u.pn, row0 = u.pm * BM + wr * 64 + fr, cw = wc * 32 + 8 * fq;
#pragma unroll
        for (int ai = 0; ai < 2; ++ai)
#pragma unroll
            for (int m = 0; m < 4; ++m) { const int row = row0 + ai * HALF + m * 16;
                const f32x4* sp = (const f32x4*)(ssq + (size_t)row * 16); const f32x4 t = (sp[0] + sp[1]) + (sp[2] + sp[3]);
                const float rs = __builtin_amdgcn_rsqf(((t[0] + t[1]) + (t[2] + t[3])) * (1.0f / 1024.0f) + RMS_EPS);
#pragma unroll
                for (int bj = 0; bj < 2; ++bj) st8(U + (size_t)row * ldu + pn * 256 + bj * HALF + cw, acc[ai][bj][m][0] * rs, acc[ai][bj][m][1] * rs);
                asm volatile("" ::: "memory"); }
    }
};

__device__ __forceinline__ float dpp_prev(float x) { return __int_as_float(__builtin_amdgcn_update_dpp(__float_as_int(x), __float_as_int(x), 0x121, 0xf, 0xf, true)); }
__device__ __forceinline__ float dpp_next(float x) { return __int_as_float(__builtin_amdgcn_update_dpp(__float_as_int(x), __float_as_int(x), 0x12f, 0xf, 0xf, true)); }
struct EpiUpConv {
    static constexpr bool PERM = true, AFTER_DRAIN = false;
    bf16_t* act; float* halo; const float* ssq; const float* conv_w; const float* conv_b;
    __device__ __forceinline__ void operator()(f32x4 (&acc)[2][2][4][2], const Unit& u, int wr, int wc, int fr, int fq) const {
        { const int l_ = lane_id_fresh(); fr = l_ & 15; fq = l_ >> 4; }
        const int pn = u.pn, row0 = u.pm * BM + wr * 64 + fr, cw = wc * 32 + 8 * fq;
        { f32x4 tv[2][4];
#pragma unroll
        for (int ai = 0; ai < 2; ++ai)
#pragma unroll
            for (int m = 0; m < 4; ++m) tv[ai][m] = *(const f32x4*)(ssq + (unsigned)(row0 + ai * HALF + m * 16) * 16 + 4 * fq);
        asm volatile("" ::: "memory");
#pragma unroll
        for (int ai = 0; ai < 2; ++ai)
#pragma unroll
            for (int m = 0; m < 4; ++m) { const f32x4 t = tv[ai][m];
                const float rs = __builtin_amdgcn_rsqf(fq_sum((t[0] + t[1]) + (t[2] + t[3])) * (1.0f / 1024.0f) + RMS_EPS);
#pragma unroll
                for (int bj = 0; bj < 2; ++bj) { acc[ai][bj][m][0] = acc[ai][bj][m][0] * rs; acc[ai][bj][m][1] = acc[ai][bj][m][1] * rs; }
                if (m == 1 || m == 3) __builtin_amdgcn_sched_barrier(0); } }
        const bool first = fr == 0, last = fr == 15;
        u32x2 pk[2][4];
#pragma unroll
        for (int n = 0; n < 2; ++n) {
            const int c = pn * 128 + cw + 4 * n;
            const f32x4 wg0 = *(const f32x4*)(conv_w + c), wg1 = *(const f32x4*)(conv_w + 2 * DFF + c), wg2 = *(const f32x4*)(conv_w + 4 * DFF + c), bg = *(const f32x4*)(conv_b + c);
            const f32x4 wv0 = *(const f32x4*)(conv_w + DFF + c), wv1 = *(const f32x4*)(conv_w + 3 * DFF + c), wv2 = *(const f32x4*)(conv_w + 5 * DFF + c), bv = *(const f32x4*)(conv_b + DFF + c);
#pragma unroll
            for (int ai = 0; ai < 2; ++ai) {
                float* hb = halo + (unsigned)((4 * u.pm + 2 * ai + wr) * (4 * 2 * DFF) + pn * 256 + cw + 4 * n);
                f32x4 Apg = {0.f, 0.f, 0.f, 0.f}, Apv = Apg, Bcg, Bcv;
#pragma unroll
                for (int e = 0; e < 4; ++e) { Bcg[e] = dpp_next(acc[ai][0][0][n][e]); Bcv[e] = dpp_next(acc[ai][1][0][n][e]); }
#pragma unroll
                for (int m = 0; m < 4; ++m) { const int row = row0 + ai * HALF + m * 16;
                    const f32x4 ug = acc[ai][0][m][n], uv = acc[ai][1][m][n]; f32x4 G, V, Acg, Acv, Bng = {0.f, 0.f, 0.f, 0.f}, Bnv = Bng;
#pragma unroll
                    for (int e = 0; e < 4; ++e) { Acg[e] = dpp_prev(ug[e]); Acv[e] = dpp_prev(uv[e]);
                        if (m < 3) { Bng[e] = dpp_next(acc[ai][0][m < 3 ? m + 1 : 3][n][e]); Bnv[e] = dpp_next(acc[ai][1][m < 3 ? m + 1 : 3][n][e]); }
                        const float pg = first ? Apg[e] : Acg[e], pv = first ? Apv[e] : Acv[e], ng = last ? Bng[e] : Bcg[e], nv = last ? Bnv[e] : Bcv[e];
                        G[e] = wg0[e] * pg + wg1[e] * ug[e] + wg2[e] * ng + bg[e]; V[e] = wv0[e] * pv + wv1[e] * uv[e] + wv2[e] * nv + bv[e]; }
                    Apg = Acg; Apv = Acv; Bcg = Bng; Bcv = Bnv;
                    bool edge = false;
                    if (m == 0) { if (first) { edge = true; *(f32x4*)(hb) = ug; *(f32x4*)(hb + 128) = uv; *(f32x4*)(hb + 2 * 2 * DFF) = G; *(f32x4*)(hb + 2 * 2 * DFF + 128) = V; } }
                    if (m == 3) { if (last) { edge = true; *(f32x4*)(hb + 2 * DFF) = ug; *(f32x4*)(hb + 2 * DFF + 128) = uv; *(f32x4*)(hb + 3 * 2 * DFF) = G; *(f32x4*)(hb + 3 * 2 * DFF + 128) = V; } }
                    f32x4 o;
#pragma unroll
                    for (int e = 0; e < 4; ++e) o[e] = G[e] * fast_sigmoid(G[e]) * V[e];
                    u32x2 w; w.x = cvt_pk_bf16(o[0], o[1]); w.y = cvt_pk_bf16(o[2], o[3]);
                    if (n == 0) pk[ai][m] = w;
                    else if (!edge) { u32x4 w4; w4.x = pk[ai][m].x; w4.y = pk[ai][m].y; w4.z = w.x; w4.w = w.y; *(u32x4*)(act + ((unsigned)row * (unsigned)DFF + (unsigned)(c - 4))) = w4; }
                    __builtin_amdgcn_sched_barrier(0);
                }
                asm volatile("" ::: "memory");
            }
        }
    }
};

struct EpiFinal {
    static constexpr bool PERM = true, AFTER_DRAIN = false;
    const bf16_t* x1b; float* out; float* ssq; unsigned* cnt; const float* gf;
    __device__ __forceinline__ void operator()(f32x4 (&acc)[2][2][4][2], const Unit& u, int wr, int wc, int fr, int fq) const {
        const int l_ = lane_id_fresh(); fr = l_ & 15; fq = l_ >> 4;
        const int pn = u.pn, row0 = u.pm * BM + wr * 64 + fr, cw = wc * 32 + 8 * fq;
        const unsigned off0 = (unsigned)row0 * DM + pn * 256 + cw;
#pragma unroll
        for (int ai = 0; ai < 2; ++ai) {
            u32x4 xw[4][2];
#pragma unroll
            for (int m = 0; m < 4; ++m)
#pragma unroll
                for (int bj = 0; bj < 2; ++bj) xw[m][bj] = *(const u32x4*)(x1b + off0 + (unsigned)((ai * HALF + m * 16) * DM + bj * HALF));
            asm volatile("" ::: "memory");
#pragma unroll
            for (int m = 0; m < 4; ++m) { const int row = row0 + ai * HALF + m * 16; float s = 0.f;
#pragma unroll
                for (int bj = 0; bj < 2; ++bj) { const u32x4 w = xw[m][bj];
                    const f32x4 x0 = {__uint_as_float(w.x << 16), __uint_as_float(w.x & 0xffff0000u), __uint_as_float(w.y << 16), __uint_as_float(w.y & 0xffff0000u)};
                    const f32x4 x1v = {__uint_as_float(w.z << 16), __uint_as_float(w.z & 0xffff0000u), __uint_as_float(w.w << 16), __uint_as_float(w.w & 0xffff0000u)};
                    acc[ai][bj][m][0] = acc[ai][bj][m][0] + x0; acc[ai][bj][m][1] = acc[ai][bj][m][1] + x1v;
                    s += sq4(acc[ai][bj][m][0]) + sq4(acc[ai][bj][m][1]); }
                s = fq_sum(s); if (fq == 0) __hip_atomic_store(ssq + (unsigned)row * 16 + pn * 4 + wc, s, __ATOMIC_RELAXED, __HIP_MEMORY_SCOPE_AGENT); }
            asm volatile("" ::: "memory");
        }
        asm volatile("s_waitcnt vmcnt(0)" ::: "memory");
        __builtin_amdgcn_s_barrier(); asm volatile("" ::: "memory");
        if (wr == 0 && wc == 0) {
            unsigned* c = cnt + 64 * u.pm;
            if (l_ == 0) __hip_atomic_fetch_add(c, 1u, __ATOMIC_RELAXED, __HIP_MEMORY_SCOPE_AGENT);
            for (unsigned sp = 0; sp < (1u << 22); ++sp) {
                if ((unsigned)__builtin_amdgcn_readfirstlane(__hip_atomic_load(c, __ATOMIC_RELAXED, __HIP_MEMORY_SCOPE_AGENT)) >= 4u) break;
                __builtin_amdgcn_s_sleep(2); }
            __builtin_amdgcn_fence(__ATOMIC_ACQUIRE, "agent");
            asm volatile("s_waitcnt vmcnt(0)" ::: "memory");
        }
        __builtin_amdgcn_s_barrier(); asm volatile("" ::: "memory");
        f32x4 gv[2][2];
#pragma unroll
        for (int bj = 0; bj < 2; ++bj) { gv[bj][0] = *(const f32x4*)(gf + pn * 256 + bj * HALF + cw); gv[bj][1] = *(const f32x4*)(gf + pn * 256 + bj * HALF + cw + 4); }
        f32x4 tv[2][4];
#pragma unroll
        for (int ai = 0; ai < 2; ++ai)
#pragma unroll
            for (int m = 0; m < 4; ++m) tv[ai][m] = *(const f32x4*)(ssq + (unsigned)(row0 + ai * HALF + m * 16) * 16 + 4 * fq);
        asm volatile("" ::: "memory");
#pragma unroll
        for (int ai = 0; ai < 2; ++ai)
#pragma unroll
            for (int m = 0; m < 4; ++m) { const f32x4 t = tv[ai][m];
                const float rs = __builtin_amdgcn_rsqf(fq_sum((t[0] + t[1]) + (t[2] + t[3])) * (1.0f / 1024.0f) + RMS_EPS);
#pragma unroll
                for (int bj = 0; bj < 2; ++bj) { const unsigned off = off0 + (unsigned)((ai * HALF + m * 16) * DM + bj * HALF);
                    *(f32x4*)(out + off) = acc[ai][bj][m][0] * rs * gv[bj][0]; *(f32x4*)(out + off + 4) = acc[ai][bj][m][1] * rs * gv[bj][1]; }
                if (m == 1 || m == 3) __builtin_amdgcn_sched_barrier(0); }
    }
};
template <class Epi, class Sched, bool ALIGN_EPI = false, bool SP2 = false>
__device__ __forceinline__ void gemm_phase(PG8_LAS unsigned char* lds, const Gemm g, const Sched& S, const Epi& E, const int wave_id  ) {
    const int lane = lane_id_fresh(), wid = wave_id, tid = wid * 64 + lane,
              wr = wid >> 2, wc = wid & 3, fr = lane & 15, fq = lane >> 4;
    const int K = g.K, nt = K / BK;
    unsigned voffA[2], voffB[2]; int aoff, boff;
#define PG8_LANE_CONSTS() do { const int l_ = lane_id_fresh(), t_ = wid * 64 + l_, fr_ = l_ & 15, fq_ = l_ >> 4; \
        _Pragma("unroll") for (int i = 0; i < 2; ++i) { int R, C; stage_rc(t_ * 16 + i * 8192, R, C); const int Rb = Epi::PERM ? ((R & ~31) + perm32(R & 31)) : R; \
            voffA[i] = (unsigned)(R * K + C) * 2u; voffB[i] = (unsigned)(Rb * K + C) * 2u; } \
        aoff = lds_byte(wr * 64 + fr_, fq_ * 8); boff = lds_byte(wc * 32 + fr_, fq_ * 8); } while (0)
    PG8_LANE_CONSTS();
    const size_t kstep = (size_t)(BK * 2);
    const size_t hstep = (size_t)HALF * K * 2;
    const size_t tstep = 2 * hstep;
    const unsigned ldsw = (unsigned)wid * 1024u;
#define PG8_SA(b, h) (((b) * 2 + (h)) * HTB)
#define PG8_SB(b, h) ((4 + (b) * 2 + (h)) * HTB)
#define PG8_STAGE(bufoff, gbase, voff) do { _Pragma("unroll") for (int _i = 0; _i < 2; ++_i) \
        __builtin_amdgcn_global_load_lds((const unsigned*)((const char*)(gbase) + (voff)[_i]), (PG8_LAS unsigned*)(lds + (bufoff) + ldsw + _i * 8192), 16, 0, 0); } while (0)
#define PG8_LDA(dst, b, h) do { _Pragma("unroll") for (int m = 0; m < 4; ++m) _Pragma("unroll") for (int k = 0; k < 2; ++k) dst[m][k] = *(const PG8_LAS bf16x8*)(lds + PG8_SA(b, h) + aoff + m * 2048 + k * 1024); } while (0)
#define PG8_LDB(dst, b, h) do { _Pragma("unroll") for (int n = 0; n < 2; ++n) _Pragma("unroll") for (int k = 0; k < 2; ++k) dst[n][k] = *(const PG8_LAS bf16x8*)(lds + PG8_SB(b, h) + boff + n * 2048 + k * 1024); } while (0)
#define PG8_MMA(ai, bj, At, Bt) do { __builtin_amdgcn_s_setprio(1); _Pragma("unroll") for (int m = 0; m < 4; ++m) _Pragma("unroll") for (int n = 0; n < 2; ++n) _Pragma("unroll") for (int k = 0; k < 2; ++k) \
        acc[ai][bj][m][n] = __builtin_amdgcn_mfma_f32_16x16x32_bf16(Bt[n][k], At[m][k], acc[ai][bj][m][n], 0, 0, 0); __builtin_amdgcn_s_setprio(0); } while (0)
#define PG8_WAIT_V(n) asm volatile("s_waitcnt vmcnt(" #n ")" ::: "memory")
#define PG8_WAIT_L(n) asm volatile("s_waitcnt lgkmcnt(" #n ")" ::: "memory")
#define PG8_BAR __builtin_amdgcn_s_barrier()
#define PG8_SCHED __builtin_amdgcn_sched_barrier(0)
    Unit cur, nxt; int ui = 0;
    if (!S.next(0, cur)) return;
    f32x4 acc[2][2][4][2];
#pragma unroll
    for (int a = 0; a < 2; ++a)
#pragma unroll
        for (int b = 0; b < 2; ++b)
#pragma unroll
            for (int m = 0; m < 4; ++m)
#pragma unroll
                for (int n = 0; n < 2; ++n) acc[a][b][m][n] = (f32x4){0.f, 0.f, 0.f, 0.f};
    bf16x8 At[4][2], B0[2][2], B1[2][2];
    const char* cA = (const char*)g.A + (size_t)cur.pm * tstep; const char* cB = (const char*)g.Bt + (size_t)cur.pn * tstep;
    S.a_ready(cur);
    if constexpr (SP2) {
        PG8_STAGE(PG8_SB(0, 0), cB, voffB); PG8_STAGE(PG8_SB(0, 1), cB + hstep, voffB); PG8_STAGE(PG8_SA(0, 0), cA, voffA); PG8_STAGE(PG8_SA(0, 1), cA + hstep, voffA);
        if (wr == 1) PG8_BAR;
        PG8_WAIT_V(2); PG8_BAR;
        PG8_STAGE(PG8_SB(1, 0), cB + kstep, voffB); PG8_STAGE(PG8_SA(1, 0), cA + kstep, voffA); PG8_STAGE(PG8_SB(1, 1), cB + hstep + kstep, voffB);
        PG8_WAIT_V(6); PG8_BAR;
    } else {
        PG8_STAGE(PG8_SB(0, 0), cB, voffB); PG8_STAGE(PG8_SA(0, 0), cA, voffA); PG8_STAGE(PG8_SB(0, 1), cB + hstep, voffB); PG8_STAGE(PG8_SA(0, 1), cA + hstep, voffA);
        if (wr == 1) PG8_BAR;
        PG8_WAIT_V(4); PG8_BAR;
        PG8_STAGE(PG8_SB(1, 0), cB + kstep, voffB); PG8_STAGE(PG8_SA(1, 0), cA + kstep, voffA); PG8_STAGE(PG8_SB(1, 1), cB + hstep + kstep, voffB);
        PG8_WAIT_V(6); PG8_BAR;
    }
    for (;;) {
        const bool has_next = S.next(ui + 1, nxt);
        const char* nA = has_next ? (const char*)g.A + (size_t)nxt.pm * tstep : cA; const char* nB = has_next ? (const char*)g.Bt + (size_t)nxt.pn * tstep : cB;
        for (int t = 0; t < nt; t += 2) {
            const bool last = (t == nt - 2);
            const char* a1 = cA + (size_t)(t + 1) * kstep;
            const char* a2 = last ? nA : cA + (size_t)(t + 2) * kstep; const char* b2 = last ? nB : cB + (size_t)(t + 2) * kstep;
            const char* a3 = a2 + kstep; const char* b3 = b2 + kstep;
            if (last && has_next) S.a_ready(nxt);
            if constexpr (SP2) {
            PG8_LDB(B0, 0, 0); PG8_LDB(B1, 0, 1); PG8_SCHED; PG8_LDA(At, 0, 0); PG8_STAGE(PG8_SA(1, 1), a1 + hstep, voffA);
            PG8_WAIT_V(8); PG8_WAIT_L(0); PG8_BAR; PG8_MMA(0, 0, At, B0); PG8_MMA(0, 1, At, B1); PG8_BAR; PG8_SCHED;
            PG8_LDA(At, 0, 1); PG8_STAGE(PG8_SB(0, 0), b2, voffB); PG8_STAGE(PG8_SB(0, 1), b2 + hstep, voffB); PG8_STAGE(PG8_SA(0, 0), a2, voffA);
            PG8_WAIT_V(8); PG8_WAIT_L(0); PG8_BAR; PG8_MMA(1, 0, At, B0); PG8_MMA(1, 1, At, B1); PG8_BAR; PG8_SCHED;
            PG8_LDB(B0, 1, 0); PG8_LDB(B1, 1, 1); PG8_SCHED; PG8_LDA(At, 1, 0); PG8_STAGE(PG8_SA(0, 1), a2 + hstep, voffA);
            PG8_WAIT_V(8); PG8_WAIT_L(0); PG8_BAR; PG8_MMA(0, 0, At, B0); PG8_MMA(0, 1, At, B1); PG8_BAR; PG8_SCHED;
            PG8_LDA(At, 1, 1); PG8_STAGE(PG8_SB(1, 0), b3, voffB); PG8_STAGE(PG8_SB(1, 1), b3 + hstep, voffB); PG8_STAGE(PG8_SA(1, 0), a3, voffA);
            PG8_WAIT_V(8); PG8_WAIT_L(0); PG8_BAR; PG8_MMA(1, 0, At, B0); PG8_MMA(1, 1, At, B1); PG8_BAR; PG8_SCHED;
            } else {
            PG8_LDB(B0, 0, 0); PG8_SCHED; PG8_LDA(At, 0, 0); PG8_STAGE(PG8_SA(1, 1), a1 + hstep, voffA);
            PG8_WAIT_L(8); PG8_BAR; PG8_WAIT_L(0); PG8_MMA(0, 0, At, B0); PG8_BAR; PG8_SCHED;
            PG8_LDB(B1, 0, 1); PG8_STAGE(PG8_SB(0, 0), b2, voffB);
            PG8_BAR; PG8_WAIT_L(0); PG8_MMA(0, 1, At, B1); PG8_BAR;
            PG8_LDA(At, 0, 1); PG8_STAGE(PG8_SA(0, 0), a2, voffA);
            PG8_BAR; PG8_WAIT_L(0); PG8_MMA(1, 0, At, B0); PG8_BAR; PG8_SCHED;
            PG8_STAGE(PG8_SB(0, 1), b2 + hstep, voffB);
            PG8_WAIT_V(6); PG8_BAR; PG8_MMA(1, 1, At, B1); PG8_BAR;
            PG8_LDB(B0, 1, 0); PG8_SCHED; PG8_LDA(At, 1, 0); PG8_STAGE(PG8_SA(0, 1), a2 + hstep, voffA);
            PG8_WAIT_L(8); PG8_BAR; PG8_WAIT_L(0); PG8_MMA(0, 0, At, B0); PG8_BAR; PG8_SCHED;
            PG8_LDB(B1, 1, 1); PG8_STAGE(PG8_SB(1, 0), b3, voffB);
            PG8_BAR; PG8_WAIT_L(0); PG8_MMA(0, 1, At, B1); PG8_BAR;
            PG8_LDA(At, 1, 1); PG8_STAGE(PG8_SA(1, 0), a3, voffA);
            PG8_BAR; PG8_WAIT_L(0); PG8_MMA(1, 0, At, B0); PG8_BAR; PG8_SCHED;
            PG8_STAGE(PG8_SB(1, 1), b3 + hstep, voffB);
            PG8_WAIT_V(6); PG8_BAR; PG8_MMA(1, 1, At, B1); PG8_BAR;
            }
        }
        if constexpr (ALIGN_EPI) { if (wr == 0) PG8_BAR; }
        if constexpr (!Epi::AFTER_DRAIN) { E(acc, cur, wr, wc, fr, fq); S.done(cur); PG8_LANE_CONSTS(); }
        if (!has_next) break;
#pragma unroll
        for (int a = 0; a < 2; ++a)
#pragma unroll
            for (int b = 0; b < 2; ++b)
#pragma unroll
                for (int m = 0; m < 4; ++m)
#pragma unroll
                    for (int n = 0; n < 2; ++n) acc[a][b][m][n] = (f32x4){0.f, 0.f, 0.f, 0.f};
        cur = nxt; cA = nA; cB = nB; ++ui;
        if constexpr (ALIGN_EPI) { if (wr == 1) PG8_BAR; }
    }
    PG8_WAIT_V(0);
    if constexpr (!ALIGN_EPI) { if (wr == 0) PG8_BAR; }
    PG8_BAR;
    if constexpr (Epi::AFTER_DRAIN) { E.fused(acc, cur, wr, wc, fr, fq, lds, wid, lane); S.done(cur); }
#undef PG8_LANE_CONSTS
#undef PG8_SA
#undef PG8_SB
#undef PG8_STAGE
#undef PG8_LDA
#undef PG8_LDB
#undef PG8_MMA
#undef PG8_WAIT_V
#undef PG8_WAIT_L
#undef PG8_BAR
#undef PG8_SCHED
}
}
using pg8::SEQ; using pg8::NBATCH; using pg8::MTOK; using pg8::DM; using pg8::DFF; using pg8::RMS_EPS; using pg8::LOG2E;
#ifndef PG8_SP2
#define PG8_SP2 true
#endif
#ifndef PG8_ALIGN
#define PG8_ALIGN true
#endif
#ifndef MLA_OT
#define MLA_OT 1
#endif
namespace att {
using bf16x8 = __attribute__((ext_vector_type(8))) short;
using s16x4  = __attribute__((ext_vector_type(4))) short;
using f32x16 = __attribute__((ext_vector_type(16))) float;
using u32x4  = __attribute__((ext_vector_type(4))) unsigned;
typedef unsigned short bf16_t;
#define SBAR() __builtin_amdgcn_sched_barrier(0)
#define ATT_WAIT_BAR(N) asm volatile("s_waitcnt vmcnt(" #N ") lgkmcnt(0)\n\ts_barrier" ::: "memory")
__device__ __forceinline__ int crow(int r, int hi) { return (r & 3) + 8 * (r >> 2) + 4 * hi; }
__device__ __forceinline__ unsigned cvtpk(float lo, float hi) { unsigned r; asm volatile("v_cvt_pk_bf16_f32 %0, %1, %2" : "=v"(r) : "v"(lo), "v"(hi)); return r; }
__device__ __forceinline__ float bf2f(bf16_t b) { return __uint_as_float((unsigned)b << 16); }
__device__ __forceinline__ bf16_t f2bf(float f) { return (bf16_t)(cvtpk(f, f) & 0xffffu); }
__device__ __forceinline__ void glds16(const void* gsrc, unsigned lds_dst) { unsigned keep;
    asm volatile("s_mov_b32 %0, m0\n\ts_mov_b32 m0, %2\n\ts_nop 0\n\tglobal_load_lds_dwordx4 %1, off\n\ts_mov_b32 m0, %0" : "=&s"(keep) : "v"(gsrc), "s"(lds_dst) : "memory"); }
template <int IMM> __device__ __forceinline__ void glds16s(const void* sbase, unsigned voff, unsigned lds_dst) { unsigned keep;
    asm volatile("s_mov_b32 %0, m0\n\ts_mov_b32 m0, %3\n\ts_nop 4\n\tglobal_load_lds_dwordx4 %1, %2 offset:%4\n\ts_mov_b32 m0, %0" : "=&s"(keep) : "v"(voff), "s"(sbase), "s"(lds_dst), "i"(IMM) : "memory"); }
__device__ __forceinline__ int swap23(int k) { return (k & ~0xC) | ((k & 4) << 1) | ((k & 8) >> 1); }
__device__ __forceinline__ int v_rd_base(int lane) { return ((lane & 3) << 3) | (((lane >> 2) & 3) << 6) | (((lane >> 4) & 1) << 5) | (((lane >> 5) & 1) << 8); }
template <int OFF> __device__ __forceinline__ s16x4 tr_read(int vb) { s16x4 r; asm volatile("ds_read_b64_tr_b16 %0, %1 offset:%2" : "=&v"(r) : "v"(vb), "i"(OFF) : "memory"); return r; }
__device__ __forceinline__ void pack_p(const f32x16& p0, const f32x16& p1, bf16x8& pa0, bf16x8& pa1, bf16x8& pa2, bf16x8& pa3) {
#define PK4(P, BASE, OUT) do { unsigned a0 = cvtpk(P[BASE + 0], P[BASE + 1]), a1 = cvtpk(P[BASE + 2], P[BASE + 3]);   \
    unsigned b0 = cvtpk(P[BASE + 4], P[BASE + 5]), b1 = cvtpk(P[BASE + 6], P[BASE + 7]);                              \
    auto r0 = __builtin_amdgcn_permlane32_swap(a0, b0, false, false); auto r1 = __builtin_amdgcn_permlane32_swap(a1, b1, false, false); \
    u32x4 w = {r0[0], r1[0], r0[1], r1[1]}; OUT = *reinterpret_cast<bf16x8*>(&w); } while (0)
    PK4(p0, 0, pa0); PK4(p0, 8, pa1); PK4(p1, 0, pa2); PK4(p1, 8, pa3);
#undef PK4
}
__device__ __forceinline__ float half_max(float v) { auto rr = __builtin_amdgcn_permlane32_swap(__float_as_uint(v), __float_as_uint(v), false, false); return fmaxf(__uint_as_float(rr[0]), __uint_as_float(rr[1])); }
__device__ __forceinline__ float half_sum(float v) { auto rr = __builtin_amdgcn_permlane32_swap(__float_as_uint(v), __float_as_uint(v), false, false); return __uint_as_float(rr[0]) + __uint_as_float(rr[1]); }
template <int ND0, int D0> __device__ __forceinline__ void pv_one(f32x16& od, int vb, bf16x8 pa0, bf16x8 pa1, bf16x8 pa2, bf16x8 pa3) {
    constexpr int KS = 1024 * ND0, HF = 512 * ND0;
    const s16x4 l0 = tr_read<D0 * 512 + 0 * KS>(vb), h0 = tr_read<D0 * 512 + 0 * KS + HF>(vb), l1 = tr_read<D0 * 512 + 1 * KS>(vb), h1 = tr_read<D0 * 512 + 1 * KS + HF>(vb);
    const s16x4 l2 = tr_read<D0 * 512 + 2 * KS>(vb), h2 = tr_read<D0 * 512 + 2 * KS + HF>(vb), l3 = tr_read<D0 * 512 + 3 * KS>(vb), h3 = tr_read<D0 * 512 + 3 * KS + HF>(vb);
    asm volatile("s_waitcnt lgkmcnt(0)" ::: "memory"); SBAR();
#define PK(L, H) (bf16x8){L[0], L[1], L[2], L[3], H[0], H[1], H[2], H[3]}
    od = __builtin_amdgcn_mfma_f32_32x32x16_bf16(pa0, PK(l0, h0), od, 0, 0, 0);
    od = __builtin_amdgcn_mfma_f32_32x32x16_bf16(pa1, PK(l1, h1), od, 0, 0, 0);
    od = __builtin_amdgcn_mfma_f32_32x32x16_bf16(pa2, PK(l2, h2), od, 0, 0, 0);
    od = __builtin_amdgcn_mfma_f32_32x32x16_bf16(pa3, PK(l3, h3), od, 0, 0, 0);
#undef PK
}
struct PvFrag { s16x4 l0, h0, l1, h1, l2, h2, l3, h3; };
template <int ND0, int D0> __device__ __forceinline__ void pv_issue(PvFrag& f, int vb) {
    constexpr int KS = 1024 * ND0, HF = 512 * ND0;
    f.l0 = tr_read<D0 * 512 + 0 * KS>(vb); f.h0 = tr_read<D0 * 512 + 0 * KS + HF>(vb); f.l1 = tr_read<D0 * 512 + 1 * KS>(vb); f.h1 = tr_read<D0 * 512 + 1 * KS + HF>(vb);
    f.l2 = tr_read<D0 * 512 + 2 * KS>(vb); f.h2 = tr_read<D0 * 512 + 2 * KS + HF>(vb); f.l3 = tr_read<D0 * 512 + 3 * KS>(vb); f.h3 = tr_read<D0 * 512 + 3 * KS + HF>(vb);
}
__device__ __forceinline__ void pv_mma(f32x16& od, const PvFrag& f, bf16x8 pa0, bf16x8 pa1, bf16x8 pa2, bf16x8 pa3) {
    asm volatile("s_waitcnt lgkmcnt(0)" ::: "memory"); SBAR();
#define PK(L, H) (bf16x8){L[0], L[1], L[2], L[3], H[0], H[1], H[2], H[3]}
    od = __builtin_amdgcn_mfma_f32_32x32x16_bf16(pa0, PK(f.l0, f.h0), od, 0, 0, 0);
    od = __builtin_amdgcn_mfma_f32_32x32x16_bf16(pa1, PK(f.l1, f.h1), od, 0, 0, 0);
    od = __builtin_amdgcn_mfma_f32_32x32x16_bf16(pa2, PK(f.l2, f.h2), od, 0, 0, 0);
    od = __builtin_amdgcn_mfma_f32_32x32x16_bf16(pa3, PK(f.l3, f.h3), od, 0, 0, 0);
#undef PK
}
template <int NK16, int RS, int CS> __device__ __forceinline__ void qkt(f32x16& p0, f32x16& p1, const char* Ks, const bf16x8* qr, int r32, int hi) {
    p0 = f32x16{}; p1 = f32x16{};
    const char* kb = Ks + hi * CS + r32 * RS;
#pragma unroll
    for (int d0 = 0; d0 < NK16; ++d0) {
        const bf16x8 b0 = *reinterpret_cast<const bf16x8*>(kb + d0 * 2 * CS), b1 = *reinterpret_cast<const bf16x8*>(kb + d0 * 2 * CS + 32 * RS);
        p0 = __builtin_amdgcn_mfma_f32_32x32x16_bf16(b0, qr[d0], p0, 0, 0, 0);
        p1 = __builtin_amdgcn_mfma_f32_32x32x16_bf16(b1, qr[d0], p1, 0, 0, 0); }
}

template <int NK16, int RS, int CS> __device__ __forceinline__ void qkt_c(f32x16& p0, f32x16& p1, const f32x16& c, const char* Ks, const bf16x8* qr, int r32, int hi) {
    const char* kb = Ks + hi * CS + r32 * RS;
    { const bf16x8 b0 = *reinterpret_cast<const bf16x8*>(kb), b1 = *reinterpret_cast<const bf16x8*>(kb + 32 * RS);
      p0 = __builtin_amdgcn_mfma_f32_32x32x16_bf16(b0, qr[0], c, 0, 0, 0);
      p1 = __builtin_amdgcn_mfma_f32_32x32x16_bf16(b1, qr[0], c, 0, 0, 0); }
#pragma unroll
    for (int d0 = 1; d0 < NK16; ++d0) {
        const bf16x8 b0 = *reinterpret_cast<const bf16x8*>(kb + d0 * 2 * CS), b1 = *reinterpret_cast<const bf16x8*>(kb + d0 * 2 * CS + 32 * RS);
        p0 = __builtin_amdgcn_mfma_f32_32x32x16_bf16(b0, qr[d0], p0, 0, 0, 0);
        p1 = __builtin_amdgcn_mfma_f32_32x32x16_bf16(b1, qr[d0], p1, 0, 0, 0); }
}
__device__ __forceinline__ float max3f(float a, float b, float c) { float r; asm("v_max3_f32 %0, %1, %2, %3" : "=v"(r) : "v"(a), "v"(b), "v"(c)); return r; }

namespace mla {
constexpr int NTILE = SEQ / 64;
constexpr int KPITCH = 400, KSLOT = 64 * KPITCH  , NSLOT = 4;
constexpr int LDS_K = 0, LDS_WS = NSLOT * KSLOT, LDS_BYTES = LDS_WS + 8 * 256;
constexpr int OST_PITCH = 272, OST_WAVE = 32 * OST_PITCH;
static_assert(8 * OST_WAVE <= NSLOT * KSLOT, "o_lat staging fits the ring");
#ifndef MLA_XVALU
#define MLA_XVALU 0
#endif
constexpr float THR = 8.f;
template <bool FIRST> __device__ __forceinline__ void partialSM(f32x16& p0, f32x16& p1, f32x16& negm, float& alpha) {
    float a = max3f(p0[0], p0[1], p0[2]), b = max3f(p0[9], p0[10], p0[11]), c = max3f(p1[0], p1[1], p1[2]), e = max3f(p1[9], p1[10], p1[11]);
    a = max3f(a, p0[3], p0[4]); b = max3f(b, p0[12], p0[13]); c = max3f(c, p1[3], p1[4]); e = max3f(e, p1[12], p1[13]);
    a = max3f(a, p0[5], p0[6]); b = max3f(b, p0[14], p0[15]); c = max3f(c, p1[5], p1[6]); e = max3f(e, p1[14], p1[15]);
    a = max3f(a, p0[7], p0[8]); c = max3f(c, p1[7], p1[8]);
    float pmax = max3f(a, b, c);
    pmax = max3f(pmax, e, e);
    { auto rr = __builtin_amdgcn_permlane32_swap(__float_as_uint(pmax), __float_as_uint(pmax), false, false); pmax = max3f(__uint_as_float(rr[0]), __uint_as_float(rr[1]), __uint_as_float(rr[1])); }
    alpha = 1.f;
    if (FIRST || !__builtin_expect(__all(pmax <= THR), 1)) {
        const float dl = FIRST ? pmax : fmaxf(pmax, 0.f);
        if (!FIRST) alpha = __builtin_amdgcn_exp2f(-dl);
#pragma unroll
        for (int r = 0; r < 16; ++r) { p0[r] -= dl; p1[r] -= dl; negm[r] -= dl; }
        asm volatile("" : "+v"(negm));
    }
#pragma unroll
    for (int r = 0; r < 16; ++r) p0[r] = __builtin_amdgcn_exp2f(p0[r]);
}
__device__ __forceinline__ void finishSM(f32x16& p0, f32x16& p1, float alpha, float& l_reg, bf16x8& pa0, bf16x8& pa1, bf16x8& pa2, bf16x8& pa3) {
#pragma unroll
    for (int r = 0; r < 16; ++r) p1[r] = __builtin_amdgcn_exp2f(p1[r]);
    float s0 = p0[0] + p0[1], s1 = p0[2] + p0[3], s2 = p1[0] + p1[1], s3 = p1[2] + p1[3];
#pragma unroll
    for (int r = 4; r < 16; r += 4) { s0 += p0[r]; s0 += p0[r + 1]; s1 += p0[r + 2]; s1 += p0[r + 3]; s2 += p1[r]; s2 += p1[r + 1]; s3 += p1[r + 2]; s3 += p1[r + 3]; }
    float ps = (s0 + s1) + (s2 + s3);
    ps = half_sum(ps);
    l_reg = l_reg * alpha + ps;
#if MLA_OT
#define MLA_PK(P, B) (u32x4){cvtpk(P[B], P[B + 1]), cvtpk(P[B + 2], P[B + 3]), cvtpk(P[B + 4], P[B + 5]), cvtpk(P[B + 6], P[B + 7])}
    { u32x4 w0 = MLA_PK(p0, 0), w1 = MLA_PK(p0, 8), w2 = MLA_PK(p1, 0), w3 = MLA_PK(p1, 8);
      pa0 = *reinterpret_cast<bf16x8*>(&w0); pa1 = *reinterpret_cast<bf16x8*>(&w1); pa2 = *reinterpret_cast<bf16x8*>(&w2); pa3 = *reinterpret_cast<bf16x8*>(&w3); }
#undef MLA_PK
#else
    pack_p(p0, p1, pa0, pa1, pa2, pa3);
#endif
}
__device__ __forceinline__ int v_rm_base(int lane) { return (8 * (lane >> 5) + ((lane >> 2) & 3)) * KPITCH + 32 * ((lane >> 4) & 1) + 8 * (lane & 3); }
template <int D0> __device__ __forceinline__ void pvr_issue(PvFrag& f, int vb) {
    constexpr int KS = 16 * KPITCH, HF = 4 * KPITCH;
    f.l0 = tr_read<D0 * 64 + 0 * KS>(vb); f.h0 = tr_read<D0 * 64 + 0 * KS + HF>(vb); f.l1 = tr_read<D0 * 64 + 1 * KS>(vb); f.h1 = tr_read<D0 * 64 + 1 * KS + HF>(vb);
    f.l2 = tr_read<D0 * 64 + 2 * KS>(vb); f.h2 = tr_read<D0 * 64 + 2 * KS + HF>(vb); f.l3 = tr_read<D0 * 64 + 3 * KS>(vb); f.h3 = tr_read<D0 * 64 + 3 * KS + HF>(vb);
}
template <int D0> __device__ __forceinline__ void pvr_one(f32x16& od, int vb, bf16x8 pa0, bf16x8 pa1, bf16x8 pa2, bf16x8 pa3) { PvFrag f; pvr_issue<D0>(f, vb); pv_mma(od, f, pa0, pa1, pa2, pa3); }
#if MLA_OT
__device__ __forceinline__ int vt_rm_base(int lane) { return (4 * (lane >> 5) + ((lane >> 2) & 3)) * KPITCH + 32 * ((lane >> 4) & 1) + 8 * (lane & 3); }
template <int D0> __device__ __forceinline__ void pvt_issue(PvFrag& f, int vb) {
    constexpr int KS = 16 * KPITCH, HF = 8 * KPITCH;
    f.l0 = tr_read<D0 * 64 + 0 * KS>(vb); f.h0 = tr_read<D0 * 64 + 0 * KS + HF>(vb); f.l1 = tr_read<D0 * 64 + 1 * KS>(vb); f.h1 = tr_read<D0 * 64 + 1 * KS + HF>(vb);
    f.l2 = tr_read<D0 * 64 + 2 * KS>(vb); f.h2 = tr_read<D0 * 64 + 2 * KS + HF>(vb); f.l3 = tr_read<D0 * 64 + 3 * KS>(vb); f.h3 = tr_read<D0 * 64 + 3 * KS + HF>(vb);
}
__device__ __forceinline__ void pvt_mma(f32x16& od, const PvFrag& f, bf16x8 pa0, bf16x8 pa1, bf16x8 pa2, bf16x8 pa3) {
    asm volatile("s_waitcnt lgkmcnt(0)" ::: "memory"); SBAR();
#define PK(L, H) (bf16x8){L[0], L[1], L[2], L[3], H[0], H[1], H[2], H[3]}
    od = __builtin_amdgcn_mfma_f32_32x32x16_bf16(PK(f.l0, f.h0), pa0, od, 0, 0, 0);
    od = __builtin_amdgcn_mfma_f32_32x32x16_bf16(PK(f.l1, f.h1), pa1, od, 0, 0, 0);
    od = __builtin_amdgcn_mfma_f32_32x32x16_bf16(PK(f.l2, f.h2), pa2, od, 0, 0, 0);
    od = __builtin_amdgcn_mfma_f32_32x32x16_bf16(PK(f.l3, f.h3), pa3, od, 0, 0, 0);
#undef PK
}
template <int D0> __device__ __forceinline__ void pvt_one(f32x16& od, int vb, bf16x8 pa0, bf16x8 pa1, bf16x8 pa2, bf16x8 pa3) { PvFrag f; pvt_issue<D0>(f, vb); pvt_mma(od, f, pa0, pa1, pa2, pa3); }
#define MLA_PV_ISSUE pvt_issue
#define MLA_PV_MMA pvt_mma
#define MLA_PV_ONE pvt_one
#define MLA_V_BASE vt_rm_base
#else
#define MLA_PV_ISSUE pvr_issue
#define MLA_PV_MMA pv_mma
#define MLA_PV_ONE pvr_one
#define MLA_V_BASE v_rm_base
#endif
struct Tensors { const bf16_t* QA; const bf16_t* KL; const bf16_t* WV; const bf16_t* GA; const bf16_t* OB; bf16_t* MIX; };
__device__ __forceinline__ void unit(int b, int h, int qb, const Tensors& T, char* shm, const int wave_id) {
    const int lane = pg8::lane_id_fresh(), wid = wave_id, r32 = lane & 31, hi = lane >> 5;
    const long rowbase = (long)b * SEQ; const int q0 = qb * 256;
    const unsigned lds0 = (unsigned)(uintptr_t)shm;
    float* wsf = (float*)(shm + LDS_WS) + wid * 64; float* al_l = wsf; float* li_l = wsf + 32;
    const char* klb = (const char*)(T.KL + rowbase * 192);
    unsigned koff0, koff1, koff2;
    { int s = 64 * wid + lane, row = s / 25, pos = s - 25 * row; koff0 = (unsigned)(row * 384 + (pos < 24 ? pos : 23) * 16);
      s += 512; row = s / 25; pos = s - 25 * row; koff1 = (unsigned)(row * 384 + (pos < 24 ? pos : 23) * 16);
      s += 512; row = s / 25; pos = s - 25 * row; koff2 = (unsigned)(row * 384 + (pos < 24 ? pos : 23) * 16); }
#define MLA_DMA(t) do { const unsigned kd_ = (unsigned)__builtin_amdgcn_readfirstlane(lds0 + LDS_K + ((t) & 3) * KSLOT + wid * 1024); const char* kb_ = klb + (size_t)(t) * 24576; \
        glds16s<0>(kb_, koff0, kd_); glds16s<0>(kb_, koff1, kd_ + 8192); glds16s<0>(kb_, koff2, kd_ + 16384); \
        if (wid == 0) { const int s_ = 1536 + lane, row_ = 61 + (lane >= 14) + (lane >= 39), pos_ = s_ - 25 * row_; glds16s<0>(kb_, (unsigned)(row_ * 384 + (pos_ < 24 ? pos_ : 23) * 16), kd_ + 24576); } } while (0)
    MLA_DMA(0); MLA_DMA(1);
    bf16x8 qr[12];
    { const bf16_t* Qw = T.QA + (rowbase + q0 + wid * 32 + r32) * 1536 + h * 192 + hi * 8;
#pragma unroll
      for (int d0 = 0; d0 < 12; ++d0) qr[d0] = *reinterpret_cast<const bf16x8*>(Qw + d0 * 16); }
    const int vb0 = (int)(lds0 + LDS_K) + MLA_V_BASE(lane);
    float l_reg = 0.f; f32x16 o[4] = {};
    f32x16 negm = {}; asm volatile("" : "+v"(negm));
    f32x16 pA0, pA1, pB0, pB1; float alA, alB; bf16x8 pa0, pa1, pa2, pa3;
#if MLA_OT
#define MLA_RESC(a) do { if (__any((a) < 1.f)) { _Pragma("unroll") for (int d = 0; d < 4; ++d) _Pragma("unroll") for (int r = 0; r < 16; ++r) o[d][r] *= (a); } } while (0)
#else
#define MLA_RESC(a) do { if (__any((a) < 1.f)) { if (hi == 0) al_l[r32] = (a); asm volatile("s_waitcnt lgkmcnt(0)" ::: "memory"); \
        _Pragma("unroll") for (int d = 0; d < 4; ++d) _Pragma("unroll") for (int r = 0; r < 16; ++r) o[d][r] *= al_l[crow(r, hi)]; } } while (0)
#endif
#define ATT_BAR_L() asm volatile("s_waitcnt lgkmcnt(0)\n\ts_barrier" ::: "memory")
    ATT_WAIT_BAR(0);
    if (wid >= 4) ATT_BAR_L();
    qkt<12, KPITCH, 16>(pA0, pA1, shm + LDS_K, qr, r32, hi); ATT_WAIT_BAR(0);
    MLA_DMA(2); partialSM<true>(pA0, pA1, negm, alA); ATT_BAR_L();
#define MLA_STEP(C0, C1, P0, P1, alC, alP, t, HASN) do { \
        qkt_c<12, KPITCH, 16>(C0, C1, negm, shm + LDS_K + ((t) & 3) * KSLOT, qr, r32, hi); \
        finishSM(P0, P1, alP, l_reg, pa0, pa1, pa2, pa3); if (MLA_XVALU) { float d0_ = alP, d1_ = l_reg, d2_ = alP, d3_ = alC; _Pragma("unroll") for (int i_ = 0; i_ < 4; ++i_) { d0_ = __builtin_amdgcn_exp2f(d0_); d1_ = __builtin_amdgcn_exp2f(d1_); d2_ = __builtin_amdgcn_exp2f(d2_); d3_ = __builtin_amdgcn_exp2f(d3_); asm volatile("" : "+v"(d0_), "+v"(d1_), "+v"(d2_), "+v"(d3_)); } asm volatile("" :: "v"(d0_), "v"(d1_), "v"(d2_), "v"(d3_)); } SBAR(); ATT_WAIT_BAR(0); \
        { const int vb_ = vb0 + (((t) - 1) & 3) * KSLOT; PvFrag f0_; MLA_PV_ISSUE<0>(f0_, vb_);                  \
          if (HASN) { MLA_DMA((t) + 2); } \
          MLA_PV_MMA(o[0], f0_, pa0, pa1, pa2, pa3); MLA_PV_ONE<1>(o[1], vb_, pa0, pa1, pa2, pa3); MLA_PV_ONE<2>(o[2], vb_, pa0, pa1, pa2, pa3); MLA_PV_ONE<3>(o[3], vb_, pa0, pa1, pa2, pa3); } \
        partialSM<false>(C0, C1, negm, alC); \
        ATT_BAR_L(); MLA_RESC(alC); } while (0)
    for (int t = 1; t + 1 < NTILE; t += 2) {
        MLA_STEP(pB0, pB1, pA0, pA1, alB, alA, t, true);
        MLA_STEP(pA0, pA1, pB0, pB1, alA, alB, t + 1, (t + 3 < NTILE));
    }
    { qkt_c<12, KPITCH, 16>(pB0, pB1, negm, shm + LDS_K + ((NTILE - 1) & 3) * KSLOT, qr, r32, hi);
      finishSM(pA0, pA1, alA, l_reg, pa0, pa1, pa2, pa3); SBAR(); ATT_WAIT_BAR(0);
      { const int vb_ = vb0 + ((NTILE - 2) & 3) * KSLOT; MLA_PV_ONE<0>(o[0], vb_, pa0, pa1, pa2, pa3); MLA_PV_ONE<1>(o[1], vb_, pa0, pa1, pa2, pa3); MLA_PV_ONE<2>(o[2], vb_, pa0, pa1, pa2, pa3); MLA_PV_ONE<3>(o[3], vb_, pa0, pa1, pa2, pa3); }
      partialSM<false>(pB0, pB1, negm, alB);
      ATT_BAR_L(); MLA_RESC(alB);
      finishSM(pB0, pB1, alB, l_reg, pa0, pa1, pa2, pa3); SBAR();
      { const int vb_ = vb0 + ((NTILE - 1) & 3) * KSLOT; MLA_PV_ONE<0>(o[0], vb_, pa0, pa1, pa2, pa3); MLA_PV_ONE<1>(o[1], vb_, pa0, pa1, pa2, pa3); MLA_PV_ONE<2>(o[2], vb_, pa0, pa1, pa2, pa3); MLA_PV_ONE<3>(o[3], vb_, pa0, pa1, pa2, pa3); } }
    if (wid < 4) ATT_BAR_L();
#if MLA_OT
    { const float rl = __builtin_amdgcn_rcpf(l_reg);
      bf16x8 pb[8];
#pragma unroll
      for (int ks = 0; ks < 8; ++ks) { const int bl = ks >> 1, b8 = (ks & 1) * 8;
          u32x4 w = {cvtpk(o[bl][b8 + 0] * rl, o[bl][b8 + 1] * rl), cvtpk(o[bl][b8 + 2] * rl, o[bl][b8 + 3] * rl), cvtpk(o[bl][b8 + 4] * rl, o[bl][b8 + 5] * rl), cvtpk(o[bl][b8 + 6] * rl, o[bl][b8 + 7] * rl)};
          pb[ks] = *reinterpret_cast<bf16x8*>(&w); }
      const bf16_t* wv = T.WV + ((size_t)(h * 128 + r32) * 128 + hi * 8);
      const size_t rowoff = (size_t)(rowbase + q0 + wid * 32 + r32) * 1024 + h * 128 + 4 * hi;
#pragma unroll
      for (int db = 0; db < 4; ++db) { f32x16 oa = f32x16{};
#pragma unroll
          for (int ks = 0; ks < 8; ++ks) { const bf16x8 bw = *reinterpret_cast<const bf16x8*>(wv + (size_t)db * 32 * 128 + ks * 16);
              oa = __builtin_amdgcn_mfma_f32_32x32x16_bf16(bw, pb[ks], oa, 0, 0, 0); }
#pragma unroll
          for (int g = 0; g < 4; ++g) { const size_t off = rowoff + db * 32 + 8 * g;
              const pg8::u32x2 ga = *reinterpret_cast<const pg8::u32x2*>(T.GA + off), ob = *reinterpret_cast<const pg8::u32x2*>(T.OB + off);
              const float v0 = oa[4 * g + 0] * __uint_as_float(ga.x << 16) + __uint_as_float(ob.x << 16), v1 = oa[4 * g + 1] * __uint_as_float(ga.x & 0xffff0000u) + __uint_as_float(ob.x & 0xffff0000u);
              const float v2 = oa[4 * g + 2] * __uint_as_float(ga.y << 16) + __uint_as_float(ob.y << 16), v3 = oa[4 * g + 3] * __uint_as_float(ga.y & 0xffff0000u) + __uint_as_float(ob.y & 0xffff0000u);
              pg8::u32x2 w; w.x = cvtpk(v0, v1); w.y = cvtpk(v2, v3); *reinterpret_cast<pg8::u32x2*>(T.MIX + off) = w; } } }
#else
    if (hi == 0) li_l[r32] = l_reg; asm volatile("s_waitcnt lgkmcnt(0)" ::: "memory");
    ATT_BAR_L();
    { char* stg = shm + LDS_K + wid * OST_WAVE;
#if MLA_OT
#pragma unroll
      for (int r = 0; r < 16; ++r) { const float rl = __builtin_amdgcn_rcpf(l_reg);
#pragma unroll
          for (int d0 = 0; d0 < 4; ++d0) *(bf16_t*)(stg + r32 * OST_PITCH + (d0 * 32 + crow(r, hi)) * 2) = f2bf(o[d0][r] * rl); }
#else
#pragma unroll
      for (int r = 0; r < 16; ++r) { const float rl = __builtin_amdgcn_rcpf(li_l[crow(r, hi)]);
#pragma unroll
          for (int d0 = 0; d0 < 4; ++d0) *(bf16_t*)(stg + crow(r, hi) * OST_PITCH + (d0 * 32 + r32) * 2) = f2bf(o[d0][r] * rl); }
#endif
      asm volatile("s_waitcnt lgkmcnt(0)" ::: "memory");
      bf16x8 af[8];
#pragma unroll
      for (int ks = 0; ks < 8; ++ks) af[ks] = *reinterpret_cast<const bf16x8*>(stg + r32 * OST_PITCH + ks * 32 + hi * 16);
      const bf16_t* wv = T.WV + ((size_t)(h * 128 + r32) * 128 + hi * 8);
#pragma unroll
      for (int d0 = 0; d0 < 4; ++d0) { o[d0] = f32x16{};
#pragma unroll
          for (int ks = 0; ks < 8; ++ks) { const bf16x8 bw = *reinterpret_cast<const bf16x8*>(wv + (size_t)d0 * 32 * 128 + ks * 16);
              o[d0] = __builtin_amdgcn_mfma_f32_32x32x16_bf16(af[ks], bw, o[d0], 0, 0, 0); } } }
    const long orow0 = rowbase + q0 + wid * 32;
#pragma unroll
    for (int r = 0; r < 16; ++r) { const long off = (orow0 + crow(r, hi)) * 1024 + h * 128 + r32;
#pragma unroll
        for (int d0 = 0; d0 < 4; ++d0) { const float v = o[d0][r] * bf2f(T.GA[off + d0 * 32]) + bf2f(T.OB[off + d0 * 32]); T.MIX[off + d0 * 32] = f2bf(v); } }
#endif
    asm volatile("s_waitcnt lgkmcnt(0)\n\ts_barrier" ::: "memory");
#undef MLA_DMA
#undef MLA_RESC
#undef ATT_BAR_L
#undef MLA_STEP
#undef MLA_PV_ISSUE
#undef MLA_PV_MMA
#undef MLA_PV_ONE
#undef MLA_V_BASE
}
}

namespace mla2 {
using mla::NTILE; using mla::KPITCH; using mla::KSLOT; using mla::THR; using mla::OST_PITCH; using mla::OST_WAVE;
constexpr int NSLOT = 3;
constexpr int LDS_K = 0, LDS_P = NSLOT * KSLOT  , LDS_X = LDS_P + 65536  , LDS_BYTES = LDS_X + 4096;
static_assert(8 * OST_WAVE <= NSLOT * KSLOT, "o_lat staging fits the ring");
using mla::Tensors;
__device__ __forceinline__ void softmax_block(f32x16& p0, f32x16& p1, float& m_reg, float& l_reg, float& alpha, bf16x8& pa0, bf16x8& pa1, bf16x8& pa2, bf16x8& pa3) {
    float pm0 = fmaxf(p0[0], p0[1]), pm1 = fmaxf(p0[2], p0[3]), pm2 = fmaxf(p1[0], p1[1]), pm3 = fmaxf(p1[2], p1[3]);
#pragma unroll
    for (int r = 4; r < 16; r += 4) { pm0 = fmaxf(fmaxf(pm0, p0[r]), p0[r + 1]); pm1 = fmaxf(fmaxf(pm1, p0[r + 2]), p0[r + 3]); pm2 = fmaxf(fmaxf(pm2, p1[r]), p1[r + 1]); pm3 = fmaxf(fmaxf(pm3, p1[r + 2]), p1[r + 3]); }
    const float pmax = half_max(fmaxf(fmaxf(pm0, pm1), fmaxf(pm2, pm3)));
    const bool keep = __all(pmax - m_reg <= THR);
    const float mn = keep ? m_reg : fmaxf(m_reg, pmax); alpha = __builtin_amdgcn_exp2f(m_reg - mn); m_reg = mn;
#pragma unroll
    for (int r = 0; r < 16; ++r) { p0[r] = __builtin_amdgcn_exp2f(p0[r] - mn); p1[r] = __builtin_amdgcn_exp2f(p1[r] - mn); }
    float s0 = p0[0] + p0[1], s1 = p0[2] + p0[3], s2 = p1[0] + p1[1], s3 = p1[2] + p1[3];
#pragma unroll
    for (int r = 4; r < 16; r += 4) { s0 += p0[r]; s0 += p0[r + 1]; s1 += p0[r + 2]; s1 += p0[r + 3]; s2 += p1[r]; s2 += p1[r + 1]; s3 += p1[r + 2]; s3 += p1[r + 3]; }
    l_reg = l_reg * alpha + half_sum((s0 + s1) + (s2 + s3));
    pack_p(p0, p1, pa0, pa1, pa2, pa3);
}
__device__ __forceinline__ void out_block(const char* stg, const Tensors& T, int h, long orow0, int r32, int hi) {
    bf16x8 af[8];
#pragma unroll
    for (int ks = 0; ks < 8; ++ks) af[ks] = *reinterpret_cast<const bf16x8*>(stg + r32 * OST_PITCH + ks * 32 + hi * 16);
    const bf16_t* wv = T.WV + ((size_t)(h * 128 + r32) * 128 + hi * 8);
    f32x16 oa[4];
#pragma unroll
    for (int d0 = 0; d0 < 4; ++d0) { oa[d0] = f32x16{};
#pragma unroll
        for (int ks = 0; ks < 8; ++ks) { const bf16x8 bw = *reinterpret_cast<const bf16x8*>(wv + (size_t)d0 * 32 * 128 + ks * 16);
            oa[d0] = __builtin_amdgcn_mfma_f32_32x32x16_bf16(af[ks], bw, oa[d0], 0, 0, 0); } }
#pragma unroll
    for (int r = 0; r < 16; ++r) { const long off = (orow0 + crow(r, hi)) * 1024 + h * 128 + r32;
#pragma unroll
        for (int d0 = 0; d0 < 4; ++d0) { const float v = oa[d0][r] * bf2f(T.GA[off + d0 * 32]) + bf2f(T.OB[off + d0 * 32]); T.MIX[off + d0 * 32] = f2bf(v); } }
}
__device__ __forceinline__ void unit(int b, int h, int qb, const Tensors& T, char* shm, const int wave_id) {
    const int lane = pg8::lane_id_fresh(), wid = wave_id, r32 = lane & 31, hi = lane >> 5;
    const bool is_qk = wid < 4; const int pair = wid & 3;
    const long rowbase = (long)b * SEQ; const int q0 = qb * 256;
    const unsigned lds0 = (unsigned)(uintptr_t)shm;
    char* Pp = shm + LDS_P + pair * 8192; char* Xp = shm + LDS_X + pair * 1024;
    float* alx = (float*)Xp; float* lx = (float*)(Xp + 512); unsigned* fx = (unsigned*)(Xp + 768);
#define M2_BAR() asm volatile("s_waitcnt vmcnt(0) lgkmcnt(0)\n\ts_barrier" ::: "memory")
    const char* klb = (const char*)(T.KL + rowbase * 192);
#define M2_PIECE(kb_, p_, dst_) do { const int s_ = 64 * (p_) + lane, row_ = (s_ * 1311) >> 15, pos_ = s_ - 25 * row_; \
        glds16s<0>(kb_, (unsigned)(row_ * 384 + (pos_ < 24 ? pos_ : 23) * 16), (unsigned)__builtin_amdgcn_readfirstlane(dst_ + (p_) * 1024)); } while (0)
#define M2_DMA(t) do { const unsigned sd_ = lds0 + LDS_K + ((t) % 3) * KSLOT; const char* kb_ = klb + (size_t)(t) * 24576; \
        _Pragma("unroll") for (int i_ = 0; i_ < 6; ++i_) M2_PIECE(kb_, pair + 4 * i_, sd_); if (pair == 0) M2_PIECE(kb_, 24, sd_); } while (0)
    const int vb0 = (int)(lds0 + LDS_K) + mla::v_rm_base(lane);
#define M2_BAR_L() asm volatile("s_waitcnt lgkmcnt(0)\n\ts_barrier" ::: "memory")
    if (is_qk) {
        bf16x8 qA[12], qB[12]; float mA = -1e30f, mB = -1e30f, lA = 0.f, lB = 0.f;
        { const bf16_t* Qw = T.QA + (rowbase + q0 + pair * 64 + r32) * 1536 + h * 192 + hi * 8;
#pragma unroll
          for (int d0 = 0; d0 < 12; ++d0) { qA[d0] = *reinterpret_cast<const bf16x8*>(Qw + d0 * 16); qB[d0] = *reinterpret_cast<const bf16x8*>(Qw + 32 * 1536 + d0 * 16); } }
        f32x16 pA0, pA1, pB0, pB1;
        char* pw = Pp + lane * 16;
#define M2_QK(P0, P1, Q, t) do { P0 = f32x16{}; P1 = f32x16{}; const char* kb_ = shm + LDS_K + ((t) % 3) * KSLOT + hi * 16 + r32 * KPITCH; \
        _Pragma("unroll") for (int d0 = 0; d0 < 12; ++d0) { const bf16x8 b0_ = *reinterpret_cast<const bf16x8*>(kb_ + d0 * 32), b1_ = *reinterpret_cast<const bf16x8*>(kb_ + d0 * 32 + 32 * KPITCH); \
            P0 = __builtin_amdgcn_mfma_f32_32x32x16_bf16(b0_, Q[d0], P0, 0, 0, 0); P1 = __builtin_amdgcn_mfma_f32_32x32x16_bf16(b1_, Q[d0], P1, 0, 0, 0); } } while (0)
#define M2_SM(P0, P1, M, L, BLK) do { bf16x8 a0_, a1_, a2_, a3_; float al_; softmax_block(P0, P1, M, L, al_, a0_, a1_, a2_, a3_); \
        *reinterpret_cast<bf16x8*>(pw + (BLK) * 4096) = a0_; *reinterpret_cast<bf16x8*>(pw + (BLK) * 4096 + 1024) = a1_; *reinterpret_cast<bf16x8*>(pw + (BLK) * 4096 + 2048) = a2_; *reinterpret_cast<bf16x8*>(pw + (BLK) * 4096 + 3072) = a3_; \
        const bool f_ = __any(al_ < 1.f); if (hi == 0) alx[(BLK) * 32 + r32] = al_; if (lane == 0) fx[BLK] = f_ ? 1u : 0u; } while (0)
        M2_BAR();
        M2_QK(pA0, pA1, qA, 0); M2_BAR_L();
        M2_QK(pB0, pB1, qB, 0); M2_SM(pA0, pA1, mA, lA, 0); M2_BAR_L();
        for (int t = 1; t < NTILE; ++t) {
            M2_QK(pA0, pA1, qA, t); M2_SM(pB0, pB1, mB, lB, 1); M2_BAR_L();
            M2_QK(pB0, pB1, qB, t); M2_SM(pA0, pA1, mA, lA, 0); M2_BAR_L();
        }
        M2_SM(pB0, pB1, mB, lB, 1); M2_BAR_L();
        M2_BAR_L();
        if (hi == 0) { lx[r32] = lA; lx[32 + r32] = lB; }
        M2_BAR();
        M2_BAR();
#undef M2_QK
#undef M2_SM
    } else {
        f32x16 oA[4] = {}, oB[4] = {};
        const char* pr = Pp + lane * 16;
#define M2_PVB(O, BLK, t1) do { const int vb_ = vb0 + ((t1) % 3) * KSLOT; \
        const bf16x8 a0_ = *reinterpret_cast<const bf16x8*>(pr + (BLK) * 4096), a1_ = *reinterpret_cast<const bf16x8*>(pr + (BLK) * 4096 + 1024), a2_ = *reinterpret_cast<const bf16x8*>(pr + (BLK) * 4096 + 2048), a3_ = *reinterpret_cast<const bf16x8*>(pr + (BLK) * 4096 + 3072); \
        if (fx[BLK] != 0u) { _Pragma("unroll") for (int d = 0; d < 4; ++d) _Pragma("unroll") for (int r = 0; r < 16; ++r) O[d][r] *= alx[(BLK) * 32 + crow(r, hi)]; } \
        mla::pvr_one<0>(O[0], vb_, a0_, a1_, a2_, a3_); mla::pvr_one<1>(O[1], vb_, a0_, a1_, a2_, a3_); mla::pvr_one<2>(O[2], vb_, a0_, a1_, a2_, a3_); mla::pvr_one<3>(O[3], vb_, a0_, a1_, a2_, a3_); } while (0)
        M2_DMA(0);
        M2_BAR();
        M2_DMA(1); M2_BAR_L();
        M2_BAR();
        for (int t = 1; t < NTILE; ++t) {
            if (t + 1 < NTILE) M2_DMA(t + 1);
            M2_PVB(oA, 0, t - 1); M2_BAR_L();
            M2_PVB(oB, 1, t - 1); M2_BAR();
        }
        M2_PVB(oA, 0, NTILE - 1); M2_BAR_L();
        M2_PVB(oB, 1, NTILE - 1); M2_BAR_L();
#undef M2_PVB
        M2_BAR();
        { char* stgA = shm + LDS_K + (2 * pair) * OST_WAVE; char* stgB = stgA + OST_WAVE;
#pragma unroll
          for (int r = 0; r < 16; ++r) { const float ra = __builtin_amdgcn_rcpf(lx[crow(r, hi)]), rb = __builtin_amdgcn_rcpf(lx[32 + crow(r, hi)]);
#pragma unroll
              for (int d0 = 0; d0 < 4; ++d0) { *(bf16_t*)(stgA + crow(r, hi) * OST_PITCH + (d0 * 32 + r32) * 2) = f2bf(oA[d0][r] * ra); *(bf16_t*)(stgB + crow(r, hi) * OST_PITCH + (d0 * 32 + r32) * 2) = f2bf(oB[d0][r] * rb); } } }
        M2_BAR();
    }
#undef M2_BAR_L
    { const char* stg = shm + LDS_K + (2 * pair + (is_qk ? 1 : 0)) * OST_WAVE;
      out_block(stg, T, h, rowbase + q0 + pair * 64 + (is_qk ? 32 : 0), r32, hi); }
    asm volatile("s_waitcnt lgkmcnt(0)\n\ts_barrier" ::: "memory");
#undef M2_BAR
#undef M2_PIECE
#undef M2_DMA
}
}

namespace swa {
constexpr int KP = 144  , KT = 64 * KP  ;
constexpr int LDS_K = 0, LDS_V = 5 * KT, LDS_TAB = LDS_V + 5 * 8192, LDS_WS = LDS_TAB + 4 * 384 * 4, LDS_BYTES = LDS_WS + 8 * 256;
struct Tensors { const bf16_t* QB; const bf16_t* KB; const bf16_t* VB; bf16_t* GOB; const float* BT2; const float* SINK2; };
__device__ __forceinline__ int vt_base64(int lane) { return ((lane & 3) << 3) | (((lane >> 2) & 3) << 6) | (((lane >> 4) & 1) << 5) | ((lane >> 5) << 10); }
template <int D0> __device__ __forceinline__ void pvt64(f32x16& od, int vb, bf16x8 pa0, bf16x8 pa1, bf16x8 pa2, bf16x8 pa3) {
    const s16x4 l0 = tr_read<D0 * 512 + 0 * 2048>(vb), h0 = tr_read<D0 * 512 + 0 * 2048 + 256>(vb), l1 = tr_read<D0 * 512 + 1 * 2048>(vb), h1 = tr_read<D0 * 512 + 1 * 2048 + 256>(vb);
    const s16x4 l2 = tr_read<D0 * 512 + 2 * 2048>(vb), h2 = tr_read<D0 * 512 + 2 * 2048 + 256>(vb), l3 = tr_read<D0 * 512 + 3 * 2048>(vb), h3 = tr_read<D0 * 512 + 3 * 2048 + 256>(vb);
    asm volatile("s_waitcnt lgkmcnt(0)" ::: "memory"); SBAR();
#define PK(L, H) (bf16x8){L[0], L[1], L[2], L[3], H[0], H[1], H[2], H[3]}
    od = __builtin_amdgcn_mfma_f32_32x32x16_bf16(PK(l0, h0), pa0, od, 0, 0, 0);
    od = __builtin_amdgcn_mfma_f32_32x32x16_bf16(PK(l1, h1), pa1, od, 0, 0, 0);
    od = __builtin_amdgcn_mfma_f32_32x32x16_bf16(PK(l2, h2), pa2, od, 0, 0, 0);
    od = __builtin_amdgcn_mfma_f32_32x32x16_bf16(PK(l3, h3), pa3, od, 0, 0, 0);
#undef PK
}
__device__ __forceinline__ void unit(int b, int kvh, int qblk, const Tensors& T, char* shm, const int wave_id) {
    const int lane = pg8::lane_id_fresh(), wid = wave_id, tid = wid * 64 + lane, r32 = lane & 31, hi = lane >> 5;
    const int g = wid >> 1, rh = wid & 1, head = kvh * 4 + g;
    const long rowbase = (long)b * SEQ; const int q0 = qblk * 64;
    const unsigned lds0 = (unsigned)(uintptr_t)shm;
    float* wsf = (float*)(shm + LDS_WS) + wid * 64; float* al_l = wsf; float* li_l = wsf + 32;
    const int t_lo = (q0 < 128) ? (128 - q0) / 64 : 0, t_hi = (SEQ - (q0 - 128)) / 64 < 5 ? (SEQ - (q0 - 128)) / 64 : 5;
    { const int st = 2 * wid + (lane >> 5), kk = (st >> 1) * 8 + ((lane & 31) >> 2), k = swap23(kk), c = (st & 1) * 32 + (lane & 3) * 8;
      const unsigned vvoff = (unsigned)((k * 256 + c) * 2);
      unsigned kvoff, kvoff8; { int s = 64 * wid + lane, row = s / 9, pos = s - 9 * row; kvoff = (unsigned)(row * 512 + (pos < 8 ? pos : 7) * 16); s = 512 + lane; row = s / 9; pos = s - 9 * row; kvoff8 = (unsigned)(row * 512 + (pos < 8 ? pos : 7) * 16); }
      for (int t = t_lo; t < t_hi; ++t) { const long kb = rowbase + q0 - 128 + 64 * t;
          glds16s<0>((const char*)(T.KB + kb * 256 + kvh * 64), kvoff, (unsigned)__builtin_amdgcn_readfirstlane(lds0 + LDS_K + t * KT + wid * 1024));
          if (wid == 0) glds16s<0>((const char*)(T.KB + kb * 256 + kvh * 64), kvoff8, (unsigned)__builtin_amdgcn_readfirstlane(lds0 + LDS_K + t * KT + 8192));
          glds16s<0>((const char*)(T.VB + kb * 256 + kvh * 64), vvoff, (unsigned)__builtin_amdgcn_readfirstlane(lds0 + LDS_V + t * 8192 + wid * 1024)); } }
    { float* tab = (float*)(shm + LDS_TAB);
      for (int i = tid; i < 4 * 384; i += 512) { const int gg = i / 384, rel = i % 384 - 192;
          tab[i] = (rel >= -128 && rel <= 128) ? T.BT2[(kvh * 4 + gg) * 264 + rel + 128] : -1e30f; } }
    bf16x8 qr[4];
    { const bf16_t* Qw = T.QB + (rowbase + q0 + rh * 32 + r32) * 1024 + head * 64 + hi * 8;
#pragma unroll
      for (int d0 = 0; d0 < 4; ++d0) qr[d0] = *reinterpret_cast<const bf16x8*>(Qw + d0 * 16); }
    float m_reg = T.SINK2[head], l_reg = 1.0f; f32x16 o[2] = {};
    const int vb0 = (int)(lds0 + LDS_V) + vt_base64(lane);
    const float* tabg = (const float*)(shm + LDS_TAB) + g * 384;
    ATT_WAIT_BAR(0);
    for (int t = t_lo; t < t_hi; ++t) {
        f32x16 p0, p1; bf16x8 pa0, pa1, pa2, pa3;
        qkt<4, KP, 16>(p0, p1, shm + LDS_K + t * KT, qr, r32, hi);
        const float* tb = tabg + (64 * t + 64 - 32 * rh - r32 + 4 * hi);
#pragma unroll
        for (int r = 0; r < 16; ++r) { p0[r] += tb[(r & 3) + 8 * (r >> 2)]; p1[r] += tb[32 + (r & 3) + 8 * (r >> 2)]; }
        float pmax = p0[0];
#pragma unroll
        for (int r = 1; r < 16; ++r) pmax = fmaxf(pmax, p0[r]);
#pragma unroll
        for (int r = 0; r < 16; ++r) pmax = fmaxf(pmax, p1[r]);
        pmax = half_max(pmax);
        const float mn = fmaxf(m_reg, pmax), alpha = __builtin_amdgcn_exp2f(m_reg - mn); m_reg = mn;
        float ps = 0.f;
#pragma unroll
        for (int r = 0; r < 16; ++r) { p0[r] = __builtin_amdgcn_exp2f(p0[r] - mn); p1[r] = __builtin_amdgcn_exp2f(p1[r] - mn); ps += p0[r] + p1[r]; }
        ps = half_sum(ps); l_reg = l_reg * alpha + ps;
#define SWA_PK(P, B) (u32x4){cvtpk(P[B], P[B + 1]), cvtpk(P[B + 2], P[B + 3]), cvtpk(P[B + 4], P[B + 5]), cvtpk(P[B + 6], P[B + 7])}
        { u32x4 w0 = SWA_PK(p0, 0), w1 = SWA_PK(p0, 8), w2 = SWA_PK(p1, 0), w3 = SWA_PK(p1, 8);
          pa0 = *reinterpret_cast<bf16x8*>(&w0); pa1 = *reinterpret_cast<bf16x8*>(&w1); pa2 = *reinterpret_cast<bf16x8*>(&w2); pa3 = *reinterpret_cast<bf16x8*>(&w3); }
#undef SWA_PK
        if (__any(alpha < 1.f)) {
#pragma unroll
            for (int d = 0; d < 2; ++d)
#pragma unroll
                for (int r = 0; r < 16; ++r) o[d][r] *= alpha; }
        SBAR();
        pvt64<0>(o[0], vb0 + t * 8192, pa0, pa1, pa2, pa3); pvt64<1>(o[1], vb0 + t * 8192, pa0, pa1, pa2, pa3);
    }
    { const float rl = __builtin_amdgcn_rcpf(l_reg);
      bf16_t* orow = T.GOB + (size_t)(rowbase + q0 + rh * 32 + r32) * 1024 + head * 64 + 4 * hi;
#pragma unroll
      for (int d0 = 0; d0 < 2; ++d0)
#pragma unroll
          for (int gq = 0; gq < 4; ++gq) { bf16_t* p = orow + d0 * 32 + 8 * gq; const pg8::u32x2 gt = *reinterpret_cast<const pg8::u32x2*>(p);
              const float v0 = o[d0][4 * gq + 0] * rl * __uint_as_float(gt.x << 16), v1 = o[d0][4 * gq + 1] * rl * __uint_as_float(gt.x & 0xffff0000u);
              const float v2 = o[d0][4 * gq + 2] * rl * __uint_as_float(gt.y << 16), v3 = o[d0][4 * gq + 3] * rl * __uint_as_float(gt.y & 0xffff0000u);
              pg8::u32x2 w; w.x = cvtpk(v0, v1); w.y = cvtpk(v2, v3); *reinterpret_cast<pg8::u32x2*>(p) = w; } }
    asm volatile("s_waitcnt lgkmcnt(0)\n\ts_barrier" ::: "memory");
}
}
#undef SBAR
#undef ATT_WAIT_BAR
}
constexpr int NWAVES = 8;
#ifndef MK_PER_PHASE
#define MK_PER_PHASE 0
#endif
constexpr int N_PHASES = 8;

constexpr size_t MiB = 1u << 20;
constexpr size_t WS_CTL = 0, CTL_ZERO_BYTES = 128 * 1024;
constexpr size_t WS_COS = 1 * MiB, WS_SIN = WS_COS + 512 * 1024;
constexpr size_t WS_BT2 = 2 * MiB, WS_SINK2 = WS_BT2 + 16 * 264 * 4;
constexpr size_t WS_SSQQ = 3 * MiB, WS_SSQKV = WS_SSQQ + 512 * 1024;
constexpr size_t WS_SSQ2 = 4 * MiB, WS_SSQ3 = 6 * MiB;
constexpr size_t WS_WIN = 8 * MiB, WS_WQB = 16 * MiB, WS_WVT = 17 * MiB, WS_WOUT = 18 * MiB, WS_WUP = 20 * MiB, WS_WDN = 31 * MiB;
constexpr size_t WS_A0 = 40 * MiB;
constexpr size_t WS_XN = WS_A0;
constexpr size_t WS_X1B = WS_A0;
constexpr size_t WS_QLAT = 104 * MiB, WS_KL = 120 * MiB  , WS_QB = 132 * MiB, WS_KB = 196 * MiB, WS_VB = 212 * MiB, WS_GA = 228 * MiB, WS_GB = 292 * MiB;
constexpr size_t WS_MIX = WS_QB;
constexpr size_t WS_HALO = 104 * MiB;
constexpr size_t WS_ACT = 296 * MiB;
constexpr size_t WS_END = 472 * MiB;
static_assert(WS_ACT + (size_t)MTOK * DFF * 2 <= WS_END && WS_HALO + (size_t)(MTOK / 64) * 4 * 5632 * 4 <= WS_ACT && WS_KL + (size_t)MTOK * 192 * 2 <= WS_QB, "d_ws map");
constexpr int CW_BAR = 4096;
static_assert((CW_BAR + 3456) * 4 <= 65536, "barrier words below the panel counters");
constexpr int CW_PANEL = 16384;

constexpr int RING_OFF = 0, RING_BYTES = 146432;
constexpr int LDSCTL_OFF = RING_BYTES, MISC_OFF = LDSCTL_OFF + 320;
constexpr int LDS_BYTES = 147456;
static_assert(att::mla::LDS_BYTES <= RING_BYTES && att::mla2::LDS_BYTES <= RING_BYTES && att::swa::LDS_BYTES <= RING_BYTES && pg8::STAGE_BYTES <= RING_BYTES && MISC_OFF + 64 <= LDS_BYTES, "LDS map");

#define GAS __attribute__((address_space(1)))
#define LAS __attribute__((address_space(3)))
typedef unsigned short bf16;
typedef unsigned v4u __attribute__((ext_vector_type(4)));
typedef float f32x4 __attribute__((ext_vector_type(4)));
typedef short bf16x8 __attribute__((ext_vector_type(8)));
typedef GAS unsigned gu32;
typedef GAS unsigned long long gu64;
#define RLX_AGENT __ATOMIC_RELAXED, __HIP_MEMORY_SCOPE_AGENT
#define LDS_WAIT() asm volatile("s_waitcnt lgkmcnt(0)" ::: "memory")
#define VM_WAIT() asm volatile("s_waitcnt vmcnt(0)" ::: "memory")
__device__ __forceinline__ unsigned long long rt() { return __builtin_amdgcn_s_memrealtime(); }
__device__ __forceinline__ unsigned f2bf(float f) { unsigned u = __builtin_bit_cast(unsigned, f); return (u + 0x7fffu + ((u >> 16) & 1u)) >> 16; }
__device__ __forceinline__ unsigned pk2(float lo, float hi) { return f2bf(lo) | (f2bf(hi) << 16); }

#define XB_TMO      128
#define XB_XCNT(j)  (256  + 64 * (j))
#define XB_XSUB(j)  (1280 + 64 * (j))
#define XB_XGEN(j)  (2304 + 64 * (j))
#define XB_TOP      3328
#define XB_TOPGEN   3392
#define XCD_BAR_WORDS 3456
#define XB_SPIN_CAP (1u << 18)

__device__ __forceinline__ unsigned xb_ld(unsigned* p)              { return __hip_atomic_load(p, __ATOMIC_RELAXED, __HIP_MEMORY_SCOPE_AGENT); }
__device__ __forceinline__ unsigned xb_add(unsigned* p, unsigned v) { return __hip_atomic_fetch_add(p, v, __ATOMIC_RELAXED, __HIP_MEMORY_SCOPE_AGENT); }
__device__ __forceinline__ unsigned xb_xcc_id() { return (unsigned)__builtin_amdgcn_s_getreg((3 << 11) | 20) & 0xFu; }
#define XB_SPIN(cond, bar) do { unsigned _sp = 0; while (cond) { __builtin_amdgcn_s_sleep(1); \
    if ((++_sp & 255u) == 0u) { if (xb_ld(&(bar)[XB_TMO])) break; if (_sp > XB_SPIN_CAP) { atomicAdd(&(bar)[XB_TMO], 1u); break; } } } } while (0)

struct XcdBarrier {
    unsigned* bar; unsigned x; int w;
    volatile LAS unsigned* st;
};

__device__ __forceinline__ XcdBarrier xcd_barrier_post(unsigned* bar, volatile LAS unsigned* st) {
    XcdBarrier b; b.bar = bar; b.x = xb_xcc_id(); b.st = st;
    if (threadIdx.x == 0) (void)xb_add(&bar[XB_XCNT(b.x)], 1u);
    return b;
}
__device__ __forceinline__ void xcd_barrier_complete(unsigned* bar, unsigned x, unsigned& nloc, unsigned& nx) {
    const unsigned G = gridDim.x * gridDim.y * gridDim.z;
    unsigned sum, cnt, mine, sp = 0u;
    for (;;) {
        sum = 0u; cnt = 0u; mine = 0u;
#pragma unroll
        for (unsigned j = 0; j < 16; ++j) { const unsigned c = xb_ld(&bar[XB_XCNT(j)]); sum += c; cnt += (c > 0u) ? 1u : 0u; mine = (j == x) ? c : mine; }
        if (sum == G) break;
        __builtin_amdgcn_s_sleep(1);
        if ((++sp & 255u) == 0u) { if (xb_ld(&bar[XB_TMO])) break; if (sp > XB_SPIN_CAP) { atomicAdd(&bar[XB_TMO], 1u); break; } }
    }
    nloc = mine > 0u ? mine : 1u; nx = cnt > 0u ? cnt : 1u;
}

__device__ __forceinline__ void xcd_barrier(const XcdBarrier& b) {
    asm volatile("s_waitcnt vmcnt(0)" ::: "memory");
    __syncthreads();
    if (b.w == 0 && pg8::lane_id_fresh() == 0) {
        unsigned* bar = b.bar;
        __builtin_amdgcn_s_waitcnt(0);
        unsigned nloc = b.st[0], nx = b.st[1];
        if (nloc == 0u) { xcd_barrier_complete(bar, b.x, nloc, nx); b.st[0] = nloc; b.st[1] = nx; }
        const unsigned old = xb_add(&bar[XB_XSUB(b.x)], 1u);
        const unsigned gen = old / nloc;
        if (old + 1u == (gen + 1u) * nloc) {
            __builtin_amdgcn_fence(__ATOMIC_RELEASE, "agent");
            asm volatile("s_waitcnt vmcnt(0)" ::: "memory");
            const unsigned og = xb_add(&bar[XB_TOP], 1u);
            const unsigned tg = og / nx;
            if (og + 1u == (tg + 1u) * nx) xb_add(&bar[XB_TOPGEN], 1u);
            else XB_SPIN(xb_ld(&bar[XB_TOPGEN]) == tg, bar);
            __builtin_amdgcn_fence(__ATOMIC_ACQUIRE, "agent");
            xb_add(&bar[XB_XGEN(b.x)], 1u);
            asm volatile("s_waitcnt vmcnt(0)" ::: "memory");
        } else {
            XB_SPIN(xb_ld(&bar[XB_XGEN(b.x)]) == gen, bar);
            __builtin_amdgcn_fence(__ATOMIC_ACQUIRE, "agent");
            asm volatile("s_waitcnt vmcnt(0)" ::: "memory");
        }
    }
    __syncthreads();
}

struct Frame {
    LAS unsigned char* lds; volatile LAS unsigned* MISC; gu32* ctl;
    int wave, vcu, G;
};
__device__ __forceinline__ float wave_sum(float v) {
#pragma unroll
    for (int o = 1; o < 64; o <<= 1) v += __shfl_xor(v, o);
    return v;
}
template <class RowMap>
__device__ __forceinline__ void p0_transpose_item(const float* W, int K, int N, bf16* WT, const float* kscale, const RowMap& rm, LAS float* scr, int item, int lane) {
    const int nblk = N / 32, kb = item / nblk, nb = item % nblk, k0 = 64 * kb, n0 = 32 * nb;
#pragma unroll 8
    for (int i = 0; i < 32; ++i) { const int kk = 2 * i + (lane >> 5); const float sc = kscale ? kscale[k0 + kk] : 1.0f; scr[kk * 33 + (lane & 31)] = W[(size_t)(k0 + kk) * N + n0 + (lane & 31)] * sc; }
    LDS_WAIT(); asm volatile("" ::: "memory");
    const int c = lane & 7;
#pragma unroll
    for (int j = 0; j < 4; ++j) { const int n = (lane >> 3) + 8 * j; const LAS float* s = scr + (8 * c) * 33 + n;
        v4u o; o.x = pk2(s[0 * 33], s[1 * 33]); o.y = pk2(s[2 * 33], s[3 * 33]); o.z = pk2(s[4 * 33], s[5 * 33]); o.w = pk2(s[6 * 33], s[7 * 33]);
        const int rr = rm(n0 + n); if (rr >= 0) *(GAS v4u*)(WT + (size_t)rr * K + k0 + 8 * c) = o; }
    LDS_WAIT(); asm volatile("" ::: "memory");
}
struct MapIdent { __device__ __forceinline__ int operator()(int n) const { return n; } };
struct MapWin { __device__ __forceinline__ int operator()(int n) const {
    if (n < 256) return n; if (n >= 448) return n + 64; const int j = n - 256; if (j < 128) return 256 + j; const int d = j - 128; return 384 + (d < 32 ? 2 * d : 2 * (d - 32) + 1); } };
struct MapWqb { __device__ __forceinline__ int operator()(int n) const {
    const int h = n / 192, d = n % 192; if (d < 128) return -1  ; const int r = d - 128; return 1024 + h * 64 + (r < 32 ? 2 * r : 2 * (r - 32) + 1); } };
struct MapWup { __device__ __forceinline__ int operator()(int n) const {
    const int v = n >= DFF, c = v ? n - DFF : n; return 256 * (c >> 7) + 128 * v + (c & 127); } };

__device__ __forceinline__ int t5_bucket(int rel) {
    const int n = rel < 0 ? -rel : rel; int bk;
    if (n < 8) bk = n; else { const int e = (31 - __builtin_clz((unsigned)(n * n))) - 6; bk = 8 + e; if (bk > 15) bk = 15; }
    return (rel > 0 ? 16 : 0) + bk;
}
#ifndef MLA_SPLIT
#define MLA_SPLIT 0
#endif
struct Args {
    const float* x; const int* positions; const float* norm1_g; const float* w_in; const float* q_a_norm_g; const float* w_q_b; const float* kv_a_norm_g; const float* w_kv_b;
    const float* rel_bias; const float* sinks; const float* w_out; const float* norm2_g; const float* w_up; const float* conv_w; const float* conv_b; const float* w_down; const float* final_norm_g;
    float* out; unsigned char* ws; int ph_lo, ph_hi;
};

__device__ __forceinline__ void p0_prologue(Frame& F, const Args& a) {
    unsigned char* ws = a.ws;
    LAS float* scr = (LAS float*)(F.lds + RING_OFF + F.wave * 16384);
    const int lane = pg8::lane_id_fresh();
    const int gw = F.vcu * NWAVES + F.wave, NGW = F.G * NWAVES;
    constexpr int I_IN = (1024 / 64) * (4032 / 32), I_QB = (256 / 64) * (1536 / 32), I_OUT = (1024 / 64) * (1024 / 32), I_UP = (1024 / 64) * (5632 / 32), I_DN = (DFF / 64) * (1024 / 32);
    constexpr int NITEMS = I_IN + I_QB + I_OUT + I_UP + I_DN;
#ifndef P0DUP
#define P0DUP 0
#endif
    for (int rp_ = 0; rp_ <= (P0DUP & 1); ++rp_)
    for (int it = gw; it < NITEMS; it += NGW) {
        int r = it;
        if (r < I_IN) { p0_transpose_item(a.w_in, 1024, 4032, (bf16*)(ws + WS_WIN), nullptr, MapWin(), scr, r, lane); continue; } r -= I_IN;
        if (r < I_QB) { p0_transpose_item(a.w_q_b, 256, 1536, (bf16*)(ws + WS_WQB), a.q_a_norm_g, MapWqb(), scr, r, lane); continue; } r -= I_QB;
        if (r < I_OUT) { p0_transpose_item(a.w_out, 1024, 1024, (bf16*)(ws + WS_WOUT), nullptr, MapIdent(), scr, r, lane); continue; } r -= I_OUT;
        if (r < I_UP) { p0_transpose_item(a.w_up, 1024, 5632, (bf16*)(ws + WS_WUP), a.norm2_g, MapWup(), scr, r, lane); continue; } r -= I_UP;
        p0_transpose_item(a.w_down, DFF, 1024, (bf16*)(ws + WS_WDN), nullptr, MapIdent(), scr, r, lane);
    }
    const int gt = gw * 64 + lane, NGT = NGW * 64;
    for (int rp_ = 0; rp_ <= ((P0DUP >> 2) & 1); ++rp_)
    for (int i = gt; i < 1024 * 256; i += NGT) { const int row = i >> 8, j = i & 255, hh = row >> 7, c = row & 127;
        const f32x4* qp = (const f32x4*)(a.w_q_b + (size_t)j * 1536 + hh * 192); const f32x4* kp = (const f32x4*)(a.w_kv_b + (size_t)c * 2048 + hh * 256);
        float s0 = 0.f, s1 = 0.f;
#pragma unroll 8
        for (int d4 = 0; d4 < 32; ++d4) { const f32x4 x = qp[d4], y = kp[d4]; s0 += x[0] * y[0] + x[1] * y[1]; s1 += x[2] * y[2] + x[3] * y[3]; }
        ((bf16*)(ws + WS_WQB))[i] = (bf16)f2bf((s0 + s1) * a.q_a_norm_g[j] * a.kv_a_norm_g[c]); }
    for (int i = gt; i < 8 * 128 * 128; i += NGT) { const int hh = i >> 14, dd = (i >> 7) & 127, cp = i & 127, c = MLA_OT ? ((cp & ~0xC) | ((cp & 4) << 1) | ((cp & 8) >> 1)) : cp;
        ((bf16*)(ws + WS_WVT))[i] = (bf16)f2bf(a.w_kv_b[(size_t)c * 2048 + hh * 256 + 128 + dd] * a.kv_a_norm_g[c]); }
    for (int i = gt; i < 64 * 1024 / 8; i += NGT) *(GAS v4u*)((bf16*)(ws + WS_WIN) + (size_t)448 * 1024 + (size_t)i * 8) = (v4u){0u, 0u, 0u, 0u};
    for (int rp_ = 0; rp_ <= ((P0DUP >> 3) & 1); ++rp_)
    for (int i = gt; i < SEQ * 32; i += NGT) { const int s = i >> 5, d = i & 31;
        const float invf = __builtin_amdgcn_exp2f(-(float)d * (13.287712379549449f / 32.0f));
        const float ang = (float)a.positions[s] * invf;
        const double rev = (double)ang * 0.15915494309189535; const float fr = (float)(rev - __builtin_rint(rev));
        ((float*)(ws + WS_COS))[i] = __builtin_amdgcn_cosf(fr); ((float*)(ws + WS_SIN))[i] = __builtin_amdgcn_sinf(fr); }
    for (int i = gt; i < 16 * 264; i += NGT) { const int h = i / 264, j = i % 264; float v = 0.f; if (j <= 256) v = a.rel_bias[t5_bucket(j - 128) * 16 + h] * LOG2E; ((float*)(ws + WS_BT2))[i] = v; }
    if (gt < 16) ((float*)(ws + WS_SINK2))[gt] = a.sinks[gt] * LOG2E;
    for (int rp_ = 0; rp_ <= ((P0DUP >> 1) & 1); ++rp_)
    for (int m = gw; m < MTOK; m += NGW) {
        const GAS f32x4* xr = (const GAS f32x4*)(a.x + (size_t)m * DM) + lane; const GAS f32x4* gr = (const GAS f32x4*)a.norm1_g + lane;
        f32x4 v[4]; float s = 0.f;
#pragma unroll
        for (int j = 0; j < 4; ++j) { v[j] = xr[64 * j]; s += (v[j].x * v[j].x + v[j].y * v[j].y) + (v[j].z * v[j].z + v[j].w * v[j].w); }
        const float rs = 1.0f / sqrtf(wave_sum(s) * (1.0f / DM) + RMS_EPS);
        GAS unsigned long long* o8 = (GAS unsigned long long*)((bf16*)(ws + WS_XN) + (size_t)m * DM) + lane;
#pragma unroll
        for (int j = 0; j < 4; ++j) { const f32x4 g = gr[64 * j]; o8[64 * j] = (unsigned long long)pk2(v[j].x * rs * g.x, v[j].y * rs * g.y) | ((unsigned long long)pk2(v[j].z * rs * g.z, v[j].w * rs * g.w) << 32); }
    }
}

__device__ __forceinline__ void p6_fixup(Frame& F, const Args& a) {
    const int lane = pg8::lane_id_fresh();
    const int gw = F.vcu * NWAVES + F.wave, NGW = F.G * NWAVES;
    const float* halo = (const float*)(a.ws + WS_HALO); bf16* ACT = (bf16*)(a.ws + WS_ACT);
    constexpr int NBLK = MTOK / 64, HROW = 2 * DFF, HBLK = 4 * HROW;
    for (int it = gw; it < NBLK * 2 * 11; it += NGW) {
        const int cg = it % 11, which = (it / 11) & 1, blk = it / 22;
        const int c = cg * 256 + lane * 4, cu = 256 * (c >> 7) + (c & 127);
        const int r = 64 * blk + (which ? 63 : 0);
        const float* hp = halo + (size_t)blk * HBLK + (2 + which) * HROW + cu;
        f32x4 G = *(const f32x4*)hp, V = *(const f32x4*)(hp + 128);
        const bool has = which ? (((r + 1) & (SEQ - 1)) != 0) : ((r & (SEQ - 1)) != 0);
        if (has) { const float* np = halo + (size_t)(which ? blk + 1 : blk - 1) * HBLK + (which ? 0 : 1) * HROW + cu;
            const f32x4 rg = *(const f32x4*)np, rv = *(const f32x4*)(np + 128);
            const f32x4 wg = *(const f32x4*)(a.conv_w + (which ? 4 : 0) * DFF + c), wv = *(const f32x4*)(a.conv_w + (which ? 5 : 1) * DFF + c);
            G = G + wg * rg; V = V + wv * rv; }
        f32x4 o;
#pragma unroll
        for (int e = 0; e < 4; ++e) o[e] = G[e] * pg8::fast_sigmoid(G[e]) * V[e];
        pg8::st4((pg8::bf16_t*)(ACT + (size_t)r * DFF + c), o);
    }
}

__device__ __forceinline__ void p8_final_norm(Frame& F, const Args& a) {
    const int gw = F.vcu * NWAVES + F.wave, NGW = F.G * NWAVES;
    const int lane = pg8::lane_id_fresh();
    const float* ssq = (const float*)(a.ws + WS_SSQ3);
    for (int m = gw; m < MTOK; m += NGW) {
        const f32x4* sp = (const f32x4*)(ssq + (size_t)m * 16); const f32x4 t = (sp[0] + sp[1]) + (sp[2] + sp[3]);
        const float rs = 1.0f / sqrtf(((t[0] + t[1]) + (t[2] + t[3])) * (1.0f / DM) + RMS_EPS);
        GAS f32x4* xr = (GAS f32x4*)(a.out + (size_t)m * DM) + lane; const GAS f32x4* gr = (const GAS f32x4*)a.final_norm_g + lane;
#pragma unroll
        for (int j = 0; j < 4; ++j) { const f32x4 v = xr[64 * j], g = gr[64 * j]; xr[64 * j] = v * rs * g; }
    }
}

__global__ void __launch_bounds__(NWAVES * 64, 2) enc_fwd(Args args) {
    extern __shared__ __attribute__((aligned(16))) unsigned char lds[];
    Frame F;
    F.lds = (LAS unsigned char*)lds; F.MISC = (volatile LAS unsigned*)(F.lds + MISC_OFF);
    F.wave = __builtin_amdgcn_readfirstlane(threadIdx.x >> 6);
    F.G = gridDim.x; { const int bx = blockIdx.x; F.vcu = (F.G % 8 == 0) ? (bx % 8) * (F.G / 8) + bx / 8 : bx; }
    unsigned char* ws = args.ws;
    F.ctl = (gu32*)(ws + WS_CTL);
    for (int u = threadIdx.x; u < (LDS_BYTES - LDSCTL_OFF) / 4; u += NWAVES * 64) ((LAS unsigned*)(F.lds + LDSCTL_OFF))[u] = 0u;
    __syncthreads();
    XcdBarrier bar; bar.bar = (unsigned*)(F.ctl + CW_BAR); bar.x = 0; bar.st = nullptr;
    if (!MK_PER_PHASE) bar = xcd_barrier_post((unsigned*)(F.ctl + CW_BAR), F.MISC + 8);
    bar.w = F.wave;
    const int lo = args.ph_lo, hi = args.ph_hi;
#ifndef PHMASK
#define PHMASK 0xff
#endif
#define IN(k) (((PHMASK >> (k)) & 1) && lo <= (k) && (k) < hi)
#ifndef DUPMASK
#define DUPMASK 0
#endif
#define REP(k) for (int rep_ = 0; rep_ <= ((DUPMASK >> (k)) & 1); ++rep_)
#define SEAM(k) do { if (IN(k) && IN((k) + 1)) xcd_barrier(bar); } while (0)
    bf16* const WIN = (bf16*)(ws + WS_WIN); bf16* const WQB = (bf16*)(ws + WS_WQB); bf16* const WOUT = (bf16*)(ws + WS_WOUT);
    bf16* const WUP = (bf16*)(ws + WS_WUP); bf16* const WDN = (bf16*)(ws + WS_WDN);
    const float* const COS = (const float*)(ws + WS_COS); const float* const SIN = (const float*)(ws + WS_SIN);
    bf16* const QA = (bf16*)args.out;

#ifdef TP_PHASE
    unsigned long long tp_r0 = 0, tp_r1 = 0, tp_c0 = 0, tp_c1 = 0;
#ifndef TP_END
#define TP_END (TP_PHASE + 1)
#endif
#define TP_MARK(k) do { if ((k) == TP_PHASE) { tp_r0 = __builtin_amdgcn_s_memrealtime(); tp_c0 = __builtin_amdgcn_s_memtime(); } if ((k) == TP_END) { tp_r1 = __builtin_amdgcn_s_memrealtime(); tp_c1 = __builtin_amdgcn_s_memtime(); } } while (0)
#else
#define TP_MARK(k)
#endif
    TP_MARK(0);
    if (IN(0)) REP(0) { p0_prologue(F, args); } SEAM(0);
    TP_MARK(1);

    if (IN(1)) REP(1) {
        pg8::Gemm g{(bf16*)(ws + WS_XN), WIN, MTOK, 4096, 1024}; pg8::StaticOrder S; S.init(MTOK, 4096, F.G, (int)blockIdx.x);
        pg8::EpiInProj E{(bf16*)(ws + WS_QLAT), (bf16*)(ws + WS_KL), (bf16*)(ws + WS_QB), (bf16*)(ws + WS_KB), (bf16*)(ws + WS_VB), (bf16*)(ws + WS_GA), (bf16*)(ws + WS_GB),
                         (float*)(ws + WS_SSQQ), (float*)(ws + WS_SSQKV), COS, SIN};
        pg8::gemm_phase<pg8::EpiInProj, pg8::StaticOrder, PG8_ALIGN, PG8_SP2>(F.lds + RING_OFF, g, S, E, F.wave);
    } SEAM(1);

    TP_MARK(2);
    if (IN(2)) REP(2) {
#ifndef P2SUB
#define P2SUB 7
#endif
#ifndef P2DUPG
#define P2DUPG 0
#endif
        for (int rg_ = 0; rg_ <= P2DUPG; ++rg_) {
        if (P2SUB & 1) { pg8::Gemm g{(bf16*)(ws + WS_QLAT), WQB, MTOK, 1536, 256}; pg8::StaticOrder S; S.init(MTOK, 1536, F.G, (int)blockIdx.x);
          pg8::EpiQProj E{QA, (const float*)(ws + WS_SSQQ), COS, SIN};
          pg8::gemm_phase<pg8::EpiQProj, pg8::StaticOrder, PG8_ALIGN, PG8_SP2>(F.lds + RING_OFF, g, S, E, F.wave); }
        }
        if (P2SUB & 4) { const att::swa::Tensors T{(const bf16*)(ws + WS_QB), (const bf16*)(ws + WS_KB), (const bf16*)(ws + WS_VB), (bf16*)(ws + WS_GB), (const float*)(ws + WS_BT2), (const float*)(ws + WS_SINK2)};
          for (int u = F.vcu; u < NBATCH * 4 * (SEQ / 64); u += F.G) { const int qblk = u % (SEQ / 64), bk = u / (SEQ / 64); att::swa::unit(bk >> 2, bk & 3, qblk, T, (char*)lds + RING_OFF, F.wave); } }
    } SEAM(2);

    TP_MARK(3);
    if (IN(3)) REP(3) {
        const att::mla::Tensors T{QA, (const bf16*)(ws + WS_KL), (const bf16*)(ws + WS_WVT), (const bf16*)(ws + WS_GA), (const bf16*)(ws + WS_GB), (bf16*)(ws + WS_MIX)};
        for (int u = F.vcu; u < NBATCH * 8 * (SEQ / 256); u += F.G) { const int qb = u & 15, bh = u >> 4;
#if MLA_SPLIT
            att::mla2::unit(bh >> 3, bh & 7, qb, T, (char*)lds + RING_OFF, F.wave);
#else
            att::mla::unit(bh >> 3, bh & 7, qb, T, (char*)lds + RING_OFF, F.wave);
#endif
        }
    } SEAM(3);

    TP_MARK(4);
    if (IN(4)) REP(4) {
        pg8::Gemm g{(bf16*)(ws + WS_MIX), WOUT, MTOK, 1024, 1024}; pg8::StaticOrder S; S.init(MTOK, 1024, F.G, (int)blockIdx.x);
        pg8::EpiResidual E{args.x, nullptr, (bf16*)(ws + WS_X1B), (float*)(ws + WS_SSQ2)};
        pg8::gemm_phase<pg8::EpiResidual, pg8::StaticOrder, PG8_ALIGN, PG8_SP2>(F.lds + RING_OFF, g, S, E, F.wave);
    } SEAM(4);

    TP_MARK(5);
    if (IN(5)) REP(5) {
        pg8::Gemm g{(bf16*)(ws + WS_X1B), WUP, MTOK, 2 * DFF, 1024}; pg8::StaticOrder S; S.init(MTOK, 2 * DFF, F.G, (int)blockIdx.x);
        pg8::EpiUpConv E{(bf16*)(ws + WS_ACT), (float*)(ws + WS_HALO), (const float*)(ws + WS_SSQ2), args.conv_w, args.conv_b};
        pg8::gemm_phase<pg8::EpiUpConv, pg8::StaticOrder, PG8_ALIGN, PG8_SP2>(F.lds + RING_OFF, g, S, E, F.wave);
    } SEAM(5);
    TP_MARK(6);
    if (IN(6)) REP(6) { p6_fixup(F, args); } SEAM(6);

    TP_MARK(7);
    if (IN(7)) REP(7) {
        pg8::Gemm g{(bf16*)(ws + WS_ACT), WDN, MTOK, 1024, DFF}; pg8::StaticOrder S; S.init(MTOK, 1024, F.G, (int)blockIdx.x);
        pg8::EpiFinal E{(const bf16*)(ws + WS_X1B), args.out, (float*)(ws + WS_SSQ3), (unsigned*)(F.ctl + CW_PANEL), args.final_norm_g};
        pg8::gemm_phase<pg8::EpiFinal, pg8::StaticOrder, PG8_ALIGN, PG8_SP2>(F.lds + RING_OFF, g, S, E, F.wave);
    }
#ifdef TP_PHASE
    TP_MARK(8);
#ifndef TP_CLK
#define TP_CLK 0
#endif
#ifndef TP_GAIN
#define TP_GAIN 4
#endif
    if (blockIdx.x == 0 && F.wave == 0) {
        const unsigned long long dr = tp_r1 - tp_r0, dc = tp_c1 - tp_c0;
        const unsigned long long ticks = (TP_CLK ? dc * 100ull / dr : dr) * (unsigned long long)TP_GAIN;
        const unsigned long long t0 = __builtin_amdgcn_s_memrealtime();
        while (__builtin_amdgcn_s_memrealtime() - t0 < ticks) __builtin_amdgcn_s_sleep(8); }
#endif
#undef IN
#undef SEAM
}

extern "C" void kernel_launch(void* const* d_in, const int* in_sizes, int n_in, void* d_out, int out_size, void* d_ws, size_t ws_size, hipStream_t stream) {
    static int grid = 0;
    if (grid == 0) {
        if (n_in != 17 || in_sizes[0] != MTOK * DM || out_size != MTOK * DM || ws_size < WS_END) { fprintf(stderr, "kernel_launch: unexpected shapes (n_in %d, in0 %d, out %d, ws %zu; need ws >= %zu); nothing launched\n", n_in, n_in > 0 ? in_sizes[0] : -1, out_size, ws_size, (size_t)WS_END); grid = -1; return; }
        int dev = 0, cus = 0, per_cu = 0;
        if (hipGetDevice(&dev) != hipSuccess || hipDeviceGetAttribute(&cus, hipDeviceAttributeMultiprocessorCount, dev) != hipSuccess) { fprintf(stderr, "kernel_launch: device query failed\n"); grid = -1; return; }
        if (hipFuncSetAttribute((const void*)enc_fwd, hipFuncAttributeMaxDynamicSharedMemorySize, LDS_BYTES) != hipSuccess) { fprintf(stderr, "kernel_launch: hipFuncSetAttribute failed\n"); grid = -1; return; }
        if (hipOccupancyMaxActiveBlocksPerMultiprocessor(&per_cu, (const void*)enc_fwd, NWAVES * 64, LDS_BYTES) != hipSuccess || per_cu < 1) { fprintf(stderr, "kernel_launch: occupancy query reports %d workgroups per CU\n", per_cu); }
        (void)hipGetLastError();
        grid = cus;
    }
    if (grid < 0) return;
    if (hipMemsetAsync((char*)d_ws + WS_CTL, 0, CTL_ZERO_BYTES, stream) != hipSuccess) { fprintf(stderr, "kernel_launch: hipMemsetAsync failed\n"); return; }
    Args a{};
    a.x = (const float*)d_in[0]; a.positions = (const int*)d_in[1]; a.norm1_g = (const float*)d_in[2]; a.w_in = (const float*)d_in[3]; a.q_a_norm_g = (const float*)d_in[4]; a.w_q_b = (const float*)d_in[5];
    a.kv_a_norm_g = (const float*)d_in[6]; a.w_kv_b = (const float*)d_in[7]; a.rel_bias = (const float*)d_in[8]; a.sinks = (const float*)d_in[9]; a.w_out = (const float*)d_in[10]; a.norm2_g = (const float*)d_in[11];
    a.w_up = (const float*)d_in[12]; a.conv_w = (const float*)d_in[13]; a.conv_b = (const float*)d_in[14]; a.w_down = (const float*)d_in[15]; a.final_norm_g = (const float*)d_in[16];
    a.out = (float*)d_out; a.ws = (unsigned char*)d_ws;
#if MK_PER_PHASE
    for (int p = 0; p < N_PHASES; ++p) { a.ph_lo = p; a.ph_hi = p + 1; hipLaunchKernelGGL(enc_fwd, dim3(grid), dim3(NWAVES * 64), LDS_BYTES, stream, a); }
#else
    a.ph_lo = 0; a.ph_hi = N_PHASES; hipLaunchKernelGGL(enc_fwd, dim3(grid), dim3(NWAVES * 64), LDS_BYTES, stream, a);
#endif
    const hipError_t le = hipPeekAtLastError();
    if (le != hipSuccess) fprintf(stderr, "kernel_launch: launch failed: %s (grid %d)\n", hipGetErrorName(le), grid);
}
```

```cpp
#include <hip/hip_runtime.h>
#include <cstdio>
#include <cstdint>
namespace pg8 {
#define PG8_LAS __attribute__((address_space(3)))
typedef unsigned short bf16_t;
typedef short bf16x8 __attribute__((ext_vector_type(8)));
typedef float f32x4 __attribute__((ext_vector_type(4)));
typedef unsigned u32x4 __attribute__((ext_vector_type(4)));
constexpr int BM = 256, BK = 64, HALF = 128, HTB = HALF * BK * 2  , STAGE_BYTES = 8 * HTB, NXCD = 8, WGM = 8;

__host__ __device__ __forceinline__ int lds_byte(int r, int c) { const int st = (r >> 4) * 2 + (c >> 5), rr = r & 15, cc = c & 31, ob = rr * 64 + cc * 2; return st * 1024 + (ob ^ (((ob >> 9) & 1) << 5)); }
__host__ __device__ __forceinline__ void stage_rc(int b, int& R, int& C) { const int st = b / 1024, sb = b % 1024, swz = sb ^ (((sb >> 9) & 1) << 5); R = (st >> 1) * 16 + swz / 64; C = (st & 1) * 32 + (swz % 64) / 2; }
__host__ __device__ __forceinline__ int perm32(int rho) { const int n = rho >> 4, i = rho & 15; return 8 * (i >> 2) + 4 * n + (i & 3); }

struct Unit { int pm, pn; };
struct Gemm { const bf16_t* A; const bf16_t* Bt; int M, N, K; };

struct StaticOrder {
    int nM, nN, nwg, G, c;
    __host__ __device__ void init(int M, int N, int G_, int c_) { nM = M / BM; nN = N / BM; nwg = nM * nN; G = G_; c = c_; }
    __host__ __device__ bool next(int i, Unit& u) const {
        const long L = (long)i * G + c; if (L >= nwg) return false;
        int wgid = (int)L; { const int q = nwg / NXCD, r = nwg % NXCD, xcd = wgid % NXCD, off = wgid / NXCD; wgid = (xcd < r ? xcd * (q + 1) : r * (q + 1) + (xcd - r) * q) + off; }
        const int nig = WGM * nN, gid = wgid / nig, fm = gid * WGM, gsz = (nM - fm) < WGM ? (nM - fm) : WGM;
        u.pm = fm + ((wgid % nig) % gsz); u.pn = (wgid % nig) / gsz; return true;
    }
    __device__ __forceinline__ void a_ready(const Unit&) const {}
    __device__ __forceinline__ void done(const Unit&) const {}
};

__device__ __forceinline__ unsigned cvt_pk_bf16(float lo, float hi) { unsigned r; asm volatile("v_cvt_pk_bf16_f32 %0, %1, %2" : "=v"(r) : "v"(lo), "v"(hi)); return r; }
constexpr int SEQ = 4096, NBATCH = 8, MTOK = NBATCH * SEQ, DM = 1024;
constexpr int DFF = 2816;
constexpr float RMS_EPS = 1e-6f;
constexpr float LOG2E = 1.4426950408889634f;
constexpr float C_MLA = 0.07216878364870322f * LOG2E;
constexpr float C_SWA = 0.125f * LOG2E;

typedef unsigned u32x2 __attribute__((ext_vector_type(2)));
__device__ __forceinline__ int lane_id_fresh() { int l; asm volatile("v_mbcnt_lo_u32_b32 %0, -1, 0\n\tv_mbcnt_hi_u32_b32 %0, -1, %0" : "=v"(l)); return l; }
__device__ __forceinline__ float fast_sigmoid(float v) { return __builtin_amdgcn_rcpf(1.0f + __builtin_amdgcn_exp2f(-LOG2E * v)); }
__device__ __forceinline__ void st8(bf16_t* p, f32x4 v0, f32x4 v1) {
    u32x4 w; w.x = cvt_pk_bf16(v0[0], v0[1]); w.y = cvt_pk_bf16(v0[2], v0[3]); w.z = cvt_pk_bf16(v1[0], v1[1]); w.w = cvt_pk_bf16(v1[2], v1[3]); *(u32x4*)p = w; }
__device__ __forceinline__ void st4(bf16_t* p, f32x4 v) { u32x2 w; w.x = cvt_pk_bf16(v[0], v[1]); w.y = cvt_pk_bf16(v[2], v[3]); *(u32x2*)p = w; }
__device__ __forceinline__ float sq4(f32x4 x) { return (x[0] * x[0] + x[1] * x[1]) + (x[2] * x[2] + x[3] * x[3]); }
__device__ __forceinline__ float fq_sum(float s) { s += __shfl_xor(s, 16); s += __shfl_xor(s, 32); return s; }

__device__ __forceinline__ void rope_store(bf16_t* dst  , int d, int srow, const float* cosT, const float* sinT, f32x4 a, f32x4 b, float sc) {
    const f32x4 c4 = *(const f32x4*)(cosT + srow * 32 + d), s4 = *(const f32x4*)(sinT + srow * 32 + d);
    const f32x4 x1 = {a[0] * sc, a[2] * sc, b[0] * sc, b[2] * sc}, x2 = {a[1] * sc, a[3] * sc, b[1] * sc, b[3] * sc};
    st4(dst + d, x1 * c4 - x2 * s4); st4(dst + 32 + d, x2 * c4 + x1 * s4);
}

struct EpiInProj {
    static constexpr bool PERM = true, AFTER_DRAIN = false;
    bf16_t *qlat, *kl, *qb, *kb, *vb, *ga, *gb; float *ssq_q, *ssq_kv; const float *cosT, *sinT;
    __device__ __forceinline__ void operator()(f32x4 (&acc)[2][2][4][2], const Unit& u, int wr, int wc, int fr, int fq) const {
        { const int l_ = lane_id_fresh(); fr = l_ & 15; fq = l_ >> 4; }
        const int pn = u.pn, row0 = u.pm * BM + wr * 64 + fr, cw = wc * 32 + 8 * fq;
        if (pn == 0) {
#pragma unroll
            for (int ai = 0; ai < 2; ++ai)
#pragma unroll
                for (int m = 0; m < 4; ++m) { const int row = row0 + ai * HALF + m * 16;
                    float s = (sq4(acc[ai][0][m][0]) + sq4(acc[ai][0][m][1])) + (sq4(acc[ai][1][m][0]) + sq4(acc[ai][1][m][1]));
                    s = fq_sum(s); if (fq == 0) ssq_q[(size_t)row * 4 + wc] = s;
                    st8(qlat + (size_t)row * 256 + cw, acc[ai][0][m][0], acc[ai][0][m][1]); st8(qlat + (size_t)row * 256 + HALF + cw, acc[ai][1][m][0], acc[ai][1][m][1]);
                    asm volatile("" ::: "memory"); }
        } else if (pn == 1) {
#pragma unroll
            for (int ai = 0; ai < 2; ++ai)
#pragma unroll
                for (int m = 0; m < 4; ++m) { const int row = row0 + ai * HALF + m * 16;
                    float s = sq4(acc[ai][0][m][0]) + sq4(acc[ai][0][m][1]);
                    s = fq_sum(s); if (fq == 0) __hip_atomic_store(ssq_kv + (unsigned)row * 4 + wc, s, __ATOMIC_RELAXED, __HIP_MEMORY_SCOPE_AGENT); }
            asm volatile("s_waitcnt vmcnt(0)" ::: "memory");
            __builtin_amdgcn_s_barrier(); asm volatile("" ::: "memory");
#pragma unroll
            for (int ai = 0; ai < 2; ++ai)
#pragma unroll
                for (int m = 0; m < 4; ++m) { const int row = row0 + ai * HALF + m * 16; const float* sp = ssq_kv + (unsigned)row * 4;
                    const float t = (__hip_atomic_load(sp, __ATOMIC_RELAXED, __HIP_MEMORY_SCOPE_AGENT) + __hip_atomic_load(sp + 1, __ATOMIC_RELAXED, __HIP_MEMORY_SCOPE_AGENT))
                                  + (__hip_atomic_load(sp + 2, __ATOMIC_RELAXED, __HIP_MEMORY_SCOPE_AGENT) + __hip_atomic_load(sp + 3, __ATOMIC_RELAXED, __HIP_MEMORY_SCOPE_AGENT));
                    const float rs = __builtin_amdgcn_rsqf(t * (1.0f / 128.0f) + RMS_EPS);
                    bf16_t* krow = kl + (size_t)row * 192;
                    st8(krow + cw, acc[ai][0][m][0] * rs, acc[ai][0][m][1] * rs);
                    if (wc < 2) rope_store(krow + 128, 16 * wc + 4 * fq, row & (SEQ - 1), cosT, sinT, acc[ai][1][m][0], acc[ai][1][m][1], 1.0f);
                    if (m == 1 || m == 3) asm volatile("" ::: "memory"); }
        } else {
            bf16_t* base; int ld, col0; float sc = 1.0f; bool sig = false;
            if (pn < 6) { base = qb; ld = 1024; col0 = (pn - 2) * 256; sc = C_SWA; }
            else if (pn == 6) { base = kb; ld = 256; col0 = 0; }
            else if (pn == 7) { base = vb; ld = 256; col0 = 0; }
            else if (pn < 12) { base = ga; ld = 1024; col0 = (pn - 8) * 256; sig = true; }
            else { base = gb; ld = 1024; col0 = (pn - 12) * 256; sig = true; }
            bf16_t* rowp = base + (size_t)row0 * ld + col0 + cw; const size_t rstep = (size_t)16 * ld;
#pragma unroll
            for (int ai = 0; ai < 2; ++ai)
#pragma unroll
                for (int m = 0; m < 4; ++m) { bf16_t* rp = rowp + (size_t)(ai * 8 + m) * rstep;
#pragma unroll
                    for (int bj = 0; bj < 2; ++bj) { f32x4 v0 = acc[ai][bj][m][0], v1 = acc[ai][bj][m][1];
                        if (sig) {
#pragma unroll
                            for (int e = 0; e < 4; ++e) { v0[e] = fast_sigmoid(v0[e]); v1[e] = fast_sigmoid(v1[e]); } }
                        else { v0 = v0 * sc; v1 = v1 * sc; }
                        st8(rp + bj * HALF, v0, v1); }
                    asm volatile("" ::: "memory"); }
        }
    }
};

struct EpiQProj {
    static constexpr bool PERM = true, AFTER_DRAIN = false;
    bf16_t* qa; const float* ssq; const float *cosT, *sinT;
    __device__ __forceinline__ void operator()(f32x4 (&acc)[2][2][4][2], const Unit& u, int wr, int wc, int fr, int fq) const {
        { const int l_ = lane_id_fresh(); fr = l_ & 15; fq = l_ >> 4; }
        const int pn = u.pn, row0 = u.pm * BM + wr * 64 + fr, cw = wc * 32 + 8 * fq;
        f32x4 sv[2][4];
#pragma unroll
        for (int ai = 0; ai < 2; ++ai)
#pragma unroll
            for (int m = 0; m < 4; ++m) sv[ai][m] = *(const f32x4*)(ssq + (unsigned)(row0 + ai * HALF + m * 16) * 4);
        asm volatile("" ::: "memory");
#pragma unroll
        for (int ai = 0; ai < 2; ++ai)
#pragma unroll
            for (int m = 0; m < 4; ++m) { const int row = row0 + ai * HALF + m * 16;
                const f32x4 s4 = sv[ai][m];
                const float rs = C_MLA * __builtin_amdgcn_rsqf(((s4[0] + s4[1]) + (s4[2] + s4[3])) * (1.0f / 256.0f) + RMS_EPS);
                bf16_t* qrow = qa + (size_t)row * 1536;
                if (pn < 4) {
#pragma unroll
                    for (int bj = 0; bj < 2; ++bj) st8(qrow + (2 * pn + bj) * 192 + cw, acc[ai][bj][m][0] * rs, acc[ai][bj][m][1] * rs);
                } else {
#pragma unroll
                    for (int bj = 0; bj < 2; ++bj) { const int head = 4 * (pn - 4) + 2 * bj + (wc >> 1);
                        rope_store(qrow + head * 192 + 128, 16 * (wc & 1) + 4 * fq, row & (SEQ - 1), cosT, sinT, acc[ai][bj][m][0], acc[ai][bj][m][1], rs); }
                }
                if (m == 1 || m == 3) asm volatile("" ::: "memory");
            }
    }
};

struct EpiResidual {
    static constexpr bool PERM = true, AFTER_DRAIN = false;
    const float* base; float* y; bf16_t* yb; float* ssq;
    __device__ __forceinline__ void operator()(f32x4 (&acc)[2][2][4][2], const Unit& u, int wr, int wc, int fr, int fq) const {
        { const int l_ = lane_id_fresh(); fr = l_ & 15; fq = l_ >> 4; }
        const int pn = u.pn, row0 = u.pm * BM + wr * 64 + fr, cw = wc * 32 + 8 * fq;
        const unsigned off0 = (unsigned)row0 * DM + pn * 256 + cw;
#pragma unroll
        for (int ai = 0; ai < 2; ++ai) {
            f32x4 xv[4][2][2];
#pragma unroll
            for (int m = 0; m < 4; ++m)
#pragma unroll
                for (int bj = 0; bj < 2; ++bj) { const unsigned off = off0 + (unsigned)((ai * HALF + m * 16) * DM + bj * HALF);
                    xv[m][bj][0] = *(const f32x4*)(base + off); xv[m][bj][1] = *(const f32x4*)(base + off + 4); }
            asm volatile("" ::: "memory");
#pragma unroll
            for (int m = 0; m < 4; ++m) { const int row = row0 + ai * HALF + m * 16; float s = 0.f;
#pragma unroll
                for (int bj = 0; bj < 2; ++bj) { const unsigned off = off0 + (unsigned)((ai * HALF + m * 16) * DM + bj * HALF);
                    const f32x4 v0 = xv[m][bj][0] + acc[ai][bj][m][0], v1 = xv[m][bj][1] + acc[ai][bj][m][1];
                    if (y) { *(f32x4*)(y + off) = v0; *(f32x4*)(y + off + 4) = v1; } if (yb) st8(yb + off, v0, v1);
                    s += sq4(v0) + sq4(v1); }
                s = fq_sum(s); if (fq == 0) ssq[(unsigned)row * 16 + pn * 4 + wc] = s; }
            asm volatile("" ::: "memory");
        }
    }
};

struct EpiUp {
    static constexpr bool PERM = true, AFTER_DRAIN = false;
    bf16_t* U; int ldu; const float* ssq;
    __device__ __forceinline__ void operator()(f32x4 (&acc)[2][2][4][2], const Unit& u, int wr, int wc, int fr, int fq) const {
        { const int l_ = lane_id_fresh(); fr = l_ & 15; fq = l_ >> 4; }
        const int pn = u.pn, row0 = u.pm * BM + wr * 64 + fr, cw = wc * 32 + 8 * fq;
#pragma unroll
        for (int ai = 0; ai < 2; ++ai)
#pragma unroll
            for (int m = 0; m < 4; ++m) { const int row = row0 + ai * HALF + m * 16;
                const f32x4* sp = (const f32x4*)(ssq + (size_t)row * 16); const f32x4 t = (sp[0] + sp[1]) + (sp[2] + sp[3]);
                const float rs = __builtin_amdgcn_rsqf(((t[0] + t[1]) + (t[2] + t[3])) * (1.0f / 1024.0f) + RMS_EPS);
#pragma unroll
                for (int bj = 0; bj < 2; ++bj) st8(U + (size_t)row * ldu + pn * 256 + bj * HALF + cw, acc[ai][bj][m][0] * rs, acc[ai][bj][m][1] * rs);
                asm volatile("" ::: "memory"); }
    }
};

__device__ __forceinline__ float dpp_prev(float x) { return __int_as_float(__builtin_amdgcn_update_dpp(__float_as_int(x), __float_as_int(x), 0x121, 0xf, 0xf, true)); }
__device__ __forceinline__ float dpp_next(float x) { return __int_as_float(__builtin_amdgcn_update_dpp(__float_as_int(x), __float_as_int(x), 0x12f, 0xf, 0xf, true)); }
struct EpiUpConv {
    static constexpr bool PERM = true, AFTER_DRAIN = false;
    bf16_t* act; float* halo; const float* ssq; const float* conv_w; const float* conv_b;
    __device__ __forceinline__ void operator()(f32x4 (&acc)[2][2][4][2], const Unit& u, int wr, int wc, int fr, int fq) const {
        { const int l_ = lane_id_fresh(); fr = l_ & 15; fq = l_ >> 4; }
        const int pn = u.pn, row0 = u.pm * BM + wr * 64 + fr, cw = wc * 32 + 8 * fq;
        { f32x4 tv[2][4];
#pragma unroll
        for (int ai = 0; ai < 2; ++ai)
#pragma unroll
            for (int m = 0; m < 4; ++m) tv[ai][m] = *(const f32x4*)(ssq + (unsigned)(row0 + ai * HALF + m * 16) * 16 + 4 * fq);
        asm volatile("" ::: "memory");
#pragma unroll
        for (int ai = 0; ai < 2; ++ai)
#pragma unroll
            for (int m = 0; m < 4; ++m) { const f32x4 t = tv[ai][m];
                const float rs = __builtin_amdgcn_rsqf(fq_sum((t[0] + t[1]) + (t[2] + t[3])) * (1.0f / 1024.0f) + RMS_EPS);
#pragma unroll
                for (int bj = 0; bj < 2; ++bj) { acc[ai][bj][m][0] = acc[ai][bj][m][0] * rs; acc[ai][bj][m][1] = acc[ai][bj][m][1] * rs; }
                if (m == 1 || m == 3) __builtin_amdgcn_sched_barrier(0); } }
        const bool first = fr == 0, last = fr == 15;
        u32x2 pk[2][4];
#pragma unroll
        for (int n = 0; n < 2; ++n) {
            const int c = pn * 128 + cw + 4 * n;
            const f32x4 wg0 = *(const f32x4*)(conv_w + c), wg1 = *(const f32x4*)(conv_w + 2 * DFF + c), wg2 = *(const f32x4*)(conv_w + 4 * DFF + c), bg = *(const f32x4*)(conv_b + c);
            const f32x4 wv0 = *(const f32x4*)(conv_w + DFF + c), wv1 = *(const f32x4*)(conv_w + 3 * DFF + c), wv2 = *(const f32x4*)(conv_w + 5 * DFF + c), bv = *(const f32x4*)(conv_b + DFF + c);
#pragma unroll
            for (int ai = 0; ai < 2; ++ai) {
                float* hb = halo + (unsigned)((4 * u.pm + 2 * ai + wr) * (4 * 2 * DFF) + pn * 256 + cw + 4 * n);
                f32x4 Apg = {0.f, 0.f, 0.f, 0.f}, Apv = Apg, Bcg, Bcv;
#pragma unroll
                for (int e = 0; e < 4; ++e) { Bcg[e] = dpp_next(acc[ai][0][0][n][e]); Bcv[e] = dpp_next(acc[ai][1][0][n][e]); }
#pragma unroll
                for (int m = 0; m < 4; ++m) { const int row = row0 + ai * HALF + m * 16;
                    const f32x4 ug = acc[ai][0][m][n], uv = acc[ai][1][m][n]; f32x4 G, V, Acg, Acv, Bng = {0.f, 0.f, 0.f, 0.f}, Bnv = Bng;
#pragma unroll
                    for (int e = 0; e < 4; ++e) { Acg[e] = dpp_prev(ug[e]); Acv[e] = dpp_prev(uv[e]);
                        if (m < 3) { Bng[e] = dpp_next(acc[ai][0][m < 3 ? m + 1 : 3][n][e]); Bnv[e] = dpp_next(acc[ai][1][m < 3 ? m + 1 : 3][n][e]); }
                        const float pg = first ? Apg[e] : Acg[e], pv = first ? Apv[e] : Acv[e], ng = last ? Bng[e] : Bcg[e], nv = last ? Bnv[e] : Bcv[e];
                        G[e] = wg0[e] * pg + wg1[e] * ug[e] + wg2[e] * ng + bg[e]; V[e] = wv0[e] * pv + wv1[e] * uv[e] + wv2[e] * nv + bv[e]; }
                    Apg = Acg; Apv = Acv; Bcg = Bng; Bcv = Bnv;
                    bool edge = false;
                    if (m == 0) { if (first) { edge = true; *(f32x4*)(hb) = ug; *(f32x4*)(hb + 128) = uv; *(f32x4*)(hb + 2 * 2 * DFF) = G; *(f32x4*)(hb + 2 * 2 * DFF + 128) = V; } }
                    if (m == 3) { if (last) { edge = true; *(f32x4*)(hb + 2 * DFF) = ug; *(f32x4*)(hb + 2 * DFF + 128) = uv; *(f32x4*)(hb + 3 * 2 * DFF) = G; *(f32x4*)(hb + 3 * 2 * DFF + 128) = V; } }
                    f32x4 o;
#pragma unroll
                    for (int e = 0; e < 4; ++e) o[e] = G[e] * fast_sigmoid(G[e]) * V[e];
                    u32x2 w; w.x = cvt_pk_bf16(o[0], o[1]); w.y = cvt_pk_bf16(o[2], o[3]);
                    if (n == 0) pk[ai][m] = w;
                    else if (!edge) { u32x4 w4; w4.x = pk[ai][m].x; w4.y = pk[ai][m].y; w4.z = w.x; w4.w = w.y; *(u32x4*)(act + ((unsigned)row * (unsigned)DFF + (unsigned)(c - 4))) = w4; }
                    __builtin_amdgcn_sched_barrier(0);
                }
                asm volatile("" ::: "memory");
            }
        }
    }
};

struct EpiFinal {
    static constexpr bool PERM = true, AFTER_DRAIN = false;
    const bf16_t* x1b; float* out; float* ssq; unsigned* cnt; const float* gf;
    __device__ __forceinline__ void operator()(f32x4 (&acc)[2][2][4][2], const Unit& u, int wr, int wc, int fr, int fq) const {
        const int l_ = lane_id_fresh(); fr = l_ & 15; fq = l_ >> 4;
        const int pn = u.pn, row0 = u.pm * BM + wr * 64 + fr, cw = wc * 32 + 8 * fq;
        const unsigned off0 = (unsigned)row0 * DM + pn * 256 + cw;
#pragma unroll
        for (int ai = 0; ai < 2; ++ai) {
            u32x4 xw[4][2];
#pragma unroll
            for (int m = 0; m < 4; ++m)
#pragma unroll
                for (int bj = 0; bj < 2; ++bj) xw[m][bj] = *(const u32x4*)(x1b + off0 + (unsigned)((ai * HALF + m * 16) * DM + bj * HALF));
            asm volatile("" ::: "memory");
#pragma unroll
            for (int m = 0; m < 4; ++m) { const int row = row0 + ai * HALF + m * 16; float s = 0.f;
#pragma unroll
                for (int bj = 0; bj < 2; ++bj) { const u32x4 w = xw[m][bj];
                    const f32x4 x0 = {__uint_as_float(w.x << 16), __uint_as_float(w.x & 0xffff0000u), __uint_as_float(w.y << 16), __uint_as_float(w.y & 0xffff0000u)};
                    const f32x4 x1v = {__uint_as_float(w.z << 16), __uint_as_float(w.z & 0xffff0000u), __uint_as_float(w.w << 16), __uint_as_float(w.w & 0xffff0000u)};
                    acc[ai][bj][m][0] = acc[ai][bj][m][0] + x0; acc[ai][bj][m][1] = acc[ai][bj][m][1] + x1v;
                    s += sq4(acc[ai][bj][m][0]) + sq4(acc[ai][bj][m][1]); }
                s = fq_sum(s); if (fq == 0) __hip_atomic_store(ssq + (unsigned)row * 16 + pn * 4 + wc, s, __ATOMIC_RELAXED, __HIP_MEMORY_SCOPE_AGENT); }
            asm volatile("" ::: "memory");
        }
        asm volatile("s_waitcnt vmcnt(0)" ::: "memory");
        __builtin_amdgcn_s_barrier(); asm volatile("" ::: "memory");
        if (wr == 0 && wc == 0) {
            unsigned* c = cnt + 64 * u.pm;
            if (l_ == 0) __hip_atomic_fetch_add(c, 1u, __ATOMIC_RELAXED, __HIP_MEMORY_SCOPE_AGENT);
            for (unsigned sp = 0; sp < (1u << 22); ++sp) {
                if ((unsigned)__builtin_amdgcn_readfirstlane(__hip_atomic_load(c, __ATOMIC_RELAXED, __HIP_MEMORY_SCOPE_AGENT)) >= 4u) break;
                __builtin_amdgcn_s_sleep(2); }
            __builtin_amdgcn_fence(__ATOMIC_ACQUIRE, "agent");
            asm volatile("s_waitcnt vmcnt(0)" ::: "memory");
        }
        __builtin_amdgcn_s_barrier(); asm volatile("" ::: "memory");
        f32x4 gv[2][2];
#pragma unroll
        for (int bj = 0; bj < 2; ++bj) { gv[bj][0] = *(const f32x4*)(gf + pn * 256 + bj * HALF + cw); gv[bj][1] = *(const f32x4*)(gf + pn * 256 + bj * HALF + cw + 4); }
        f32x4 tv[2][4];
#pragma unroll
        for (int ai = 0; ai < 2; ++ai)
#pragma unroll
            for (int m = 0; m < 4; ++m) tv[ai][m] = *(const f32x4*)(ssq + (unsigned)(row0 + ai * HALF + m * 16) * 16 + 4 * fq);
        asm volatile("" ::: "memory");
#pragma unroll
        for (int ai = 0; ai < 2; ++ai)
#pragma unroll
            for (int m = 0; m < 4; ++m) { const f32x4 t = tv[ai][m];
                const float rs = __builtin_amdgcn_rsqf(fq_sum((t[0] + t[1]) + (t[2] + t[3])) * (1.0f / 1024.0f) + RMS_EPS);
#pragma unroll
                for (int bj = 0; bj < 2; ++bj) { const unsigned off = off0 + (unsigned)((ai * HALF + m * 16) * DM + bj * HALF);
                    *(f32x4*)(out + off) = acc[ai][bj][m][0] * rs * gv[bj][0]; *(f32x4*)(out + off + 4) = acc[ai][bj][m][1] * rs * gv[bj][1]; }
                if (m == 1 || m == 3) __builtin_amdgcn_sched_barrier(0); }
    }
};
template <class Epi, class Sched, bool ALIGN_EPI = false, bool SP2 = false>
__device__ __forceinline__ void gemm_phase(PG8_LAS unsigned char* lds, const Gemm g, const Sched& S, const Epi& E, const int wave_id  ) {
    const int lane = lane_id_fresh(), wid = wave_id, tid = wid * 64 + lane,
              wr = wid >> 2, wc = wid & 3, fr = lane & 15, fq = lane >> 4;
    const int K = g.K, nt = K / BK;
    unsigned voffA[2], voffB[2]; int aoff, boff;
#define PG8_LANE_CONSTS() do { const int l_ = lane_id_fresh(), t_ = wid * 64 + l_, fr_ = l_ & 15, fq_ = l_ >> 4; \
        _Pragma("unroll") for (int i = 0; i < 2; ++i) { int R, C; stage_rc(t_ * 16 + i * 8192, R, C); const int Rb = Epi::PERM ? ((R & ~31) + perm32(R & 31)) : R; \
            voffA[i] = (unsigned)(R * K + C) * 2u; voffB[i] = (unsigned)(Rb * K + C) * 2u; } \
        aoff = lds_byte(wr * 64 + fr_, fq_ * 8); boff = lds_byte(wc * 32 + fr_, fq_ * 8); } while (0)
    PG8_LANE_CONSTS();
    const size_t kstep = (size_t)(BK * 2);
    const size_t hstep = (size_t)HALF * K * 2;
    const size_t tstep = 2 * hstep;
    const unsigned ldsw = (unsigned)wid * 1024u;
#define PG8_SA(b, h) (((b) * 2 + (h)) * HTB)
#define PG8_SB(b, h) ((4 + (b) * 2 + (h)) * HTB)
#define PG8_STAGE(bufoff, gbase, voff) do { _Pragma("unroll") for (int _i = 0; _i < 2; ++_i) \
        __builtin_amdgcn_global_load_lds((const unsigned*)((const char*)(gbase) + (voff)[_i]), (PG8_LAS unsigned*)(lds + (bufoff) + ldsw + _i * 8192), 16, 0, 0); } while (0)
#define PG8_LDA(dst, b, h) do { _Pragma("unroll") for (int m = 0; m < 4; ++m) _Pragma("unroll") for (int k = 0; k < 2; ++k) dst[m][k] = *(const PG8_LAS bf16x8*)(lds + PG8_SA(b, h) + aoff + m * 2048 + k * 1024); } while (0)
#define PG8_LDB(dst, b, h) do { _Pragma("unroll") for (int n = 0; n < 2; ++n) _Pragma("unroll") for (int k = 0; k < 2; ++k) dst[n][k] = *(const PG8_LAS bf16x8*)(lds + PG8_SB(b, h) + boff + n * 2048 + k * 1024); } while (0)
#define PG8_MMA(ai, bj, At, Bt) do { __builtin_amdgcn_s_setprio(1); _Pragma("unroll") for (int m = 0; m < 4; ++m) _Pragma("unroll") for (int n = 0; n < 2; ++n) _Pragma("unroll") for (int k = 0; k < 2; ++k) \
        acc[ai][bj][m][n] = __builtin_amdgcn_mfma_f32_16x16x32_bf16(Bt[n][k], At[m][k], acc[ai][bj][m][n], 0, 0, 0); __builtin_amdgcn_s_setprio(0); } while (0)
#define PG8_WAIT_V(n) asm volatile("s_waitcnt vmcnt(" #n ")" ::: "memory")
#define PG8_WAIT_L(n) asm volatile("s_waitcnt lgkmcnt(" #n ")" ::: "memory")
#define PG8_BAR __builtin_amdgcn_s_barrier()
#define PG8_SCHED __builtin_amdgcn_sched_barrier(0)
    Unit cur, nxt; int ui = 0;
    if (!S.next(0, cur)) return;
    f32x4 acc[2][2][4][2];
#pragma unroll
    for (int a = 0; a < 2; ++a)
#pragma unroll
        for (int b = 0; b < 2; ++b)
#pragma unroll
            for (int m = 0; m < 4; ++m)
#pragma unroll
                for (int n = 0; n < 2; ++n) acc[a][b][m][n] = (f32x4){0.f, 0.f, 0.f, 0.f};
    bf16x8 At[4][2], B0[2][2], B1[2][2];
    const char* cA = (const char*)g.A + (size_t)cur.pm * tstep; const char* cB = (const char*)g.Bt + (size_t)cur.pn * tstep;
    S.a_ready(cur);
    if constexpr (SP2) {
        PG8_STAGE(PG8_SB(0, 0), cB, voffB); PG8_STAGE(PG8_SB(0, 1), cB + hstep, voffB); PG8_STAGE(PG8_SA(0, 0), cA, voffA); PG8_STAGE(PG8_SA(0, 1), cA + hstep, voffA);
        if (wr == 1) PG8_BAR;
        PG8_WAIT_V(2); PG8_BAR;
        PG8_STAGE(PG8_SB(1, 0), cB + kstep, voffB); PG8_STAGE(PG8_SA(1, 0), cA + kstep, voffA); PG8_STAGE(PG8_SB(1, 1), cB + hstep + kstep, voffB);
        PG8_WAIT_V(6); PG8_BAR;
    } else {
        PG8_STAGE(PG8_SB(0, 0), cB, voffB); PG8_STAGE(PG8_SA(0, 0), cA, voffA); PG8_STAGE(PG8_SB(0, 1), cB + hstep, voffB); PG8_STAGE(PG8_SA(0, 1), cA + hstep, voffA);
        if (wr == 1) PG8_BAR;
        PG8_WAIT_V(4); PG8_BAR;
        PG8_STAGE(PG8_SB(1, 0), cB + kstep, voffB); PG8_STAGE(PG8_SA(1, 0), cA + kstep, voffA); PG8_STAGE(PG8_SB(1, 1), cB + hstep + kstep, voffB);
        PG8_WAIT_V(6); PG8_BAR;
    }
    for (;;) {
        const bool has_next = S.next(ui + 1, nxt);
        const char* nA = has_next ? (const char*)g.A + (size_t)nxt.pm * tstep : cA; const char* nB = has_next ? (const char*)g.Bt + (size_t)nxt.pn * tstep : cB;
        for (int t = 0; t < nt; t += 2) {
            const bool last = (t == nt - 2);
            const char* a1 = cA + (size_t)(t + 1) * kstep;
            const char* a2 = last ? nA : cA + (size_t)(t + 2) * kstep; const char* b2 = last ? nB : cB + (size_t)(t + 2) * kstep;
            const char* a3 = a2 + kstep; const char* b3 = b2 + kstep;
            if (last && has_next) S.a_ready(nxt);
            if constexpr (SP2) {
            PG8_LDB(B0, 0, 0); PG8_LDB(B1, 0, 1); PG8_SCHED; PG8_LDA(At, 0, 0); PG8_STAGE(PG8_SA(1, 1), a1 + hstep, voffA);
            PG8_WAIT_V(8); PG8_WAIT_L(0); PG8_BAR; PG8_MMA(0, 0, At, B0); PG8_MMA(0, 1, At, B1); PG8_BAR; PG8_SCHED;
            PG8_LDA(At, 0, 1); PG8_STAGE(PG8_SB(0, 0), b2, voffB); PG8_STAGE(PG8_SB(0, 1), b2 + hstep, voffB); PG8_STAGE(PG8_SA(0, 0), a2, voffA);
            PG8_WAIT_V(8); PG8_WAIT_L(0); PG8_BAR; PG8_MMA(1, 0, At, B0); PG8_MMA(1, 1, At, B1); PG8_BAR; PG8_SCHED;
            PG8_LDB(B0, 1, 0); PG8_LDB(B1, 1, 1); PG8_SCHED; PG8_LDA(At, 1, 0); PG8_STAGE(PG8_SA(0, 1), a2 + hstep, voffA);
            PG8_WAIT_V(8); PG8_WAIT_L(0); PG8_BAR; PG8_MMA(0, 0, At, B0); PG8_MMA(0, 1, At, B1); PG8_BAR; PG8_SCHED;
            PG8_LDA(At, 1, 1); PG8_STAGE(PG8_SB(1, 0), b3, voffB); PG8_STAGE(PG8_SB(1, 1), b3 + hstep, voffB); PG8_STAGE(PG8_SA(1, 0), a3, voffA);
            PG8_WAIT_V(8); PG8_WAIT_L(0); PG8_BAR; PG8_MMA(1, 0, At, B0); PG8_MMA(1, 1, At, B1); PG8_BAR; PG8_SCHED;
            } else {
            PG8_LDB(B0, 0, 0); PG8_SCHED; PG8_LDA(At, 0, 0); PG8_STAGE(PG8_SA(1, 1), a1 + hstep, voffA);
            PG8_WAIT_L(8); PG8_BAR; PG8_WAIT_L(0); PG8_MMA(0, 0, At, B0); PG8_BAR; PG8_SCHED;
            PG8_LDB(B1, 0, 1); PG8_STAGE(PG8_SB(0, 0), b2, voffB);
            PG8_BAR; PG8_WAIT_L(0); PG8_MMA(0, 1, At, B1); PG8_BAR;
            PG8_LDA(At, 0, 1); PG8_STAGE(PG8_SA(0, 0), a2, voffA);
            PG8_BAR; PG8_WAIT_L(0); PG8_MMA(1, 0, At, B0); PG8_BAR; PG8_SCHED;
            PG8_STAGE(PG8_SB(0, 1), b2 + hstep, voffB);
            PG8_WAIT_V(6); PG8_BAR; PG8_MMA(1, 1, At, B1); PG8_BAR;
            PG8_LDB(B0, 1, 0); PG8_SCHED; PG8_LDA(At, 1, 0); PG8_STAGE(PG8_SA(0, 1), a2 + hstep, voffA);
            PG8_WAIT_L(8); PG8_BAR; PG8_WAIT_L(0); PG8_MMA(0, 0, At, B0); PG8_BAR; PG8_SCHED;
            PG8_LDB(B1, 1, 1); PG8_STAGE(PG8_SB(1, 0), b3, voffB);
            PG8_BAR; PG8_WAIT_L(0); PG8_MMA(0, 1, At, B1); PG8_BAR;
            PG8_LDA(At, 1, 1); PG8_STAGE(PG8_SA(1, 0), a3, voffA);
            PG8_BAR; PG8_WAIT_L(0); PG8_MMA(1, 0, At, B0); PG8_BAR; PG8_SCHED;
            PG8_STAGE(PG8_SB(1, 1), b3 + hstep, voffB);
            PG8_WAIT_V(6); PG8_BAR; PG8_MMA(1, 1, At, B1); PG8_BAR;
            }
        }
        if constexpr (ALIGN_EPI) { if (wr == 0) PG8_BAR; }
        if constexpr (!Epi::AFTER_DRAIN) { E(acc, cur, wr, wc, fr, fq); S.done(cur); PG8_LANE_CONSTS(); }
        if (!has_next) break;
#pragma unroll
        for (int a = 0; a < 2; ++a)
#pragma unroll
            for (int b = 0; b < 2; ++b)
#pragma unroll
                for (int m = 0; m < 4; ++m)
#pragma unroll
                    for (int n = 0; n < 2; ++n) acc[a][b][m][n] = (f32x4){0.f, 0.f, 0.f, 0.f};
        cur = nxt; cA = nA; cB = nB; ++ui;
        if constexpr (ALIGN_EPI) { if (wr == 1) PG8_BAR; }
    }
    PG8_WAIT_V(0);
    if constexpr (!ALIGN_EPI) { if (wr == 0) PG8_BAR; }
    PG8_BAR;
    if constexpr (Epi::AFTER_DRAIN) { E.fused(acc, cur, wr, wc, fr, fq, lds, wid, lane); S.done(cur); }
#undef PG8_LANE_CONSTS
#undef PG8_SA
#undef PG8_SB
#undef PG8_STAGE
#undef PG8_LDA
#undef PG8_LDB
#undef PG8_MMA
#undef PG8_WAIT_V
#undef PG8_WAIT_L
#undef PG8_BAR
#undef PG8_SCHED
}
}
using pg8::SEQ; using pg8::NBATCH; using pg8::MTOK; using pg8::DM; using pg8::DFF; using pg8::RMS_EPS; using pg8::LOG2E;
#ifndef PG8_SP2
#define PG8_SP2 true
#endif
#ifndef PG8_ALIGN
#define PG8_ALIGN true
#endif
#ifndef MLA_OT
#define MLA_OT 1
#endif
namespace att {
using bf16x8 = __attribute__((ext_vector_type(8))) short;
using s16x4  = __attribute__((ext_vector_type(4))) short;
using f32x16 = __attribute__((ext_vector_type(16))) float;
using u32x4  = __attribute__((ext_vector_type(4))) unsigned;
typedef unsigned short bf16_t;
#define SBAR() __builtin_amdgcn_sched_barrier(0)
#define ATT_WAIT_BAR(N) asm volatile("s_waitcnt vmcnt(" #N ") lgkmcnt(0)\n\ts_barrier" ::: "memory")
__device__ __forceinline__ int crow(int r, int hi) { return (r & 3) + 8 * (r >> 2) + 4 * hi; }
__device__ __forceinline__ unsigned cvtpk(float lo, float hi) { unsigned r; asm volatile("v_cvt_pk_bf16_f32 %0, %1, %2" : "=v"(r) : "v"(lo), "v"(hi)); return r; }
__device__ __forceinline__ float bf2f(bf16_t b) { return __uint_as_float((unsigned)b << 16); }
typedef float f32x2_t __attribute__((ext_vector_type(2))); typedef __bf16 bf16x2_t __attribute__((ext_vector_type(2)));
__device__ __forceinline__ unsigned cvtpk2(float lo, float hi) { f32x2_t v = {lo, hi}; bf16x2_t r = __builtin_convertvector(v, bf16x2_t); return __builtin_bit_cast(unsigned, r); }
__device__ __forceinline__ bf16_t f2bf(float f) { return (bf16_t)(cvtpk(f, f) & 0xffffu); }
__device__ __forceinline__ void glds16(const void* gsrc, unsigned lds_dst) { unsigned keep;
    asm volatile("s_mov_b32 %0, m0\n\ts_mov_b32 m0, %2\n\ts_nop 0\n\tglobal_load_lds_dwordx4 %1, off\n\ts_mov_b32 m0, %0" : "=&s"(keep) : "v"(gsrc), "s"(lds_dst) : "memory"); }
template <int IMM> __device__ __forceinline__ void glds16s(const void* sbase, unsigned voff, unsigned lds_dst) { unsigned keep;
    asm volatile("s_mov_b32 %0, m0\n\ts_mov_b32 m0, %3\n\ts_nop 4\n\tglobal_load_lds_dwordx4 %1, %2 offset:%4\n\ts_mov_b32 m0, %0" : "=&s"(keep) : "v"(voff), "s"(sbase), "s"(lds_dst), "i"(IMM) : "memory"); }
__device__ __forceinline__ int swap23(int k) { return (k & ~0xC) | ((k & 4) << 1) | ((k & 8) >> 1); }
__device__ __forceinline__ int v_rd_base(int lane) { return ((lane & 3) << 3) | (((lane >> 2) & 3) << 6) | (((lane >> 4) & 1) << 5) | (((lane >> 5) & 1) << 8); }
template <int OFF> __device__ __forceinline__ s16x4 tr_read(int vb) { s16x4 r; asm volatile("ds_read_b64_tr_b16 %0, %1 offset:%2" : "=&v"(r) : "v"(vb), "i"(OFF) : "memory"); return r; }
__device__ __forceinline__ void pack_p(const f32x16& p0, const f32x16& p1, bf16x8& pa0, bf16x8& pa1, bf16x8& pa2, bf16x8& pa3) {
#define PK4(P, BASE, OUT) do { unsigned a0 = cvtpk(P[BASE + 0], P[BASE + 1]), a1 = cvtpk(P[BASE + 2], P[BASE + 3]);   \
    unsigned b0 = cvtpk(P[BASE + 4], P[BASE + 5]), b1 = cvtpk(P[BASE + 6], P[BASE + 7]);                              \
    auto r0 = __builtin_amdgcn_permlane32_swap(a0, b0, false, false); auto r1 = __builtin_amdgcn_permlane32_swap(a1, b1, false, false); \
    u32x4 w = {r0[0], r1[0], r0[1], r1[1]}; OUT = *reinterpret_cast<bf16x8*>(&w); } while (0)
    PK4(p0, 0, pa0); PK4(p0, 8, pa1); PK4(p1, 0, pa2); PK4(p1, 8, pa3);
#undef PK4
}
__device__ __forceinline__ float half_max(float v) { auto rr = __builtin_amdgcn_permlane32_swap(__float_as_uint(v), __float_as_uint(v), false, false); return fmaxf(__uint_as_float(rr[0]), __uint_as_float(rr[1])); }
__device__ __forceinline__ float half_sum(float v) { auto rr = __builtin_amdgcn_permlane32_swap(__float_as_uint(v), __float_as_uint(v), false, false); return __uint_as_float(rr[0]) + __uint_as_float(rr[1]); }
template <int ND0, int D0> __device__ __forceinline__ void pv_one(f32x16& od, int vb, bf16x8 pa0, bf16x8 pa1, bf16x8 pa2, bf16x8 pa3) {
    constexpr int KS = 1024 * ND0, HF = 512 * ND0;
    const s16x4 l0 = tr_read<D0 * 512 + 0 * KS>(vb), h0 = tr_read<D0 * 512 + 0 * KS + HF>(vb), l1 = tr_read<D0 * 512 + 1 * KS>(vb), h1 = tr_read<D0 * 512 + 1 * KS + HF>(vb);
    const s16x4 l2 = tr_read<D0 * 512 + 2 * KS>(vb), h2 = tr_read<D0 * 512 + 2 * KS + HF>(vb), l3 = tr_read<D0 * 512 + 3 * KS>(vb), h3 = tr_read<D0 * 512 + 3 * KS + HF>(vb);
    asm volatile("s_waitcnt lgkmcnt(0)" ::: "memory"); SBAR();
#define PK(L, H) (bf16x8){L[0], L[1], L[2], L[3], H[0], H[1], H[2], H[3]}
    od = __builtin_amdgcn_mfma_f32_32x32x16_bf16(pa0, PK(l0, h0), od, 0, 0, 0);
    od = __builtin_amdgcn_mfma_f32_32x32x16_bf16(pa1, PK(l1, h1), od, 0, 0, 0);
    od = __builtin_amdgcn_mfma_f32_32x32x16_bf16(pa2, PK(l2, h2), od, 0, 0, 0);
    od = __builtin_amdgcn_mfma_f32_32x32x16_bf16(pa3, PK(l3, h3), od, 0, 0, 0);
#undef PK
}
struct PvFrag { s16x4 l0, h0, l1, h1, l2, h2, l3, h3; };
template <int ND0, int D0> __device__ __forceinline__ void pv_issue(PvFrag& f, int vb) {
    constexpr int KS = 1024 * ND0, HF = 512 * ND0;
    f.l0 = tr_read<D0 * 512 + 0 * KS>(vb); f.h0 = tr_read<D0 * 512 + 0 * KS + HF>(vb); f.l1 = tr_read<D0 * 512 + 1 * KS>(vb); f.h1 = tr_read<D0 * 512 + 1 * KS + HF>(vb);
    f.l2 = tr_read<D0 * 512 + 2 * KS>(vb); f.h2 = tr_read<D0 * 512 + 2 * KS + HF>(vb); f.l3 = tr_read<D0 * 512 + 3 * KS>(vb); f.h3 = tr_read<D0 * 512 + 3 * KS + HF>(vb);
}
__device__ __forceinline__ void pv_mma(f32x16& od, const PvFrag& f, bf16x8 pa0, bf16x8 pa1, bf16x8 pa2, bf16x8 pa3) {
    asm volatile("s_waitcnt lgkmcnt(0)" ::: "memory"); SBAR();
#define PK(L, H) (bf16x8){L[0], L[1], L[2], L[3], H[0], H[1], H[2], H[3]}
    od = __builtin_amdgcn_mfma_f32_32x32x16_bf16(pa0, PK(f.l0, f.h0), od, 0, 0, 0);
    od = __builtin_amdgcn_mfma_f32_32x32x16_bf16(pa1, PK(f.l1, f.h1), od, 0, 0, 0);
    od = __builtin_amdgcn_mfma_f32_32x32x16_bf16(pa2, PK(f.l2, f.h2), od, 0, 0, 0);
    od = __builtin_amdgcn_mfma_f32_32x32x16_bf16(pa3, PK(f.l3, f.h3), od, 0, 0, 0);
#undef PK
}
template <int NK16, int RS, int CS> __device__ __forceinline__ void qkt(f32x16& p0, f32x16& p1, const char* Ks, const bf16x8* qr, int r32, int hi) {
    p0 = f32x16{}; p1 = f32x16{};
    const char* kb = Ks + hi * CS + r32 * RS;
#pragma unroll
    for (int d0 = 0; d0 < NK16; ++d0) {
        const bf16x8 b0 = *reinterpret_cast<const bf16x8*>(kb + d0 * 2 * CS), b1 = *reinterpret_cast<const bf16x8*>(kb + d0 * 2 * CS + 32 * RS);
        p0 = __builtin_amdgcn_mfma_f32_32x32x16_bf16(b0, qr[d0], p0, 0, 0, 0);
        p1 = __builtin_amdgcn_mfma_f32_32x32x16_bf16(b1, qr[d0], p1, 0, 0, 0); }
}

template <int NK16, int RS, int CS> __device__ __forceinline__ void qkt_c(f32x16& p0, f32x16& p1, const f32x16& c, const char* Ks, const bf16x8* qr, int r32, int hi) {
    const char* kb = Ks + hi * CS + r32 * RS;
    { const bf16x8 b0 = *reinterpret_cast<const bf16x8*>(kb), b1 = *reinterpret_cast<const bf16x8*>(kb + 32 * RS);
      p0 = __builtin_amdgcn_mfma_f32_32x32x16_bf16(b0, qr[0], c, 0, 0, 0);
      p1 = __builtin_amdgcn_mfma_f32_32x32x16_bf16(b1, qr[0], c, 0, 0, 0); }
#pragma unroll
    for (int d0 = 1; d0 < NK16; ++d0) {
        const bf16x8 b0 = *reinterpret_cast<const bf16x8*>(kb + d0 * 2 * CS), b1 = *reinterpret_cast<const bf16x8*>(kb + d0 * 2 * CS + 32 * RS);
        p0 = __builtin_amdgcn_mfma_f32_32x32x16_bf16(b0, qr[d0], p0, 0, 0, 0);
        p1 = __builtin_amdgcn_mfma_f32_32x32x16_bf16(b1, qr[d0], p1, 0, 0, 0); }
}
__device__ __forceinline__ float max3f(float a, float b, float c) { float r; asm("v_max3_f32 %0, %1, %2, %3" : "=v"(r) : "v"(a), "v"(b), "v"(c)); return r; }

namespace mla {
constexpr int NTILE = SEQ / 64;
constexpr int KPITCH = 400, KSLOT = 64 * KPITCH  , NSLOT = 4;
constexpr int LDS_K = 0, LDS_WS = NSLOT * KSLOT, LDS_BYTES = LDS_WS + 8 * 256;
constexpr int OST_PITCH = 272, OST_WAVE = 32 * OST_PITCH;
static_assert(8 * OST_WAVE <= NSLOT * KSLOT, "o_lat staging fits the ring");
#ifndef MLA_XVALU
#define MLA_XVALU 0
#endif
constexpr float THR = 8.f;
template <bool FIRST> __device__ __forceinline__ void partialSM(f32x16& p0, f32x16& p1, f32x16& negm, float& alpha) {
    float a = max3f(p0[0], p0[1], p0[2]), b = max3f(p0[9], p0[10], p0[11]), c = max3f(p1[0], p1[1], p1[2]), e = max3f(p1[9], p1[10], p1[11]);
    a = max3f(a, p0[3], p0[4]); b = max3f(b, p0[12], p0[13]); c = max3f(c, p1[3], p1[4]); e = max3f(e, p1[12], p1[13]);
    a = max3f(a, p0[5], p0[6]); b = max3f(b, p0[14], p0[15]); c = max3f(c, p1[5], p1[6]); e = max3f(e, p1[14], p1[15]);
    a = max3f(a, p0[7], p0[8]); c = max3f(c, p1[7], p1[8]);
    float pmax = max3f(a, b, c);
    pmax = max3f(pmax, e, e);
    { auto rr = __builtin_amdgcn_permlane32_swap(__float_as_uint(pmax), __float_as_uint(pmax), false, false); pmax = max3f(__uint_as_float(rr[0]), __uint_as_float(rr[1]), __uint_as_float(rr[1])); }
    alpha = 1.f;
    if (FIRST || !__builtin_expect(__all(pmax <= THR), 1)) {
        const float dl = FIRST ? pmax : fmaxf(pmax, 0.f);
        if (!FIRST) alpha = __builtin_amdgcn_exp2f(-dl);
#pragma unroll
        for (int r = 0; r < 16; ++r) { p0[r] -= dl; p1[r] -= dl; negm[r] -= dl; }
        asm volatile("" : "+v"(negm));
    }
#pragma unroll
    for (int r = 0; r < 16; ++r) p0[r] = __builtin_amdgcn_exp2f(p0[r]);
}
__device__ __forceinline__ void finishSM(f32x16& p0, f32x16& p1, float alpha, float& l_reg, bf16x8& pa0, bf16x8& pa1, bf16x8& pa2, bf16x8& pa3) {
#pragma unroll
    for (int r = 0; r < 16; ++r) p1[r] = __builtin_amdgcn_exp2f(p1[r]);
    float s0 = p0[0] + p0[1], s1 = p0[2] + p0[3], s2 = p1[0] + p1[1], s3 = p1[2] + p1[3];
#pragma unroll
    for (int r = 4; r < 16; r += 4) { s0 += p0[r]; s0 += p0[r + 1]; s1 += p0[r + 2]; s1 += p0[r + 3]; s2 += p1[r]; s2 += p1[r + 1]; s3 += p1[r + 2]; s3 += p1[r + 3]; }
    float ps = (s0 + s1) + (s2 + s3);
    ps = half_sum(ps);
    l_reg = l_reg * alpha + ps;
#if MLA_OT
#define MLA_PK(P, B) (u32x4){cvtpk2(P[B], P[B + 1]), cvtpk2(P[B + 2], P[B + 3]), cvtpk2(P[B + 4], P[B + 5]), cvtpk2(P[B + 6], P[B + 7])}
    { u32x4 w0 = MLA_PK(p0, 0), w1 = MLA_PK(p0, 8), w2 = MLA_PK(p1, 0), w3 = MLA_PK(p1, 8);
      pa0 = *reinterpret_cast<bf16x8*>(&w0); pa1 = *reinterpret_cast<bf16x8*>(&w1); pa2 = *reinterpret_cast<bf16x8*>(&w2); pa3 = *reinterpret_cast<bf16x8*>(&w3); }
#undef MLA_PK
#else
    pack_p(p0, p1, pa0, pa1, pa2, pa3);
#endif
}
__device__ __forceinline__ int v_rm_base(int lane) { return (8 * (lane >> 5) + ((lane >> 2) & 3)) * KPITCH + 32 * ((lane >> 4) & 1) + 8 * (lane & 3); }
template <int D0> __device__ __forceinline__ void pvr_issue(PvFrag& f, int vb) {
    constexpr int KS = 16 * KPITCH, HF = 4 * KPITCH;
    f.l0 = tr_read<D0 * 64 + 0 * KS>(vb); f.h0 = tr_read<D0 * 64 + 0 * KS + HF>(vb); f.l1 = tr_read<D0 * 64 + 1 * KS>(vb); f.h1 = tr_read<D0 * 64 + 1 * KS + HF>(vb);
    f.l2 = tr_read<D0 * 64 + 2 * KS>(vb); f.h2 = tr_read<D0 * 64 + 2 * KS + HF>(vb); f.l3 = tr_read<D0 * 64 + 3 * KS>(vb); f.h3 = tr_read<D0 * 64 + 3 * KS + HF>(vb);
}
template <int D0> __device__ __forceinline__ void pvr_one(f32x16& od, int vb, bf16x8 pa0, bf16x8 pa1, bf16x8 pa2, bf16x8 pa3) { PvFrag f; pvr_issue<D0>(f, vb); pv_mma(od, f, pa0, pa1, pa2, pa3); }
#if MLA_OT
__device__ __forceinline__ int vt_rm_base(int lane) { return (4 * (lane >> 5) + ((lane >> 2) & 3)) * KPITCH + 32 * ((lane >> 4) & 1) + 8 * (lane & 3); }
template <int D0> __device__ __forceinline__ void pvt_issue(PvFrag& f, int vb) {
    constexpr int KS = 16 * KPITCH, HF = 8 * KPITCH;
    f.l0 = tr_read<D0 * 64 + 0 * KS>(vb); f.h0 = tr_read<D0 * 64 + 0 * KS + HF>(vb); f.l1 = tr_read<D0 * 64 + 1 * KS>(vb); f.h1 = tr_read<D0 * 64 + 1 * KS + HF>(vb);
    f.l2 = tr_read<D0 * 64 + 2 * KS>(vb); f.h2 = tr_read<D0 * 64 + 2 * KS + HF>(vb); f.l3 = tr_read<D0 * 64 + 3 * KS>(vb); f.h3 = tr_read<D0 * 64 + 3 * KS + HF>(vb);
}
__device__ __forceinline__ void pvt_mma(f32x16& od, const PvFrag& f, bf16x8 pa0, bf16x8 pa1, bf16x8 pa2, bf16x8 pa3) {
    asm volatile("s_waitcnt lgkmcnt(0)" ::: "memory"); SBAR();
#define PK(L, H) (bf16x8){L[0], L[1], L[2], L[3], H[0], H[1], H[2], H[3]}
    od = __builtin_amdgcn_mfma_f32_32x32x16_bf16(PK(f.l0, f.h0), pa0, od, 0, 0, 0);
    od = __builtin_amdgcn_mfma_f32_32x32x16_bf16(PK(f.l1, f.h1), pa1, od, 0, 0, 0);
    od = __builtin_amdgcn_mfma_f32_32x32x16_bf16(PK(f.l2, f.h2), pa2, od, 0, 0, 0);
    od = __builtin_amdgcn_mfma_f32_32x32x16_bf16(PK(f.l3, f.h3), pa3, od, 0, 0, 0);
#undef PK
}
template <int D0> __device__ __forceinline__ void pvt_one(f32x16& od, int vb, bf16x8 pa0, bf16x8 pa1, bf16x8 pa2, bf16x8 pa3) { PvFrag f; pvt_issue<D0>(f, vb); pvt_mma(od, f, pa0, pa1, pa2, pa3); }
#define MLA_PV_ISSUE pvt_issue
#define MLA_PV_MMA pvt_mma
#define MLA_PV_ONE pvt_one
#define MLA_V_BASE vt_rm_base
#else
#define MLA_PV_ISSUE pvr_issue
#define MLA_PV_MMA pv_mma
#define MLA_PV_ONE pvr_one
#define MLA_V_BASE v_rm_base
#endif
__device__ __forceinline__ void h1_qk_finish(f32x16& C0, f32x16& C1, f32x16& P0, f32x16& P1, const f32x16& negm, const char* Ks, const bf16x8* qr, int r32, int hi,
                                             float alP, float& l_reg, bf16x8& pa0, bf16x8& pa1, bf16x8& pa2, bf16x8& pa3) {
    const char* kb = Ks + hi * 16 + r32 * KPITCH;
    bf16x8 b0 = *reinterpret_cast<const bf16x8*>(kb), b1 = *reinterpret_cast<const bf16x8*>(kb + 32 * KPITCH);
    float a0 = 0.f, a1 = 0.f, c0 = 0.f, c1 = 0.f; unsigned w[16];
#pragma unroll
    for (int k = 0; k < 12; ++k) {
        bf16x8 n0 = b0, n1 = b1;
        if (k < 11) { n0 = *reinterpret_cast<const bf16x8*>(kb + (k + 1) * 32); n1 = *reinterpret_cast<const bf16x8*>(kb + (k + 1) * 32 + 32 * KPITCH); }
        if (k == 0) { C0 = __builtin_amdgcn_mfma_f32_32x32x16_bf16(b0, qr[0], negm, 0, 0, 0); C1 = __builtin_amdgcn_mfma_f32_32x32x16_bf16(b1, qr[0], negm, 0, 0, 0); }
        else { C0 = __builtin_amdgcn_mfma_f32_32x32x16_bf16(b0, qr[k], C0, 0, 0, 0); C1 = __builtin_amdgcn_mfma_f32_32x32x16_bf16(b1, qr[k], C1, 0, 0, 0); }
        if (k < 8) { float e0 = __builtin_amdgcn_exp2f(P1[2 * k]), e1 = __builtin_amdgcn_exp2f(P1[2 * k + 1]);
            if (k == 0) { a0 = P0[0]; a1 = P0[1]; } else { a0 += P0[2 * k]; a1 += P0[2 * k + 1]; }
            w[k] = cvtpk2(P0[2 * k], P0[2 * k + 1]);
            asm volatile("" : "+v"(e0), "+v"(e1), "+v"(a0), "+v"(a1), "+v"(w[k]));
            P1[2 * k] = e0; P1[2 * k + 1] = e1; }
        else { const int e = 4 * (k - 8);
            if (k == 8) { c0 = P1[0] + P1[2]; c1 = P1[1] + P1[3]; } else { c0 += P1[e]; c1 += P1[e + 1]; c0 += P1[e + 2]; c1 += P1[e + 3]; }
            w[8 + 2 * (k - 8)] = cvtpk2(P1[e], P1[e + 1]); w[9 + 2 * (k - 8)] = cvtpk2(P1[e + 2], P1[e + 3]);
            asm volatile("" : "+v"(c0), "+v"(c1), "+v"(w[8 + 2 * (k - 8)]), "+v"(w[9 + 2 * (k - 8)])); }
        SBAR();
        b0 = n0; b1 = n1;
    }
    l_reg = l_reg * alP + half_sum((a0 + a1) + (c0 + c1));
    { u32x4 w0 = {w[0], w[1], w[2], w[3]}, w1 = {w[4], w[5], w[6], w[7]}, w2 = {w[8], w[9], w[10], w[11]}, w3 = {w[12], w[13], w[14], w[15]};
      pa0 = *reinterpret_cast<bf16x8*>(&w0); pa1 = *reinterpret_cast<bf16x8*>(&w1); pa2 = *reinterpret_cast<bf16x8*>(&w2); pa3 = *reinterpret_cast<bf16x8*>(&w3); }
}
__device__ __forceinline__ void max_head(const f32x16& p0, const f32x16& p1, float& a, float& b, float& c, float& e) {
    a = max3f(p0[0], p0[1], p0[2]); b = max3f(p0[9], p0[10], p0[11]); c = max3f(p1[0], p1[1], p1[2]); e = max3f(p1[9], p1[10], p1[11]);
    a = max3f(a, p0[3], p0[4]); b = max3f(b, p0[12], p0[13]); c = max3f(c, p1[3], p1[4]); e = max3f(e, p1[12], p1[13]);
}
__device__ __forceinline__ float max_tail(const f32x16& p0, const f32x16& p1, float a, float b, float c, float e) {
    a = max3f(a, p0[5], p0[6]); b = max3f(b, p0[14], p0[15]); c = max3f(c, p1[5], p1[6]); e = max3f(e, p1[14], p1[15]);
    a = max3f(a, p0[7], p0[8]); c = max3f(c, p1[7], p1[8]);
    float pmax = max3f(a, b, c); pmax = max3f(pmax, e, e);
    auto rr = __builtin_amdgcn_permlane32_swap(__float_as_uint(pmax), __float_as_uint(pmax), false, false);
    return max3f(__uint_as_float(rr[0]), __uint_as_float(rr[1]), __uint_as_float(rr[1]));
}
struct Tensors { const bf16_t* QA; const bf16_t* KL; const bf16_t* WV; const bf16_t* GA; const bf16_t* OB; bf16_t* MIX; };
__device__ __forceinline__ void unit(int b, int h, int qb, const Tensors& T, char* shm, const int wave_id) {
    const int lane = pg8::lane_id_fresh(), wid = wave_id, r32 = lane & 31, hi = lane >> 5;
    const long rowbase = (long)b * SEQ; const int q0 = qb * 256;
    const unsigned lds0 = (unsigned)(uintptr_t)shm;
    float* wsf = (float*)(shm + LDS_WS) + wid * 64; float* al_l = wsf; float* li_l = wsf + 32;
    const char* klb = (const char*)(T.KL + rowbase * 192);
    unsigned koff0, koff1, koff2;
    { int s = 64 * wid + lane, row = s / 25, pos = s - 25 * row; koff0 = (unsigned)(row * 384 + (pos < 24 ? pos : 23) * 16);
      s += 512; row = s / 25; pos = s - 25 * row; koff1 = (unsigned)(row * 384 + (pos < 24 ? pos : 23) * 16);
      s += 512; row = s / 25; pos = s - 25 * row; koff2 = (unsigned)(row * 384 + (pos < 24 ? pos : 23) * 16); }
#define MLA_DMA(t) do { const unsigned kd_ = (unsigned)__builtin_amdgcn_readfirstlane(lds0 + LDS_K + ((t) & 3) * KSLOT + wid * 1024); const char* kb_ = klb + (size_t)(t) * 24576; \
        glds16s<0>(kb_, koff0, kd_); glds16s<0>(kb_, koff1, kd_ + 8192); glds16s<0>(kb_, koff2, kd_ + 16384); \
        if (wid == 0) { const int s_ = 1536 + lane, row_ = 61 + (lane >= 14) + (lane >= 39), pos_ = s_ - 25 * row_; glds16s<0>(kb_, (unsigned)(row_ * 384 + (pos_ < 24 ? pos_ : 23) * 16), kd_ + 24576); } } while (0)
    MLA_DMA(0); MLA_DMA(1);
    bf16x8 qr[12];
    { const bf16_t* Qw = T.QA + (rowbase + q0 + wid * 32 + r32) * 1536 + h * 192 + hi * 8;
#pragma unroll
      for (int d0 = 0; d0 < 12; ++d0) qr[d0] = *reinterpret_cast<const bf16x8*>(Qw + d0 * 16); }
    const int vb0 = (int)(lds0 + LDS_K) + MLA_V_BASE(lane);
    float l_reg = 0.f; f32x16 o[4] = {};
    f32x16 negm = {}; asm volatile("" : "+v"(negm));
    f32x16 pA0, pA1, pB0, pB1; float alA, alB; bf16x8 pa0, pa1, pa2, pa3;
#if MLA_OT
#define MLA_RESC(a) do { if (__any((a) < 1.f)) { _Pragma("unroll") for (int d = 0; d < 4; ++d) _Pragma("unroll") for (int r = 0; r < 16; ++r) o[d][r] *= (a); } } while (0)
#else
#define MLA_RESC(a) do { if (__any((a) < 1.f)) { if (hi == 0) al_l[r32] = (a); asm volatile("s_waitcnt lgkmcnt(0)" ::: "memory"); \
        _Pragma("unroll") for (int d = 0; d < 4; ++d) _Pragma("unroll") for (int r = 0; r < 16; ++r) o[d][r] *= al_l[crow(r, hi)]; } } while (0)
#endif
#define ATT_BAR_L() asm volatile("s_waitcnt lgkmcnt(0)\n\ts_barrier" ::: "memory")
    ATT_WAIT_BAR(0);
    if (wid >= 4) ATT_BAR_L();
    qkt<12, KPITCH, 16>(pA0, pA1, shm + LDS_K, qr, r32, hi); ATT_WAIT_BAR(0);
    MLA_DMA(2); partialSM<true>(pA0, pA1, negm, alA); ATT_BAR_L();
#define MLA_STEP(C0, C1, P0, P1, alC, alP, t, HASN) do { \
        h1_qk_finish(C0, C1, P0, P1, negm, shm + LDS_K + ((t) & 3) * KSLOT, qr, r32, hi, alP, l_reg, pa0, pa1, pa2, pa3); SBAR(); ATT_WAIT_BAR(0); \
        { const int vb_ = vb0 + (((t) - 1) & 3) * KSLOT; float ma_, mb_, mc_, me_, pmx_; \
          { PvFrag f_; MLA_PV_ISSUE<0>(f_, vb_); if (HASN) { MLA_DMA((t) + 2); } max_head(C0, C1, ma_, mb_, mc_, me_); SBAR(); MLA_PV_MMA(o[0], f_, pa0, pa1, pa2, pa3); } \
          { PvFrag f_; MLA_PV_ISSUE<1>(f_, vb_); pmx_ = max_tail(C0, C1, ma_, mb_, mc_, me_); SBAR(); MLA_PV_MMA(o[1], f_, pa0, pa1, pa2, pa3); } \
          alC = 1.f; \
          if (!__builtin_expect(__all(pmx_ <= THR), 1)) { const float dl_ = fmaxf(pmx_, 0.f); alC = __builtin_amdgcn_exp2f(-dl_); \
              _Pragma("unroll") for (int r_ = 0; r_ < 16; ++r_) { C0[r_] -= dl_; C1[r_] -= dl_; negm[r_] -= dl_; } asm volatile("" : "+v"(negm)); } \
          { PvFrag f_; MLA_PV_ISSUE<2>(f_, vb_); _Pragma("unroll") for (int r_ = 0; r_ < 8; ++r_) C0[r_] = __builtin_amdgcn_exp2f(C0[r_]); asm volatile("" : "+v"(C0)); SBAR(); MLA_PV_MMA(o[2], f_, pa0, pa1, pa2, pa3); } \
          { PvFrag f_; MLA_PV_ISSUE<3>(f_, vb_); _Pragma("unroll") for (int r_ = 8; r_ < 16; ++r_) C0[r_] = __builtin_amdgcn_exp2f(C0[r_]); asm volatile("" : "+v"(C0)); SBAR(); MLA_PV_MMA(o[3], f_, pa0, pa1, pa2, pa3); } } \
        SBAR(); ATT_BAR_L(); MLA_RESC(alC); } while (0)
    for (int t = 1; t + 1 < NTILE; t += 2) {
        MLA_STEP(pB0, pB1, pA0, pA1, alB, alA, t, true);
        MLA_STEP(pA0, pA1, pB0, pB1, alA, alB, t + 1, (t + 3 < NTILE));
    }
    { qkt_c<12, KPITCH, 16>(pB0, pB1, negm, shm + LDS_K + ((NTILE - 1) & 3) * KSLOT, qr, r32, hi);
      finishSM(pA0, pA1, alA, l_reg, pa0, pa1, pa2, pa3); SBAR(); ATT_WAIT_BAR(0);
      { const int vb_ = vb0 + ((NTILE - 2) & 3) * KSLOT; MLA_PV_ONE<0>(o[0], vb_, pa0, pa1, pa2, pa3); MLA_PV_ONE<1>(o[1], vb_, pa0, pa1, pa2, pa3); MLA_PV_ONE<2>(o[2], vb_, pa0, pa1, pa2, pa3); MLA_PV_ONE<3>(o[3], vb_, pa0, pa1, pa2, pa3); }
      partialSM<false>(pB0, pB1, negm, alB);
      ATT_BAR_L(); MLA_RESC(alB);
      finishSM(pB0, pB1, alB, l_reg, pa0, pa1, pa2, pa3); SBAR();
      { const int vb_ = vb0 + ((NTILE - 1) & 3) * KSLOT; MLA_PV_ONE<0>(o[0], vb_, pa0, pa1, pa2, pa3); MLA_PV_ONE<1>(o[1], vb_, pa0, pa1, pa2, pa3); MLA_PV_ONE<2>(o[2], vb_, pa0, pa1, pa2, pa3); MLA_PV_ONE<3>(o[3], vb_, pa0, pa1, pa2, pa3); } }
    if (wid < 4) ATT_BAR_L();
#if MLA_OT
    { const float rl = __builtin_amdgcn_rcpf(l_reg);
      bf16x8 pb[8];
#pragma unroll
      for (int ks = 0; ks < 8; ++ks) { const int bl = ks >> 1, b8 = (ks & 1) * 8;
          u32x4 w = {cvtpk(o[bl][b8 + 0] * rl, o[bl][b8 + 1] * rl), cvtpk(o[bl][b8 + 2] * rl, o[bl][b8 + 3] * rl), cvtpk(o[bl][b8 + 4] * rl, o[bl][b8 + 5] * rl), cvtpk(o[bl][b8 + 6] * rl, o[bl][b8 + 7] * rl)};
          pb[ks] = *reinterpret_cast<bf16x8*>(&w); }
      const bf16_t* wv = T.WV + ((size_t)(h * 128 + r32) * 128 + hi * 8);
      const size_t rowoff = (size_t)(rowbase + q0 + wid * 32 + r32) * 1024 + h * 128 + 4 * hi;
#pragma unroll
      for (int db = 0; db < 4; ++db) { f32x16 oa = f32x16{};
#pragma unroll
          for (int ks = 0; ks < 8; ++ks) { const bf16x8 bw = *reinterpret_cast<const bf16x8*>(wv + (size_t)db * 32 * 128 + ks * 16);
              oa = __builtin_amdgcn_mfma_f32_32x32x16_bf16(bw, pb[ks], oa, 0, 0, 0); }
#pragma unroll
          for (int g = 0; g < 4; ++g) { const size_t off = rowoff + db * 32 + 8 * g;
              const pg8::u32x2 ga = *reinterpret_cast<const pg8::u32x2*>(T.GA + off), ob = *reinterpret_cast<const pg8::u32x2*>(T.OB + off);
              const float v0 = oa[4 * g + 0] * __uint_as_float(ga.x << 16) + __uint_as_float(ob.x << 16), v1 = oa[4 * g + 1] * __uint_as_float(ga.x & 0xffff0000u) + __uint_as_float(ob.x & 0xffff0000u);
              const float v2 = oa[4 * g + 2] * __uint_as_float(ga.y << 16) + __uint_as_float(ob.y << 16), v3 = oa[4 * g + 3] * __uint_as_float(ga.y & 0xffff0000u) + __uint_as_float(ob.y & 0xffff0000u);
              pg8::u32x2 w; w.x = cvtpk(v0, v1); w.y = cvtpk(v2, v3); *reinterpret_cast<pg8::u32x2*>(T.MIX + off) = w; } } }
#else
    if (hi == 0) li_l[r32] = l_reg; asm volatile("s_waitcnt lgkmcnt(0)" ::: "memory");
    ATT_BAR_L();
    { char* stg = shm + LDS_K + wid * OST_WAVE;
#if MLA_OT
#pragma unroll
      for (int r = 0; r < 16; ++r) { const float rl = __builtin_amdgcn_rcpf(l_reg);
#pragma unroll
          for (int d0 = 0; d0 < 4; ++d0) *(bf16_t*)(stg + r32 * OST_PITCH + (d0 * 32 + crow(r, hi)) * 2) = f2bf(o[d0][r] * rl); }
#else
#pragma unroll
      for (int r = 0; r < 16; ++r) { const float rl = __builtin_amdgcn_rcpf(li_l[crow(r, hi)]);
#pragma unroll
          for (int d0 = 0; d0 < 4; ++d0) *(bf16_t*)(stg + crow(r, hi) * OST_PITCH + (d0 * 32 + r32) * 2) = f2bf(o[d0][r] * rl); }
#endif
      asm volatile("s_waitcnt lgkmcnt(0)" ::: "memory");
      bf16x8 af[8];
#pragma unroll
      for (int ks = 0; ks < 8; ++ks) af[ks] = *reinterpret_cast<const bf16x8*>(stg + r32 * OST_PITCH + ks * 32 + hi * 16);
      const bf16_t* wv = T.WV + ((size_t)(h * 128 + r32) * 128 + hi * 8);
#pragma unroll
      for (int d0 = 0; d0 < 4; ++d0) { o[d0] = f32x16{};
#pragma unroll
          for (int ks = 0; ks < 8; ++ks) { const bf16x8 bw = *reinterpret_cast<const bf16x8*>(wv + (size_t)d0 * 32 * 128 + ks * 16);
              o[d0] = __builtin_amdgcn_mfma_f32_32x32x16_bf16(af[ks], bw, o[d0], 0, 0, 0); } } }
    const long orow0 = rowbase + q0 + wid * 32;
#pragma unroll
    for (int r = 0; r < 16; ++r) { const long off = (orow0 + crow(r, hi)) * 1024 + h * 128 + r32;
#pragma unroll
        for (int d0 = 0; d0 < 4; ++d0) { const float v = o[d0][r] * bf2f(T.GA[off + d0 * 32]) + bf2f(T.OB[off + d0 * 32]); T.MIX[off + d0 * 32] = f2bf(v); } }
#endif
    asm volatile("s_waitcnt lgkmcnt(0)\n\ts_barrier" ::: "memory");
#undef MLA_DMA
#undef MLA_RESC
#undef ATT_BAR_L
#undef MLA_STEP
#undef MLA_PV_ISSUE
#undef MLA_PV_MMA
#undef MLA_PV_ONE
#undef MLA_V_BASE
}
}

namespace mla2 {
using mla::NTILE; using mla::KPITCH; using mla::KSLOT; using mla::THR; using mla::OST_PITCH; using mla::OST_WAVE;
constexpr int NSLOT = 3;
constexpr int LDS_K = 0, LDS_P = NSLOT * KSLOT  , LDS_X = LDS_P + 65536  , LDS_BYTES = LDS_X + 4096;
static_assert(8 * OST_WAVE <= NSLOT * KSLOT, "o_lat staging fits the ring");
using mla::Tensors;
__device__ __forceinline__ void softmax_block(f32x16& p0, f32x16& p1, float& m_reg, float& l_reg, float& alpha, bf16x8& pa0, bf16x8& pa1, bf16x8& pa2, bf16x8& pa3) {
    float pm0 = fmaxf(p0[0], p0[1]), pm1 = fmaxf(p0[2], p0[3]), pm2 = fmaxf(p1[0], p1[1]), pm3 = fmaxf(p1[2], p1[3]);
#pragma unroll
    for (int r = 4; r < 16; r += 4) { pm0 = fmaxf(fmaxf(pm0, p0[r]), p0[r + 1]); pm1 = fmaxf(fmaxf(pm1, p0[r + 2]), p0[r + 3]); pm2 = fmaxf(fmaxf(pm2, p1[r]), p1[r + 1]); pm3 = fmaxf(fmaxf(pm3, p1[r + 2]), p1[r + 3]); }
    const float pmax = half_max(fmaxf(fmaxf(pm0, pm1), fmaxf(pm2, pm3)));
    const bool keep = __all(pmax - m_reg <= THR);
    const float mn = keep ? m_reg : fmaxf(m_reg, pmax); alpha = __builtin_amdgcn_exp2f(m_reg - mn); m_reg = mn;
#pragma unroll
    for (int r = 0; r < 16; ++r) { p0[r] = __builtin_amdgcn_exp2f(p0[r] - mn); p1[r] = __builtin_amdgcn_exp2f(p1[r] - mn); }
    float s0 = p0[0] + p0[1], s1 = p0[2] + p0[3], s2 = p1[0] + p1[1], s3 = p1[2] + p1[3];
#pragma unroll
    for (int r = 4; r < 16; r += 4) { s0 += p0[r]; s0 += p0[r + 1]; s1 += p0[r + 2]; s1 += p0[r + 3]; s2 += p1[r]; s2 += p1[r + 1]; s3 += p1[r + 2]; s3 += p1[r + 3]; }
    l_reg = l_reg * alpha + half_sum((s0 + s1) + (s2 + s3));
    pack_p(p0, p1, pa0, pa1, pa2, pa3);
}
__device__ __forceinline__ void out_block(const char* stg, const Tensors& T, int h, long orow0, int r32, int hi) {
    bf16x8 af[8];
#pragma unroll
    for (int ks = 0; ks < 8; ++ks) af[ks] = *reinterpret_cast<const bf16x8*>(stg + r32 * OST_PITCH + ks * 32 + hi * 16);
    const bf16_t* wv = T.WV + ((size_t)(h * 128 + r32) * 128 + hi * 8);
    f32x16 oa[4];
#pragma unroll
    for (int d0 = 0; d0 < 4; ++d0) { oa[d0] = f32x16{};
#pragma unroll
        for (int ks = 0; ks < 8; ++ks) { const bf16x8 bw = *reinterpret_cast<const bf16x8*>(wv + (size_t)d0 * 32 * 128 + ks * 16);
            oa[d0] = __builtin_amdgcn_mfma_f32_32x32x16_bf16(af[ks], bw, oa[d0], 0, 0, 0); } }
#pragma unroll
    for (int r = 0; r < 16; ++r) { const long off = (orow0 + crow(r, hi)) * 1024 + h * 128 + r32;
#pragma unroll
        for (int d0 = 0; d0 < 4; ++d0) { const float v = oa[d0][r] * bf2f(T.GA[off + d0 * 32]) + bf2f(T.OB[off + d0 * 32]); T.MIX[off + d0 * 32] = f2bf(v); } }
}
__device__ __forceinline__ void unit(int b, int h, int qb, const Tensors& T, char* shm, const int wave_id) {
    const int lane = pg8::lane_id_fresh(), wid = wave_id, r32 = lane & 31, hi = lane >> 5;
    const bool is_qk = wid < 4; const int pair = wid & 3;
    const long rowbase = (long)b * SEQ; const int q0 = qb * 256;
    const unsigned lds0 = (unsigned)(uintptr_t)shm;
    char* Pp = shm + LDS_P + pair * 8192; char* Xp = shm + LDS_X + pair * 1024;
    float* alx = (float*)Xp; float* lx = (float*)(Xp + 512); unsigned* fx = (unsigned*)(Xp + 768);
#define M2_BAR() asm volatile("s_waitcnt vmcnt(0) lgkmcnt(0)\n\ts_barrier" ::: "memory")
    const char* klb = (const char*)(T.KL + rowbase * 192);
#define M2_PIECE(kb_, p_, dst_) do { const int s_ = 64 * (p_) + lane, row_ = (s_ * 1311) >> 15, pos_ = s_ - 25 * row_; \
        glds16s<0>(kb_, (unsigned)(row_ * 384 + (pos_ < 24 ? pos_ : 23) * 16), (unsigned)__builtin_amdgcn_readfirstlane(dst_ + (p_) * 1024)); } while (0)
#define M2_DMA(t) do { const unsigned sd_ = lds0 + LDS_K + ((t) % 3) * KSLOT; const char* kb_ = klb + (size_t)(t) * 24576; \
        _Pragma("unroll") for (int i_ = 0; i_ < 6; ++i_) M2_PIECE(kb_, pair + 4 * i_, sd_); if (pair == 0) M2_PIECE(kb_, 24, sd_); } while (0)
    const int vb0 = (int)(lds0 + LDS_K) + mla::v_rm_base(lane);
#define M2_BAR_L() asm volatile("s_waitcnt lgkmcnt(0)\n\ts_barrier" ::: "memory")
    if (is_qk) {
        bf16x8 qA[12], qB[12]; float mA = -1e30f, mB = -1e30f, lA = 0.f, lB = 0.f;
        { const bf16_t* Qw = T.QA + (rowbase + q0 + pair * 64 + r32) * 1536 + h * 192 + hi * 8;
#pragma unroll
          for (int d0 = 0; d0 < 12; ++d0) { qA[d0] = *reinterpret_cast<const bf16x8*>(Qw + d0 * 16); qB[d0] = *reinterpret_cast<const bf16x8*>(Qw + 32 * 1536 + d0 * 16); } }
        f32x16 pA0, pA1, pB0, pB1;
        char* pw = Pp + lane * 16;
#define M2_QK(P0, P1, Q, t) do { P0 = f32x16{}; P1 = f32x16{}; const char* kb_ = shm + LDS_K + ((t) % 3) * KSLOT + hi * 16 + r32 * KPITCH; \
        _Pragma("unroll") for (int d0 = 0; d0 < 12; ++d0) { const bf16x8 b0_ = *reinterpret_cast<const bf16x8*>(kb_ + d0 * 32), b1_ = *reinterpret_cast<const bf16x8*>(kb_ + d0 * 32 + 32 * KPITCH); \
            P0 = __builtin_amdgcn_mfma_f32_32x32x16_bf16(b0_, Q[d0], P0, 0, 0, 0); P1 = __builtin_amdgcn_mfma_f32_32x32x16_bf16(b1_, Q[d0], P1, 0, 0, 0); } } while (0)
#define M2_SM(P0, P1, M, L, BLK) do { bf16x8 a0_, a1_, a2_, a3_; float al_; softmax_block(P0, P1, M, L, al_, a0_, a1_, a2_, a3_); \
        *reinterpret_cast<bf16x8*>(pw + (BLK) * 4096) = a0_; *reinterpret_cast<bf16x8*>(pw + (BLK) * 4096 + 1024) = a1_; *reinterpret_cast<bf16x8*>(pw + (BLK) * 4096 + 2048) = a2_; *reinterpret_cast<bf16x8*>(pw + (BLK) * 4096 + 3072) = a3_; \
        const bool f_ = __any(al_ < 1.f); if (hi == 0) alx[(BLK) * 32 + r32] = al_; if (lane == 0) fx[BLK] = f_ ? 1u : 0u; } while (0)
        M2_BAR();
        M2_QK(pA0, pA1, qA, 0); M2_BAR_L();
        M2_QK(pB0, pB1, qB, 0); M2_SM(pA0, pA1, mA, lA, 0); M2_BAR_L();
        for (int t = 1; t < NTILE; ++t) {
            M2_QK(pA0, pA1, qA, t); M2_SM(pB0, pB1, mB, lB, 1); M2_BAR_L();
            M2_QK(pB0, pB1, qB, t); M2_SM(pA0, pA1, mA, lA, 0); M2_BAR_L();
        }
        M2_SM(pB0, pB1, mB, lB, 1); M2_BAR_L();
        M2_BAR_L();
        if (hi == 0) { lx[r32] = lA; lx[32 + r32] = lB; }
        M2_BAR();
        M2_BAR();
#undef M2_QK
#undef M2_SM
    } else {
        f32x16 oA[4] = {}, oB[4] = {};
        const char* pr = Pp + lane * 16;
#define M2_PVB(O, BLK, t1) do { const int vb_ = vb0 + ((t1) % 3) * KSLOT; \
        const bf16x8 a0_ = *reinterpret_cast<const bf16x8*>(pr + (BLK) * 4096), a1_ = *reinterpret_cast<const bf16x8*>(pr + (BLK) * 4096 + 1024), a2_ = *reinterpret_cast<const bf16x8*>(pr + (BLK) * 4096 + 2048), a3_ = *reinterpret_cast<const bf16x8*>(pr + (BLK) * 4096 + 3072); \
        if (fx[BLK] != 0u) { _Pragma("unroll") for (int d = 0; d < 4; ++d) _Pragma("unroll") for (int r = 0; r < 16; ++r) O[d][r] *= alx[(BLK) * 32 + crow(r, hi)]; } \
        mla::pvr_one<0>(O[0], vb_, a0_, a1_, a2_, a3_); mla::pvr_one<1>(O[1], vb_, a0_, a1_, a2_, a3_); mla::pvr_one<2>(O[2], vb_, a0_, a1_, a2_, a3_); mla::pvr_one<3>(O[3], vb_, a0_, a1_, a2_, a3_); } while (0)
        M2_DMA(0);
        M2_BAR();
        M2_DMA(1); M2_BAR_L();
        M2_BAR();
        for (int t = 1; t < NTILE; ++t) {
            if (t + 1 < NTILE) M2_DMA(t + 1);
            M2_PVB(oA, 0, t - 1); M2_BAR_L();
            M2_PVB(oB, 1, t - 1); M2_BAR();
        }
        M2_PVB(oA, 0, NTILE - 1); M2_BAR_L();
        M2_PVB(oB, 1, NTILE - 1); M2_BAR_L();
#undef M2_PVB
        M2_BAR();
        { char* stgA = shm + LDS_K + (2 * pair) * OST_WAVE; char* stgB = stgA + OST_WAVE;
#pragma unroll
          for (int r = 0; r < 16; ++r) { const float ra = __builtin_amdgcn_rcpf(lx[crow(r, hi)]), rb = __builtin_amdgcn_rcpf(lx[32 + crow(r, hi)]);
#pragma unroll
              for (int d0 = 0; d0 < 4; ++d0) { *(bf16_t*)(stgA + crow(r, hi) * OST_PITCH + (d0 * 32 + r32) * 2) = f2bf(oA[d0][r] * ra); *(bf16_t*)(stgB + crow(r, hi) * OST_PITCH + (d0 * 32 + r32) * 2) = f2bf(oB[d0][r] * rb); } } }
        M2_BAR();
    }
#undef M2_BAR_L
    { const char* stg = shm + LDS_K + (2 * pair + (is_qk ? 1 : 0)) * OST_WAVE;
      out_block(stg, T, h, rowbase + q0 + pair * 64 + (is_qk ? 32 : 0), r32, hi); }
    asm volatile("s_waitcnt lgkmcnt(0)\n\ts_barrier" ::: "memory");
#undef M2_BAR
#undef M2_PIECE
#undef M2_DMA
}
}

namespace swa {
constexpr int KP = 144  , KT = 64 * KP  ;
constexpr int LDS_K = 0, LDS_V = 5 * KT, LDS_TAB = LDS_V + 5 * 8192, LDS_WS = LDS_TAB + 4 * 384 * 4, LDS_BYTES = LDS_WS + 8 * 256;
struct Tensors { const bf16_t* QB; const bf16_t* KB; const bf16_t* VB; bf16_t* GOB; const float* BT2; const float* SINK2; };
__device__ __forceinline__ int vt_base64(int lane) { return ((lane & 3) << 3) | (((lane >> 2) & 3) << 6) | (((lane >> 4) & 1) << 5) | ((lane >> 5) << 10); }
template <int D0> __device__ __forceinline__ void pvt64(f32x16& od, int vb, bf16x8 pa0, bf16x8 pa1, bf16x8 pa2, bf16x8 pa3) {
    const s16x4 l0 = tr_read<D0 * 512 + 0 * 2048>(vb), h0 = tr_read<D0 * 512 + 0 * 2048 + 256>(vb), l1 = tr_read<D0 * 512 + 1 * 2048>(vb), h1 = tr_read<D0 * 512 + 1 * 2048 + 256>(vb);
    const s16x4 l2 = tr_read<D0 * 512 + 2 * 2048>(vb), h2 = tr_read<D0 * 512 + 2 * 2048 + 256>(vb), l3 = tr_read<D0 * 512 + 3 * 2048>(vb), h3 = tr_read<D0 * 512 + 3 * 2048 + 256>(vb);
    asm volatile("s_waitcnt lgkmcnt(0)" ::: "memory"); SBAR();
#define PK(L, H) (bf16x8){L[0], L[1], L[2], L[3], H[0], H[1], H[2], H[3]}
    od = __builtin_amdgcn_mfma_f32_32x32x16_bf16(PK(l0, h0), pa0, od, 0, 0, 0);
    od = __builtin_amdgcn_mfma_f32_32x32x16_bf16(PK(l1, h1), pa1, od, 0, 0, 0);
    od = __builtin_amdgcn_mfma_f32_32x32x16_bf16(PK(l2, h2), pa2, od, 0, 0, 0);
    od = __builtin_amdgcn_mfma_f32_32x32x16_bf16(PK(l3, h3), pa3, od, 0, 0, 0);
#undef PK
}
__device__ __forceinline__ void unit(int b, int kvh, int qblk, const Tensors& T, char* shm, const int wave_id) {
    const int lane = pg8::lane_id_fresh(), wid = wave_id, tid = wid * 64 + lane, r32 = lane & 31, hi = lane >> 5;
    const int g = wid >> 1, rh = wid & 1, head = kvh * 4 + g;
    const long rowbase = (long)b * SEQ; const int q0 = qblk * 64;
    const unsigned lds0 = (unsigned)(uintptr_t)shm;
    float* wsf = (float*)(shm + LDS_WS) + wid * 64; float* al_l = wsf; float* li_l = wsf + 32;
    const int t_lo = (q0 < 128) ? (128 - q0) / 64 : 0, t_hi = (SEQ - (q0 - 128)) / 64 < 5 ? (SEQ - (q0 - 128)) / 64 : 5;
    { const int st = 2 * wid + (lane >> 5), kk = (st >> 1) * 8 + ((lane & 31) >> 2), k = swap23(kk), c = (st & 1) * 32 + (lane & 3) * 8;
      const unsigned vvoff = (unsigned)((k * 256 + c) * 2);
      unsigned kvoff, kvoff8; { int s = 64 * wid + lane, row = s / 9, pos = s - 9 * row; kvoff = (unsigned)(row * 512 + (pos < 8 ? pos : 7) * 16); s = 512 + lane; row = s / 9; pos = s - 9 * row; kvoff8 = (unsigned)(row * 512 + (pos < 8 ? pos : 7) * 16); }
      for (int t = t_lo; t < t_hi; ++t) { const long kb = rowbase + q0 - 128 + 64 * t;
          glds16s<0>((const char*)(T.KB + kb * 256 + kvh * 64), kvoff, (unsigned)__builtin_amdgcn_readfirstlane(lds0 + LDS_K + t * KT + wid * 1024));
          if (wid == 0) glds16s<0>((const char*)(T.KB + kb * 256 + kvh * 64), kvoff8, (unsigned)__builtin_amdgcn_readfirstlane(lds0 + LDS_K + t * KT + 8192));
          glds16s<0>((const char*)(T.VB + kb * 256 + kvh * 64), vvoff, (unsigned)__builtin_amdgcn_readfirstlane(lds0 + LDS_V + t * 8192 + wid * 1024)); } }
    { float* tab = (float*)(shm + LDS_TAB);
      for (int i = tid; i < 4 * 384; i += 512) { const int gg = i / 384, rel = i % 384 - 192;
          tab[i] = (rel >= -128 && rel <= 128) ? T.BT2[(kvh * 4 + gg) * 264 + rel + 128] : -1e30f; } }
    bf16x8 qr[4];
    { const bf16_t* Qw = T.QB + (rowbase + q0 + rh * 32 + r32) * 1024 + head * 64 + hi * 8;
#pragma unroll
      for (int d0 = 0; d0 < 4; ++d0) qr[d0] = *reinterpret_cast<const bf16x8*>(Qw + d0 * 16); }
    float m_reg = T.SINK2[head], l_reg = 1.0f; f32x16 o[2] = {};
    const int vb0 = (int)(lds0 + LDS_V) + vt_base64(lane);
    const float* tabg = (const float*)(shm + LDS_TAB) + g * 384;
    ATT_WAIT_BAR(0);
    for (int t = t_lo; t < t_hi; ++t) {
        f32x16 p0, p1; bf16x8 pa0, pa1, pa2, pa3;
        qkt<4, KP, 16>(p0, p1, shm + LDS_K + t * KT, qr, r32, hi);
        const float* tb = tabg + (64 * t + 64 - 32 * rh - r32 + 4 * hi);
#pragma unroll
        for (int r = 0; r < 16; ++r) { p0[r] += tb[(r & 3) + 8 * (r >> 2)]; p1[r] += tb[32 + (r & 3) + 8 * (r >> 2)]; }
        float pmax = p0[0];
#pragma unroll
        for (int r = 1; r < 16; ++r) pmax = fmaxf(pmax, p0[r]);
#pragma unroll
        for (int r = 0; r < 16; ++r) pmax = fmaxf(pmax, p1[r]);
        pmax = half_max(pmax);
        const float mn = fmaxf(m_reg, pmax), alpha = __builtin_amdgcn_exp2f(m_reg - mn); m_reg = mn;
        float ps = 0.f;
#pragma unroll
        for (int r = 0; r < 16; ++r) { p0[r] = __builtin_amdgcn_exp2f(p0[r] - mn); p1[r] = __builtin_amdgcn_exp2f(p1[r] - mn); ps += p0[r] + p1[r]; }
        ps = half_sum(ps); l_reg = l_reg * alpha + ps;
#define SWA_PK(P, B) (u32x4){cvtpk(P[B], P[B + 1]), cvtpk(P[B + 2], P[B + 3]), cvtpk(P[B + 4], P[B + 5]), cvtpk(P[B + 6], P[B + 7])}
        { u32x4 w0 = SWA_PK(p0, 0), w1 = SWA_PK(p0, 8), w2 = SWA_PK(p1, 0), w3 = SWA_PK(p1, 8);
          pa0 = *reinterpret_cast<bf16x8*>(&w0); pa1 = *reinterpret_cast<bf16x8*>(&w1); pa2 = *reinterpret_cast<bf16x8*>(&w2); pa3 = *reinterpret_cast<bf16x8*>(&w3); }
#undef SWA_PK
        if (__any(alpha < 1.f)) {
#pragma unroll
            for (int d = 0; d < 2; ++d)
#pragma unroll
                for (int r = 0; r < 16; ++r) o[d][r] *= alpha; }
        SBAR();
        pvt64<0>(o[0], vb0 + t * 8192, pa0, pa1, pa2, pa3); pvt64<1>(o[1], vb0 + t * 8192, pa0, pa1, pa2, pa3);
    }
    { const float rl = __builtin_amdgcn_rcpf(l_reg);
      bf16_t* orow = T.GOB + (size_t)(rowbase + q0 + rh * 32 + r32) * 1024 + head * 64 + 4 * hi;
#pragma unroll
      for (int d0 = 0; d0 < 2; ++d0)
#pragma unroll
          for (int gq = 0; gq < 4; ++gq) { bf16_t* p = orow + d0 * 32 + 8 * gq; const pg8::u32x2 gt = *reinterpret_cast<const pg8::u32x2*>(p);
              const float v0 = o[d0][4 * gq + 0] * rl * __uint_as_float(gt.x << 16), v1 = o[d0][4 * gq + 1] * rl * __uint_as_float(gt.x & 0xffff0000u);
              const float v2 = o[d0][4 * gq + 2] * rl * __uint_as_float(gt.y << 16), v3 = o[d0][4 * gq + 3] * rl * __uint_as_float(gt.y & 0xffff0000u);
              pg8::u32x2 w; w.x = cvtpk(v0, v1); w.y = cvtpk(v2, v3); *reinterpret_cast<pg8::u32x2*>(p) = w; } }
    asm volatile("s_waitcnt lgkmcnt(0)\n\ts_barrier" ::: "memory");
}
}
#undef SBAR
#undef ATT_WAIT_BAR
}
constexpr int NWAVES = 8;
#ifndef MK_PER_PHASE
#define MK_PER_PHASE 0
#endif
constexpr int N_PHASES = 8;

constexpr size_t MiB = 1u << 20;
constexpr size_t WS_CTL = 0, CTL_ZERO_BYTES = 128 * 1024;
constexpr size_t WS_COS = 1 * MiB, WS_SIN = WS_COS + 512 * 1024;
constexpr size_t WS_BT2 = 2 * MiB, WS_SINK2 = WS_BT2 + 16 * 264 * 4;
constexpr size_t WS_SSQQ = 3 * MiB, WS_SSQKV = WS_SSQQ + 512 * 1024;
constexpr size_t WS_SSQ2 = 4 * MiB, WS_SSQ3 = 6 * MiB;
constexpr size_t WS_WIN = 8 * MiB, WS_WQB = 16 * MiB, WS_WVT = 17 * MiB, WS_WOUT = 18 * MiB, WS_WUP = 20 * MiB, WS_WDN = 31 * MiB;
constexpr size_t WS_A0 = 40 * MiB;
constexpr size_t WS_XN = WS_A0;
constexpr size_t WS_X1B = WS_A0;
constexpr size_t WS_QLAT = 104 * MiB, WS_KL = 120 * MiB  , WS_QB = 132 * MiB, WS_KB = 196 * MiB, WS_VB = 212 * MiB, WS_GA = 228 * MiB, WS_GB = 292 * MiB;
constexpr size_t WS_MIX = WS_QB;
constexpr size_t WS_HALO = 104 * MiB;
constexpr size_t WS_ACT = 296 * MiB;
constexpr size_t WS_END = 472 * MiB;
static_assert(WS_ACT + (size_t)MTOK * DFF * 2 <= WS_END && WS_HALO + (size_t)(MTOK / 64) * 4 * 5632 * 4 <= WS_ACT && WS_KL + (size_t)MTOK * 192 * 2 <= WS_QB, "d_ws map");
constexpr int CW_BAR = 4096;
static_assert((CW_BAR + 3456) * 4 <= 65536, "barrier words below the panel counters");
constexpr int CW_PANEL = 16384;

constexpr int RING_OFF = 0, RING_BYTES = 146432;
constexpr int LDSCTL_OFF = RING_BYTES, MISC_OFF = LDSCTL_OFF + 320;
constexpr int LDS_BYTES = 147456;
static_assert(att::mla::LDS_BYTES <= RING_BYTES && att::mla2::LDS_BYTES <= RING_BYTES && att::swa::LDS_BYTES <= RING_BYTES && pg8::STAGE_BYTES <= RING_BYTES && MISC_OFF + 64 <= LDS_BYTES, "LDS map");

#define GAS __attribute__((address_space(1)))
#define LAS __attribute__((address_space(3)))
typedef unsigned short bf16;
typedef unsigned v4u __attribute__((ext_vector_type(4)));
typedef float f32x4 __attribute__((ext_vector_type(4)));
typedef short bf16x8 __attribute__((ext_vector_type(8)));
typedef GAS unsigned gu32;
typedef GAS unsigned long long gu64;
#define RLX_AGENT __ATOMIC_RELAXED, __HIP_MEMORY_SCOPE_AGENT
#define LDS_WAIT() asm volatile("s_waitcnt lgkmcnt(0)" ::: "memory")
#define VM_WAIT() asm volatile("s_waitcnt vmcnt(0)" ::: "memory")
__device__ __forceinline__ unsigned long long rt() { return __builtin_amdgcn_s_memrealtime(); }
__device__ __forceinline__ unsigned f2bf(float f) { unsigned u = __builtin_bit_cast(unsigned, f); return (u + 0x7fffu + ((u >> 16) & 1u)) >> 16; }
__device__ __forceinline__ unsigned pk2(float lo, float hi) { return f2bf(lo) | (f2bf(hi) << 16); }

#define XB_TMO      128
#define XB_XCNT(j)  (256  + 64 * (j))
#define XB_XSUB(j)  (1280 + 64 * (j))
#define XB_XGEN(j)  (2304 + 64 * (j))
#define XB_TOP      3328
#define XB_TOPGEN   3392
#define XCD_BAR_WORDS 3456
#define XB_SPIN_CAP (1u << 18)

__device__ __forceinline__ unsigned xb_ld(unsigned* p)              { return __hip_atomic_load(p, __ATOMIC_RELAXED, __HIP_MEMORY_SCOPE_AGENT); }
__device__ __forceinline__ unsigned xb_add(unsigned* p, unsigned v) { return __hip_atomic_fetch_add(p, v, __ATOMIC_RELAXED, __HIP_MEMORY_SCOPE_AGENT); }
__device__ __forceinline__ unsigned xb_xcc_id() { return (unsigned)__builtin_amdgcn_s_getreg((3 << 11) | 20) & 0xFu; }
#define XB_SPIN(cond, bar) do { unsigned _sp = 0; while (cond) { __builtin_amdgcn_s_sleep(1); \
    if ((++_sp & 255u) == 0u) { if (xb_ld(&(bar)[XB_TMO])) break; if (_sp > XB_SPIN_CAP) { atomicAdd(&(bar)[XB_TMO], 1u); break; } } } } while (0)

struct XcdBarrier {
    unsigned* bar; unsigned x; int w;
    volatile LAS unsigned* st;
};

__device__ __forceinline__ XcdBarrier xcd_barrier_post(unsigned* bar, volatile LAS unsigned* st) {
    XcdBarrier b; b.bar = bar; b.x = xb_xcc_id(); b.st = st;
    if (threadIdx.x == 0) (void)xb_add(&bar[XB_XCNT(b.x)], 1u);
    return b;
}
__device__ __forceinline__ void xcd_barrier_complete(unsigned* bar, unsigned x, unsigned& nloc, unsigned& nx) {
    const unsigned G = gridDim.x * gridDim.y * gridDim.z;
    unsigned sum, cnt, mine, sp = 0u;
    for (;;) {
        sum = 0u; cnt = 0u; mine = 0u;
#pragma unroll
        for (unsigned j = 0; j < 16; ++j) { const unsigned c = xb_ld(&bar[XB_XCNT(j)]); sum += c; cnt += (c > 0u) ? 1u : 0u; mine = (j == x) ? c : mine; }
        if (sum == G) break;
        __builtin_amdgcn_s_sleep(1);
        if ((++sp & 255u) == 0u) { if (xb_ld(&bar[XB_TMO])) break; if (sp > XB_SPIN_CAP) { atomicAdd(&bar[XB_TMO], 1u); break; } }
    }
    nloc = mine > 0u ? mine : 1u; nx = cnt > 0u ? cnt : 1u;
}

__device__ __forceinline__ void xcd_barrier(const XcdBarrier& b) {
    asm volatile("s_waitcnt vmcnt(0)" ::: "memory");
    __syncthreads();
    if (b.w == 0 && pg8::lane_id_fresh() == 0) {
        unsigned* bar = b.bar;
        __builtin_amdgcn_s_waitcnt(0);
        unsigned nloc = b.st[0], nx = b.st[1];
        if (nloc == 0u) { xcd_barrier_complete(bar, b.x, nloc, nx); b.st[0] = nloc; b.st[1] = nx; }
        const unsigned old = xb_add(&bar[XB_XSUB(b.x)], 1u);
        const unsigned gen = old / nloc;
        if (old + 1u == (gen + 1u) * nloc) {
            __builtin_amdgcn_fence(__ATOMIC_RELEASE, "agent");
            asm volatile("s_waitcnt vmcnt(0)" ::: "memory");
            const unsigned og = xb_add(&bar[XB_TOP], 1u);
            const unsigned tg = og / nx;
            if (og + 1u == (tg + 1u) * nx) xb_add(&bar[XB_TOPGEN], 1u);
            else XB_SPIN(xb_ld(&bar[XB_TOPGEN]) == tg, bar);
            __builtin_amdgcn_fence(__ATOMIC_ACQUIRE, "agent");
            xb_add(&bar[XB_XGEN(b.x)], 1u);
            asm volatile("s_waitcnt vmcnt(0)" ::: "memory");
        } else {
            XB_SPIN(xb_ld(&bar[XB_XGEN(b.x)]) == gen, bar);
            __builtin_amdgcn_fence(__ATOMIC_ACQUIRE, "agent");
            asm volatile("s_waitcnt vmcnt(0)" ::: "memory");
        }
    }
    __syncthreads();
}

struct Frame {
    LAS unsigned char* lds; volatile LAS unsigned* MISC; gu32* ctl;
    int wave, vcu, G;
};
__device__ __forceinline__ float wave_sum(float v) {
#pragma unroll
    for (int o = 1; o < 64; o <<= 1) v += __shfl_xor(v, o);
    return v;
}
template <class RowMap>
__device__ __forceinline__ void p0_transpose_item(const float* W, int K, int N, bf16* WT, const float* kscale, const RowMap& rm, LAS float* scr, int item, int lane) {
    const int nblk = N / 32, kb = item / nblk, nb = item % nblk, k0 = 64 * kb, n0 = 32 * nb;
#pragma unroll 8
    for (int i = 0; i < 32; ++i) { const int kk = 2 * i + (lane >> 5); const float sc = kscale ? kscale[k0 + kk] : 1.0f; scr[kk * 33 + (lane & 31)] = W[(size_t)(k0 + kk) * N + n0 + (lane & 31)] * sc; }
    LDS_WAIT(); asm volatile("" ::: "memory");
    const int c = lane & 7;
#pragma unroll
    for (int j = 0; j < 4; ++j) { const int n = (lane >> 3) + 8 * j; const LAS float* s = scr + (8 * c) * 33 + n;
        v4u o; o.x = pk2(s[0 * 33], s[1 * 33]); o.y = pk2(s[2 * 33], s[3 * 33]); o.z = pk2(s[4 * 33], s[5 * 33]); o.w = pk2(s[6 * 33], s[7 * 33]);
        const int rr = rm(n0 + n); if (rr >= 0) *(GAS v4u*)(WT + (size_t)rr * K + k0 + 8 * c) = o; }
    LDS_WAIT(); asm volatile("" ::: "memory");
}
struct MapIdent { __device__ __forceinline__ int operator()(int n) const { return n; } };
struct MapWin { __device__ __forceinline__ int operator()(int n) const {
    if (n < 256) return n; if (n >= 448) return n + 64; const int j = n - 256; if (j < 128) return 256 + j; const int d = j - 128; return 384 + (d < 32 ? 2 * d : 2 * (d - 32) + 1); } };
struct MapWqb { __device__ __forceinline__ int operator()(int n) const {
    const int h = n / 192, d = n % 192; if (d < 128) return -1  ; const int r = d - 128; return 1024 + h * 64 + (r < 32 ? 2 * r : 2 * (r - 32) + 1); } };
struct MapWup { __device__ __forceinline__ int operator()(int n) const {
    const int v = n >= DFF, c = v ? n - DFF : n; return 256 * (c >> 7) + 128 * v + (c & 127); } };

__device__ __forceinline__ int t5_bucket(int rel) {
    const int n = rel < 0 ? -rel : rel; int bk;
    if (n < 8) bk = n; else { const int e = (31 - __builtin_clz((unsigned)(n * n))) - 6; bk = 8 + e; if (bk > 15) bk = 15; }
    return (rel > 0 ? 16 : 0) + bk;
}
#ifndef MLA_SPLIT
#define MLA_SPLIT 0
#endif
struct Args {
    const float* x; const int* positions; const float* norm1_g; const float* w_in; const float* q_a_norm_g; const float* w_q_b; const float* kv_a_norm_g; const float* w_kv_b;
    const float* rel_bias; const float* sinks; const float* w_out; const float* norm2_g; const float* w_up; const float* conv_w; const float* conv_b; const float* w_down; const float* final_norm_g;
    float* out; unsigned char* ws; int ph_lo, ph_hi;
};

__device__ __forceinline__ void p0_prologue(Frame& F, const Args& a) {
    unsigned char* ws = a.ws;
    LAS float* scr = (LAS float*)(F.lds + RING_OFF + F.wave * 16384);
    const int lane = pg8::lane_id_fresh();
    const int gw = F.vcu * NWAVES + F.wave, NGW = F.G * NWAVES;
    constexpr int I_IN = (1024 / 64) * (4032 / 32), I_QB = (256 / 64) * (1536 / 32), I_OUT = (1024 / 64) * (1024 / 32), I_UP = (1024 / 64) * (5632 / 32), I_DN = (DFF / 64) * (1024 / 32);
    constexpr int NITEMS = I_IN + I_QB + I_OUT + I_UP + I_DN;
#ifndef P0DUP
#define P0DUP 0
#endif
    for (int rp_ = 0; rp_ <= (P0DUP & 1); ++rp_)
    for (int it = gw; it < NITEMS; it += NGW) {
        int r = it;
        if (r < I_IN) { p0_transpose_item(a.w_in, 1024, 4032, (bf16*)(ws + WS_WIN), nullptr, MapWin(), scr, r, lane); continue; } r -= I_IN;
        if (r < I_QB) { p0_transpose_item(a.w_q_b, 256, 1536, (bf16*)(ws + WS_WQB), a.q_a_norm_g, MapWqb(), scr, r, lane); continue; } r -= I_QB;
        if (r < I_OUT) { p0_transpose_item(a.w_out, 1024, 1024, (bf16*)(ws + WS_WOUT), nullptr, MapIdent(), scr, r, lane); continue; } r -= I_OUT;
        if (r < I_UP) { p0_transpose_item(a.w_up, 1024, 5632, (bf16*)(ws + WS_WUP), a.norm2_g, MapWup(), scr, r, lane); continue; } r -= I_UP;
        p0_transpose_item(a.w_down, DFF, 1024, (bf16*)(ws + WS_WDN), nullptr, MapIdent(), scr, r, lane);
    }
    const int gt = gw * 64 + lane, NGT = NGW * 64;
    for (int rp_ = 0; rp_ <= ((P0DUP >> 2) & 1); ++rp_)
    for (int i = gt; i < 1024 * 256; i += NGT) { const int row = i >> 8, j = i & 255, hh = row >> 7, c = row & 127;
        const f32x4* qp = (const f32x4*)(a.w_q_b + (size_t)j * 1536 + hh * 192); const f32x4* kp = (const f32x4*)(a.w_kv_b + (size_t)c * 2048 + hh * 256);
        float s0 = 0.f, s1 = 0.f;
#pragma unroll 8
        for (int d4 = 0; d4 < 32; ++d4) { const f32x4 x = qp[d4], y = kp[d4]; s0 += x[0] * y[0] + x[1] * y[1]; s1 += x[2] * y[2] + x[3] * y[3]; }
        ((bf16*)(ws + WS_WQB))[i] = (bf16)f2bf((s0 + s1) * a.q_a_norm_g[j] * a.kv_a_norm_g[c]); }
    for (int i = gt; i < 8 * 128 * 128; i += NGT) { const int hh = i >> 14, dd = (i >> 7) & 127, cp = i & 127, c = MLA_OT ? ((cp & ~0xC) | ((cp & 4) << 1) | ((cp & 8) >> 1)) : cp;
        ((bf16*)(ws + WS_WVT))[i] = (bf16)f2bf(a.w_kv_b[(size_t)c * 2048 + hh * 256 + 128 + dd] * a.kv_a_norm_g[c]); }
    for (int i = gt; i < 64 * 1024 / 8; i += NGT) *(GAS v4u*)((bf16*)(ws + WS_WIN) + (size_t)448 * 1024 + (size_t)i * 8) = (v4u){0u, 0u, 0u, 0u};
    for (int rp_ = 0; rp_ <= ((P0DUP >> 3) & 1); ++rp_)
    for (int i = gt; i < SEQ * 32; i += NGT) { const int s = i >> 5, d = i & 31;
        const float invf = __builtin_amdgcn_exp2f(-(float)d * (13.287712379549449f / 32.0f));
        const float ang = (float)a.positions[s] * invf;
        const double rev = (double)ang * 0.15915494309189535; const float fr = (float)(rev - __builtin_rint(rev));
        ((float*)(ws + WS_COS))[i] = __builtin_amdgcn_cosf(fr); ((float*)(ws + WS_SIN))[i] = __builtin_amdgcn_sinf(fr); }
    for (int i = gt; i < 16 * 264; i += NGT) { const int h = i / 264, j = i % 264; float v = 0.f; if (j <= 256) v = a.rel_bias[t5_bucket(j - 128) * 16 + h] * LOG2E; ((float*)(ws + WS_BT2))[i] = v; }
    if (gt < 16) ((float*)(ws + WS_SINK2))[gt] = a.sinks[gt] * LOG2E;
    for (int rp_ = 0; rp_ <= ((P0DUP >> 1) & 1); ++rp_)
    for (int m = gw; m < MTOK; m += NGW) {
        const GAS f32x4* xr = (const GAS f32x4*)(a.x + (size_t)m * DM) + lane; const GAS f32x4* gr = (const GAS f32x4*)a.norm1_g + lane;
        f32x4 v[4]; float s = 0.f;
#pragma unroll
        for (int j = 0; j < 4; ++j) { v[j] = xr[64 * j]; s += (v[j].x * v[j].x + v[j].y * v[j].y) + (v[j].z * v[j].z + v[j].w * v[j].w); }
        const float rs = 1.0f / sqrtf(wave_sum(s) * (1.0f / DM) + RMS_EPS);
        GAS unsigned long long* o8 = (GAS unsigned long long*)((bf16*)(ws + WS_XN) + (size_t)m * DM) + lane;
#pragma unroll
        for (int j = 0; j < 4; ++j) { const f32x4 g = gr[64 * j]; o8[64 * j] = (unsigned long long)pk2(v[j].x * rs * g.x, v[j].y * rs * g.y) | ((unsigned long long)pk2(v[j].z * rs * g.z, v[j].w * rs * g.w) << 32); }
    }
}

__device__ __forceinline__ void p6_fixup(Frame& F, const Args& a) {
    const int lane = pg8::lane_id_fresh();
    const int gw = F.vcu * NWAVES + F.wave, NGW = F.G * NWAVES;
    const float* halo = (const float*)(a.ws + WS_HALO); bf16* ACT = (bf16*)(a.ws + WS_ACT);
    constexpr int NBLK = MTOK / 64, HROW = 2 * DFF, HBLK = 4 * HROW;
    for (int it = gw; it < NBLK * 2 * 11; it += NGW) {
        const int cg = it % 11, which = (it / 11) & 1, blk = it / 22;
        const int c = cg * 256 + lane * 4, cu = 256 * (c >> 7) + (c & 127);
        const int r = 64 * blk + (which ? 63 : 0);
        const float* hp = halo + (size_t)blk * HBLK + (2 + which) * HROW + cu;
        f32x4 G = *(const f32x4*)hp, V = *(const f32x4*)(hp + 128);
        const bool has = which ? (((r + 1) & (SEQ - 1)) != 0) : ((r & (SEQ - 1)) != 0);
        if (has) { const float* np = halo + (size_t)(which ? blk + 1 : blk - 1) * HBLK + (which ? 0 : 1) * HROW + cu;
            const f32x4 rg = *(const f32x4*)np, rv = *(const f32x4*)(np + 128);
            const f32x4 wg = *(const f32x4*)(a.conv_w + (which ? 4 : 0) * DFF + c), wv = *(const f32x4*)(a.conv_w + (which ? 5 : 1) * DFF + c);
            G = G + wg * rg; V = V + wv * rv; }
        f32x4 o;
#pragma unroll
        for (int e = 0; e < 4; ++e) o[e] = G[e] * pg8::fast_sigmoid(G[e]) * V[e];
        pg8::st4((pg8::bf16_t*)(ACT + (size_t)r * DFF + c), o);
    }
}

__device__ __forceinline__ void p8_final_norm(Frame& F, const Args& a) {
    const int gw = F.vcu * NWAVES + F.wave, NGW = F.G * NWAVES;
    const int lane = pg8::lane_id_fresh();
    const float* ssq = (const float*)(a.ws + WS_SSQ3);
    for (int m = gw; m < MTOK; m += NGW) {
        const f32x4* sp = (const f32x4*)(ssq + (size_t)m * 16); const f32x4 t = (sp[0] + sp[1]) + (sp[2] + sp[3]);
        const float rs = 1.0f / sqrtf(((t[0] + t[1]) + (t[2] + t[3])) * (1.0f / DM) + RMS_EPS);
        GAS f32x4* xr = (GAS f32x4*)(a.out + (size_t)m * DM) + lane; const GAS f32x4* gr = (const GAS f32x4*)a.final_norm_g + lane;
#pragma unroll
        for (int j = 0; j < 4; ++j) { const f32x4 v = xr[64 * j], g = gr[64 * j]; xr[64 * j] = v * rs * g; }
    }
}

__global__ void __launch_bounds__(NWAVES * 64, 2) enc_fwd(Args args) {
    extern __shared__ __attribute__((aligned(16))) unsigned char lds[];
    Frame F;
    F.lds = (LAS unsigned char*)lds; F.MISC = (volatile LAS unsigned*)(F.lds + MISC_OFF);
    F.wave = __builtin_amdgcn_readfirstlane(threadIdx.x >> 6);
    F.G = gridDim.x; { const int bx = blockIdx.x; F.vcu = (F.G % 8 == 0) ? (bx % 8) * (F.G / 8) + bx / 8 : bx; }
    unsigned char* ws = args.ws;
    F.ctl = (gu32*)(ws + WS_CTL);
    for (int u = threadIdx.x; u < (LDS_BYTES - LDSCTL_OFF) / 4; u += NWAVES * 64) ((LAS unsigned*)(F.lds + LDSCTL_OFF))[u] = 0u;
    __syncthreads();
    XcdBarrier bar; bar.bar = (unsigned*)(F.ctl + CW_BAR); bar.x = 0; bar.st = nullptr;
    if (!MK_PER_PHASE) bar = xcd_barrier_post((unsigned*)(F.ctl + CW_BAR), F.MISC + 8);
    bar.w = F.wave;
    const int lo = args.ph_lo, hi = args.ph_hi;
#ifndef PHMASK
#define PHMASK 0xff
#endif
#define IN(k) (((PHMASK >> (k)) & 1) && lo <= (k) && (k) < hi)
#ifndef DUPMASK
#define DUPMASK 0
#endif
#define REP(k) for (int rep_ = 0; rep_ <= ((DUPMASK >> (k)) & 1); ++rep_)
#define SEAM(k) do { if (IN(k) && IN((k) + 1)) xcd_barrier(bar); } while (0)
    bf16* const WIN = (bf16*)(ws + WS_WIN); bf16* const WQB = (bf16*)(ws + WS_WQB); bf16* const WOUT = (bf16*)(ws + WS_WOUT);
    bf16* const WUP = (bf16*)(ws + WS_WUP); bf16* const WDN = (bf16*)(ws + WS_WDN);
    const float* const COS = (const float*)(ws + WS_COS); const float* const SIN = (const float*)(ws + WS_SIN);
    bf16* const QA = (bf16*)args.out;

#ifdef TP_PHASE
    unsigned long long tp_r0 = 0, tp_r1 = 0, tp_c0 = 0, tp_c1 = 0;
#ifndef TP_END
#define TP_END (TP_PHASE + 1)
#endif
#define TP_MARK(k) do { if ((k) == TP_PHASE) { tp_r0 = __builtin_amdgcn_s_memrealtime(); tp_c0 = __builtin_amdgcn_s_memtime(); } if ((k) == TP_END) { tp_r1 = __builtin_amdgcn_s_memrealtime(); tp_c1 = __builtin_amdgcn_s_memtime(); } } while (0)
#else
#define TP_MARK(k)
#endif
    TP_MARK(0);
    if (IN(0)) REP(0) { p0_prologue(F, args); } SEAM(0);
    TP_MARK(1);

    if (IN(1)) REP(1) {
        pg8::Gemm g{(bf16*)(ws + WS_XN), WIN, MTOK, 4096, 1024}; pg8::StaticOrder S; S.init(MTOK, 4096, F.G, (int)blockIdx.x);
        pg8::EpiInProj E{(bf16*)(ws + WS_QLAT), (bf16*)(ws + WS_KL), (bf16*)(ws + WS_QB), (bf16*)(ws + WS_KB), (bf16*)(ws + WS_VB), (bf16*)(ws + WS_GA), (bf16*)(ws + WS_GB),
                         (float*)(ws + WS_SSQQ), (float*)(ws + WS_SSQKV), COS, SIN};
        pg8::gemm_phase<pg8::EpiInProj, pg8::StaticOrder, PG8_ALIGN, PG8_SP2>(F.lds + RING_OFF, g, S, E, F.wave);
    } SEAM(1);

    TP_MARK(2);
    if (IN(2)) REP(2) {
#ifndef P2SUB
#define P2SUB 7
#endif
#ifndef P2DUPG
#define P2DUPG 0
#endif
        for (int rg_ = 0; rg_ <= P2DUPG; ++rg_) {
        if (P2SUB & 1) { pg8::Gemm g{(bf16*)(ws + WS_QLAT), WQB, MTOK, 1536, 256}; pg8::StaticOrder S; S.init(MTOK, 1536, F.G, (int)blockIdx.x);
          pg8::EpiQProj E{QA, (const float*)(ws + WS_SSQQ), COS, SIN};
          pg8::gemm_phase<pg8::EpiQProj, pg8::StaticOrder, PG8_ALIGN, PG8_SP2>(F.lds + RING_OFF, g, S, E, F.wave); }
        }
        if (P2SUB & 4) { const att::swa::Tensors T{(const bf16*)(ws + WS_QB), (const bf16*)(ws + WS_KB), (const bf16*)(ws + WS_VB), (bf16*)(ws + WS_GB), (const float*)(ws + WS_BT2), (const float*)(ws + WS_SINK2)};
          for (int u = F.vcu; u < NBATCH * 4 * (SEQ / 64); u += F.G) { const int qblk = u % (SEQ / 64), bk = u / (SEQ / 64); att::swa::unit(bk >> 2, bk & 3, qblk, T, (char*)lds + RING_OFF, F.wave); } }
    } SEAM(2);

    TP_MARK(3);
    if (IN(3)) REP(3) {
        const att::mla::Tensors T{QA, (const bf16*)(ws + WS_KL), (const bf16*)(ws + WS_WVT), (const bf16*)(ws + WS_GA), (const bf16*)(ws + WS_GB), (bf16*)(ws + WS_MIX)};
        for (int u = F.vcu; u < NBATCH * 8 * (SEQ / 256); u += F.G) { const int qb = u & 15, bh = u >> 4;
#if MLA_SPLIT
            att::mla2::unit(bh >> 3, bh & 7, qb, T, (char*)lds + RING_OFF, F.wave);
#else
            att::mla::unit(bh >> 3, bh & 7, qb, T, (char*)lds + RING_OFF, F.wave);
#endif
        }
    } SEAM(3);

    TP_MARK(4);
    if (IN(4)) REP(4) {
        pg8::Gemm g{(bf16*)(ws + WS_MIX), WOUT, MTOK, 1024, 1024}; pg8::StaticOrder S; S.init(MTOK, 1024, F.G, (int)blockIdx.x);
        pg8::EpiResidual E{args.x, nullptr, (bf16*)(ws + WS_X1B), (float*)(ws + WS_SSQ2)};
        pg8::gemm_phase<pg8::EpiResidual, pg8::StaticOrder, PG8_ALIGN, PG8_SP2>(F.lds + RING_OFF, g, S, E, F.wave);
    } SEAM(4);

    TP_MARK(5);
    if (IN(5)) REP(5) {
        pg8::Gemm g{(bf16*)(ws + WS_X1B), WUP, MTOK, 2 * DFF, 1024}; pg8::StaticOrder S; S.init(MTOK, 2 * DFF, F.G, (int)blockIdx.x);
        pg8::EpiUpConv E{(bf16*)(ws + WS_ACT), (float*)(ws + WS_HALO), (const float*)(ws + WS_SSQ2), args.conv_w, args.conv_b};
        pg8::gemm_phase<pg8::EpiUpConv, pg8::StaticOrder, PG8_ALIGN, PG8_SP2>(F.lds + RING_OFF, g, S, E, F.wave);
    } SEAM(5);
    TP_MARK(6);
    if (IN(6)) REP(6) { p6_fixup(F, args); } SEAM(6);

    TP_MARK(7);
    if (IN(7)) REP(7) {
        pg8::Gemm g{(bf16*)(ws + WS_ACT), WDN, MTOK, 1024, DFF}; pg8::StaticOrder S; S.init(MTOK, 1024, F.G, (int)blockIdx.x);
        pg8::EpiFinal E{(const bf16*)(ws + WS_X1B), args.out, (float*)(ws + WS_SSQ3), (unsigned*)(F.ctl + CW_PANEL), args.final_norm_g};
        pg8::gemm_phase<pg8::EpiFinal, pg8::StaticOrder, PG8_ALIGN, PG8_SP2>(F.lds + RING_OFF, g, S, E, F.wave);
    }
#ifdef TP_PHASE
    TP_MARK(8);
#ifndef TP_CLK
#define TP_CLK 0
#endif
#ifndef TP_GAIN
#define TP_GAIN 4
#endif
    if (blockIdx.x == 0 && F.wave == 0) {
        const unsigned long long dr = tp_r1 - tp_r0, dc = tp_c1 - tp_c0;
        const unsigned long long ticks = (TP_CLK ? dc * 100ull / dr : dr) * (unsigned long long)TP_GAIN;
        const unsigned long long t0 = __builtin_amdgcn_s_memrealtime();
        while (__builtin_amdgcn_s_memrealtime() - t0 < ticks) __builtin_amdgcn_s_sleep(8); }
#endif
#undef IN
#undef SEAM
}

extern "C" void kernel_launch(void* const* d_in, const int* in_sizes, int n_in, void* d_out, int out_size, void* d_ws, size_t ws_size, hipStream_t stream) {
    static int grid = 0;
    if (grid == 0) {
        if (n_in != 17 || in_sizes[0] != MTOK * DM || out_size != MTOK * DM || ws_size < WS_END) { fprintf(stderr, "kernel_launch: unexpected shapes (n_in %d, in0 %d, out %d, ws %zu; need ws >= %zu); nothing launched\n", n_in, n_in > 0 ? in_sizes[0] : -1, out_size, ws_size, (size_t)WS_END); grid = -1; return; }
        int dev = 0, cus = 0, per_cu = 0;
        if (hipGetDevice(&dev) != hipSuccess || hipDeviceGetAttribute(&cus, hipDeviceAttributeMultiprocessorCount, dev) != hipSuccess) { fprintf(stderr, "kernel_launch: device query failed\n"); grid = -1; return; }
        if (hipFuncSetAttribute((const void*)enc_fwd, hipFuncAttributeMaxDynamicSharedMemorySize, LDS_BYTES) != hipSuccess) { fprintf(stderr, "kernel_launch: hipFuncSetAttribute failed\n"); grid = -1; return; }
        if (hipOccupancyMaxActiveBlocksPerMultiprocessor(&per_cu, (const void*)enc_fwd, NWAVES * 64, LDS_BYTES) != hipSuccess || per_cu < 1) { fprintf(stderr, "kernel_launch: occupancy query reports %d workgroups per CU\n", per_cu); }
        (void)hipGetLastError();
        grid = cus;
    }
    if (grid < 0) return;
    if (hipMemsetAsync((char*)d_ws + WS_CTL, 0, CTL_ZERO_BYTES, stream) != hipSuccess) { fprintf(stderr, "kernel_launch: hipMemsetAsync failed\n"); return; }
    Args a{};
    a.x = (const float*)d_in[0]; a.positions = (const int*)d_in[1]; a.norm1_g = (const float*)d_in[2]; a.w_in = (const float*)d_in[3]; a.q_a_norm_g = (const float*)d_in[4]; a.w_q_b = (const float*)d_in[5];
    a.kv_a_norm_g = (const float*)d_in[6]; a.w_kv_b = (const float*)d_in[7]; a.rel_bias = (const float*)d_in[8]; a.sinks = (const float*)d_in[9]; a.w_out = (const float*)d_in[10]; a.norm2_g = (const float*)d_in[11];
    a.w_up = (const float*)d_in[12]; a.conv_w = (const float*)d_in[13]; a.conv_b = (const float*)d_in[14]; a.w_down = (const float*)d_in[15]; a.final_norm_g = (const float*)d_in[16];
    a.out = (float*)d_out; a.ws = (unsigned char*)d_ws;
#if MK_PER_PHASE
    for (int p = 0; p < N_PHASES; ++p) { a.ph_lo = p; a.ph_hi = p + 1; hipLaunchKernelGGL(enc_fwd, dim3(grid), dim3(NWAVES * 64), LDS_BYTES, stream, a); }
#else
    a.ph_lo = 0; a.ph_hi = N_PHASES; hipLaunchKernelGGL(enc_fwd, dim3(grid), dim3(NWAVES * 64), LDS_BYTES, stream, a);
#endif
    const hipError_t le = hipPeekAtLastError();
    if (le != hipSuccess) fprintf(stderr, "kernel_launch: launch failed: %s (grid %d)\n", hipGetErrorName(le), grid);
}
```

```cpp
#include <hip/hip_runtime.h>
#include <cstdio>
#include <cstdint>
namespace pg8 {
#define PG8_LAS __attribute__((address_space(3)))
typedef unsigned short bf16_t;
typedef short bf16x8 __attribute__((ext_vector_type(8)));
typedef float f32x4 __attribute__((ext_vector_type(4)));
typedef unsigned u32x4 __attribute__((ext_vector_type(4)));
constexpr int BM = 256, BK = 64, HALF = 128, HTB = HALF * BK * 2  , STAGE_BYTES = 8 * HTB, NXCD = 8, WGM = 8;

__host__ __device__ __forceinline__ int lds_byte(int r, int c) { const int st = (r >> 4) * 2 + (c >> 5), rr = r & 15, cc = c & 31, ob = rr * 64 + cc * 2; return st * 1024 + (ob ^ (((ob >> 9) & 1) << 5)); }
__host__ __device__ __forceinline__ void stage_rc(int b, int& R, int& C) { const int st = b / 1024, sb = b % 1024, swz = sb ^ (((sb >> 9) & 1) << 5); R = (st >> 1) * 16 + swz / 64; C = (st & 1) * 32 + (swz % 64) / 2; }
__host__ __device__ __forceinline__ int perm32(int rho) { const int n = rho >> 4, i = rho & 15; return 8 * (i >> 2) + 4 * n + (i & 3); }

struct Unit { int pm, pn; };
struct Gemm { const bf16_t* A; const bf16_t* Bt; int M, N, K; };

struct StaticOrder {
    int nM, nN, nwg, G, c;
    __host__ __device__ void init(int M, int N, int G_, int c_) { nM = M / BM; nN = N / BM; nwg = nM * nN; G = G_; c = c_; }
    __host__ __device__ bool next(int i, Unit& u) const {
        const long L = (long)i * G + c; if (L >= nwg) return false;
        int wgid = (int)L; { const int q = nwg / NXCD, r = nwg % NXCD, xcd = wgid % NXCD, off = wgid / NXCD; wgid = (xcd < r ? xcd * (q + 1) : r * (q + 1) + (xcd - r) * q) + off; }
        const int nig = WGM * nN, gid = wgid / nig, fm = gid * WGM, gsz = (nM - fm) < WGM ? (nM - fm) : WGM;
        u.pm = fm + ((wgid % nig) % gsz); u.pn = (wgid % nig) / gsz; return true;
    }
    __device__ __forceinline__ void a_ready(const Unit&) const {}
    __device__ __forceinline__ void done(const Unit&) const {}
};

__device__ __forceinline__ unsigned cvt_pk_bf16(float lo, float hi) { unsigned r; asm volatile("v_cvt_pk_bf16_f32 %0, %1, %2" : "=v"(r) : "v"(lo), "v"(hi)); return r; }
constexpr int SEQ = 4096, NBATCH = 8, MTOK = NBATCH * SEQ, DM = 1024;
constexpr int DFF = 2816;
constexpr float RMS_EPS = 1e-6f;
constexpr float LOG2E = 1.4426950408889634f;
constexpr float C_MLA = 0.07216878364870322f * LOG2E;
constexpr float C_SWA = 0.125f * LOG2E;

typedef unsigned u32x2 __attribute__((ext_vector_type(2)));
__device__ __forceinline__ int lane_id_fresh() { int l; asm volatile("v_mbcnt_lo_u32_b32 %0, -1, 0\n\tv_mbcnt_hi_u32_b32 %0, -1, %0" : "=v"(l)); return l; }
__device__ __forceinline__ float fast_sigmoid(float v) { return __builtin_amdgcn_rcpf(1.0f + __builtin_amdgcn_exp2f(-LOG2E * v)); }
__device__ __forceinline__ void st8(bf16_t* p, f32x4 v0, f32x4 v1) {
    u32x4 w; w.x = cvt_pk_bf16(v0[0], v0[1]); w.y = cvt_pk_bf16(v0[2], v0[3]); w.z = cvt_pk_bf16(v1[0], v1[1]); w.w = cvt_pk_bf16(v1[2], v1[3]); *(u32x4*)p = w; }
__device__ __forceinline__ void st4(bf16_t* p, f32x4 v) { u32x2 w; w.x = cvt_pk_bf16(v[0], v[1]); w.y = cvt_pk_bf16(v[2], v[3]); *(u32x2*)p = w; }
__device__ __forceinline__ float sq4(f32x4 x) { return (x[0] * x[0] + x[1] * x[1]) + (x[2] * x[2] + x[3] * x[3]); }
__device__ __forceinline__ float fq_sum(float s) { s += __shfl_xor(s, 16); s += __shfl_xor(s, 32); return s; }

__device__ __forceinline__ void rope_store(bf16_t* dst  , int d, int srow, const float* cosT, const float* sinT, f32x4 a, f32x4 b, float sc) {
    const f32x4 c4 = *(const f32x4*)(cosT + srow * 32 + d), s4 = *(const f32x4*)(sinT + srow * 32 + d);
    const f32x4 x1 = {a[0] * sc, a[2] * sc, b[0] * sc, b[2] * sc}, x2 = {a[1] * sc, a[3] * sc, b[1] * sc, b[3] * sc};
    st4(dst + d, x1 * c4 - x2 * s4); st4(dst + 32 + d, x2 * c4 + x1 * s4);
}

struct EpiInProj {
    static constexpr bool PERM = true, AFTER_DRAIN = false;
    bf16_t *qlat, *kl, *qb, *kb, *vb, *ga, *gb; float *ssq_q, *ssq_kv; const float *cosT, *sinT;
    __device__ __forceinline__ void operator()(f32x4 (&acc)[2][2][4][2], const Unit& u, int wr, int wc, int fr, int fq) const {
        { const int l_ = lane_id_fresh(); fr = l_ & 15; fq = l_ >> 4; }
        const int pn = u.pn, row0 = u.pm * BM + wr * 64 + fr, cw = wc * 32 + 8 * fq;
        if (pn == 0) {
#pragma unroll
            for (int ai = 0; ai < 2; ++ai)
#pragma unroll
                for (int m = 0; m < 4; ++m) { const int row = row0 + ai * HALF + m * 16;
                    float s = (sq4(acc[ai][0][m][0]) + sq4(acc[ai][0][m][1])) + (sq4(acc[ai][1][m][0]) + sq4(acc[ai][1][m][1]));
                    s = fq_sum(s); if (fq == 0) ssq_q[(size_t)row * 4 + wc] = s;
                    st8(qlat + (size_t)row * 256 + cw, acc[ai][0][m][0], acc[ai][0][m][1]); st8(qlat + (size_t)row * 256 + HALF + cw, acc[ai][1][m][0], acc[ai][1][m][1]);
                    asm volatile("" ::: "memory"); }
        } else if (pn == 1) {
#pragma unroll
            for (int ai = 0; ai < 2; ++ai)
#pragma unroll
                for (int m = 0; m < 4; ++m) { const int row = row0 + ai * HALF + m * 16;
                    float s = sq4(acc[ai][0][m][0]) + sq4(acc[ai][0][m][1]);
                    s = fq_sum(s); if (fq == 0) __hip_atomic_store(ssq_kv + (unsigned)row * 4 + wc, s, __ATOMIC_RELAXED, __HIP_MEMORY_SCOPE_AGENT); }
            asm volatile("s_waitcnt vmcnt(0)" ::: "memory");
            __builtin_amdgcn_s_barrier(); asm volatile("" ::: "memory");
#pragma unroll
            for (int ai = 0; ai < 2; ++ai)
#pragma unroll
                for (int m = 0; m < 4; ++m) { const int row = row0 + ai * HALF + m * 16; const float* sp = ssq_kv + (unsigned)row * 4;
                    const float t = (__hip_atomic_load(sp, __ATOMIC_RELAXED, __HIP_MEMORY_SCOPE_AGENT) + __hip_atomic_load(sp + 1, __ATOMIC_RELAXED, __HIP_MEMORY_SCOPE_AGENT))
                                  + (__hip_atomic_load(sp + 2, __ATOMIC_RELAXED, __HIP_MEMORY_SCOPE_AGENT) + __hip_atomic_load(sp + 3, __ATOMIC_RELAXED, __HIP_MEMORY_SCOPE_AGENT));
                    const float rs = __builtin_amdgcn_rsqf(t * (1.0f / 128.0f) + RMS_EPS);
                    bf16_t* krow = kl + (size_t)row * 192;
                    st8(krow + cw, acc[ai][0][m][0] * rs, acc[ai][0][m][1] * rs);
                    if (wc < 2) rope_store(krow + 128, 16 * wc + 4 * fq, row & (SEQ - 1), cosT, sinT, acc[ai][1][m][0], acc[ai][1][m][1], 1.0f);
                    if (m == 1 || m == 3) asm volatile("" ::: "memory"); }
        } else {
            bf16_t* base; int ld, col0; float sc = 1.0f; bool sig = false;
            if (pn < 6) { base = qb; ld = 1024; col0 = (pn - 2) * 256; sc = C_SWA; }
            else if (pn == 6) { base = kb; ld = 256; col0 = 0; }
            else if (pn == 7) { base = vb; ld = 256; col0 = 0; }
            else if (pn < 12) { base = ga; ld = 1024; col0 = (pn - 8) * 256; sig = true; }
            else { base = gb; ld = 1024; col0 = (pn - 12) * 256; sig = true; }
            bf16_t* rowp = base + (size_t)row0 * ld + col0 + cw; const size_t rstep = (size_t)16 * ld;
#pragma unroll
            for (int ai = 0; ai < 2; ++ai)
#pragma unroll
                for (int m = 0; m < 4; ++m) { bf16_t* rp = rowp + (size_t)(ai * 8 + m) * rstep;
#pragma unroll
                    for (int bj = 0; bj < 2; ++bj) { f32x4 v0 = acc[ai][bj][m][0], v1 = acc[ai][bj][m][1];
                        if (sig) {
#pragma unroll
                            for (int e = 0; e < 4; ++e) { v0[e] = fast_sigmoid(v0[e]); v1[e] = fast_sigmoid(v1[e]); } }
                        else { v0 = v0 * sc; v1 = v1 * sc; }
                        st8(rp + bj * HALF, v0, v1); }
                    asm volatile("" ::: "memory"); }
        }
    }
};

struct EpiQProj {
    static constexpr bool PERM = true, AFTER_DRAIN = false;
    bf16_t* qa; const float* ssq; const float *cosT, *sinT;
    __device__ __forceinline__ void operator()(f32x4 (&acc)[2][2][4][2], const Unit& u, int wr, int wc, int fr, int fq) const {
        { const int l_ = lane_id_fresh(); fr = l_ & 15; fq = l_ >> 4; }
        const int pn = u.pn, row0 = u.pm * BM + wr * 64 + fr, cw = wc * 32 + 8 * fq;
        f32x4 sv[2][4];
#pragma unroll
        for (int ai = 0; ai < 2; ++ai)
#pragma unroll
            for (int m = 0; m < 4; ++m) sv[ai][m] = *(const f32x4*)(ssq + (unsigned)(row0 + ai * HALF + m * 16) * 4);
        asm volatile("" ::: "memory");
#pragma unroll
        for (int ai = 0; ai < 2; ++ai)
#pragma unroll
            for (int m = 0; m < 4; ++m) { const int row = row0 + ai * HALF + m * 16;
                const f32x4 s4 = sv[ai][m];
                const float rs = C_MLA * __builtin_amdgcn_rsqf(((s4[0] + s4[1]) + (s4[2] + s4[3])) * (1.0f / 256.0f) + RMS_EPS);
                bf16_t* qrow = qa + (size_t)row * 1536;
                if (pn < 4) {
#pragma unroll
                    for (int bj = 0; bj < 2; ++bj) st8(qrow + (2 * pn + bj) * 192 + cw, acc[ai][bj][m][0] * rs, acc[ai][bj][m][1] * rs);
                } else {
#pragma unroll
                    for (int bj = 0; bj < 2; ++bj) { const int head = 4 * (pn - 4) + 2 * bj + (wc >> 1);
                        rope_store(qrow + head * 192 + 128, 16 * (wc & 1) + 4 * fq, row & (SEQ - 1), cosT, sinT, acc[ai][bj][m][0], acc[ai][bj][m][1], rs); }
                }
                if (m == 1 || m == 3) asm volatile("" ::: "memory");
            }
    }
};

struct EpiResidual {
    static constexpr bool PERM = true, AFTER_DRAIN = false;
    const float* base; float* y; bf16_t* yb; float* ssq;
    __device__ __forceinline__ void operator()(f32x4 (&acc)[2][2][4][2], const Unit& u, int wr, int wc, int fr, int fq) const {
        { const int l_ = lane_id_fresh(); fr = l_ & 15; fq = l_ >> 4; }
        const int pn = u.pn, row0 = u.pm * BM + wr * 64 + fr, cw = wc * 32 + 8 * fq;
        const unsigned off0 = (unsigned)row0 * DM + pn * 256 + cw;
#pragma unroll
        for (int ai = 0; ai < 2; ++ai) {
            f32x4 xv[4][2][2];
#pragma unroll
            for (int m = 0; m < 4; ++m)
#pragma unroll
                for (int bj = 0; bj < 2; ++bj) { const unsigned off = off0 + (unsigned)((ai * HALF + m * 16) * DM + bj * HALF);
                    xv[m][bj][0] = *(const f32x4*)(base + off); xv[m][bj][1] = *(const f32x4*)(base + off + 4); }
            asm volatile("" ::: "memory");
#pragma unroll
            for (int m = 0; m < 4; ++m) { const int row = row0 + ai * HALF + m * 16; float s = 0.f;
#pragma unroll
                for (int bj = 0; bj < 2; ++bj) { const unsigned off = off0 + (unsigned)((ai * HALF + m * 16) * DM + bj * HALF);
                    const f32x4 v0 = xv[m][bj][0] + acc[ai][bj][m][0], v1 = xv[m][bj][1] + acc[ai][bj][m][1];
                    if (y) { *(f32x4*)(y + off) = v0; *(f32x4*)(y + off + 4) = v1; } if (yb) st8(yb + off, v0, v1);
                    s += sq4(v0) + sq4(v1); }
                s = fq_sum(s); if (fq == 0) ssq[(unsigned)row * 16 + pn * 4 + wc] = s; }
            asm volatile("" ::: "memory");
        }
    }
};

struct EpiUp {
    static constexpr bool PERM = true, AFTER_DRAIN = false;
    bf16_t* U; int ldu; const float* ssq;
    __device__ __forceinline__ void operator()(f32x4 (&acc)[2][2][4][2], const Unit& u, int wr, int wc, int fr, int fq) const {
        { const int l_ = lane_id_fresh(); fr = l_ & 15; fq = l_ >> 4; }
        const int pn = u.pn, row0 = u.pm * BM + wr * 64 + fr, cw = wc * 32 + 8 * fq;
#pragma unroll
        for (int ai = 0; ai < 2; ++ai)
#pragma unroll
            for (int m = 0; m < 4; ++m) { const int row = row0 + ai * HALF + m * 16;
                const f32x4* sp = (const f32x4*)(ssq + (size_t)row * 16); const f32x4 t = (sp[0] + sp[1]) + (sp[2] + sp[3]);
                const float rs = __builtin_amdgcn_rsqf(((t[0] + t[1]) + (t[2] + t[3])) * (1.0f / 1024.0f) + RMS_EPS);
#pragma unroll
                for (int bj = 0; bj < 2; ++bj) st8(U + (size_t)row * ldu + pn * 256 + bj * HALF + cw, acc[ai][bj][m][0] * rs, acc[ai][bj][m][1] * rs);
                asm volatile("" ::: "memory"); }
    }
};

__device__ __forceinline__ float dpp_prev(float x) { return __int_as_float(__builtin_amdgcn_update_dpp(__float_as_int(x), __float_as_int(x), 0x121, 0xf, 0xf, true)); }
__device__ __forceinline__ float dpp_next(float x) { return __int_as_float(__builtin_amdgcn_update_dpp(__float_as_int(x), __float_as_int(x), 0x12f, 0xf, 0xf, true)); }
struct EpiUpConv {
    static constexpr bool PERM = true, AFTER_DRAIN = false;
    bf16_t* act; float* halo; const float* ssq; const float* conv_w; const float* conv_b;
    __device__ __forceinline__ void operator()(f32x4 (&acc)[2][2][4][2], const Unit& u, int wr, int wc, int fr, int fq) const {
        { const int l_ = lane_id_fresh(); fr = l_ & 15; fq = l_ >> 4; }
        const int pn = u.pn, row0 = u.pm * BM + wr * 64 + fr, cw = wc * 32 + 8 * fq;
        { f32x4 tv[2][4];
#pragma unroll
        for (int ai = 0; ai < 2; ++ai)
#pragma unroll
            for (int m = 0; m < 4; ++m) tv[ai][m] = *(const f32x4*)(ssq + (unsigned)(row0 + ai * HALF + m * 16) * 16 + 4 * fq);
        asm volatile("" ::: "memory");
#pragma unroll
        for (int ai = 0; ai < 2; ++ai)
#pragma unroll
            for (int m = 0; m < 4; ++m) { const f32x4 t = tv[ai][m];
                const float rs = __builtin_amdgcn_rsqf(fq_sum((t[0] + t[1]) + (t[2] + t[3])) * (1.0f / 1024.0f) + RMS_EPS);
#pragma unroll
                for (int bj = 0; bj < 2; ++bj) { acc[ai][bj][m][0] = acc[ai][bj][m][0] * rs; acc[ai][bj][m][1] = acc[ai][bj][m][1] * rs; }
                if (m == 1 || m == 3) __builtin_amdgcn_sched_barrier(0); } }
        const bool first = fr == 0, last = fr == 15;
        u32x2 pk[2][4];
#pragma unroll
        for (int n = 0; n < 2; ++n) {
            const int c = pn * 128 + cw + 4 * n;
            const f32x4 wg0 = *(const f32x4*)(conv_w + c), wg1 = *(const f32x4*)(conv_w + 2 * DFF + c), wg2 = *(const f32x4*)(conv_w + 4 * DFF + c), bg = *(const f32x4*)(conv_b + c);
            const f32x4 wv0 = *(const f32x4*)(conv_w + DFF + c), wv1 = *(const f32x4*)(conv_w + 3 * DFF + c), wv2 = *(const f32x4*)(conv_w + 5 * DFF + c), bv = *(const f32x4*)(conv_b + DFF + c);
#pragma unroll
            for (int ai = 0; ai < 2; ++ai) {
                float* hb = halo + (unsigned)((4 * u.pm + 2 * ai + wr) * (4 * 2 * DFF) + pn * 256 + cw + 4 * n);
                f32x4 Apg = {0.f, 0.f, 0.f, 0.f}, Apv = Apg, Bcg, Bcv;
#pragma unroll
                for (int e = 0; e < 4; ++e) { Bcg[e] = dpp_next(acc[ai][0][0][n][e]); Bcv[e] = dpp_next(acc[ai][1][0][n][e]); }
#pragma unroll
                for (int m = 0; m < 4; ++m) { const int row = row0 + ai * HALF + m * 16;
                    const f32x4 ug = acc[ai][0][m][n], uv = acc[ai][1][m][n]; f32x4 G, V, Acg, Acv, Bng = {0.f, 0.f, 0.f, 0.f}, Bnv = Bng;
#pragma unroll
                    for (int e = 0; e < 4; ++e) { Acg[e] = dpp_prev(ug[e]); Acv[e] = dpp_prev(uv[e]);
                        if (m < 3) { Bng[e] = dpp_next(acc[ai][0][m < 3 ? m + 1 : 3][n][e]); Bnv[e] = dpp_next(acc[ai][1][m < 3 ? m + 1 : 3][n][e]); }
                        const float pg = first ? Apg[e] : Acg[e], pv = first ? Apv[e] : Acv[e], ng = last ? Bng[e] : Bcg[e], nv = last ? Bnv[e] : Bcv[e];
                        G[e] = wg0[e] * pg + wg1[e] * ug[e] + wg2[e] * ng + bg[e]; V[e] = wv0[e] * pv + wv1[e] * uv[e] + wv2[e] * nv + bv[e]; }
                    Apg = Acg; Apv = Acv; Bcg = Bng; Bcv = Bnv;
                    bool edge = false;
                    if (m == 0) { if (first) { edge = true; *(f32x4*)(hb) = ug; *(f32x4*)(hb + 128) = uv; *(f32x4*)(hb + 2 * 2 * DFF) = G; *(f32x4*)(hb + 2 * 2 * DFF + 128) = V; } }
                    if (m == 3) { if (last) { edge = true; *(f32x4*)(hb + 2 * DFF) = ug; *(f32x4*)(hb + 2 * DFF + 128) = uv; *(f32x4*)(hb + 3 * 2 * DFF) = G; *(f32x4*)(hb + 3 * 2 * DFF + 128) = V; } }
                    f32x4 o;
#pragma unroll
                    for (int e = 0; e < 4; ++e) o[e] = G[e] * fast_sigmoid(G[e]) * V[e];
                    u32x2 w; w.x = cvt_pk_bf16(o[0], o[1]); w.y = cvt_pk_bf16(o[2], o[3]);
                    if (n == 0) pk[ai][m] = w;
                    else if (!edge) { u32x4 w4; w4.x = pk[ai][m].x; w4.y = pk[ai][m].y; w4.z = w.x; w4.w = w.y; *(u32x4*)(act + ((unsigned)row * (unsigned)DFF + (unsigned)(c - 4))) = w4; }
                    __builtin_amdgcn_sched_barrier(0);
                }
                asm volatile("" ::: "memory");
            }
        }
    }
};

struct EpiFinal {
    static constexpr bool PERM = true, AFTER_DRAIN = false;
    const bf16_t* x1b; float* out; float* ssq; unsigned* cnt; const float* gf;
    __device__ __forceinline__ void operator()(f32x4 (&acc)[2][2][4][2], const Unit& u, int wr, int wc, int fr, int fq) const {
        const int l_ = lane_id_fresh(); fr = l_ & 15; fq = l_ >> 4;
        const int pn = u.pn, row0 = u.pm * BM + wr * 64 + fr, cw = wc * 32 + 8 * fq;
        const unsigned off0 = (unsigned)row0 * DM + pn * 256 + cw;
#pragma unroll
        for (int ai = 0; ai < 2; ++ai) {
            u32x4 xw[4][2];
#pragma unroll
            for (int m = 0; m < 4; ++m)
#pragma unroll
                for (int bj = 0; bj < 2; ++bj) xw[m][bj] = *(const u32x4*)(x1b + off0 + (unsigned)((ai * HALF + m * 16) * DM + bj * HALF));
            asm volatile("" ::: "memory");
#pragma unroll
            for (int m = 0; m < 4; ++m) { const int row = row0 + ai * HALF + m * 16; float s = 0.f;
#pragma unroll
                for (int bj = 0; bj < 2; ++bj) { const u32x4 w = xw[m][bj];
                    const f32x4 x0 = {__uint_as_float(w.x << 16), __uint_as_float(w.x & 0xffff0000u), __uint_as_float(w.y << 16), __uint_as_float(w.y & 0xffff0000u)};
                    const f32x4 x1v = {__uint_as_float(w.z << 16), __uint_as_float(w.z & 0xffff0000u), __uint_as_float(w.w << 16), __uint_as_float(w.w & 0xffff0000u)};
                    acc[ai][bj][m][0] = acc[ai][bj][m][0] + x0; acc[ai][bj][m][1] = acc[ai][bj][m][1] + x1v;
                    s += sq4(acc[ai][bj][m][0]) + sq4(acc[ai][bj][m][1]); }
                s = fq_sum(s); if (fq == 0) __hip_atomic_store(ssq + (unsigned)row * 16 + pn * 4 + wc, s, __ATOMIC_RELAXED, __HIP_MEMORY_SCOPE_AGENT); }
            asm volatile("" ::: "memory");
        }
        asm volatile("s_waitcnt vmcnt(0)" ::: "memory");
        __builtin_amdgcn_s_barrier(); asm volatile("" ::: "memory");
        if (wr == 0 && wc == 0) {
            unsigned* c = cnt + 64 * u.pm;
            if (l_ == 0) __hip_atomic_fetch_add(c, 1u, __ATOMIC_RELAXED, __HIP_MEMORY_SCOPE_AGENT);
            for (unsigned sp = 0; sp < (1u << 22); ++sp) {
                if ((unsigned)__builtin_amdgcn_readfirstlane(__hip_atomic_load(c, __ATOMIC_RELAXED, __HIP_MEMORY_SCOPE_AGENT)) >= 4u) break;
                __builtin_amdgcn_s_sleep(2); }
            __builtin_amdgcn_fence(__ATOMIC_ACQUIRE, "agent");
            asm volatile("s_waitcnt vmcnt(0)" ::: "memory");
        }
        __builtin_amdgcn_s_barrier(); asm volatile("" ::: "memory");
        f32x4 gv[2][2];
#pragma unroll
        for (int bj = 0; bj < 2; ++bj) { gv[bj][0] = *(const f32x4*)(gf + pn * 256 + bj * HALF + cw); gv[bj][1] = *(const f32x4*)(gf + pn * 256 + bj * HALF + cw + 4); }
        f32x4 tv[2][4];
#pragma unroll
        for (int ai = 0; ai < 2; ++ai)
#pragma unroll
            for (int m = 0; m < 4; ++m) tv[ai][m] = *(const f32x4*)(ssq + (unsigned)(row0 + ai * HALF + m * 16) * 16 + 4 * fq);
        asm volatile("" ::: "memory");
#pragma unroll
        for (int ai = 0; ai < 2; ++ai)
#pragma unroll
            for (int m = 0; m < 4; ++m) { const f32x4 t = tv[ai][m];
                const float rs = __builtin_amdgcn_rsqf(fq_sum((t[0] + t[1]) + (t[2] + t[3])) * (1.0f / 1024.0f) + RMS_EPS);
#pragma unroll
                for (int bj = 0; bj < 2; ++bj) { const unsigned off = off0 + (unsigned)((ai * HALF + m * 16) * DM + bj * HALF);
                    *(f32x4*)(out + off) = acc[ai][bj][m][0] * rs * gv[bj][0]; *(f32x4*)(out + off + 4) = acc[ai][bj][m][1] * rs * gv[bj][1]; }
                if (m == 1 || m == 3) __builtin_amdgcn_sched_barrier(0); }
    }
};
template <class Epi, class Sched, bool ALIGN_EPI = false, bool SP2 = false>
__device__ __forceinline__ void gemm_phase(PG8_LAS unsigned char* lds, const Gemm g, const Sched& S, const Epi& E, const int wave_id  ) {
    const int lane = lane_id_fresh(), wid = wave_id, tid = wid * 64 + lane,
              wr = wid >> 2, wc = wid & 3, fr = lane & 15, fq = lane >> 4;
    const int K = g.K, nt = K / BK;
    unsigned voffA[2], voffB[2]; int aoff, boff;
#define PG8_LANE_CONSTS() do { const int l_ = lane_id_fresh(), t_ = wid * 64 + l_, fr_ = l_ & 15, fq_ = l_ >> 4; \
        _Pragma("unroll") for (int i = 0; i < 2; ++i) { int R, C; stage_rc(t_ * 16 + i * 8192, R, C); const int Rb = Epi::PERM ? ((R & ~31) + perm32(R & 31)) : R; \
            voffA[i] = (unsigned)(R * K + C) * 2u; voffB[i] = (unsigned)(Rb * K + C) * 2u; } \
        aoff = lds_byte(wr * 64 + fr_, fq_ * 8); boff = lds_byte(wc * 32 + fr_, fq_ * 8); } while (0)
    PG8_LANE_CONSTS();
    const size_t kstep = (size_t)(BK * 2);
    const size_t hstep = (size_t)HALF * K * 2;
    const size_t tstep = 2 * hstep;
    const unsigned ldsw = (unsigned)wid * 1024u;
#define PG8_SA(b, h) (((b) * 2 + (h)) * HTB)
#define PG8_SB(b, h) ((4 + (b) * 2 + (h)) * HTB)
#define PG8_STAGE(bufoff, gbase, voff) do { _Pragma("unroll") for (int _i = 0; _i < 2; ++_i) \
        __builtin_amdgcn_global_load_lds((const unsigned*)((const char*)(gbase) + (voff)[_i]), (PG8_LAS unsigned*)(lds + (bufoff) + ldsw + _i * 8192), 16, 0, 0); } while (0)
#define PG8_LDA(dst, b, h) do { _Pragma("unroll") for (int m = 0; m < 4; ++m) _Pragma("unroll") for (int k = 0; k < 2; ++k) dst[m][k] = *(const PG8_LAS bf16x8*)(lds + PG8_SA(b, h) + aoff + m * 2048 + k * 1024); } while (0)
#define PG8_LDB(dst, b, h) do { _Pragma("unroll") for (int n = 0; n < 2; ++n) _Pragma("unroll") for (int k = 0; k < 2; ++k) dst[n][k] = *(const PG8_LAS bf16x8*)(lds + PG8_SB(b, h) + boff + n * 2048 + k * 1024); } while (0)
#define PG8_MMA(ai, bj, At, Bt) do { __builtin_amdgcn_s_setprio(1); _Pragma("unroll") for (int m = 0; m < 4; ++m) _Pragma("unroll") for (int n = 0; n < 2; ++n) _Pragma("unroll") for (int k = 0; k < 2; ++k) \
        acc[ai][bj][m][n] = __builtin_amdgcn_mfma_f32_16x16x32_bf16(Bt[n][k], At[m][k], acc[ai][bj][m][n], 0, 0, 0); __builtin_amdgcn_s_setprio(0); } while (0)
#define PG8_WAIT_V(n) asm volatile("s_waitcnt vmcnt(" #n ")" ::: "memory")
#define PG8_WAIT_L(n) asm volatile("s_waitcnt lgkmcnt(" #n ")" ::: "memory")
#define PG8_BAR __builtin_amdgcn_s_barrier()
#define PG8_SCHED __builtin_amdgcn_sched_barrier(0)
    Unit cur, nxt; int ui = 0;
    if (!S.next(0, cur)) return;
    f32x4 acc[2][2][4][2];
#pragma unroll
    for (int a = 0; a < 2; ++a)
#pragma unroll
        for (int b = 0; b < 2; ++b)
#pragma unroll
            for (int m = 0; m < 4; ++m)
#pragma unroll
                for (int n = 0; n < 2; ++n) acc[a][b][m][n] = (f32x4){0.f, 0.f, 0.f, 0.f};
    bf16x8 At[4][2], B0[2][2], B1[2][2];
    const char* cA = (const char*)g.A + (size_t)cur.pm * tstep; const char* cB = (const char*)g.Bt + (size_t)cur.pn * tstep;
    S.a_ready(cur);
    if constexpr (SP2) {
        PG8_STAGE(PG8_SB(0, 0), cB, voffB); PG8_STAGE(PG8_SB(0, 1), cB + hstep, voffB); PG8_STAGE(PG8_SA(0, 0), cA, voffA); PG8_STAGE(PG8_SA(0, 1), cA + hstep, voffA);
        if (wr == 1) PG8_BAR;
        PG8_WAIT_V(2); PG8_BAR;
        PG8_STAGE(PG8_SB(1, 0), cB + kstep, voffB); PG8_STAGE(PG8_SA(1, 0), cA + kstep, voffA); PG8_STAGE(PG8_SB(1, 1), cB + hstep + kstep, voffB);
        PG8_WAIT_V(6); PG8_BAR;
    } else {
        PG8_STAGE(PG8_SB(0, 0), cB, voffB); PG8_STAGE(PG8_SA(0, 0), cA, voffA); PG8_STAGE(PG8_SB(0, 1), cB + hstep, voffB); PG8_STAGE(PG8_SA(0, 1), cA + hstep, voffA);
        if (wr == 1) PG8_BAR;
        PG8_WAIT_V(4); PG8_BAR;
        PG8_STAGE(PG8_SB(1, 0), cB + kstep, voffB); PG8_STAGE(PG8_SA(1, 0), cA + kstep, voffA); PG8_STAGE(PG8_SB(1, 1), cB + hstep + kstep, voffB);
        PG8_WAIT_V(6); PG8_BAR;
    }
    for (;;) {
        const bool has_next = S.next(ui + 1, nxt);
        const char* nA = has_next ? (const char*)g.A + (size_t)nxt.pm * tstep : cA; const char* nB = has_next ? (const char*)g.Bt + (size_t)nxt.pn * tstep : cB;
        for (int t = 0; t < nt; t += 2) {
            const bool last = (t == nt - 2);
            const char* a1 = cA + (size_t)(t + 1) * kstep;
            const char* a2 = last ? nA : cA + (size_t)(t + 2) * kstep; const char* b2 = last ? nB : cB + (size_t)(t + 2) * kstep;
            const char* a3 = a2 + kstep; const char* b3 = b2 + kstep;
            if (last && has_next) S.a_ready(nxt);
            if constexpr (SP2) {
            PG8_LDB(B0, 0, 0); PG8_LDB(B1, 0, 1); PG8_SCHED; PG8_LDA(At, 0, 0); PG8_STAGE(PG8_SA(1, 1), a1 + hstep, voffA);
            PG8_WAIT_V(8); PG8_WAIT_L(0); PG8_BAR; PG8_MMA(0, 0, At, B0); PG8_MMA(0, 1, At, B1); PG8_BAR; PG8_SCHED;
            PG8_LDA(At, 0, 1); PG8_STAGE(PG8_SB(0, 0), b2, voffB); PG8_STAGE(PG8_SB(0, 1), b2 + hstep, voffB); PG8_STAGE(PG8_SA(0, 0), a2, voffA);
            PG8_WAIT_V(8); PG8_WAIT_L(0); PG8_BAR; PG8_MMA(1, 0, At, B0); PG8_MMA(1, 1, At, B1); PG8_BAR; PG8_SCHED;
            PG8_LDB(B0, 1, 0); PG8_LDB(B1, 1, 1); PG8_SCHED; PG8_LDA(At, 1, 0); PG8_STAGE(PG8_SA(0, 1), a2 + hstep, voffA);
            PG8_WAIT_V(8); PG8_WAIT_L(0); PG8_BAR; PG8_MMA(0, 0, At, B0); PG8_MMA(0, 1, At, B1); PG8_BAR; PG8_SCHED;
            PG8_LDA(At, 1, 1); PG8_STAGE(PG8_SB(1, 0), b3, voffB); PG8_STAGE(PG8_SB(1, 1), b3 + hstep, voffB); PG8_STAGE(PG8_SA(1, 0), a3, voffA);
            PG8_WAIT_V(8); PG8_WAIT_L(0); PG8_BAR; PG8_MMA(1, 0, At, B0); PG8_MMA(1, 1, At, B1); PG8_BAR; PG8_SCHED;
            } else {
            PG8_LDB(B0, 0, 0); PG8_SCHED; PG8_LDA(At, 0, 0); PG8_STAGE(PG8_SA(1, 1), a1 + hstep, voffA);
            PG8_WAIT_L(8); PG8_BAR; PG8_WAIT_L(0); PG8_MMA(0, 0, At, B0); PG8_BAR; PG8_SCHED;
            PG8_LDB(B1, 0, 1); PG8_STAGE(PG8_SB(0, 0), b2, voffB);
            PG8_BAR; PG8_WAIT_L(0); PG8_MMA(0, 1, At, B1); PG8_BAR;
            PG8_LDA(At, 0, 1); PG8_STAGE(PG8_SA(0, 0), a2, voffA);
            PG8_BAR; PG8_WAIT_L(0); PG8_MMA(1, 0, At, B0); PG8_BAR; PG8_SCHED;
            PG8_STAGE(PG8_SB(0, 1), b2 + hstep, voffB);
            PG8_WAIT_V(6); PG8_BAR; PG8_MMA(1, 1, At, B1); PG8_BAR;
            PG8_LDB(B0, 1, 0); PG8_SCHED; PG8_LDA(At, 1, 0); PG8_STAGE(PG8_SA(0, 1), a2 + hstep, voffA);
            PG8_WAIT_L(8); PG8_BAR; PG8_WAIT_L(0); PG8_MMA(0, 0, At, B0); PG8_BAR; PG8_SCHED;
            PG8_LDB(B1, 1, 1); PG8_STAGE(PG8_SB(1, 0), b3, voffB);
            PG8_BAR; PG8_WAIT_L(0); PG8_MMA(0, 1, At, B1); PG8_BAR;
            PG8_LDA(At, 1, 1); PG8_STAGE(PG8_SA(1, 0), a3, voffA);
            PG8_BAR; PG8_WAIT_L(0); PG8_MMA(1, 0, At, B0); PG8_BAR; PG8_SCHED;
            PG8_STAGE(PG8_SB(1, 1), b3 + hstep, voffB);
            PG8_WAIT_V(6); PG8_BAR; PG8_MMA(1, 1, At, B1); PG8_BAR;
            }
        }
        if constexpr (ALIGN_EPI) { if (wr == 0) PG8_BAR; }
        if constexpr (!Epi::AFTER_DRAIN) { E(acc, cur, wr, wc, fr, fq); S.done(cur); PG8_LANE_CONSTS(); }
        if (!has_next) break;
#pragma unroll
        for (int a = 0; a < 2; ++a)
#pragma unroll
            for (int b = 0; b < 2; ++b)
#pragma unroll
                for (int m = 0; m < 4; ++m)
#pragma unroll
                    for (int n = 0; n < 2; ++n) acc[a][b][m][n] = (f32x4){0.f, 0.f, 0.f, 0.f};
        cur = nxt; cA = nA; cB = nB; ++ui;
        if constexpr (ALIGN_EPI) { if (wr == 1) PG8_BAR; }
    }
    PG8_WAIT_V(0);
    if constexpr (!ALIGN_EPI) { if (wr == 0) PG8_BAR; }
    PG8_BAR;
    if constexpr (Epi::AFTER_DRAIN) { E.fused(acc, cur, wr, wc, fr, fq, lds, wid, lane); S.done(cur); }
#undef PG8_LANE_CONSTS
#undef PG8_SA
#undef PG8_SB
#undef PG8_STAGE
#undef PG8_LDA
#undef PG8_LDB
#undef PG8_MMA
#undef PG8_WAIT_V
#undef PG8_WAIT_L
#undef PG8_BAR
#undef PG8_SCHED
}
}
using pg8::SEQ; using pg8::NBATCH; using pg8::MTOK; using pg8::DM; using pg8::DFF; using pg8::RMS_EPS; using pg8::LOG2E;
#ifndef PG8_SP2
#define PG8_SP2 true
#endif
#ifndef PG8_ALIGN
#define PG8_ALIGN true
#endif
#ifndef MLA_OT
#define MLA_OT 1
#endif
namespace att {
using bf16x8 = __attribute__((ext_vector_type(8))) short;
using s16x4  = __attribute__((ext_vector_type(4))) short;
using f32x16 = __attribute__((ext_vector_type(16))) float;
using u32x4  = __attribute__((ext_vector_type(4))) unsigned;
typedef unsigned short bf16_t;
#define SBAR() __builtin_amdgcn_sched_barrier(0)
#define ATT_WAIT_BAR(N) asm volatile("s_waitcnt vmcnt(" #N ") lgkmcnt(0)\n\ts_barrier" ::: "memory")
__device__ __forceinline__ int crow(int r, int hi) { return (r & 3) + 8 * (r >> 2) + 4 * hi; }
__device__ __forceinline__ unsigned cvtpk(float lo, float hi) { unsigned r; asm volatile("v_cvt_pk_bf16_f32 %0, %1, %2" : "=v"(r) : "v"(lo), "v"(hi)); return r; }
__device__ __forceinline__ float bf2f(bf16_t b) { return __uint_as_float((unsigned)b << 16); }
typedef float f32x2_t __attribute__((ext_vector_type(2))); typedef __bf16 bf16x2_t __attribute__((ext_vector_type(2)));
__device__ __forceinline__ unsigned cvtpk2(float lo, float hi) { f32x2_t v = {lo, hi}; bf16x2_t r = __builtin_convertvector(v, bf16x2_t); return __builtin_bit_cast(unsigned, r); }
__device__ __forceinline__ bf16_t f2bf(float f) { return (bf16_t)(cvtpk(f, f) & 0xffffu); }
__device__ __forceinline__ void glds16(const void* gsrc, unsigned lds_dst) { unsigned keep;
    asm volatile("s_mov_b32 %0, m0\n\ts_mov_b32 m0, %2\n\ts_nop 0\n\tglobal_load_lds_dwordx4 %1, off\n\ts_mov_b32 m0, %0" : "=&s"(keep) : "v"(gsrc), "s"(lds_dst) : "memory"); }
template <int IMM> __device__ __forceinline__ void glds16s(const void* sbase, unsigned voff, unsigned lds_dst) { unsigned keep;
    asm volatile("s_mov_b32 %0, m0\n\ts_mov_b32 m0, %3\n\ts_nop 4\n\tglobal_load_lds_dwordx4 %1, %2 offset:%4\n\ts_mov_b32 m0, %0" : "=&s"(keep) : "v"(voff), "s"(sbase), "s"(lds_dst), "i"(IMM) : "memory"); }
__device__ __forceinline__ int swap23(int k) { return (k & ~0xC) | ((k & 4) << 1) | ((k & 8) >> 1); }
__device__ __forceinline__ int v_rd_base(int lane) { return ((lane & 3) << 3) | (((lane >> 2) & 3) << 6) | (((lane >> 4) & 1) << 5) | (((lane >> 5) & 1) << 8); }
template <int OFF> __device__ __forceinline__ s16x4 tr_read(int vb) { s16x4 r; asm volatile("ds_read_b64_tr_b16 %0, %1 offset:%2" : "=&v"(r) : "v"(vb), "i"(OFF) : "memory"); return r; }
__device__ __forceinline__ void pack_p(const f32x16& p0, const f32x16& p1, bf16x8& pa0, bf16x8& pa1, bf16x8& pa2, bf16x8& pa3) {
#define PK4(P, BASE, OUT) do { unsigned a0 = cvtpk(P[BASE + 0], P[BASE + 1]), a1 = cvtpk(P[BASE + 2], P[BASE + 3]);   \
    unsigned b0 = cvtpk(P[BASE + 4], P[BASE + 5]), b1 = cvtpk(P[BASE + 6], P[BASE + 7]);                              \
    auto r0 = __builtin_amdgcn_permlane32_swap(a0, b0, false, false); auto r1 = __builtin_amdgcn_permlane32_swap(a1, b1, false, false); \
    u32x4 w = {r0[0], r1[0], r0[1], r1[1]}; OUT = *reinterpret_cast<bf16x8*>(&w); } while (0)
    PK4(p0, 0, pa0); PK4(p0, 8, pa1); PK4(p1, 0, pa2); PK4(p1, 8, pa3);
#undef PK4
}
__device__ __forceinline__ float half_max(float v) { auto rr = __builtin_amdgcn_permlane32_swap(__float_as_uint(v), __float_as_uint(v), false, false); return fmaxf(__uint_as_float(rr[0]), __uint_as_float(rr[1])); }
__device__ __forceinline__ float half_sum(float v) { auto rr = __builtin_amdgcn_permlane32_swap(__float_as_uint(v), __float_as_uint(v), false, false); return __uint_as_float(rr[0]) + __uint_as_float(rr[1]); }
template <int ND0, int D0> __device__ __forceinline__ void pv_one(f32x16& od, int vb, bf16x8 pa0, bf16x8 pa1, bf16x8 pa2, bf16x8 pa3) {
    constexpr int KS = 1024 * ND0, HF = 512 * ND0;
    const s16x4 l0 = tr_read<D0 * 512 + 0 * KS>(vb), h0 = tr_read<D0 * 512 + 0 * KS + HF>(vb), l1 = tr_read<D0 * 512 + 1 * KS>(vb), h1 = tr_read<D0 * 512 + 1 * KS + HF>(vb);
    const s16x4 l2 = tr_read<D0 * 512 + 2 * KS>(vb), h2 = tr_read<D0 * 512 + 2 * KS + HF>(vb), l3 = tr_read<D0 * 512 + 3 * KS>(vb), h3 = tr_read<D0 * 512 + 3 * KS + HF>(vb);
    asm volatile("s_waitcnt lgkmcnt(0)" ::: "memory"); SBAR();
#define PK(L, H) (bf16x8){L[0], L[1], L[2], L[3], H[0], H[1], H[2], H[3]}
    od = __builtin_amdgcn_mfma_f32_32x32x16_bf16(pa0, PK(l0, h0), od, 0, 0, 0);
    od = __builtin_amdgcn_mfma_f32_32x32x16_bf16(pa1, PK(l1, h1), od, 0, 0, 0);
    od = __builtin_amdgcn_mfma_f32_32x32x16_bf16(pa2, PK(l2, h2), od, 0, 0, 0);
    od = __builtin_amdgcn_mfma_f32_32x32x16_bf16(pa3, PK(l3, h3), od, 0, 0, 0);
#undef PK
}
struct PvFrag { s16x4 l0, h0, l1, h1, l2, h2, l3, h3; };
template <int ND0, int D0> __device__ __forceinline__ void pv_issue(PvFrag& f, int vb) {
    constexpr int KS = 1024 * ND0, HF = 512 * ND0;
    f.l0 = tr_read<D0 * 512 + 0 * KS>(vb); f.h0 = tr_read<D0 * 512 + 0 * KS + HF>(vb); f.l1 = tr_read<D0 * 512 + 1 * KS>(vb); f.h1 = tr_read<D0 * 512 + 1 * KS + HF>(vb);
    f.l2 = tr_read<D0 * 512 + 2 * KS>(vb); f.h2 = tr_read<D0 * 512 + 2 * KS + HF>(vb); f.l3 = tr_read<D0 * 512 + 3 * KS>(vb); f.h3 = tr_read<D0 * 512 + 3 * KS + HF>(vb);
}
__device__ __forceinline__ void pv_mma(f32x16& od, const PvFrag& f, bf16x8 pa0, bf16x8 pa1, bf16x8 pa2, bf16x8 pa3) {
    asm volatile("s_waitcnt lgkmcnt(0)" ::: "memory"); SBAR();
#define PK(L, H) (bf16x8){L[0], L[1], L[2], L[3], H[0], H[1], H[2], H[3]}
    od = __builtin_amdgcn_mfma_f32_32x32x16_bf16(pa0, PK(f.l0, f.h0), od, 0, 0, 0);
    od = __builtin_amdgcn_mfma_f32_32x32x16_bf16(pa1, PK(f.l1, f.h1), od, 0, 0, 0);
    od = __builtin_amdgcn_mfma_f32_32x32x16_bf16(pa2, PK(f.l2, f.h2), od, 0, 0, 0);
    od = __builtin_amdgcn_mfma_f32_32x32x16_bf16(pa3, PK(f.l3, f.h3), od, 0, 0, 0);
#undef PK
}
template <int NK16, int RS, int CS> __device__ __forceinline__ void qkt(f32x16& p0, f32x16& p1, const char* Ks, const bf16x8* qr, int r32, int hi) {
    p0 = f32x16{}; p1 = f32x16{};
    const char* kb = Ks + hi * CS + r32 * RS;
#pragma unroll
    for (int d0 = 0; d0 < NK16; ++d0) {
        const bf16x8 b0 = *reinterpret_cast<const bf16x8*>(kb + d0 * 2 * CS), b1 = *reinterpret_cast<const bf16x8*>(kb + d0 * 2 * CS + 32 * RS);
        p0 = __builtin_amdgcn_mfma_f32_32x32x16_bf16(b0, qr[d0], p0, 0, 0, 0);
        p1 = __builtin_amdgcn_mfma_f32_32x32x16_bf16(b1, qr[d0], p1, 0, 0, 0); }
}

template <int NK16, int RS, int CS> __device__ __forceinline__ void qkt_c(f32x16& p0, f32x16& p1, const f32x16& c, const char* Ks, const bf16x8* qr, int r32, int hi) {
    const char* kb = Ks + hi * CS + r32 * RS;
    { const bf16x8 b0 = *reinterpret_cast<const bf16x8*>(kb), b1 = *reinterpret_cast<const bf16x8*>(kb + 32 * RS);
      p0 = __builtin_amdgcn_mfma_f32_32x32x16_bf16(b0, qr[0], c, 0, 0, 0);
      p1 = __builtin_amdgcn_mfma_f32_32x32x16_bf16(b1, qr[0], c, 0, 0, 0); }
#pragma unroll
    for (int d0 = 1; d0 < NK16; ++d0) {
        const bf16x8 b0 = *reinterpret_cast<const bf16x8*>(kb + d0 * 2 * CS), b1 = *reinterpret_cast<const bf16x8*>(kb + d0 * 2 * CS + 32 * RS);
        p0 = __builtin_amdgcn_mfma_f32_32x32x16_bf16(b0, qr[d0], p0, 0, 0, 0);
        p1 = __builtin_amdgcn_mfma_f32_32x32x16_bf16(b1, qr[d0], p1, 0, 0, 0); }
}
__device__ __forceinline__ float max3f(float a, float b, float c) { float r; asm("v_max3_f32 %0, %1, %2, %3" : "=v"(r) : "v"(a), "v"(b), "v"(c)); return r; }

namespace mla {
constexpr int NTILE = SEQ / 64;
constexpr int KPITCH = 400, KSLOT = 64 * KPITCH  , NSLOT = 4;
constexpr int LDS_K = 0, LDS_WS = NSLOT * KSLOT, LDS_BYTES = LDS_WS + 8 * 256;
constexpr int OST_PITCH = 272, OST_WAVE = 32 * OST_PITCH;
static_assert(8 * OST_WAVE <= NSLOT * KSLOT, "o_lat staging fits the ring");
#ifndef MLA_XVALU
#define MLA_XVALU 0
#endif
constexpr float THR = 8.f;
template <bool FIRST> __device__ __forceinline__ void partialSM(f32x16& p0, f32x16& p1, f32x16& negm, float& alpha) {
    float a = max3f(p0[0], p0[1], p0[2]), b = max3f(p0[9], p0[10], p0[11]), c = max3f(p1[0], p1[1], p1[2]), e = max3f(p1[9], p1[10], p1[11]);
    a = max3f(a, p0[3], p0[4]); b = max3f(b, p0[12], p0[13]); c = max3f(c, p1[3], p1[4]); e = max3f(e, p1[12], p1[13]);
    a = max3f(a, p0[5], p0[6]); b = max3f(b, p0[14], p0[15]); c = max3f(c, p1[5], p1[6]); e = max3f(e, p1[14], p1[15]);
    a = max3f(a, p0[7], p0[8]); c = max3f(c, p1[7], p1[8]);
    float pmax = max3f(a, b, c);
    pmax = max3f(pmax, e, e);
    { auto rr = __builtin_amdgcn_permlane32_swap(__float_as_uint(pmax), __float_as_uint(pmax), false, false); pmax = max3f(__uint_as_float(rr[0]), __uint_as_float(rr[1]), __uint_as_float(rr[1])); }
    alpha = 1.f;
    if (FIRST || !__builtin_expect(__all(pmax <= THR), 1)) {
        const float dl = FIRST ? pmax : fmaxf(pmax, 0.f);
        if (!FIRST) alpha = __builtin_amdgcn_exp2f(-dl);
#pragma unroll
        for (int r = 0; r < 16; ++r) { p0[r] -= dl; p1[r] -= dl; negm[r] -= dl; }
        asm volatile("" : "+v"(negm));
    }
#pragma unroll
    for (int r = 0; r < 16; ++r) p0[r] = __builtin_amdgcn_exp2f(p0[r]);
}
__device__ __forceinline__ void finishSM(f32x16& p0, f32x16& p1, float alpha, float& l_reg, bf16x8& pa0, bf16x8& pa1, bf16x8& pa2, bf16x8& pa3) {
#pragma unroll
    for (int r = 0; r < 16; ++r) p1[r] = __builtin_amdgcn_exp2f(p1[r]);
    float s0 = p0[0] + p0[1], s1 = p0[2] + p0[3], s2 = p1[0] + p1[1], s3 = p1[2] + p1[3];
#pragma unroll
    for (int r = 4; r < 16; r += 4) { s0 += p0[r]; s0 += p0[r + 1]; s1 += p0[r + 2]; s1 += p0[r + 3]; s2 += p1[r]; s2 += p1[r + 1]; s3 += p1[r + 2]; s3 += p1[r + 3]; }
    float ps = (s0 + s1) + (s2 + s3);
    ps = half_sum(ps);
    l_reg = l_reg * alpha + ps;
#if MLA_OT
#define MLA_PK(P, B) (u32x4){cvtpk2(P[B], P[B + 1]), cvtpk2(P[B + 2], P[B + 3]), cvtpk2(P[B + 4], P[B + 5]), cvtpk2(P[B + 6], P[B + 7])}
    { u32x4 w0 = MLA_PK(p0, 0), w1 = MLA_PK(p0, 8), w2 = MLA_PK(p1, 0), w3 = MLA_PK(p1, 8);
      pa0 = *reinterpret_cast<bf16x8*>(&w0); pa1 = *reinterpret_cast<bf16x8*>(&w1); pa2 = *reinterpret_cast<bf16x8*>(&w2); pa3 = *reinterpret_cast<bf16x8*>(&w3); }
#undef MLA_PK
#else
    pack_p(p0, p1, pa0, pa1, pa2, pa3);
#endif
}
__device__ __forceinline__ int v_rm_base(int lane) { return (8 * (lane >> 5) + ((lane >> 2) & 3)) * KPITCH + 32 * ((lane >> 4) & 1) + 8 * (lane & 3); }
template <int D0> __device__ __forceinline__ void pvr_issue(PvFrag& f, int vb) {
    constexpr int KS = 16 * KPITCH, HF = 4 * KPITCH;
    f.l0 = tr_read<D0 * 64 + 0 * KS>(vb); f.h0 = tr_read<D0 * 64 + 0 * KS + HF>(vb); f.l1 = tr_read<D0 * 64 + 1 * KS>(vb); f.h1 = tr_read<D0 * 64 + 1 * KS + HF>(vb);
    f.l2 = tr_read<D0 * 64 + 2 * KS>(vb); f.h2 = tr_read<D0 * 64 + 2 * KS + HF>(vb); f.l3 = tr_read<D0 * 64 + 3 * KS>(vb); f.h3 = tr_read<D0 * 64 + 3 * KS + HF>(vb);
}
template <int D0> __device__ __forceinline__ void pvr_one(f32x16& od, int vb, bf16x8 pa0, bf16x8 pa1, bf16x8 pa2, bf16x8 pa3) { PvFrag f; pvr_issue<D0>(f, vb); pv_mma(od, f, pa0, pa1, pa2, pa3); }
#if MLA_OT
__device__ __forceinline__ int vt_rm_base(int lane) { return (4 * (lane >> 5) + ((lane >> 2) & 3)) * KPITCH + 32 * ((lane >> 4) & 1) + 8 * (lane & 3); }
template <int D0> __device__ __forceinline__ void pvt_issue(PvFrag& f, int vb) {
    constexpr int KS = 16 * KPITCH, HF = 8 * KPITCH;
    f.l0 = tr_read<D0 * 64 + 0 * KS>(vb); f.h0 = tr_read<D0 * 64 + 0 * KS + HF>(vb); f.l1 = tr_read<D0 * 64 + 1 * KS>(vb); f.h1 = tr_read<D0 * 64 + 1 * KS + HF>(vb);
    f.l2 = tr_read<D0 * 64 + 2 * KS>(vb); f.h2 = tr_read<D0 * 64 + 2 * KS + HF>(vb); f.l3 = tr_read<D0 * 64 + 3 * KS>(vb); f.h3 = tr_read<D0 * 64 + 3 * KS + HF>(vb);
}
__device__ __forceinline__ void pvt_mma(f32x16& od, const PvFrag& f, bf16x8 pa0, bf16x8 pa1, bf16x8 pa2, bf16x8 pa3) {
    asm volatile("s_waitcnt lgkmcnt(0)" ::: "memory"); SBAR();
#define PK(L, H) (bf16x8){L[0], L[1], L[2], L[3], H[0], H[1], H[2], H[3]}
    od = __builtin_amdgcn_mfma_f32_32x32x16_bf16(PK(f.l0, f.h0), pa0, od, 0, 0, 0);
    od = __builtin_amdgcn_mfma_f32_32x32x16_bf16(PK(f.l1, f.h1), pa1, od, 0, 0, 0);
    od = __builtin_amdgcn_mfma_f32_32x32x16_bf16(PK(f.l2, f.h2), pa2, od, 0, 0, 0);
    od = __builtin_amdgcn_mfma_f32_32x32x16_bf16(PK(f.l3, f.h3), pa3, od, 0, 0, 0);
#undef PK
}
template <int D0> __device__ __forceinline__ void pvt_one(f32x16& od, int vb, bf16x8 pa0, bf16x8 pa1, bf16x8 pa2, bf16x8 pa3) { PvFrag f; pvt_issue<D0>(f, vb); pvt_mma(od, f, pa0, pa1, pa2, pa3); }
#define MLA_PV_ISSUE pvt_issue
#define MLA_PV_MMA pvt_mma
#define MLA_PV_ONE pvt_one
#define MLA_V_BASE vt_rm_base
#else
#define MLA_PV_ISSUE pvr_issue
#define MLA_PV_MMA pv_mma
#define MLA_PV_ONE pvr_one
#define MLA_V_BASE v_rm_base
#endif
__device__ __forceinline__ void h1_qk_finish(f32x16& C0, f32x16& C1, f32x16& P0, f32x16& P1, const f32x16& negm, const char* Ks, const bf16x8* qr, int r32, int hi,
                                             float alP, float& l_reg, bf16x8& pa0, bf16x8& pa1, bf16x8& pa2, bf16x8& pa3) {
    const char* kb = Ks + hi * 16 + r32 * KPITCH;
    bf16x8 b0 = *reinterpret_cast<const bf16x8*>(kb), b1 = *reinterpret_cast<const bf16x8*>(kb + 32 * KPITCH);
    float a0 = 0.f, a1 = 0.f, c0 = 0.f, c1 = 0.f; unsigned w[16];
#pragma unroll
    for (int k = 0; k < 12; ++k) {
        bf16x8 n0 = b0, n1 = b1;
        if (k < 11) { n0 = *reinterpret_cast<const bf16x8*>(kb + (k + 1) * 32); n1 = *reinterpret_cast<const bf16x8*>(kb + (k + 1) * 32 + 32 * KPITCH); }
        if (k == 0) { C0 = __builtin_amdgcn_mfma_f32_32x32x16_bf16(b0, qr[0], negm, 0, 0, 0); C1 = __builtin_amdgcn_mfma_f32_32x32x16_bf16(b1, qr[0], negm, 0, 0, 0); }
        else { C0 = __builtin_amdgcn_mfma_f32_32x32x16_bf16(b0, qr[k], C0, 0, 0, 0); C1 = __builtin_amdgcn_mfma_f32_32x32x16_bf16(b1, qr[k], C1, 0, 0, 0); }
        if (k < 8) { float e0 = __builtin_amdgcn_exp2f(P1[2 * k]), e1 = __builtin_amdgcn_exp2f(P1[2 * k + 1]);
            if (k == 0) { a0 = P0[0]; a1 = P0[1]; } else { a0 += P0[2 * k]; a1 += P0[2 * k + 1]; }
            w[k] = cvtpk2(P0[2 * k], P0[2 * k + 1]);
            asm volatile("" : "+v"(e0), "+v"(e1), "+v"(a0), "+v"(a1), "+v"(w[k]));
            P1[2 * k] = e0; P1[2 * k + 1] = e1; }
        else { const int e = 4 * (k - 8);
            if (k == 8) { c0 = P1[0] + P1[2]; c1 = P1[1] + P1[3]; } else { c0 += P1[e]; c1 += P1[e + 1]; c0 += P1[e + 2]; c1 += P1[e + 3]; }
            w[8 + 2 * (k - 8)] = cvtpk2(P1[e], P1[e + 1]); w[9 + 2 * (k - 8)] = cvtpk2(P1[e + 2], P1[e + 3]);
            asm volatile("" : "+v"(c0), "+v"(c1), "+v"(w[8 + 2 * (k - 8)]), "+v"(w[9 + 2 * (k - 8)])); }
        SBAR();
        b0 = n0; b1 = n1;
    }
    l_reg = l_reg * alP + half_sum((a0 + a1) + (c0 + c1));
    { u32x4 w0 = {w[0], w[1], w[2], w[3]}, w1 = {w[4], w[5], w[6], w[7]}, w2 = {w[8], w[9], w[10], w[11]}, w3 = {w[12], w[13], w[14], w[15]};
      pa0 = *reinterpret_cast<bf16x8*>(&w0); pa1 = *reinterpret_cast<bf16x8*>(&w1); pa2 = *reinterpret_cast<bf16x8*>(&w2); pa3 = *reinterpret_cast<bf16x8*>(&w3); }
}
__device__ __forceinline__ void max_head(const f32x16& p0, const f32x16& p1, float& a, float& b, float& c, float& e) {
    a = max3f(p0[0], p0[1], p0[2]); b = max3f(p0[9], p0[10], p0[11]); c = max3f(p1[0], p1[1], p1[2]); e = max3f(p1[9], p1[10], p1[11]);
    a = max3f(a, p0[3], p0[4]); b = max3f(b, p0[12], p0[13]); c = max3f(c, p1[3], p1[4]); e = max3f(e, p1[12], p1[13]);
}
__device__ __forceinline__ float max_tail(const f32x16& p0, const f32x16& p1, float a, float b, float c, float e) {
    a = max3f(a, p0[5], p0[6]); b = max3f(b, p0[14], p0[15]); c = max3f(c, p1[5], p1[6]); e = max3f(e, p1[14], p1[15]);
    a = max3f(a, p0[7], p0[8]); c = max3f(c, p1[7], p1[8]);
    float pmax = max3f(a, b, c); pmax = max3f(pmax, e, e);
    auto rr = __builtin_amdgcn_permlane32_swap(__float_as_uint(pmax), __float_as_uint(pmax), false, false);
    return max3f(__uint_as_float(rr[0]), __uint_as_float(rr[1]), __uint_as_float(rr[1]));
}
struct Tensors { const bf16_t* QA; const bf16_t* KL; const bf16_t* WV; const bf16_t* GA; const bf16_t* OB; bf16_t* MIX; };
__device__ __forceinline__ void unit(int b, int h, int qb, const Tensors& T, char* shm, const int wave_id) {
    const int lane = pg8::lane_id_fresh(), wid = wave_id, r32 = lane & 31, hi = lane >> 5;
    const long rowbase = (long)b * SEQ; const int q0 = qb * 256;
    const unsigned lds0 = (unsigned)(uintptr_t)shm;
    float* wsf = (float*)(shm + LDS_WS) + wid * 64; float* al_l = wsf; float* li_l = wsf + 32;
    const char* klb = (const char*)(T.KL + rowbase * 192);
    unsigned koff0, koff1, koff2;
    { int s = 64 * wid + lane, row = s / 25, pos = s - 25 * row; koff0 = (unsigned)(row * 384 + (pos < 24 ? pos : 23) * 16);
      s += 512; row = s / 25; pos = s - 25 * row; koff1 = (unsigned)(row * 384 + (pos < 24 ? pos : 23) * 16);
      s += 512; row = s / 25; pos = s - 25 * row; koff2 = (unsigned)(row * 384 + (pos < 24 ? pos : 23) * 16); }
#define MLA_DMA(t) do { const unsigned kd_ = (unsigned)__builtin_amdgcn_readfirstlane(lds0 + LDS_K + ((t) & 3) * KSLOT + wid * 1024); const char* kb_ = klb + (size_t)(t) * 24576; \
        glds16s<0>(kb_, koff0, kd_); glds16s<0>(kb_, koff1, kd_ + 8192); glds16s<0>(kb_, koff2, kd_ + 16384); \
        if (wid == 0) { const int s_ = 1536 + lane, row_ = 61 + (lane >= 14) + (lane >= 39), pos_ = s_ - 25 * row_; glds16s<0>(kb_, (unsigned)(row_ * 384 + (pos_ < 24 ? pos_ : 23) * 16), kd_ + 24576); } } while (0)
    MLA_DMA(0); MLA_DMA(1);
    bf16x8 qr[12];
    { const bf16_t* Qw = T.QA + (rowbase + q0 + wid * 32 + r32) * 1536 + h * 192 + hi * 8;
#pragma unroll
      for (int d0 = 0; d0 < 12; ++d0) qr[d0] = *reinterpret_cast<const bf16x8*>(Qw + d0 * 16); }
    const int vb0 = (int)(lds0 + LDS_K) + MLA_V_BASE(lane);
    float l_reg = 0.f; f32x16 o[4] = {};
    f32x16 negm = {}; asm volatile("" : "+v"(negm));
    f32x16 pA0, pA1, pB0, pB1; float alA, alB; bf16x8 pa0, pa1, pa2, pa3;
#if MLA_OT
#define MLA_RESC(a) do { if (__any((a) < 1.f)) { _Pragma("unroll") for (int d = 0; d < 4; ++d) _Pragma("unroll") for (int r = 0; r < 16; ++r) o[d][r] *= (a); } } while (0)
#else
#define MLA_RESC(a) do { if (__any((a) < 1.f)) { if (hi == 0) al_l[r32] = (a); asm volatile("s_waitcnt lgkmcnt(0)" ::: "memory"); \
        _Pragma("unroll") for (int d = 0; d < 4; ++d) _Pragma("unroll") for (int r = 0; r < 16; ++r) o[d][r] *= al_l[crow(r, hi)]; } } while (0)
#endif
#define ATT_BAR_L() asm volatile("s_waitcnt lgkmcnt(0)\n\ts_barrier" ::: "memory")
    ATT_WAIT_BAR(0);
    if (wid >= 4) ATT_BAR_L();
    qkt<12, KPITCH, 16>(pA0, pA1, shm + LDS_K, qr, r32, hi); ATT_WAIT_BAR(0);
    MLA_DMA(2); partialSM<true>(pA0, pA1, negm, alA); ATT_BAR_L();
#define MLA_STEP(C0, C1, P0, P1, alC, alP, t, HASN) do { \
        h1_qk_finish(C0, C1, P0, P1, negm, shm + LDS_K + ((t) & 3) * KSLOT, qr, r32, hi, alP, l_reg, pa0, pa1, pa2, pa3); SBAR(); ATT_WAIT_BAR(0); \
        { const int vb_ = vb0 + (((t) - 1) & 3) * KSLOT; float ma_, mb_, mc_, me_, pmx_; \
          { PvFrag f_; MLA_PV_ISSUE<0>(f_, vb_); if (HASN) { MLA_DMA((t) + 2); } max_head(C0, C1, ma_, mb_, mc_, me_); SBAR(); MLA_PV_MMA(o[0], f_, pa0, pa1, pa2, pa3); } \
          { PvFrag f_; MLA_PV_ISSUE<1>(f_, vb_); pmx_ = max_tail(C0, C1, ma_, mb_, mc_, me_); SBAR(); MLA_PV_MMA(o[1], f_, pa0, pa1, pa2, pa3); } \
          alC = 1.f; \
          if (!__builtin_expect(__all(pmx_ <= THR), 1)) { const float dl_ = fmaxf(pmx_, 0.f); alC = __builtin_amdgcn_exp2f(-dl_); \
              _Pragma("unroll") for (int r_ = 0; r_ < 16; ++r_) { C0[r_] -= dl_; C1[r_] -= dl_; negm[r_] -= dl_; } asm volatile("" : "+v"(negm)); } \
          { PvFrag f_; MLA_PV_ISSUE<2>(f_, vb_); _Pragma("unroll") for (int r_ = 0; r_ < 8; ++r_) C0[r_] = __builtin_amdgcn_exp2f(C0[r_]); asm volatile("" : "+v"(C0)); SBAR(); MLA_PV_MMA(o[2], f_, pa0, pa1, pa2, pa3); } \
          { PvFrag f_; MLA_PV_ISSUE<3>(f_, vb_); _Pragma("unroll") for (int r_ = 8; r_ < 16; ++r_) C0[r_] = __builtin_amdgcn_exp2f(C0[r_]); asm volatile("" : "+v"(C0)); SBAR(); MLA_PV_MMA(o[3], f_, pa0, pa1, pa2, pa3); } } \
        SBAR(); ATT_BAR_L(); MLA_RESC(alC); } while (0)
    for (int t = 1; t + 1 < NTILE; t += 2) {
        MLA_STEP(pB0, pB1, pA0, pA1, alB, alA, t, true);
        MLA_STEP(pA0, pA1, pB0, pB1, alA, alB, t + 1, (t + 3 < NTILE));
    }
    { qkt_c<12, KPITCH, 16>(pB0, pB1, negm, shm + LDS_K + ((NTILE - 1) & 3) * KSLOT, qr, r32, hi);
      finishSM(pA0, pA1, alA, l_reg, pa0, pa1, pa2, pa3); SBAR(); ATT_WAIT_BAR(0);
      { const int vb_ = vb0 + ((NTILE - 2) & 3) * KSLOT; MLA_PV_ONE<0>(o[0], vb_, pa0, pa1, pa2, pa3); MLA_PV_ONE<1>(o[1], vb_, pa0, pa1, pa2, pa3); MLA_PV_ONE<2>(o[2], vb_, pa0, pa1, pa2, pa3); MLA_PV_ONE<3>(o[3], vb_, pa0, pa1, pa2, pa3); }
      partialSM<false>(pB0, pB1, negm, alB);
      ATT_BAR_L(); MLA_RESC(alB);
      finishSM(pB0, pB1, alB, l_reg, pa0, pa1, pa2, pa3); SBAR();
      { const int vb_ = vb0 + ((NTILE - 1) & 3) * KSLOT; MLA_PV_ONE<0>(o[0], vb_, pa0, pa1, pa2, pa3); MLA_PV_ONE<1>(o[1], vb_, pa0, pa1, pa2, pa3); MLA_PV_ONE<2>(o[2], vb_, pa0, pa1, pa2, pa3); MLA_PV_ONE<3>(o[3], vb_, pa0, pa1, pa2, pa3); } }
    if (wid < 4) ATT_BAR_L();
#if MLA_OT
    { const float rl = __builtin_amdgcn_rcpf(l_reg);
      bf16x8 pb[8];
#pragma unroll
      for (int ks = 0; ks < 8; ++ks) { const int bl = ks >> 1, b8 = (ks & 1) * 8;
          u32x4 w = {cvtpk(o[bl][b8 + 0] * rl, o[bl][b8 + 1] * rl), cvtpk(o[bl][b8 + 2] * rl, o[bl][b8 + 3] * rl), cvtpk(o[bl][b8 + 4] * rl, o[bl][b8 + 5] * rl), cvtpk(o[bl][b8 + 6] * rl, o[bl][b8 + 7] * rl)};
          pb[ks] = *reinterpret_cast<bf16x8*>(&w); }
      const bf16_t* wv = T.WV + ((size_t)(h * 128 + r32) * 128 + hi * 8);
      const size_t rowoff = (size_t)(rowbase + q0 + wid * 32 + r32) * 1024 + h * 128 + 4 * hi;
#pragma unroll
      for (int db = 0; db < 4; ++db) { f32x16 oa = f32x16{};
#pragma unroll
          for (int ks = 0; ks < 8; ++ks) { const bf16x8 bw = *reinterpret_cast<const bf16x8*>(wv + (size_t)db * 32 * 128 + ks * 16);
              oa = __builtin_amdgcn_mfma_f32_32x32x16_bf16(bw, pb[ks], oa, 0, 0, 0); }
#pragma unroll
          for (int g = 0; g < 4; ++g) { const size_t off = rowoff + db * 32 + 8 * g;
              const pg8::u32x2 ga = *reinterpret_cast<const pg8::u32x2*>(T.GA + off), ob = *reinterpret_cast<const pg8::u32x2*>(T.OB + off);
              const float v0 = oa[4 * g + 0] * __uint_as_float(ga.x << 16) + __uint_as_float(ob.x << 16), v1 = oa[4 * g + 1] * __uint_as_float(ga.x & 0xffff0000u) + __uint_as_float(ob.x & 0xffff0000u);
              const float v2 = oa[4 * g + 2] * __uint_as_float(ga.y << 16) + __uint_as_float(ob.y << 16), v3 = oa[4 * g + 3] * __uint_as_float(ga.y & 0xffff0000u) + __uint_as_float(ob.y & 0xffff0000u);
              pg8::u32x2 w; w.x = cvtpk(v0, v1); w.y = cvtpk(v2, v3); *reinterpret_cast<pg8::u32x2*>(T.MIX + off) = w; } } }
#else
    if (hi == 0) li_l[r32] = l_reg; asm volatile("s_waitcnt lgkmcnt(0)" ::: "memory");
    ATT_BAR_L();
    { char* stg = shm + LDS_K + wid * OST_WAVE;
#if MLA_OT
#pragma unroll
      for (int r = 0; r < 16; ++r) { const float rl = __builtin_amdgcn_rcpf(l_reg);
#pragma unroll
          for (int d0 = 0; d0 < 4; ++d0) *(bf16_t*)(stg + r32 * OST_PITCH + (d0 * 32 + crow(r, hi)) * 2) = f2bf(o[d0][r] * rl); }
#else
#pragma unroll
      for (int r = 0; r < 16; ++r) { const float rl = __builtin_amdgcn_rcpf(li_l[crow(r, hi)]);
#pragma unroll
          for (int d0 = 0; d0 < 4; ++d0) *(bf16_t*)(stg + crow(r, hi) * OST_PITCH + (d0 * 32 + r32) * 2) = f2bf(o[d0][r] * rl); }
#endif
      asm volatile("s_waitcnt lgkmcnt(0)" ::: "memory");
      bf16x8 af[8];
#pragma unroll
      for (int ks = 0; ks < 8; ++ks) af[ks] = *reinterpret_cast<const bf16x8*>(stg + r32 * OST_PITCH + ks * 32 + hi * 16);
      const bf16_t* wv = T.WV + ((size_t)(h * 128 + r32) * 128 + hi * 8);
#pragma unroll
      for (int d0 = 0; d0 < 4; ++d0) { o[d0] = f32x16{};
#pragma unroll
          for (int ks = 0; ks < 8; ++ks) { const bf16x8 bw = *reinterpret_cast<const bf16x8*>(wv + (size_t)d0 * 32 * 128 + ks * 16);
              o[d0] = __builtin_amdgcn_mfma_f32_32x32x16_bf16(af[ks], bw, o[d0], 0, 0, 0); } } }
    const long orow0 = rowbase + q0 + wid * 32;
#pragma unroll
    for (int r = 0; r < 16; ++r) { const long off = (orow0 + crow(r, hi)) * 1024 + h * 128 + r32;
#pragma unroll
        for (int d0 = 0; d0 < 4; ++d0) { const float v = o[d0][r] * bf2f(T.GA[off + d0 * 32]) + bf2f(T.OB[off + d0 * 32]); T.MIX[off + d0 * 32] = f2bf(v); } }
#endif
    asm volatile("s_waitcnt lgkmcnt(0)\n\ts_barrier" ::: "memory");
#undef MLA_DMA
#undef MLA_RESC
#undef ATT_BAR_L
#undef MLA_STEP
#undef MLA_PV_ISSUE
#undef MLA_PV_MMA
#undef MLA_PV_ONE
#undef MLA_V_BASE
}
}

namespace mla2 {
using mla::NTILE; using mla::KPITCH; using mla::KSLOT; using mla::THR; using mla::OST_PITCH; using mla::OST_WAVE;
constexpr int NSLOT = 3;
constexpr int LDS_K = 0, LDS_P = NSLOT * KSLOT  , LDS_X = LDS_P + 65536  , LDS_BYTES = LDS_X + 4096;
static_assert(8 * OST_WAVE <= NSLOT * KSLOT, "o_lat staging fits the ring");
using mla::Tensors;
__device__ __forceinline__ void softmax_block(f32x16& p0, f32x16& p1, float& m_reg, float& l_reg, float& alpha, bf16x8& pa0, bf16x8& pa1, bf16x8& pa2, bf16x8& pa3) {
    float pm0 = fmaxf(p0[0], p0[1]), pm1 = fmaxf(p0[2], p0[3]), pm2 = fmaxf(p1[0], p1[1]), pm3 = fmaxf(p1[2], p1[3]);
#pragma unroll
    for (int r = 4; r < 16; r += 4) { pm0 = fmaxf(fmaxf(pm0, p0[r]), p0[r + 1]); pm1 = fmaxf(fmaxf(pm1, p0[r + 2]), p0[r + 3]); pm2 = fmaxf(fmaxf(pm2, p1[r]), p1[r + 1]); pm3 = fmaxf(fmaxf(pm3, p1[r + 2]), p1[r + 3]); }
    const float pmax = half_max(fmaxf(fmaxf(pm0, pm1), fmaxf(pm2, pm3)));
    const bool keep = __all(pmax - m_reg <= THR);
    const float mn = keep ? m_reg : fmaxf(m_reg, pmax); alpha = __builtin_amdgcn_exp2f(m_reg - mn); m_reg = mn;
#pragma unroll
    for (int r = 0; r < 16; ++r) { p0[r] = __builtin_amdgcn_exp2f(p0[r] - mn); p1[r] = __builtin_amdgcn_exp2f(p1[r] - mn); }
    float s0 = p0[0] + p0[1], s1 = p0[2] + p0[3], s2 = p1[0] + p1[1], s3 = p1[2] + p1[3];
#pragma unroll
    for (int r = 4; r < 16; r += 4) { s0 += p0[r]; s0 += p0[r + 1]; s1 += p0[r + 2]; s1 += p0[r + 3]; s2 += p1[r]; s2 += p1[r + 1]; s3 += p1[r + 2]; s3 += p1[r + 3]; }
    l_reg = l_reg * alpha + half_sum((s0 + s1) + (s2 + s3));
    pack_p(p0, p1, pa0, pa1, pa2, pa3);
}
__device__ __forceinline__ void out_block(const char* stg, const Tensors& T, int h, long orow0, int r32, int hi) {
    bf16x8 af[8];
#pragma unroll
    for (int ks = 0; ks < 8; ++ks) af[ks] = *reinterpret_cast<const bf16x8*>(stg + r32 * OST_PITCH + ks * 32 + hi * 16);
    const bf16_t* wv = T.WV + ((size_t)(h * 128 + r32) * 128 + hi * 8);
    f32x16 oa[4];
#pragma unroll
    for (int d0 = 0; d0 < 4; ++d0) { oa[d0] = f32x16{};
#pragma unroll
        for (int ks = 0; ks < 8; ++ks) { const bf16x8 bw = *reinterpret_cast<const bf16x8*>(wv + (size_t)d0 * 32 * 128 + ks * 16);
            oa[d0] = __builtin_amdgcn_mfma_f32_32x32x16_bf16(af[ks], bw, oa[d0], 0, 0, 0); } }
#pragma unroll
    for (int r = 0; r < 16; ++r) { const long off = (orow0 + crow(r, hi)) * 1024 + h * 128 + r32;
#pragma unroll
        for (int d0 = 0; d0 < 4; ++d0) { const float v = oa[d0][r] * bf2f(T.GA[off + d0 * 32]) + bf2f(T.OB[off + d0 * 32]); T.MIX[off + d0 * 32] = f2bf(v); } }
}
__device__ __forceinline__ void unit(int b, int h, int qb, const Tensors& T, char* shm, const int wave_id) {
    const int lane = pg8::lane_id_fresh(), wid = wave_id, r32 = lane & 31, hi = lane >> 5;
    const bool is_qk = wid < 4; const int pair = wid & 3;
    const long rowbase = (long)b * SEQ; const int q0 = qb * 256;
    const unsigned lds0 = (unsigned)(uintptr_t)shm;
    char* Pp = shm + LDS_P + pair * 8192; char* Xp = shm + LDS_X + pair * 1024;
    float* alx = (float*)Xp; float* lx = (float*)(Xp + 512); unsigned* fx = (unsigned*)(Xp + 768);
#define M2_BAR() asm volatile("s_waitcnt vmcnt(0) lgkmcnt(0)\n\ts_barrier" ::: "memory")
    const char* klb = (const char*)(T.KL + rowbase * 192);
#define M2_PIECE(kb_, p_, dst_) do { const int s_ = 64 * (p_) + lane, row_ = (s_ * 1311) >> 15, pos_ = s_ - 25 * row_; \
        glds16s<0>(kb_, (unsigned)(row_ * 384 + (pos_ < 24 ? pos_ : 23) * 16), (unsigned)__builtin_amdgcn_readfirstlane(dst_ + (p_) * 1024)); } while (0)
#define M2_DMA(t) do { const unsigned sd_ = lds0 + LDS_K + ((t) % 3) * KSLOT; const char* kb_ = klb + (size_t)(t) * 24576; \
        _Pragma("unroll") for (int i_ = 0; i_ < 6; ++i_) M2_PIECE(kb_, pair + 4 * i_, sd_); if (pair == 0) M2_PIECE(kb_, 24, sd_); } while (0)
    const int vb0 = (int)(lds0 + LDS_K) + mla::v_rm_base(lane);
#define M2_BAR_L() asm volatile("s_waitcnt lgkmcnt(0)\n\ts_barrier" ::: "memory")
    if (is_qk) {
        bf16x8 qA[12], qB[12]; float mA = -1e30f, mB = -1e30f, lA = 0.f, lB = 0.f;
        { const bf16_t* Qw = T.QA + (rowbase + q0 + pair * 64 + r32) * 1536 + h * 192 + hi * 8;
#pragma unroll
          for (int d0 = 0; d0 < 12; ++d0) { qA[d0] = *reinterpret_cast<const bf16x8*>(Qw + d0 * 16); qB[d0] = *reinterpret_cast<const bf16x8*>(Qw + 32 * 1536 + d0 * 16); } }
        f32x16 pA0, pA1, pB0, pB1;
        char* pw = Pp + lane * 16;
#define M2_QK(P0, P1, Q, t) do { P0 = f32x16{}; P1 = f32x16{}; const char* kb_ = shm + LDS_K + ((t) % 3) * KSLOT + hi * 16 + r32 * KPITCH; \
        _Pragma("unroll") for (int d0 = 0; d0 < 12; ++d0) { const bf16x8 b0_ = *reinterpret_cast<const bf16x8*>(kb_ + d0 * 32), b1_ = *reinterpret_cast<const bf16x8*>(kb_ + d0 * 32 + 32 * KPITCH); \
            P0 = __builtin_amdgcn_mfma_f32_32x32x16_bf16(b0_, Q[d0], P0, 0, 0, 0); P1 = __builtin_amdgcn_mfma_f32_32x32x16_bf16(b1_, Q[d0], P1, 0, 0, 0); } } while (0)
#define M2_SM(P0, P1, M, L, BLK) do { bf16x8 a0_, a1_, a2_, a3_; float al_; softmax_block(P0, P1, M, L, al_, a0_, a1_, a2_, a3_); \
        *reinterpret_cast<bf16x8*>(pw + (BLK) * 4096) = a0_; *reinterpret_cast<bf16x8*>(pw + (BLK) * 4096 + 1024) = a1_; *reinterpret_cast<bf16x8*>(pw + (BLK) * 4096 + 2048) = a2_; *reinterpret_cast<bf16x8*>(pw + (BLK) * 4096 + 3072) = a3_; \
        const bool f_ = __any(al_ < 1.f); if (hi == 0) alx[(BLK) * 32 + r32] = al_; if (lane == 0) fx[BLK] = f_ ? 1u : 0u; } while (0)
        M2_BAR();
        M2_QK(pA0, pA1, qA, 0); M2_BAR_L();
        M2_QK(pB0, pB1, qB, 0); M2_SM(pA0, pA1, mA, lA, 0); M2_BAR_L();
        for (int t = 1; t < NTILE; ++t) {
            M2_QK(pA0, pA1, qA, t); M2_SM(pB0, pB1, mB, lB, 1); M2_BAR_L();
            M2_QK(pB0, pB1, qB, t); M2_SM(pA0, pA1, mA, lA, 0); M2_BAR_L();
        }
        M2_SM(pB0, pB1, mB, lB, 1); M2_BAR_L();
        M2_BAR_L();
        if (hi == 0) { lx[r32] = lA; lx[32 + r32] = lB; }
        M2_BAR();
        M2_BAR();
#undef M2_QK
#undef M2_SM
    } else {
        f32x16 oA[4] = {}, oB[4] = {};
        const char* pr = Pp + lane * 16;
#define M2_PVB(O, BLK, t1) do { const int vb_ = vb0 + ((t1) % 3) * KSLOT; \
        const bf16x8 a0_ = *reinterpret_cast<const bf16x8*>(pr + (BLK) * 4096), a1_ = *reinterpret_cast<const bf16x8*>(pr + (BLK) * 4096 + 1024), a2_ = *reinterpret_cast<const bf16x8*>(pr + (BLK) * 4096 + 2048), a3_ = *reinterpret_cast<const bf16x8*>(pr + (BLK) * 4096 + 3072); \
        if (fx[BLK] != 0u) { _Pragma("unroll") for (int d = 0; d < 4; ++d) _Pragma("unroll") for (int r = 0; r < 16; ++r) O[d][r] *= alx[(BLK) * 32 + crow(r, hi)]; } \
        mla::pvr_one<0>(O[0], vb_, a0_, a1_, a2_, a3_); mla::pvr_one<1>(O[1], vb_, a0_, a1_, a2_, a3_); mla::pvr_one<2>(O[2], vb_, a0_, a1_, a2_, a3_); mla::pvr_one<3>(O[3], vb_, a0_, a1_, a2_, a3_); } while (0)
        M2_DMA(0);
        M2_BAR();
        M2_DMA(1); M2_BAR_L();
        M2_BAR();
        for (int t = 1; t < NTILE; ++t) {
            if (t + 1 < NTILE) M2_DMA(t + 1);
            M2_PVB(oA, 0, t - 1); M2_BAR_L();
            M2_PVB(oB, 1, t - 1); M2_BAR();
        }
        M2_PVB(oA, 0, NTILE - 1); M2_BAR_L();
        M2_PVB(oB, 1, NTILE - 1); M2_BAR_L();
#undef M2_PVB
        M2_BAR();
        { char* stgA = shm + LDS_K + (2 * pair) * OST_WAVE; char* stgB = stgA + OST_WAVE;
#pragma unroll
          for (int r = 0; r < 16; ++r) { const float ra = __builtin_amdgcn_rcpf(lx[crow(r, hi)]), rb = __builtin_amdgcn_rcpf(lx[32 + crow(r, hi)]);
#pragma unroll
              for (int d0 = 0; d0 < 4; ++d0) { *(bf16_t*)(stgA + crow(r, hi) * OST_PITCH + (d0 * 32 + r32) * 2) = f2bf(oA[d0][r] * ra); *(bf16_t*)(stgB + crow(r, hi) * OST_PITCH + (d0 * 32 + r32) * 2) = f2bf(oB[d0][r] * rb); } } }
        M2_BAR();
    }
#undef M2_BAR_L
    { const char* stg = shm + LDS_K + (2 * pair + (is_qk ? 1 : 0)) * OST_WAVE;
      out_block(stg, T, h, rowbase + q0 + pair * 64 + (is_qk ? 32 : 0), r32, hi); }
    asm volatile("s_waitcnt lgkmcnt(0)\n\ts_barrier" ::: "memory");
#undef M2_BAR
#undef M2_PIECE
#undef M2_DMA
}
}

namespace swa {
constexpr int KP = 144  , KT = 64 * KP  ;
constexpr int LDS_K = 0;
struct Tensors { const bf16_t* QB; const bf16_t* KB; const bf16_t* VB; bf16_t* GOB; const float* BT2; const float* SINK2; };
__device__ __forceinline__ int vt_base64(int lane) { return ((lane & 3) << 3) | (((lane >> 2) & 3) << 6) | (((lane >> 4) & 1) << 5) | ((lane >> 5) << 10); }
template <int D0> __device__ __forceinline__ void pvt64(f32x16& od, int vb, bf16x8 pa0, bf16x8 pa1, bf16x8 pa2, bf16x8 pa3) {
    const s16x4 l0 = tr_read<D0 * 512 + 0 * 2048>(vb), h0 = tr_read<D0 * 512 + 0 * 2048 + 256>(vb), l1 = tr_read<D0 * 512 + 1 * 2048>(vb), h1 = tr_read<D0 * 512 + 1 * 2048 + 256>(vb);
    const s16x4 l2 = tr_read<D0 * 512 + 2 * 2048>(vb), h2 = tr_read<D0 * 512 + 2 * 2048 + 256>(vb), l3 = tr_read<D0 * 512 + 3 * 2048>(vb), h3 = tr_read<D0 * 512 + 3 * 2048 + 256>(vb);
    asm volatile("s_waitcnt lgkmcnt(0)" ::: "memory"); SBAR();
#define PK(L, H) (bf16x8){L[0], L[1], L[2], L[3], H[0], H[1], H[2], H[3]}
    od = __builtin_amdgcn_mfma_f32_32x32x16_bf16(PK(l0, h0), pa0, od, 0, 0, 0);
    od = __builtin_amdgcn_mfma_f32_32x32x16_bf16(PK(l1, h1), pa1, od, 0, 0, 0);
    od = __builtin_amdgcn_mfma_f32_32x32x16_bf16(PK(l2, h2), pa2, od, 0, 0, 0);
    od = __builtin_amdgcn_mfma_f32_32x32x16_bf16(PK(l3, h3), pa3, od, 0, 0, 0);
#undef PK
}
constexpr int NQB = 8, RING = 6;
constexpr int LDS_V = RING * KT, LDS_TAB = LDS_V + RING * 8192, LDS_BYTES = LDS_TAB + 4 * 384 * 4;
__device__ __forceinline__ void run(int b, int kvh, int j, const Tensors& T, char* shm, const int wave_id) {
    const int lane = pg8::lane_id_fresh(), wid = wave_id, tid = wid * 64 + lane, r32 = lane & 31, hi = lane >> 5;
    const int g = wid >> 1, rh = wid & 1, head = kvh * 4 + g;
    const long rowbase = (long)b * SEQ; const int qb0 = j * NQB;
    const unsigned lds0 = (unsigned)(uintptr_t)shm;
    unsigned vvoff, kvoff, kvoff8;
    { const int st = 2 * wid + (lane >> 5), kk = (st >> 1) * 8 + ((lane & 31) >> 2), k = swap23(kk), c = (st & 1) * 32 + (lane & 3) * 8;
      vvoff = (unsigned)((k * 256 + c) * 2);
      int s = 64 * wid + lane, row = s / 9, pos = s - 9 * row; kvoff = (unsigned)(row * 512 + (pos < 8 ? pos : 7) * 16); s = 512 + lane; row = s / 9; pos = s - 9 * row; kvoff8 = (unsigned)(row * 512 + (pos < 8 ? pos : 7) * 16); }
#define SWA_DMA(TT) do { const int s_ = (TT) % RING; const long kb_ = rowbase + 64 * (TT); \
        glds16s<0>((const char*)(T.KB + kb_ * 256 + kvh * 64), kvoff, (unsigned)__builtin_amdgcn_readfirstlane(lds0 + LDS_K + s_ * KT + wid * 1024)); \
        if (wid == 0) glds16s<0>((const char*)(T.KB + kb_ * 256 + kvh * 64), kvoff8, (unsigned)__builtin_amdgcn_readfirstlane(lds0 + LDS_K + s_ * KT + 8192)); \
        glds16s<0>((const char*)(T.VB + kb_ * 256 + kvh * 64), vvoff, (unsigned)__builtin_amdgcn_readfirstlane(lds0 + LDS_V + s_ * 8192 + wid * 1024)); } while (0)
    for (int TT = qb0 - 2; TT <= qb0 + 2; ++TT) if (TT >= 0 && TT < SEQ / 64) SWA_DMA(TT);
    { float* tab = (float*)(shm + LDS_TAB);
      for (int i = tid; i < 4 * 384; i += 512) { const int gg = i / 384, rel = i % 384 - 192;
          tab[i] = (rel >= -128 && rel <= 128) ? T.BT2[(kvh * 4 + gg) * 264 + rel + 128] : -1e30f; } }
    bf16x8 qr[4];
    const bf16_t* Qw = T.QB + (rowbase + qb0 * 64 + rh * 32 + r32) * 1024 + head * 64 + hi * 8;
#pragma unroll
    for (int d0 = 0; d0 < 4; ++d0) qr[d0] = *reinterpret_cast<const bf16x8*>(Qw + d0 * 16);
    const float sink = T.SINK2[head];
    const int vb0 = (int)(lds0 + LDS_V) + vt_base64(lane);
    const float* tabg = (const float*)(shm + LDS_TAB) + g * 384;
    ATT_WAIT_BAR(0);
    for (int i = 0; i < NQB; ++i) {
        const int qb = qb0 + i;
        if (i + 1 < NQB && qb + 3 < SEQ / 64) SWA_DMA(qb + 3);
        bf16x8 qn[4];
        if (i + 1 < NQB) {
#pragma unroll
            for (int d0 = 0; d0 < 4; ++d0) qn[d0] = *reinterpret_cast<const bf16x8*>(Qw + (size_t)(i + 1) * 64 * 1024 + d0 * 16); }
        else {
#pragma unroll
            for (int d0 = 0; d0 < 4; ++d0) qn[d0] = qr[d0]; }
        bf16_t* orow = T.GOB + (size_t)(rowbase + qb * 64 + rh * 32 + r32) * 1024 + head * 64 + 4 * hi;
        pg8::u32x2 gt[8];
#pragma unroll
        for (int x = 0; x < 8; ++x) gt[x] = *reinterpret_cast<const pg8::u32x2*>(orow + (x >> 2) * 32 + 8 * (x & 3));
        float m_reg = sink, l_reg = 1.0f; f32x16 o[2] = {};
        for (int t = 0; t < 5; ++t) {
            const int TT = qb - 2 + t;
            if (TT < 0 || TT >= SEQ / 64) continue;
            const int sl = TT % RING;
            f32x16 p0, p1; bf16x8 pa0, pa1, pa2, pa3;
            qkt<4, KP, 16>(p0, p1, shm + LDS_K + sl * KT, qr, r32, hi);
            const float* tb = tabg + (64 * t + 64 - 32 * rh - r32 + 4 * hi);
#pragma unroll
            for (int r = 0; r < 16; ++r) { p0[r] += tb[(r & 3) + 8 * (r >> 2)]; p1[r] += tb[32 + (r & 3) + 8 * (r >> 2)]; }
            float pmax = p0[0];
#pragma unroll
            for (int r = 1; r < 16; ++r) pmax = fmaxf(pmax, p0[r]);
#pragma unroll
            for (int r = 0; r < 16; ++r) pmax = fmaxf(pmax, p1[r]);
            pmax = half_max(pmax);
            const float mn = fmaxf(m_reg, pmax), alpha = __builtin_amdgcn_exp2f(m_reg - mn); m_reg = mn;
            float ps = 0.f;
#pragma unroll
            for (int r = 0; r < 16; ++r) { p0[r] = __builtin_amdgcn_exp2f(p0[r] - mn); p1[r] = __builtin_amdgcn_exp2f(p1[r] - mn); ps += p0[r] + p1[r]; }
            ps = half_sum(ps); l_reg = l_reg * alpha + ps;
#define SWA_PK(P, B) (u32x4){cvtpk(P[B], P[B + 1]), cvtpk(P[B + 2], P[B + 3]), cvtpk(P[B + 4], P[B + 5]), cvtpk(P[B + 6], P[B + 7])}
            { u32x4 w0 = SWA_PK(p0, 0), w1 = SWA_PK(p0, 8), w2 = SWA_PK(p1, 0), w3 = SWA_PK(p1, 8);
              pa0 = *reinterpret_cast<bf16x8*>(&w0); pa1 = *reinterpret_cast<bf16x8*>(&w1); pa2 = *reinterpret_cast<bf16x8*>(&w2); pa3 = *reinterpret_cast<bf16x8*>(&w3); }
#undef SWA_PK
            if (__any(alpha < 1.f)) {
#pragma unroll
                for (int d = 0; d < 2; ++d)
#pragma unroll
                    for (int r = 0; r < 16; ++r) o[d][r] *= alpha; }
            SBAR();
            pvt64<0>(o[0], vb0 + sl * 8192, pa0, pa1, pa2, pa3); pvt64<1>(o[1], vb0 + sl * 8192, pa0, pa1, pa2, pa3);
        }
        { const float rl = __builtin_amdgcn_rcpf(l_reg);
#pragma unroll
          for (int x = 0; x < 8; ++x) { const int d0 = x >> 2, gq = x & 3;
              const float v0 = o[d0][4 * gq + 0] * rl * __uint_as_float(gt[x].x << 16), v1 = o[d0][4 * gq + 1] * rl * __uint_as_float(gt[x].x & 0xffff0000u);
              const float v2 = o[d0][4 * gq + 2] * rl * __uint_as_float(gt[x].y << 16), v3 = o[d0][4 * gq + 3] * rl * __uint_as_float(gt[x].y & 0xffff0000u);
              pg8::u32x2 w; w.x = cvtpk(v0, v1); w.y = cvtpk(v2, v3); *reinterpret_cast<pg8::u32x2*>(orow + d0 * 32 + 8 * gq) = w; } }
#pragma unroll
        for (int d0 = 0; d0 < 4; ++d0) qr[d0] = qn[d0];
        ATT_WAIT_BAR(0);
    }
#undef SWA_DMA
}
}
#undef SBAR
#undef ATT_WAIT_BAR
}
constexpr int NWAVES = 8;
#ifndef MK_PER_PHASE
#define MK_PER_PHASE 0
#endif
constexpr int N_PHASES = 8;

constexpr size_t MiB = 1u << 20;
constexpr size_t WS_CTL = 0, CTL_ZERO_BYTES = 128 * 1024;
constexpr size_t WS_COS = 1 * MiB, WS_SIN = WS_COS + 512 * 1024;
constexpr size_t WS_BT2 = 2 * MiB, WS_SINK2 = WS_BT2 + 16 * 264 * 4;
constexpr size_t WS_SSQQ = 3 * MiB, WS_SSQKV = WS_SSQQ + 512 * 1024;
constexpr size_t WS_SSQ2 = 4 * MiB, WS_SSQ3 = 6 * MiB;
constexpr size_t WS_WIN = 8 * MiB, WS_WQB = 16 * MiB, WS_WVT = 17 * MiB, WS_WOUT = 18 * MiB, WS_WUP = 20 * MiB, WS_WDN = 31 * MiB;
constexpr size_t WS_A0 = 40 * MiB;
constexpr size_t WS_XN = WS_A0;
constexpr size_t WS_X1B = WS_A0;
constexpr size_t WS_QLAT = 104 * MiB, WS_KL = 120 * MiB  , WS_QB = 132 * MiB, WS_KB = 196 * MiB, WS_VB = 212 * MiB, WS_GA = 228 * MiB, WS_GB = 292 * MiB;
constexpr size_t WS_MIX = WS_QB;
constexpr size_t WS_HALO = 104 * MiB;
constexpr size_t WS_ACT = 296 * MiB;
constexpr size_t WS_END = 472 * MiB;
static_assert(WS_ACT + (size_t)MTOK * DFF * 2 <= WS_END && WS_HALO + (size_t)(MTOK / 64) * 4 * 5632 * 4 <= WS_ACT && WS_KL + (size_t)MTOK * 192 * 2 <= WS_QB, "d_ws map");
constexpr int CW_BAR = 4096;
static_assert((CW_BAR + 3456) * 4 <= 65536, "barrier words below the panel counters");
constexpr int CW_PANEL = 16384;

constexpr int RING_OFF = 0, RING_BYTES = 146432;
constexpr int LDSCTL_OFF = RING_BYTES, MISC_OFF = LDSCTL_OFF + 320;
constexpr int LDS_BYTES = 147456;
static_assert(att::mla::LDS_BYTES <= RING_BYTES && att::mla2::LDS_BYTES <= RING_BYTES && att::swa::LDS_BYTES <= RING_BYTES && pg8::STAGE_BYTES <= RING_BYTES && MISC_OFF + 64 <= LDS_BYTES, "LDS map");

#define GAS __attribute__((address_space(1)))
#define LAS __attribute__((address_space(3)))
typedef unsigned short bf16;
typedef unsigned v4u __attribute__((ext_vector_type(4)));
typedef float f32x4 __attribute__((ext_vector_type(4)));
typedef short bf16x8 __attribute__((ext_vector_type(8)));
typedef GAS unsigned gu32;
typedef GAS unsigned long long gu64;
#define RLX_AGENT __ATOMIC_RELAXED, __HIP_MEMORY_SCOPE_AGENT
#define LDS_WAIT() asm volatile("s_waitcnt lgkmcnt(0)" ::: "memory")
#define VM_WAIT() asm volatile("s_waitcnt vmcnt(0)" ::: "memory")
__device__ __forceinline__ unsigned long long rt() { return __builtin_amdgcn_s_memrealtime(); }
__device__ __forceinline__ unsigned f2bf(float f) { unsigned u = __builtin_bit_cast(unsigned, f); return (u + 0x7fffu + ((u >> 16) & 1u)) >> 16; }
__device__ __forceinline__ unsigned pk2(float lo, float hi) { return f2bf(lo) | (f2bf(hi) << 16); }

#define XB_TMO      128
#define XB_XCNT(j)  (256  + 64 * (j))
#define XB_XSUB(j)  (1280 + 64 * (j))
#define XB_XGEN(j)  (2304 + 64 * (j))
#define XB_TOP      3328
#define XB_TOPGEN   3392
#define XCD_BAR_WORDS 3456
#define XB_SPIN_CAP (1u << 18)

__device__ __forceinline__ unsigned xb_ld(unsigned* p)              { return __hip_atomic_load(p, __ATOMIC_RELAXED, __HIP_MEMORY_SCOPE_AGENT); }
__device__ __forceinline__ unsigned xb_add(unsigned* p, unsigned v) { return __hip_atomic_fetch_add(p, v, __ATOMIC_RELAXED, __HIP_MEMORY_SCOPE_AGENT); }
__device__ __forceinline__ unsigned xb_xcc_id() { return (unsigned)__builtin_amdgcn_s_getreg((3 << 11) | 20) & 0xFu; }
#define XB_SPIN(cond, bar) do { unsigned _sp = 0; while (cond) { __builtin_amdgcn_s_sleep(1); \
    if ((++_sp & 255u) == 0u) { if (xb_ld(&(bar)[XB_TMO])) break; if (_sp > XB_SPIN_CAP) { atomicAdd(&(bar)[XB_TMO], 1u); break; } } } } while (0)

struct XcdBarrier {
    unsigned* bar; unsigned x; int w;
    volatile LAS unsigned* st;
};

__device__ __forceinline__ XcdBarrier xcd_barrier_post(unsigned* bar, volatile LAS unsigned* st) {
    XcdBarrier b; b.bar = bar; b.x = xb_xcc_id(); b.st = st;
    if (threadIdx.x == 0) (void)xb_add(&bar[XB_XCNT(b.x)], 1u);
    return b;
}
__device__ __forceinline__ void xcd_barrier_complete(unsigned* bar, unsigned x, unsigned& nloc, unsigned& nx) {
    const unsigned G = gridDim.x * gridDim.y * gridDim.z;
    unsigned sum, cnt, mine, sp = 0u;
    for (;;) {
        sum = 0u; cnt = 0u; mine = 0u;
#pragma unroll
        for (unsigned j = 0; j < 16; ++j) { const unsigned c = xb_ld(&bar[XB_XCNT(j)]); sum += c; cnt += (c > 0u) ? 1u : 0u; mine = (j == x) ? c : mine; }
        if (sum == G) break;
        __builtin_amdgcn_s_sleep(1);
        if ((++sp & 255u) == 0u) { if (xb_ld(&bar[XB_TMO])) break; if (sp > XB_SPIN_CAP) { atomicAdd(&bar[XB_TMO], 1u); break; } }
    }
    nloc = mine > 0u ? mine : 1u; nx = cnt > 0u ? cnt : 1u;
}

__device__ __forceinline__ void xcd_barrier(const XcdBarrier& b) {
    asm volatile("s_waitcnt vmcnt(0)" ::: "memory");
    __syncthreads();
    if (b.w == 0 && pg8::lane_id_fresh() == 0) {
        unsigned* bar = b.bar;
        __builtin_amdgcn_s_waitcnt(0);
        unsigned nloc = b.st[0], nx = b.st[1];
        if (nloc == 0u) { xcd_barrier_complete(bar, b.x, nloc, nx); b.st[0] = nloc; b.st[1] = nx; }
        const unsigned old = xb_add(&bar[XB_XSUB(b.x)], 1u);
        const unsigned gen = old / nloc;
        if (old + 1u == (gen + 1u) * nloc) {
            __builtin_amdgcn_fence(__ATOMIC_RELEASE, "agent");
            asm volatile("s_waitcnt vmcnt(0)" ::: "memory");
            const unsigned og = xb_add(&bar[XB_TOP], 1u);
            const unsigned tg = og / nx;
            if (og + 1u == (tg + 1u) * nx) xb_add(&bar[XB_TOPGEN], 1u);
            else XB_SPIN(xb_ld(&bar[XB_TOPGEN]) == tg, bar);
            __builtin_amdgcn_fence(__ATOMIC_ACQUIRE, "agent");
            xb_add(&bar[XB_XGEN(b.x)], 1u);
            asm volatile("s_waitcnt vmcnt(0)" ::: "memory");
        } else {
            XB_SPIN(xb_ld(&bar[XB_XGEN(b.x)]) == gen, bar);
            __builtin_amdgcn_fence(__ATOMIC_ACQUIRE, "agent");
            asm volatile("s_waitcnt vmcnt(0)" ::: "memory");
        }
    }
    __syncthreads();
}

struct Frame {
    LAS unsigned char* lds; volatile LAS unsigned* MISC; gu32* ctl;
    int wave, vcu, G;
};
__device__ __forceinline__ float wave_sum(float v) {
#pragma unroll
    for (int o = 1; o < 64; o <<= 1) v += __shfl_xor(v, o);
    return v;
}
template <class RowMap>
__device__ __forceinline__ void p0_transpose_item(const float* W, int K, int N, bf16* WT, const float* kscale, const RowMap& rm, LAS float* scr, int item, int lane) {
    const int nblk = N / 32, kb = item / nblk, nb = item % nblk, k0 = 64 * kb, n0 = 32 * nb;
#pragma unroll 8
    for (int i = 0; i < 32; ++i) { const int kk = 2 * i + (lane >> 5); const float sc = kscale ? kscale[k0 + kk] : 1.0f; scr[kk * 33 + (lane & 31)] = W[(size_t)(k0 + kk) * N + n0 + (lane & 31)] * sc; }
    LDS_WAIT(); asm volatile("" ::: "memory");
    const int c = lane & 7;
#pragma unroll
    for (int j = 0; j < 4; ++j) { const int n = (lane >> 3) + 8 * j; const LAS float* s = scr + (8 * c) * 33 + n;
        v4u o; o.x = pk2(s[0 * 33], s[1 * 33]); o.y = pk2(s[2 * 33], s[3 * 33]); o.z = pk2(s[4 * 33], s[5 * 33]); o.w = pk2(s[6 * 33], s[7 * 33]);
        const int rr = rm(n0 + n); if (rr >= 0) *(GAS v4u*)(WT + (size_t)rr * K + k0 + 8 * c) = o; }
    LDS_WAIT(); asm volatile("" ::: "memory");
}
struct MapIdent { __device__ __forceinline__ int operator()(int n) const { return n; } };
struct MapWin { __device__ __forceinline__ int operator()(int n) const {
    if (n < 256) return n; if (n >= 448) return n + 64; const int j = n - 256; if (j < 128) return 256 + j; const int d = j - 128; return 384 + (d < 32 ? 2 * d : 2 * (d - 32) + 1); } };
struct MapWqb { __device__ __forceinline__ int operator()(int n) const {
    const int h = n / 192, d = n % 192; if (d < 128) return -1  ; const int r = d - 128; return 1024 + h * 64 + (r < 32 ? 2 * r : 2 * (r - 32) + 1); } };
struct MapWup { __device__ __forceinline__ int operator()(int n) const {
    const int v = n >= DFF, c = v ? n - DFF : n; return 256 * (c >> 7) + 128 * v + (c & 127); } };

__device__ __forceinline__ int t5_bucket(int rel) {
    const int n = rel < 0 ? -rel : rel; int bk;
    if (n < 8) bk = n; else { const int e = (31 - __builtin_clz((unsigned)(n * n))) - 6; bk = 8 + e; if (bk > 15) bk = 15; }
    return (rel > 0 ? 16 : 0) + bk;
}
#ifndef MLA_SPLIT
#define MLA_SPLIT 0
#endif
struct Args {
    const float* x; const int* positions; const float* norm1_g; const float* w_in; const float* q_a_norm_g; const float* w_q_b; const float* kv_a_norm_g; const float* w_kv_b;
    const float* rel_bias; const float* sinks; const float* w_out; const float* norm2_g; const float* w_up; const float* conv_w; const float* conv_b; const float* w_down; const float* final_norm_g;
    float* out; unsigned char* ws; int ph_lo, ph_hi;
};

__device__ __forceinline__ void p0_prologue(Frame& F, const Args& a) {
    unsigned char* ws = a.ws;
    LAS float* scr = (LAS float*)(F.lds + RING_OFF + F.wave * 16384);
    const int lane = pg8::lane_id_fresh();
    const int gw = F.vcu * NWAVES + F.wave, NGW = F.G * NWAVES;
    constexpr int I_IN = (1024 / 64) * (4032 / 32), I_QB = (256 / 64) * (1536 / 32), I_OUT = (1024 / 64) * (1024 / 32), I_UP = (1024 / 64) * (5632 / 32), I_DN = (DFF / 64) * (1024 / 32);
    constexpr int NITEMS = I_IN + I_QB + I_OUT + I_UP + I_DN;
#ifndef P0DUP
#define P0DUP 0
#endif
    for (int rp_ = 0; rp_ <= (P0DUP & 1); ++rp_)
    for (int it = gw; it < NITEMS; it += NGW) {
        int r = it;
        if (r < I_IN) { p0_transpose_item(a.w_in, 1024, 4032, (bf16*)(ws + WS_WIN), nullptr, MapWin(), scr, r, lane); continue; } r -= I_IN;
        if (r < I_QB) { p0_transpose_item(a.w_q_b, 256, 1536, (bf16*)(ws + WS_WQB), a.q_a_norm_g, MapWqb(), scr, r, lane); continue; } r -= I_QB;
        if (r < I_OUT) { p0_transpose_item(a.w_out, 1024, 1024, (bf16*)(ws + WS_WOUT), nullptr, MapIdent(), scr, r, lane); continue; } r -= I_OUT;
        if (r < I_UP) { p0_transpose_item(a.w_up, 1024, 5632, (bf16*)(ws + WS_WUP), a.norm2_g, MapWup(), scr, r, lane); continue; } r -= I_UP;
        p0_transpose_item(a.w_down, DFF, 1024, (bf16*)(ws + WS_WDN), nullptr, MapIdent(), scr, r, lane);
    }
    const int gt = gw * 64 + lane, NGT = NGW * 64;
    for (int rp_ = 0; rp_ <= ((P0DUP >> 2) & 1); ++rp_)
    for (int i = gt; i < 1024 * 256; i += NGT) { const int row = i >> 8, j = i & 255, hh = row >> 7, c = row & 127;
        const f32x4* qp = (const f32x4*)(a.w_q_b + (size_t)j * 1536 + hh * 192); const f32x4* kp = (const f32x4*)(a.w_kv_b + (size_t)c * 2048 + hh * 256);
        float s0 = 0.f, s1 = 0.f;
#pragma unroll 8
        for (int d4 = 0; d4 < 32; ++d4) { const f32x4 x = qp[d4], y = kp[d4]; s0 += x[0] * y[0] + x[1] * y[1]; s1 += x[2] * y[2] + x[3] * y[3]; }
        ((bf16*)(ws + WS_WQB))[i] = (bf16)f2bf((s0 + s1) * a.q_a_norm_g[j] * a.kv_a_norm_g[c]); }
    for (int i = gt; i < 8 * 128 * 128; i += NGT) { const int hh = i >> 14, dd = (i >> 7) & 127, cp = i & 127, c = MLA_OT ? ((cp & ~0xC) | ((cp & 4) << 1) | ((cp & 8) >> 1)) : cp;
        ((bf16*)(ws + WS_WVT))[i] = (bf16)f2bf(a.w_kv_b[(size_t)c * 2048 + hh * 256 + 128 + dd] * a.kv_a_norm_g[c]); }
    for (int i = gt; i < 64 * 1024 / 8; i += NGT) *(GAS v4u*)((bf16*)(ws + WS_WIN) + (size_t)448 * 1024 + (size_t)i * 8) = (v4u){0u, 0u, 0u, 0u};
    for (int rp_ = 0; rp_ <= ((P0DUP >> 3) & 1); ++rp_)
    for (int i = gt; i < SEQ * 32; i += NGT) { const int s = i >> 5, d = i & 31;
        const float invf = __builtin_amdgcn_exp2f(-(float)d * (13.287712379549449f / 32.0f));
        const float ang = (float)a.positions[s] * invf;
        const double rev = (double)ang * 0.15915494309189535; const float fr = (float)(rev - __builtin_rint(rev));
        ((float*)(ws + WS_COS))[i] = __builtin_amdgcn_cosf(fr); ((float*)(ws + WS_SIN))[i] = __builtin_amdgcn_sinf(fr); }
    for (int i = gt; i < 16 * 264; i += NGT) { const int h = i / 264, j = i % 264; float v = 0.f; if (j <= 256) v = a.rel_bias[t5_bucket(j - 128) * 16 + h] * LOG2E; ((float*)(ws + WS_BT2))[i] = v; }
    if (gt < 16) ((float*)(ws + WS_SINK2))[gt] = a.sinks[gt] * LOG2E;
    for (int rp_ = 0; rp_ <= ((P0DUP >> 1) & 1); ++rp_)
    for (int m = gw; m < MTOK; m += NGW) {
        const GAS f32x4* xr = (const GAS f32x4*)(a.x + (size_t)m * DM) + lane; const GAS f32x4* gr = (const GAS f32x4*)a.norm1_g + lane;
        f32x4 v[4]; float s = 0.f;
#pragma unroll
        for (int j = 0; j < 4; ++j) { v[j] = xr[64 * j]; s += (v[j].x * v[j].x + v[j].y * v[j].y) + (v[j].z * v[j].z + v[j].w * v[j].w); }
        const float rs = 1.0f / sqrtf(wave_sum(s) * (1.0f / DM) + RMS_EPS);
        GAS unsigned long long* o8 = (GAS unsigned long long*)((bf16*)(ws + WS_XN) + (size_t)m * DM) + lane;
#pragma unroll
        for (int j = 0; j < 4; ++j) { const f32x4 g = gr[64 * j]; o8[64 * j] = (unsigned long long)pk2(v[j].x * rs * g.x, v[j].y * rs * g.y) | ((unsigned long long)pk2(v[j].z * rs * g.z, v[j].w * rs * g.w) << 32); }
    }
}

__device__ __forceinline__ void p6_fixup(Frame& F, const Args& a) {
    const int lane = pg8::lane_id_fresh();
    const int gw = F.vcu * NWAVES + F.wave, NGW = F.G * NWAVES;
    const float* halo = (const float*)(a.ws + WS_HALO); bf16* ACT = (bf16*)(a.ws + WS_ACT);
    constexpr int NBLK = MTOK / 64, HROW = 2 * DFF, HBLK = 4 * HROW;
    for (int it = gw; it < NBLK * 2 * 11; it += NGW) {
        const int cg = it % 11, which = (it / 11) & 1, blk = it / 22;
        const int c = cg * 256 + lane * 4, cu = 256 * (c >> 7) + (c & 127);
        const int r = 64 * blk + (which ? 63 : 0);
        const float* hp = halo + (size_t)blk * HBLK + (2 + which) * HROW + cu;
        f32x4 G = *(const f32x4*)hp, V = *(const f32x4*)(hp + 128);
        const bool has = which ? (((r + 1) & (SEQ - 1)) != 0) : ((r & (SEQ - 1)) != 0);
        if (has) { const float* np = halo + (size_t)(which ? blk + 1 : blk - 1) * HBLK + (which ? 0 : 1) * HROW + cu;
            const f32x4 rg = *(const f32x4*)np, rv = *(const f32x4*)(np + 128);
            const f32x4 wg = *(const f32x4*)(a.conv_w + (which ? 4 : 0) * DFF + c), wv = *(const f32x4*)(a.conv_w + (which ? 5 : 1) * DFF + c);
            G = G + wg * rg; V = V + wv * rv; }
        f32x4 o;
#pragma unroll
        for (int e = 0; e < 4; ++e) o[e] = G[e] * pg8::fast_sigmoid(G[e]) * V[e];
        pg8::st4((pg8::bf16_t*)(ACT + (size_t)r * DFF + c), o);
    }
}

__device__ __forceinline__ void p8_final_norm(Frame& F, const Args& a) {
    const int gw = F.vcu * NWAVES + F.wave, NGW = F.G * NWAVES;
    const int lane = pg8::lane_id_fresh();
    const float* ssq = (const float*)(a.ws + WS_SSQ3);
    for (int m = gw; m < MTOK; m += NGW) {
        const f32x4* sp = (const f32x4*)(ssq + (size_t)m * 16); const f32x4 t = (sp[0] + sp[1]) + (sp[2] + sp[3]);
        const float rs = 1.0f / sqrtf(((t[0] + t[1]) + (t[2] + t[3])) * (1.0f / DM) + RMS_EPS);
        GAS f32x4* xr = (GAS f32x4*)(a.out + (size_t)m * DM) + lane; const GAS f32x4* gr = (const GAS f32x4*)a.final_norm_g + lane;
#pragma unroll
        for (int j = 0; j < 4; ++j) { const f32x4 v = xr[64 * j], g = gr[64 * j]; xr[64 * j] = v * rs * g; }
    }
}

__global__ void __launch_bounds__(NWAVES * 64, 2) enc_fwd(Args args) {
    extern __shared__ __attribute__((aligned(16))) unsigned char lds[];
    Frame F;
    F.lds = (LAS unsigned char*)lds; F.MISC = (volatile LAS unsigned*)(F.lds + MISC_OFF);
    F.wave = __builtin_amdgcn_readfirstlane(threadIdx.x >> 6);
    F.G = gridDim.x; { const int bx = blockIdx.x; F.vcu = (F.G % 8 == 0) ? (bx % 8) * (F.G / 8) + bx / 8 : bx; }
    unsigned char* ws = args.ws;
    F.ctl = (gu32*)(ws + WS_CTL);
    for (int u = threadIdx.x; u < (LDS_BYTES - LDSCTL_OFF) / 4; u += NWAVES * 64) ((LAS unsigned*)(F.lds + LDSCTL_OFF))[u] = 0u;
    __syncthreads();
    XcdBarrier bar; bar.bar = (unsigned*)(F.ctl + CW_BAR); bar.x = 0; bar.st = nullptr;
    if (!MK_PER_PHASE) bar = xcd_barrier_post((unsigned*)(F.ctl + CW_BAR), F.MISC + 8);
    bar.w = F.wave;
    const int lo = args.ph_lo, hi = args.ph_hi;
#ifndef PHMASK
#define PHMASK 0xff
#endif
#define IN(k) (((PHMASK >> (k)) & 1) && lo <= (k) && (k) < hi)
#ifndef DUPMASK
#define DUPMASK 0
#endif
#define REP(k) for (int rep_ = 0; rep_ <= ((DUPMASK >> (k)) & 1); ++rep_)
#define SEAM(k) do { if (IN(k) && IN((k) + 1)) xcd_barrier(bar); } while (0)
    bf16* const WIN = (bf16*)(ws + WS_WIN); bf16* const WQB = (bf16*)(ws + WS_WQB); bf16* const WOUT = (bf16*)(ws + WS_WOUT);
    bf16* const WUP = (bf16*)(ws + WS_WUP); bf16* const WDN = (bf16*)(ws + WS_WDN);
    const float* const COS = (const float*)(ws + WS_COS); const float* const SIN = (const float*)(ws + WS_SIN);
    bf16* const QA = (bf16*)args.out;

#ifdef TP_PHASE
    unsigned long long tp_r0 = 0, tp_r1 = 0, tp_c0 = 0, tp_c1 = 0;
#ifndef TP_END
#define TP_END (TP_PHASE + 1)
#endif
#define TP_MARK(k) do { if ((k) == TP_PHASE) { tp_r0 = __builtin_amdgcn_s_memrealtime(); tp_c0 = __builtin_amdgcn_s_memtime(); } if ((k) == TP_END) { tp_r1 = __builtin_amdgcn_s_memrealtime(); tp_c1 = __builtin_amdgcn_s_memtime(); } } while (0)
#else
#define TP_MARK(k)
#endif
    TP_MARK(0);
    if (IN(0)) REP(0) { p0_prologue(F, args); } SEAM(0);
    TP_MARK(1);

    if (IN(1)) REP(1) {
        pg8::Gemm g{(bf16*)(ws + WS_XN), WIN, MTOK, 4096, 1024}; pg8::StaticOrder S; S.init(MTOK, 4096, F.G, (int)blockIdx.x);
        pg8::EpiInProj E{(bf16*)(ws + WS_QLAT), (bf16*)(ws + WS_KL), (bf16*)(ws + WS_QB), (bf16*)(ws + WS_KB), (bf16*)(ws + WS_VB), (bf16*)(ws + WS_GA), (bf16*)(ws + WS_GB),
                         (float*)(ws + WS_SSQQ), (float*)(ws + WS_SSQKV), COS, SIN};
        pg8::gemm_phase<pg8::EpiInProj, pg8::StaticOrder, PG8_ALIGN, PG8_SP2>(F.lds + RING_OFF, g, S, E, F.wave);
    } SEAM(1);

    TP_MARK(2);
    if (IN(2)) REP(2) {
#ifndef P2SUB
#define P2SUB 7
#endif
#ifndef P2DUPG
#define P2DUPG 0
#endif
        for (int rg_ = 0; rg_ <= P2DUPG; ++rg_) {
        if (P2SUB & 1) { pg8::Gemm g{(bf16*)(ws + WS_QLAT), WQB, MTOK, 1536, 256}; pg8::StaticOrder S; S.init(MTOK, 1536, F.G, (int)blockIdx.x);
          pg8::EpiQProj E{QA, (const float*)(ws + WS_SSQQ), COS, SIN};
          pg8::gemm_phase<pg8::EpiQProj, pg8::StaticOrder, PG8_ALIGN, PG8_SP2>(F.lds + RING_OFF, g, S, E, F.wave); }
        }
        if (P2SUB & 4) { const att::swa::Tensors T{(const bf16*)(ws + WS_QB), (const bf16*)(ws + WS_KB), (const bf16*)(ws + WS_VB), (bf16*)(ws + WS_GB), (const float*)(ws + WS_BT2), (const float*)(ws + WS_SINK2)};
          for (int u = F.vcu; u < NBATCH * 4 * (SEQ / 64 / att::swa::NQB); u += F.G) { const int j = u % (SEQ / 64 / att::swa::NQB), bk = u / (SEQ / 64 / att::swa::NQB); att::swa::run(bk >> 2, bk & 3, j, T, (char*)lds + RING_OFF, F.wave); } }
    } SEAM(2);

    TP_MARK(3);
    if (IN(3)) REP(3) {
        const att::mla::Tensors T{QA, (const bf16*)(ws + WS_KL), (const bf16*)(ws + WS_WVT), (const bf16*)(ws + WS_GA), (const bf16*)(ws + WS_GB), (bf16*)(ws + WS_MIX)};
        for (int u = F.vcu; u < NBATCH * 8 * (SEQ / 256); u += F.G) { const int qb = u & 15, bh = u >> 4;
#if MLA_SPLIT
            att::mla2::unit(bh >> 3, bh & 7, qb, T, (char*)lds + RING_OFF, F.wave);
#else
            att::mla::unit(bh >> 3, bh & 7, qb, T, (char*)lds + RING_OFF, F.wave);
#endif
        }
    } SEAM(3);

    TP_MARK(4);
    if (IN(4)) REP(4) {
        pg8::Gemm g{(bf16*)(ws + WS_MIX), WOUT, MTOK, 1024, 1024}; pg8::StaticOrder S; S.init(MTOK, 1024, F.G, (int)blockIdx.x);
        pg8::EpiResidual E{args.x, nullptr, (bf16*)(ws + WS_X1B), (float*)(ws + WS_SSQ2)};
        pg8::gemm_phase<pg8::EpiResidual, pg8::StaticOrder, PG8_ALIGN, PG8_SP2>(F.lds + RING_OFF, g, S, E, F.wave);
    } SEAM(4);

    TP_MARK(5);
    if (IN(5)) REP(5) {
        pg8::Gemm g{(bf16*)(ws + WS_X1B), WUP, MTOK, 2 * DFF, 1024}; pg8::StaticOrder S; S.init(MTOK, 2 * DFF, F.G, (int)blockIdx.x);
        pg8::EpiUpConv E{(bf16*)(ws + WS_ACT), (float*)(ws + WS_HALO), (const float*)(ws + WS_SSQ2), args.conv_w, args.conv_b};
        pg8::gemm_phase<pg8::EpiUpConv, pg8::StaticOrder, PG8_ALIGN, PG8_SP2>(F.lds + RING_OFF, g, S, E, F.wave);
    } SEAM(5);
    TP_MARK(6);
    if (IN(6)) REP(6) { p6_fixup(F, args); } SEAM(6);

    TP_MARK(7);
    if (IN(7)) REP(7) {
        pg8::Gemm g{(bf16*)(ws + WS_ACT), WDN, MTOK, 1024, DFF}; pg8::StaticOrder S; S.init(MTOK, 1024, F.G, (int)blockIdx.x);
        pg8::EpiFinal E{(const bf16*)(ws + WS_X1B), args.out, (float*)(ws + WS_SSQ3), (unsigned*)(F.ctl + CW_PANEL), args.final_norm_g};
        pg8::gemm_phase<pg8::EpiFinal, pg8::StaticOrder, PG8_ALIGN, PG8_SP2>(F.lds + RING_OFF, g, S, E, F.wave);
    }
#ifdef TP_PHASE
    TP_MARK(8);
#ifndef TP_CLK
#define TP_CLK 0
#endif
#ifndef TP_GAIN
#define TP_GAIN 4
#endif
    if (blockIdx.x == 0 && F.wave == 0) {
        const unsigned long long dr = tp_r1 - tp_r0, dc = tp_c1 - tp_c0;
        const unsigned long long ticks = (TP_CLK ? dc * 100ull / dr : dr) * (unsigned long long)TP_GAIN;
        const unsigned long long t0 = __builtin_amdgcn_s_memrealtime();
        while (__builtin_amdgcn_s_memrealtime() - t0 < ticks) __builtin_amdgcn_s_sleep(8); }
#endif
#undef IN
#undef SEAM
}

extern "C" void kernel_launch(void* const* d_in, const int* in_sizes, int n_in, void* d_out, int out_size, void* d_ws, size_t ws_size, hipStream_t stream) {
    static int grid = 0;
    if (grid == 0) {
        if (n_in != 17 || in_sizes[0] != MTOK * DM || out_size != MTOK * DM || ws_size < WS_END) { fprintf(stderr, "kernel_launch: unexpected shapes (n_in %d, in0 %d, out %d, ws %zu; need ws >= %zu); nothing launched\n", n_in, n_in > 0 ? in_sizes[0] : -1, out_size, ws_size, (size_t)WS_END); grid = -1; return; }
        int dev = 0, cus = 0, per_cu = 0;
        if (hipGetDevice(&dev) != hipSuccess || hipDeviceGetAttribute(&cus, hipDeviceAttributeMultiprocessorCount, dev) != hipSuccess) { fprintf(stderr, "kernel_launch: device query failed\n"); grid = -1; return; }
        if (hipFuncSetAttribute((const void*)enc_fwd, hipFuncAttributeMaxDynamicSharedMemorySize, LDS_BYTES) != hipSuccess) { fprintf(stderr, "kernel_launch: hipFuncSetAttribute failed\n"); grid = -1; return; }
        if (hipOccupancyMaxActiveBlocksPerMultiprocessor(&per_cu, (const void*)enc_fwd, NWAVES * 64, LDS_BYTES) != hipSuccess || per_cu < 1) { fprintf(stderr, "kernel_launch: occupancy query reports %d workgroups per CU\n", per_cu); }
        (void)hipGetLastError();
        grid = cus;
    }
    if (grid < 0) return;
    if (hipMemsetAsync((char*)d_ws + WS_CTL, 0, CTL_ZERO_BYTES, stream) != hipSuccess) { fprintf(stderr, "kernel_launch: hipMemsetAsync failed\n"); return; }
    Args a{};
    a.x = (const float*)d_in[0]; a.positions = (const int*)d_in[1]; a.norm1_g = (const float*)d_in[2]; a.w_in = (const float*)d_in[3]; a.q_a_norm_g = (const float*)d_in[4]; a.w_q_b = (const float*)d_in[5];
    a.kv_a_norm_g = (const float*)d_in[6]; a.w_kv_b = (const float*)d_in[7]; a.rel_bias = (const float*)d_in[8]; a.sinks = (const float*)d_in[9]; a.w_out = (const float*)d_in[10]; a.norm2_g = (const float*)d_in[11];
    a.w_up = (const float*)d_in[12]; a.conv_w = (const float*)d_in[13]; a.conv_b = (const float*)d_in[14]; a.w_down = (const float*)d_in[15]; a.final_norm_g = (const float*)d_in[16];
    a.out = (float*)d_out; a.ws = (unsigned char*)d_ws;
#if MK_PER_PHASE
    for (int p = 0; p < N_PHASES; ++p) { a.ph_lo = p; a.ph_hi = p + 1; hipLaunchKernelGGL(enc_fwd, dim3(grid), dim3(NWAVES * 64), LDS_BYTES, stream, a); }
#else
    a.ph_lo = 0; a.ph_hi = N_PHASES; hipLaunchKernelGGL(enc_fwd, dim3(grid), dim3(NWAVES * 64), LDS_BYTES, stream, a);
#endif
    const hipError_t le = hipPeekAtLastError();
    if (le != hipSuccess) fprintf(stderr, "kernel_launch: launch failed: %s (grid %d)\n", hipGetErrorName(le), grid);
}
```

```cpp
#include <hip/hip_runtime.h>
#include <cstdio>
#include <cstdint>
namespace pg8 {
#define PG8_LAS __attribute__((address_space(3)))
typedef unsigned short bf16_t;
typedef short bf16x8 __attribute__((ext_vector_type(8)));
typedef float f32x4 __attribute__((ext_vector_type(4)));
typedef unsigned u32x4 __attribute__((ext_vector_type(4)));
constexpr int BM = 256, BK = 64, HALF = 128, HTB = HALF * BK * 2  , STAGE_BYTES = 8 * HTB, NXCD = 8, WGM = 8;

__host__ __device__ __forceinline__ int lds_byte(int r, int c) { const int st = (r >> 4) * 2 + (c >> 5), rr = r & 15, cc = c & 31, ob = rr * 64 + cc * 2; return st * 1024 + (ob ^ (((ob >> 9) & 1) << 5)); }
__host__ __device__ __forceinline__ void stage_rc(int b, int& R, int& C) { const int st = b / 1024, sb = b % 1024, swz = sb ^ (((sb >> 9) & 1) << 5); R = (st >> 1) * 16 + swz / 64; C = (st & 1) * 32 + (swz % 64) / 2; }
__host__ __device__ __forceinline__ int perm32(int rho) { const int n = rho >> 4, i = rho & 15; return 8 * (i >> 2) + 4 * n + (i & 3); }

struct Unit { int pm, pn; };
struct Gemm { const bf16_t* A; const bf16_t* Bt; int M, N, K; };

struct StaticOrder {
    int nM, nN, nwg, G, c;
    __host__ __device__ void init(int M, int N, int G_, int c_) { nM = M / BM; nN = N / BM; nwg = nM * nN; G = G_; c = c_; }
    __host__ __device__ bool next(int i, Unit& u) const {
        const long L = (long)i * G + c; if (L >= nwg) return false;
        int wgid = (int)L; { const int q = nwg / NXCD, r = nwg % NXCD, xcd = wgid % NXCD, off = wgid / NXCD; wgid = (xcd < r ? xcd * (q + 1) : r * (q + 1) + (xcd - r) * q) + off; }
        const int nig = WGM * nN, gid = wgid / nig, fm = gid * WGM, gsz = (nM - fm) < WGM ? (nM - fm) : WGM;
        u.pm = fm + ((wgid % nig) % gsz); u.pn = (wgid % nig) / gsz; return true;
    }
    __device__ __forceinline__ void a_ready(const Unit&) const {}
    __device__ __forceinline__ void done(const Unit&) const {}
};

__device__ __forceinline__ unsigned cvt_pk_bf16(float lo, float hi) { unsigned r; asm volatile("v_cvt_pk_bf16_f32 %0, %1, %2" : "=v"(r) : "v"(lo), "v"(hi)); return r; }
constexpr int SEQ = 4096, NBATCH = 8, MTOK = NBATCH * SEQ, DM = 1024;
constexpr int DFF = 2816;
constexpr float RMS_EPS = 1e-6f;
constexpr float LOG2E = 1.4426950408889634f;
constexpr float C_MLA = 0.07216878364870322f * LOG2E;
constexpr float C_SWA = 0.125f * LOG2E;

typedef unsigned u32x2 __attribute__((ext_vector_type(2)));
__device__ __forceinline__ int lane_id_fresh() { int l; asm volatile("v_mbcnt_lo_u32_b32 %0, -1, 0\n\tv_mbcnt_hi_u32_b32 %0, -1, %0" : "=v"(l)); return l; }
__device__ __forceinline__ float fast_sigmoid(float v) { return __builtin_amdgcn_rcpf(1.0f + __builtin_amdgcn_exp2f(-LOG2E * v)); }
__device__ __forceinline__ void st8(bf16_t* p, f32x4 v0, f32x4 v1) {
    u32x4 w; w.x = cvt_pk_bf16(v0[0], v0[1]); w.y = cvt_pk_bf16(v0[2], v0[3]); w.z = cvt_pk_bf16(v1[0], v1[1]); w.w = cvt_pk_bf16(v1[2], v1[3]); *(u32x4*)p = w; }
__device__ __forceinline__ void st4(bf16_t* p, f32x4 v) { u32x2 w; w.x = cvt_pk_bf16(v[0], v[1]); w.y = cvt_pk_bf16(v[2], v[3]); *(u32x2*)p = w; }
__device__ __forceinline__ float sq4(f32x4 x) { return (x[0] * x[0] + x[1] * x[1]) + (x[2] * x[2] + x[3] * x[3]); }
__device__ __forceinline__ float fq_sum(float s) { s += __shfl_xor(s, 16); s += __shfl_xor(s, 32); return s; }

__device__ __forceinline__ void rope_store(bf16_t* dst  , int d, int srow, const float* cosT, const float* sinT, f32x4 a, f32x4 b, float sc) {
    const f32x4 c4 = *(const f32x4*)(cosT + srow * 32 + d), s4 = *(const f32x4*)(sinT + srow * 32 + d);
    const f32x4 x1 = {a[0] * sc, a[2] * sc, b[0] * sc, b[2] * sc}, x2 = {a[1] * sc, a[3] * sc, b[1] * sc, b[3] * sc};
    st4(dst + d, x1 * c4 - x2 * s4); st4(dst + 32 + d, x2 * c4 + x1 * s4);
}

struct EpiInProj {
    static constexpr bool PERM = true, AFTER_DRAIN = false;
    bf16_t *qlat, *kl, *qb, *kb, *vb, *ga, *gb; float *ssq_q, *ssq_kv; const float *cosT, *sinT;
    __device__ __forceinline__ void operator()(f32x4 (&acc)[2][2][4][2], const Unit& u, int wr, int wc, int fr, int fq) const {
        { const int l_ = lane_id_fresh(); fr = l_ & 15; fq = l_ >> 4; }
        const int pn = u.pn, row0 = u.pm * BM + wr * 64 + fr, cw = wc * 32 + 8 * fq;
        if (pn == 0) {
#pragma unroll
            for (int ai = 0; ai < 2; ++ai)
#pragma unroll
                for (int m = 0; m < 4; ++m) { const int row = row0 + ai * HALF + m * 16;
                    float s = (sq4(acc[ai][0][m][0]) + sq4(acc[ai][0][m][1])) + (sq4(acc[ai][1][m][0]) + sq4(acc[ai][1][m][1]));
                    s = fq_sum(s); if (fq == 0) ssq_q[(size_t)row * 4 + wc] = s;
                    st8(qlat + (size_t)row * 256 + cw, acc[ai][0][m][0], acc[ai][0][m][1]); st8(qlat + (size_t)row * 256 + HALF + cw, acc[ai][1][m][0], acc[ai][1][m][1]);
                    asm volatile("" ::: "memory"); }
        } else if (pn == 1) {
#pragma unroll
            for (int ai = 0; ai < 2; ++ai)
#pragma unroll
                for (int m = 0; m < 4; ++m) { const int row = row0 + ai * HALF + m * 16;
                    float s = sq4(acc[ai][0][m][0]) + sq4(acc[ai][0][m][1]);
                    s = fq_sum(s); if (fq == 0) __hip_atomic_store(ssq_kv + (unsigned)row * 4 + wc, s, __ATOMIC_RELAXED, __HIP_MEMORY_SCOPE_AGENT); }
            asm volatile("s_waitcnt vmcnt(0)" ::: "memory");
            __builtin_amdgcn_s_barrier(); asm volatile("" ::: "memory");
#pragma unroll
            for (int ai = 0; ai < 2; ++ai)
#pragma unroll
                for (int m = 0; m < 4; ++m) { const int row = row0 + ai * HALF + m * 16; const float* sp = ssq_kv + (unsigned)row * 4;
                    const float t = (__hip_atomic_load(sp, __ATOMIC_RELAXED, __HIP_MEMORY_SCOPE_AGENT) + __hip_atomic_load(sp + 1, __ATOMIC_RELAXED, __HIP_MEMORY_SCOPE_AGENT))
                                  + (__hip_atomic_load(sp + 2, __ATOMIC_RELAXED, __HIP_MEMORY_SCOPE_AGENT) + __hip_atomic_load(sp + 3, __ATOMIC_RELAXED, __HIP_MEMORY_SCOPE_AGENT));
                    const float rs = __builtin_amdgcn_rsqf(t * (1.0f / 128.0f) + RMS_EPS);
                    bf16_t* krow = kl + (size_t)row * 192;
                    st8(krow + cw, acc[ai][0][m][0] * rs, acc[ai][0][m][1] * rs);
                    if (wc < 2) rope_store(krow + 128, 16 * wc + 4 * fq, row & (SEQ - 1), cosT, sinT, acc[ai][1][m][0], acc[ai][1][m][1], 1.0f);
                    if (m == 1 || m == 3) asm volatile("" ::: "memory"); }
        } else {
            bf16_t* base; int ld, col0; float sc = 1.0f; bool sig = false;
            if (pn < 6) { base = qb; ld = 1024; col0 = (pn - 2) * 256; sc = C_SWA; }
            else if (pn == 6) { base = kb; ld = 256; col0 = 0; }
            else if (pn == 7) { base = vb; ld = 256; col0 = 0; }
            else if (pn < 12) { base = ga; ld = 1024; col0 = (pn - 8) * 256; sig = true; }
            else { base = gb; ld = 1024; col0 = (pn - 12) * 256; sig = true; }
            bf16_t* rowp = base + (size_t)row0 * ld + col0 + cw; const size_t rstep = (size_t)16 * ld;
#pragma unroll
            for (int ai = 0; ai < 2; ++ai)
#pragma unroll
                for (int m = 0; m < 4; ++m) { bf16_t* rp = rowp + (size_t)(ai * 8 + m) * rstep;
#pragma unroll
                    for (int bj = 0; bj < 2; ++bj) { f32x4 v0 = acc[ai][bj][m][0], v1 = acc[ai][bj][m][1];
                        if (sig) {
#pragma unroll
                            for (int e = 0; e < 4; ++e) { v0[e] = fast_sigmoid(v0[e]); v1[e] = fast_sigmoid(v1[e]); } }
                        else { v0 = v0 * sc; v1 = v1 * sc; }
                        st8(rp + bj * HALF, v0, v1); }
                    asm volatile("" ::: "memory"); }
        }
    }
};

struct EpiQProj {
    static constexpr bool PERM = true, AFTER_DRAIN = false;
    bf16_t* qa; const float* ssq; const float *cosT, *sinT;
    __device__ __forceinline__ void operator()(f32x4 (&acc)[2][2][4][2], const Unit& u, int wr, int wc, int fr, int fq) const {
        { const int l_ = lane_id_fresh(); fr = l_ & 15; fq = l_ >> 4; }
        const int pn = u.pn, row0 = u.pm * BM + wr * 64 + fr, cw = wc * 32 + 8 * fq;
        f32x4 sv[2][4];
#pragma unroll
        for (int ai = 0; ai < 2; ++ai)
#pragma unroll
            for (int m = 0; m < 4; ++m) sv[ai][m] = *(const f32x4*)(ssq + (unsigned)(row0 + ai * HALF + m * 16) * 4);
        asm volatile("" ::: "memory");
#pragma unroll
        for (int ai = 0; ai < 2; ++ai)
#pragma unroll
            for (int m = 0; m < 4; ++m) { const int row = row0 + ai * HALF + m * 16;
                const f32x4 s4 = sv[ai][m];
                const float rs = C_MLA * __builtin_amdgcn_rsqf(((s4[0] + s4[1]) + (s4[2] + s4[3])) * (1.0f / 256.0f) + RMS_EPS);
                bf16_t* qrow = qa + (size_t)row * 1536;
                if (pn < 4) {
#pragma unroll
                    for (int bj = 0; bj < 2; ++bj) st8(qrow + (2 * pn + bj) * 192 + cw, acc[ai][bj][m][0] * rs, acc[ai][bj][m][1] * rs);
                } else {
#pragma unroll
                    for (int bj = 0; bj < 2; ++bj) { const int head = 4 * (pn - 4) + 2 * bj + (wc >> 1);
                        rope_store(qrow + head * 192 + 128, 16 * (wc & 1) + 4 * fq, row & (SEQ - 1), cosT, sinT, acc[ai][bj][m][0], acc[ai][bj][m][1], rs); }
                }
                if (m == 1 || m == 3) asm volatile("" ::: "memory");
            }
    }
};

struct EpiResidual {
    static constexpr bool PERM = true, AFTER_DRAIN = false;
    const float* base; float* y; bf16_t* yb; float* ssq;
    __device__ __forceinline__ void operator()(f32x4 (&acc)[2][2][4][2], const Unit& u, int wr, int wc, int fr, int fq) const {
        { const int l_ = lane_id_fresh(); fr = l_ & 15; fq = l_ >> 4; }
        const int pn = u.pn, row0 = u.pm * BM + wr * 64 + fr, cw = wc * 32 + 8 * fq;
        const unsigned off0 = (unsigned)row0 * DM + pn * 256 + cw;
#pragma unroll
        for (int ai = 0; ai < 2; ++ai) {
            f32x4 xv[4][2][2];
#pragma unroll
            for (int m = 0; m < 4; ++m)
#pragma unroll
                for (int bj = 0; bj < 2; ++bj) { const unsigned off = off0 + (unsigned)((ai * HALF + m * 16) * DM + bj * HALF);
                    xv[m][bj][0] = *(const f32x4*)(base + off); xv[m][bj][1] = *(const f32x4*)(base + off + 4); }
            asm volatile("" ::: "memory");
#pragma unroll
            for (int m = 0; m < 4; ++m) { const int row = row0 + ai * HALF + m * 16; float s = 0.f;
#pragma unroll
                for (int bj = 0; bj < 2; ++bj) { const unsigned off = off0 + (unsigned)((ai * HALF + m * 16) * DM + bj * HALF);
                    const f32x4 v0 = xv[m][bj][0] + acc[ai][bj][m][0], v1 = xv[m][bj][1] + acc[ai][bj][m][1];
                    if (y) { *(f32x4*)(y + off) = v0; *(f32x4*)(y + off + 4) = v1; } if (yb) st8(yb + off, v0, v1);
                    s += sq4(v0) + sq4(v1); }
                s = fq_sum(s); if (fq == 0) ssq[(unsigned)row * 16 + pn * 4 + wc] = s; }
            asm volatile("" ::: "memory");
        }
    }
};

struct EpiUp {
    static constexpr bool PERM = true, AFTER_DRAIN = false;
    bf16_t* U; int ldu; const float* ssq;
    __device__ __forceinline__ void operator()(f32x4 (&acc)[2][2][4][2], const Unit& u, int wr, int wc, int fr, int fq) const {
        { const int l_ = lane_id_fresh(); fr = l_ & 15; fq = l_ >> 4; }
        const int pn = u.pn, row0 = u.pm * BM + wr * 64 + fr, cw = wc * 32 + 8 * fq;
#pragma unroll
        for (int ai = 0; ai < 2; ++ai)
#pragma unroll
            for (int m = 0; m < 4; ++m) { const int row = row0 + ai * HALF + m * 16;
                const f32x4* sp = (const f32x4*)(ssq + (size_t)row * 16); const f32x4 t = (sp[0] + sp[1]) + (sp[2] + sp[3]);
                const float rs = __builtin_amdgcn_rsqf(((t[0] + t[1]) + (t[2] + t[3])) * (1.0f / 1024.0f) + RMS_EPS);
#pragma unroll
                for (int bj = 0; bj < 2; ++bj) st8(U + (size_t)row * ldu + pn * 256 + bj * HALF + cw, acc[ai][bj][m][0] * rs, acc[ai][bj][m][1] * rs);
                asm volatile("" ::: "memory"); }
    }
};

__device__ __forceinline__ float dpp_prev(float x) { return __int_as_float(__builtin_amdgcn_update_dpp(__float_as_int(x), __float_as_int(x), 0x121, 0xf, 0xf, true)); }
__device__ __forceinline__ float dpp_next(float x) { return __int_as_float(__builtin_amdgcn_update_dpp(__float_as_int(x), __float_as_int(x), 0x12f, 0xf, 0xf, true)); }
struct EpiUpConv {
    static constexpr bool PERM = true, AFTER_DRAIN = false;
    bf16_t* act; float* halo; const float* ssq; const float* conv_w; const float* conv_b;
    __device__ __forceinline__ void operator()(f32x4 (&acc)[2][2][4][2], const Unit& u, int wr, int wc, int fr, int fq) const {
        { const int l_ = lane_id_fresh(); fr = l_ & 15; fq = l_ >> 4; }
        const int pn = u.pn, row0 = u.pm * BM + wr * 64 + fr, cw = wc * 32 + 8 * fq;
        { f32x4 tv[2][4];
#pragma unroll
        for (int ai = 0; ai < 2; ++ai)
#pragma unroll
            for (int m = 0; m < 4; ++m) tv[ai][m] = *(const f32x4*)(ssq + (unsigned)(row0 + ai * HALF + m * 16) * 16 + 4 * fq);
        asm volatile("" ::: "memory");
#pragma unroll
        for (int ai = 0; ai < 2; ++ai)
#pragma unroll
            for (int m = 0; m < 4; ++m) { const f32x4 t = tv[ai][m];
                const float rs = __builtin_amdgcn_rsqf(fq_sum((t[0] + t[1]) + (t[2] + t[3])) * (1.0f / 1024.0f) + RMS_EPS);
#pragma unroll
                for (int bj = 0; bj < 2; ++bj) { acc[ai][bj][m][0] = acc[ai][bj][m][0] * rs; acc[ai][bj][m][1] = acc[ai][bj][m][1] * rs; }
                if (m == 1 || m == 3) __builtin_amdgcn_sched_barrier(0); } }
        const bool first = fr == 0, last = fr == 15;
        u32x2 pk[2][4];
#pragma unroll
        for (int n = 0; n < 2; ++n) {
            const int c = pn * 128 + cw + 4 * n;
            const f32x4 wg0 = *(const f32x4*)(conv_w + c), wg1 = *(const f32x4*)(conv_w + 2 * DFF + c), wg2 = *(const f32x4*)(conv_w + 4 * DFF + c), bg = *(const f32x4*)(conv_b + c);
            const f32x4 wv0 = *(const f32x4*)(conv_w + DFF + c), wv1 = *(const f32x4*)(conv_w + 3 * DFF + c), wv2 = *(const f32x4*)(conv_w + 5 * DFF + c), bv = *(const f32x4*)(conv_b + DFF + c);
#pragma unroll
            for (int ai = 0; ai < 2; ++ai) {
                float* hb = halo + (unsigned)((4 * u.pm + 2 * ai + wr) * (4 * 2 * DFF) + pn * 256 + cw + 4 * n);
                f32x4 Apg = {0.f, 0.f, 0.f, 0.f}, Apv = Apg, Bcg, Bcv;
#pragma unroll
                for (int e = 0; e < 4; ++e) { Bcg[e] = dpp_next(acc[ai][0][0][n][e]); Bcv[e] = dpp_next(acc[ai][1][0][n][e]); }
#pragma unroll
                for (int m = 0; m < 4; ++m) { const int row = row0 + ai * HALF + m * 16;
                    const f32x4 ug = acc[ai][0][m][n], uv = acc[ai][1][m][n]; f32x4 G, V, Acg, Acv, Bng = {0.f, 0.f, 0.f, 0.f}, Bnv = Bng;
#pragma unroll
                    for (int e = 0; e < 4; ++e) { Acg[e] = dpp_prev(ug[e]); Acv[e] = dpp_prev(uv[e]);
                        if (m < 3) { Bng[e] = dpp_next(acc[ai][0][m < 3 ? m + 1 : 3][n][e]); Bnv[e] = dpp_next(acc[ai][1][m < 3 ? m + 1 : 3][n][e]); }
                        const float pg = first ? Apg[e] : Acg[e], pv = first ? Apv[e] : Acv[e], ng = last ? Bng[e] : Bcg[e], nv = last ? Bnv[e] : Bcv[e];
                        G[e] = wg0[e] * pg + wg1[e] * ug[e] + wg2[e] * ng + bg[e]; V[e] = wv0[e] * pv + wv1[e] * uv[e] + wv2[e] * nv + bv[e]; }
                    Apg = Acg; Apv = Acv; Bcg = Bng; Bcv = Bnv;
                    bool edge = false;
                    if (m == 0) { if (first) { edge = true; *(f32x4*)(hb) = ug; *(f32x4*)(hb + 128) = uv; *(f32x4*)(hb + 2 * 2 * DFF) = G; *(f32x4*)(hb + 2 * 2 * DFF + 128) = V; } }
                    if (m == 3) { if (last) { edge = true; *(f32x4*)(hb + 2 * DFF) = ug; *(f32x4*)(hb + 2 * DFF + 128) = uv; *(f32x4*)(hb + 3 * 2 * DFF) = G; *(f32x4*)(hb + 3 * 2 * DFF + 128) = V; } }
                    f32x4 o;
#pragma unroll
                    for (int e = 0; e < 4; ++e) o[e] = G[e] * fast_sigmoid(G[e]) * V[e];
                    u32x2 w; w.x = cvt_pk_bf16(o[0], o[1]); w.y = cvt_pk_bf16(o[2], o[3]);
                    if (n == 0) pk[ai][m] = w;
                    else if (!edge) { u32x4 w4; w4.x = pk[ai][m].x; w4.y = pk[ai][m].y; w4.z = w.x; w4.w = w.y; *(u32x4*)(act + ((unsigned)row * (unsigned)DFF + (unsigned)(c - 4))) = w4; }
                    __builtin_amdgcn_sched_barrier(0);
                }
                asm volatile("" ::: "memory");
            }
        }
    }
};

struct EpiFinal {
    static constexpr bool PERM = true, AFTER_DRAIN = false;
    const bf16_t* x1b; float* out; float* ssq; unsigned* cnt; const float* gf;
    __device__ __forceinline__ void operator()(f32x4 (&acc)[2][2][4][2], const Unit& u, int wr, int wc, int fr, int fq) const {
        const int l_ = lane_id_fresh(); fr = l_ & 15; fq = l_ >> 4;
        const int pn = u.pn, row0 = u.pm * BM + wr * 64 + fr, cw = wc * 32 + 8 * fq;
        const unsigned off0 = (unsigned)row0 * DM + pn * 256 + cw;
#pragma unroll
        for (int ai = 0; ai < 2; ++ai) {
            u32x4 xw[4][2];
#pragma unroll
            for (int m = 0; m < 4; ++m)
#pragma unroll
                for (int bj = 0; bj < 2; ++bj) xw[m][bj] = *(const u32x4*)(x1b + off0 + (unsigned)((ai * HALF + m * 16) * DM + bj * HALF));
            asm volatile("" ::: "memory");
#pragma unroll
            for (int m = 0; m < 4; ++m) { const int row = row0 + ai * HALF + m * 16; float s = 0.f;
#pragma unroll
                for (int bj = 0; bj < 2; ++bj) { const u32x4 w = xw[m][bj];
                    const f32x4 x0 = {__uint_as_float(w.x << 16), __uint_as_float(w.x & 0xffff0000u), __uint_as_float(w.y << 16), __uint_as_float(w.y & 0xffff0000u)};
                    const f32x4 x1v = {__uint_as_float(w.z << 16), __uint_as_float(w.z & 0xffff0000u), __uint_as_float(w.w << 16), __uint_as_float(w.w & 0xffff0000u)};
                    acc[ai][bj][m][0] = acc[ai][bj][m][0] + x0; acc[ai][bj][m][1] = acc[ai][bj][m][1] + x1v;
                    s += sq4(acc[ai][bj][m][0]) + sq4(acc[ai][bj][m][1]); }
                s = fq_sum(s); if (fq == 0) __hip_atomic_store(ssq + (unsigned)row * 16 + pn * 4 + wc, s, __ATOMIC_RELAXED, __HIP_MEMORY_SCOPE_AGENT); }
            asm volatile("" ::: "memory");
        }
        asm volatile("s_waitcnt vmcnt(0)" ::: "memory");
        __builtin_amdgcn_s_barrier(); asm volatile("" ::: "memory");
        if (wr == 0 && wc == 0) {
            unsigned* c = cnt + 64 * u.pm;
            if (l_ == 0) __hip_atomic_fetch_add(c, 1u, __ATOMIC_RELAXED, __HIP_MEMORY_SCOPE_AGENT);
            for (unsigned sp = 0; sp < (1u << 22); ++sp) {
                if ((unsigned)__builtin_amdgcn_readfirstlane(__hip_atomic_load(c, __ATOMIC_RELAXED, __HIP_MEMORY_SCOPE_AGENT)) >= 4u) break;
                __builtin_amdgcn_s_sleep(2); }
            __builtin_amdgcn_fence(__ATOMIC_ACQUIRE, "agent");
            asm volatile("s_waitcnt vmcnt(0)" ::: "memory");
        }
        __builtin_amdgcn_s_barrier(); asm volatile("" ::: "memory");
        f32x4 gv[2][2];
#pragma unroll
        for (int bj = 0; bj < 2; ++bj) { gv[bj][0] = *(const f32x4*)(gf + pn * 256 + bj * HALF + cw); gv[bj][1] = *(const f32x4*)(gf + pn * 256 + bj * HALF + cw + 4); }
        f32x4 tv[2][4];
#pragma unroll
        for (int ai = 0; ai < 2; ++ai)
#pragma unroll
            for (int m = 0; m < 4; ++m) tv[ai][m] = *(const f32x4*)(ssq + (unsigned)(row0 + ai * HALF + m * 16) * 16 + 4 * fq);
        asm volatile("" ::: "memory");
#pragma unroll
        for (int ai = 0; ai < 2; ++ai)
#pragma unroll
            for (int m = 0; m < 4; ++m) { const f32x4 t = tv[ai][m];
                const float rs = __builtin_amdgcn_rsqf(fq_sum((t[0] + t[1]) + (t[2] + t[3])) * (1.0f / 1024.0f) + RMS_EPS);
#pragma unroll
                for (int bj = 0; bj < 2; ++bj) { const unsigned off = off0 + (unsigned)((ai * HALF + m * 16) * DM + bj * HALF);
                    *(f32x4*)(out + off) = acc[ai][bj][m][0] * rs * gv[bj][0]; *(f32x4*)(out + off + 4) = acc[ai][bj][m][1] * rs * gv[bj][1]; }
                if (m == 1 || m == 3) __builtin_amdgcn_sched_barrier(0); }
    }
};
template <class Epi, class Sched, bool ALIGN_EPI = false, bool SP2 = false>
__device__ __forceinline__ void gemm_phase(PG8_LAS unsigned char* lds, const Gemm g, const Sched& S, const Epi& E, const int wave_id  ) {
    const int lane = lane_id_fresh(), wid = wave_id, tid = wid * 64 + lane,
              wr = wid >> 2, wc = wid & 3, fr = lane & 15, fq = lane >> 4;
    const int K = g.K, nt = K / BK;
    unsigned voffA[2], voffB[2]; int aoff, boff;
#define PG8_LANE_CONSTS() do { const int l_ = lane_id_fresh(), t_ = wid * 64 + l_, fr_ = l_ & 15, fq_ = l_ >> 4; \
        _Pragma("unroll") for (int i = 0; i < 2; ++i) { int R, C; stage_rc(t_ * 16 + i * 8192, R, C); const int Rb = Epi::PERM ? ((R & ~31) + perm32(R & 31)) : R; \
            voffA[i] = (unsigned)(R * K + C) * 2u; voffB[i] = (unsigned)(Rb * K + C) * 2u; } \
        aoff = lds_byte(wr * 64 + fr_, fq_ * 8); boff = lds_byte(wc * 32 + fr_, fq_ * 8); } while (0)
    PG8_LANE_CONSTS();
    const size_t kstep = (size_t)(BK * 2);
    const size_t hstep = (size_t)HALF * K * 2;
    const size_t tstep = 2 * hstep;
    const unsigned ldsw = (unsigned)wid * 1024u;
#define PG8_SA(b, h) (((b) * 2 + (h)) * HTB)
#define PG8_SB(b, h) ((4 + (b) * 2 + (h)) * HTB)
#define PG8_STAGE(bufoff, gbase, voff) do { _Pragma("unroll") for (int _i = 0; _i < 2; ++_i) \
        __builtin_amdgcn_global_load_lds((const unsigned*)((const char*)(gbase) + (voff)[_i]), (PG8_LAS unsigned*)(lds + (bufoff) + ldsw + _i * 8192), 16, 0, 0); } while (0)
#define PG8_LDA(dst, b, h) do { _Pragma("unroll") for (int m = 0; m < 4; ++m) _Pragma("unroll") for (int k = 0; k < 2; ++k) dst[m][k] = *(const PG8_LAS bf16x8*)(lds + PG8_SA(b, h) + aoff + m * 2048 + k * 1024); } while (0)
#define PG8_LDB(dst, b, h) do { _Pragma("unroll") for (int n = 0; n < 2; ++n) _Pragma("unroll") for (int k = 0; k < 2; ++k) dst[n][k] = *(const PG8_LAS bf16x8*)(lds + PG8_SB(b, h) + boff + n * 2048 + k * 1024); } while (0)
#define PG8_MMA(ai, bj, At, Bt) do { __builtin_amdgcn_s_setprio(1); _Pragma("unroll") for (int m = 0; m < 4; ++m) _Pragma("unroll") for (int n = 0; n < 2; ++n) _Pragma("unroll") for (int k = 0; k < 2; ++k) \
        acc[ai][bj][m][n] = __builtin_amdgcn_mfma_f32_16x16x32_bf16(Bt[n][k], At[m][k], acc[ai][bj][m][n], 0, 0, 0); __builtin_amdgcn_s_setprio(0); } while (0)
#define PG8_WAIT_V(n) asm volatile("s_waitcnt vmcnt(" #n ")" ::: "memory")
#define PG8_WAIT_L(n) asm volatile("s_waitcnt lgkmcnt(" #n ")" ::: "memory")
#define PG8_BAR __builtin_amdgcn_s_barrier()
#define PG8_SCHED __builtin_amdgcn_sched_barrier(0)
    Unit cur, nxt; int ui = 0;
    if (!S.next(0, cur)) return;
    f32x4 acc[2][2][4][2];
#pragma unroll
    for (int a = 0; a < 2; ++a)
#pragma unroll
        for (int b = 0; b < 2; ++b)
#pragma unroll
            for (int m = 0; m < 4; ++m)
#pragma unroll
                for (int n = 0; n < 2; ++n) acc[a][b][m][n] = (f32x4){0.f, 0.f, 0.f, 0.f};
    bf16x8 At[4][2], B0[2][2], B1[2][2];
    const char* cA = (const char*)g.A + (size_t)cur.pm * tstep; const char* cB = (const char*)g.Bt + (size_t)cur.pn * tstep;
    S.a_ready(cur);
    if constexpr (SP2) {
        PG8_STAGE(PG8_SB(0, 0), cB, voffB); PG8_STAGE(PG8_SB(0, 1), cB + hstep, voffB); PG8_STAGE(PG8_SA(0, 0), cA, voffA); PG8_STAGE(PG8_SA(0, 1), cA + hstep, voffA);
        if (wr == 1) PG8_BAR;
        PG8_WAIT_V(2); PG8_BAR;
        PG8_STAGE(PG8_SB(1, 0), cB + kstep, voffB); PG8_STAGE(PG8_SA(1, 0), cA + kstep, voffA); PG8_STAGE(PG8_SB(1, 1), cB + hstep + kstep, voffB);
        PG8_WAIT_V(6); PG8_BAR;
    } else {
        PG8_STAGE(PG8_SB(0, 0), cB, voffB); PG8_STAGE(PG8_SA(0, 0), cA, voffA); PG8_STAGE(PG8_SB(0, 1), cB + hstep, voffB); PG8_STAGE(PG8_SA(0, 1), cA + hstep, voffA);
        if (wr == 1) PG8_BAR;
        PG8_WAIT_V(4); PG8_BAR;
        PG8_STAGE(PG8_SB(1, 0), cB + kstep, voffB); PG8_STAGE(PG8_SA(1, 0), cA + kstep, voffA); PG8_STAGE(PG8_SB(1, 1), cB + hstep + kstep, voffB);
        PG8_WAIT_V(6); PG8_BAR;
    }
    for (;;) {
        const bool has_next = S.next(ui + 1, nxt);
        const char* nA = has_next ? (const char*)g.A + (size_t)nxt.pm * tstep : cA; const char* nB = has_next ? (const char*)g.Bt + (size_t)nxt.pn * tstep : cB;
        for (int t = 0; t < nt; t += 2) {
            const bool last = (t == nt - 2);
            const char* a1 = cA + (size_t)(t + 1) * kstep;
            const char* a2 = last ? nA : cA + (size_t)(t + 2) * kstep; const char* b2 = last ? nB : cB + (size_t)(t + 2) * kstep;
            const char* a3 = a2 + kstep; const char* b3 = b2 + kstep;
            if (last && has_next) S.a_ready(nxt);
            if constexpr (SP2) {
            PG8_LDB(B0, 0, 0); PG8_LDB(B1, 0, 1); PG8_SCHED; PG8_LDA(At, 0, 0); PG8_STAGE(PG8_SA(1, 1), a1 + hstep, voffA);
            PG8_WAIT_V(8); PG8_WAIT_L(0); PG8_BAR; PG8_MMA(0, 0, At, B0); PG8_MMA(0, 1, At, B1); PG8_BAR; PG8_SCHED;
            PG8_LDA(At, 0, 1); PG8_STAGE(PG8_SB(0, 0), b2, voffB); PG8_STAGE(PG8_SB(0, 1), b2 + hstep, voffB); PG8_STAGE(PG8_SA(0, 0), a2, voffA);
            PG8_WAIT_V(8); PG8_WAIT_L(0); PG8_BAR; PG8_MMA(1, 0, At, B0); PG8_MMA(1, 1, At, B1); PG8_BAR; PG8_SCHED;
            PG8_LDB(B0, 1, 0); PG8_LDB(B1, 1, 1); PG8_SCHED; PG8_LDA(At, 1, 0); PG8_STAGE(PG8_SA(0, 1), a2 + hstep, voffA);
            PG8_WAIT_V(8); PG8_WAIT_L(0); PG8_BAR; PG8_MMA(0, 0, At, B0); PG8_MMA(0, 1, At, B1); PG8_BAR; PG8_SCHED;
            PG8_LDA(At, 1, 1); PG8_STAGE(PG8_SB(1, 0), b3, voffB); PG8_STAGE(PG8_SB(1, 1), b3 + hstep, voffB); PG8_STAGE(PG8_SA(1, 0), a3, voffA);
            PG8_WAIT_V(8); PG8_WAIT_L(0); PG8_BAR; PG8_MMA(1, 0, At, B0); PG8_MMA(1, 1, At, B1); PG8_BAR; PG8_SCHED;
            } else {
            PG8_LDB(B0, 0, 0); PG8_SCHED; PG8_LDA(At, 0, 0); PG8_STAGE(PG8_SA(1, 1), a1 + hstep, voffA);
            PG8_WAIT_L(8); PG8_BAR; PG8_WAIT_L(0); PG8_MMA(0, 0, At, B0); PG8_BAR; PG8_SCHED;
            PG8_LDB(B1, 0, 1); PG8_STAGE(PG8_SB(0, 0), b2, voffB);
            PG8_BAR; PG8_WAIT_L(0); PG8_MMA(0, 1, At, B1); PG8_BAR;
            PG8_LDA(At, 0, 1); PG8_STAGE(PG8_SA(0, 0), a2, voffA);
            PG8_BAR; PG8_WAIT_L(0); PG8_MMA(1, 0, At, B0); PG8_BAR; PG8_SCHED;
            PG8_STAGE(PG8_SB(0, 1), b2 + hstep, voffB);
            PG8_WAIT_V(6); PG8_BAR; PG8_MMA(1, 1, At, B1); PG8_BAR;
            PG8_LDB(B0, 1, 0); PG8_SCHED; PG8_LDA(At, 1, 0); PG8_STAGE(PG8_SA(0, 1), a2 + hstep, voffA);
            PG8_WAIT_L(8); PG8_BAR; PG8_WAIT_L(0); PG8_MMA(0, 0, At, B0); PG8_BAR; PG8_SCHED;
            PG8_LDB(B1, 1, 1); PG8_STAGE(PG8_SB(1, 0), b3, voffB);
            PG8_BAR; PG8_WAIT_L(0); PG8_MMA(0, 1, At, B1); PG8_BAR;
            PG8_LDA(At, 1, 1); PG8_STAGE(PG8_SA(1, 0), a3, voffA);
            PG8_BAR; PG8_WAIT_L(0); PG8_MMA(1, 0, At, B0); PG8_BAR; PG8_SCHED;
            PG8_STAGE(PG8_SB(1, 1), b3 + hstep, voffB);
            PG8_WAIT_V(6); PG8_BAR; PG8_MMA(1, 1, At, B1); PG8_BAR;
            }
        }
        if constexpr (ALIGN_EPI) { if (wr == 0) PG8_BAR; }
        if constexpr (!Epi::AFTER_DRAIN) { E(acc, cur, wr, wc, fr, fq); S.done(cur); PG8_LANE_CONSTS(); }
        if (!has_next) break;
#pragma unroll
        for (int a = 0; a < 2; ++a)
#pragma unroll
            for (int b = 0; b < 2; ++b)
#pragma unroll
                for (int m = 0; m < 4; ++m)
#pragma unroll
                    for (int n = 0; n < 2; ++n) acc[a][b][m][n] = (f32x4){0.f, 0.f, 0.f, 0.f};
        cur = nxt; cA = nA; cB = nB; ++ui;
        if constexpr (ALIGN_EPI) { if (wr == 1) PG8_BAR; }
    }
    PG8_WAIT_V(0);
    if constexpr (!ALIGN_EPI) { if (wr == 0) PG8_BAR; }
    PG8_BAR;
    if constexpr (Epi::AFTER_DRAIN) { E.fused(acc, cur, wr, wc, fr, fq, lds, wid, lane); S.done(cur); }
#undef PG8_LANE_CONSTS
#undef PG8_SA
#undef PG8_SB
#undef PG8_STAGE
#undef PG8_LDA
#undef PG8_LDB
#undef PG8_MMA
#undef PG8_WAIT_V
#undef PG8_WAIT_L
#undef PG8_BAR
#undef PG8_SCHED
}
}
using pg8::SEQ; using pg8::NBATCH; using pg8::MTOK; using pg8::DM; using pg8::DFF; using pg8::RMS_EPS; using pg8::LOG2E;
#ifndef PG8_SP2
#define PG8_SP2 true
#endif
#ifndef PG8_ALIGN
#define PG8_ALIGN true
#endif
#ifndef MLA_OT
#define MLA_OT 1
#endif
namespace att {
using bf16x8 = __attribute__((ext_vector_type(8))) short;
using s16x4  = __attribute__((ext_vector_type(4))) short;
using f32x16 = __attribute__((ext_vector_type(16))) float;
using u32x4  = __attribute__((ext_vector_type(4))) unsigned;
typedef unsigned short bf16_t;
#define SBAR() __builtin_amdgcn_sched_barrier(0)
#define ATT_WAIT_BAR(N) asm volatile("s_waitcnt vmcnt(" #N ") lgkmcnt(0)\n\ts_barrier" ::: "memory")
__device__ __forceinline__ int crow(int r, int hi) { return (r & 3) + 8 * (r >> 2) + 4 * hi; }
__device__ __forceinline__ unsigned cvtpk(float lo, float hi) { unsigned r; asm volatile("v_cvt_pk_bf16_f32 %0, %1, %2" : "=v"(r) : "v"(lo), "v"(hi)); return r; }
__device__ __forceinline__ float bf2f(bf16_t b) { return __uint_as_float((unsigned)b << 16); }
typedef float f32x2_t __attribute__((ext_vector_type(2))); typedef __bf16 bf16x2_t __attribute__((ext_vector_type(2)));
__device__ __forceinline__ unsigned cvtpk2(float lo, float hi) { f32x2_t v = {lo, hi}; bf16x2_t r = __builtin_convertvector(v, bf16x2_t); return __builtin_bit_cast(unsigned, r); }
__device__ __forceinline__ bf16_t f2bf(float f) { return (bf16_t)(cvtpk(f, f) & 0xffffu); }
__device__ __forceinline__ void glds16(const void* gsrc, unsigned lds_dst) { unsigned keep;
    asm volatile("s_mov_b32 %0, m0\n\ts_mov_b32 m0, %2\n\ts_nop 0\n\tglobal_load_lds_dwordx4 %1, off\n\ts_mov_b32 m0, %0" : "=&s"(keep) : "v"(gsrc), "s"(lds_dst) : "memory"); }
template <int IMM> __device__ __forceinline__ void glds16s(const void* sbase, unsigned voff, unsigned lds_dst) { unsigned keep;
    asm volatile("s_mov_b32 %0, m0\n\ts_mov_b32 m0, %3\n\ts_nop 4\n\tglobal_load_lds_dwordx4 %1, %2 offset:%4\n\ts_mov_b32 m0, %0" : "=&s"(keep) : "v"(voff), "s"(sbase), "s"(lds_dst), "i"(IMM) : "memory"); }
__device__ __forceinline__ int swap23(int k) { return (k & ~0xC) | ((k & 4) << 1) | ((k & 8) >> 1); }
__device__ __forceinline__ int v_rd_base(int lane) { return ((lane & 3) << 3) | (((lane >> 2) & 3) << 6) | (((lane >> 4) & 1) << 5) | (((lane >> 5) & 1) << 8); }
template <int OFF> __device__ __forceinline__ s16x4 tr_read(int vb) { s16x4 r; asm volatile("ds_read_b64_tr_b16 %0, %1 offset:%2" : "=&v"(r) : "v"(vb), "i"(OFF) : "memory"); return r; }
__device__ __forceinline__ void pack_p(const f32x16& p0, const f32x16& p1, bf16x8& pa0, bf16x8& pa1, bf16x8& pa2, bf16x8& pa3) {
#define PK4(P, BASE, OUT) do { unsigned a0 = cvtpk(P[BASE + 0], P[BASE + 1]), a1 = cvtpk(P[BASE + 2], P[BASE + 3]);   \
    unsigned b0 = cvtpk(P[BASE + 4], P[BASE + 5]), b1 = cvtpk(P[BASE + 6], P[BASE + 7]);                              \
    auto r0 = __builtin_amdgcn_permlane32_swap(a0, b0, false, false); auto r1 = __builtin_amdgcn_permlane32_swap(a1, b1, false, false); \
    u32x4 w = {r0[0], r1[0], r0[1], r1[1]}; OUT = *reinterpret_cast<bf16x8*>(&w); } while (0)
    PK4(p0, 0, pa0); PK4(p0, 8, pa1); PK4(p1, 0, pa2); PK4(p1, 8, pa3);
#undef PK4
}
__device__ __forceinline__ float half_max(float v) { auto rr = __builtin_amdgcn_permlane32_swap(__float_as_uint(v), __float_as_uint(v), false, false); return fmaxf(__uint_as_float(rr[0]), __uint_as_float(rr[1])); }
__device__ __forceinline__ float half_sum(float v) { auto rr = __builtin_amdgcn_permlane32_swap(__float_as_uint(v), __float_as_uint(v), false, false); return __uint_as_float(rr[0]) + __uint_as_float(rr[1]); }
template <int ND0, int D0> __device__ __forceinline__ void pv_one(f32x16& od, int vb, bf16x8 pa0, bf16x8 pa1, bf16x8 pa2, bf16x8 pa3) {
    constexpr int KS = 1024 * ND0, HF = 512 * ND0;
    const s16x4 l0 = tr_read<D0 * 512 + 0 * KS>(vb), h0 = tr_read<D0 * 512 + 0 * KS + HF>(vb), l1 = tr_read<D0 * 512 + 1 * KS>(vb), h1 = tr_read<D0 * 512 + 1 * KS + HF>(vb);
    const s16x4 l2 = tr_read<D0 * 512 + 2 * KS>(vb), h2 = tr_read<D0 * 512 + 2 * KS + HF>(vb), l3 = tr_read<D0 * 512 + 3 * KS>(vb), h3 = tr_read<D0 * 512 + 3 * KS + HF>(vb);
    asm volatile("s_waitcnt lgkmcnt(0)" ::: "memory"); SBAR();
#define PK(L, H) (bf16x8){L[0], L[1], L[2], L[3], H[0], H[1], H[2], H[3]}
    od = __builtin_amdgcn_mfma_f32_32x32x16_bf16(pa0, PK(l0, h0), od, 0, 0, 0);
    od = __builtin_amdgcn_mfma_f32_32x32x16_bf16(pa1, PK(l1, h1), od, 0, 0, 0);
    od = __builtin_amdgcn_mfma_f32_32x32x16_bf16(pa2, PK(l2, h2), od, 0, 0, 0);
    od = __builtin_amdgcn_mfma_f32_32x32x16_bf16(pa3, PK(l3, h3), od, 0, 0, 0);
#undef PK
}
struct PvFrag { s16x4 l0, h0, l1, h1, l2, h2, l3, h3; };
template <int ND0, int D0> __device__ __forceinline__ void pv_issue(PvFrag& f, int vb) {
    constexpr int KS = 1024 * ND0, HF = 512 * ND0;
    f.l0 = tr_read<D0 * 512 + 0 * KS>(vb); f.h0 = tr_read<D0 * 512 + 0 * KS + HF>(vb); f.l1 = tr_read<D0 * 512 + 1 * KS>(vb); f.h1 = tr_read<D0 * 512 + 1 * KS + HF>(vb);
    f.l2 = tr_read<D0 * 512 + 2 * KS>(vb); f.h2 = tr_read<D0 * 512 + 2 * KS + HF>(vb); f.l3 = tr_read<D0 * 512 + 3 * KS>(vb); f.h3 = tr_read<D0 * 512 + 3 * KS + HF>(vb);
}
__device__ __forceinline__ void pv_mma(f32x16& od, const PvFrag& f, bf16x8 pa0, bf16x8 pa1, bf16x8 pa2, bf16x8 pa3) {
    asm volatile("s_waitcnt lgkmcnt(0)" ::: "memory"); SBAR();
#define PK(L, H) (bf16x8){L[0], L[1], L[2], L[3], H[0], H[1], H[2], H[3]}
    od = __builtin_amdgcn_mfma_f32_32x32x16_bf16(pa0, PK(f.l0, f.h0), od, 0, 0, 0);
    od = __builtin_amdgcn_mfma_f32_32x32x16_bf16(pa1, PK(f.l1, f.h1), od, 0, 0, 0);
    od = __builtin_amdgcn_mfma_f32_32x32x16_bf16(pa2, PK(f.l2, f.h2), od, 0, 0, 0);
    od = __builtin_amdgcn_mfma_f32_32x32x16_bf16(pa3, PK(f.l3, f.h3), od, 0, 0, 0);
#undef PK
}
template <int NK16, int RS, int CS> __device__ __forceinline__ void qkt(f32x16& p0, f32x16& p1, const char* Ks, const bf16x8* qr, int r32, int hi) {
    p0 = f32x16{}; p1 = f32x16{};
    const char* kb = Ks + hi * CS + r32 * RS;
#pragma unroll
    for (int d0 = 0; d0 < NK16; ++d0) {
        const bf16x8 b0 = *reinterpret_cast<const bf16x8*>(kb + d0 * 2 * CS), b1 = *reinterpret_cast<const bf16x8*>(kb + d0 * 2 * CS + 32 * RS);
        p0 = __builtin_amdgcn_mfma_f32_32x32x16_bf16(b0, qr[d0], p0, 0, 0, 0);
        p1 = __builtin_amdgcn_mfma_f32_32x32x16_bf16(b1, qr[d0], p1, 0, 0, 0); }
}

template <int NK16, int RS, int CS> __device__ __forceinline__ void qkt_c(f32x16& p0, f32x16& p1, const f32x16& c, const char* Ks, const bf16x8* qr, int r32, int hi) {
    const char* kb = Ks + hi * CS + r32 * RS;
    { const bf16x8 b0 = *reinterpret_cast<const bf16x8*>(kb), b1 = *reinterpret_cast<const bf16x8*>(kb + 32 * RS);
      p0 = __builtin_amdgcn_mfma_f32_32x32x16_bf16(b0, qr[0], c, 0, 0, 0);
      p1 = __builtin_amdgcn_mfma_f32_32x32x16_bf16(b1, qr[0], c, 0, 0, 0); }
#pragma unroll
    for (int d0 = 1; d0 < NK16; ++d0) {
        const bf16x8 b0 = *reinterpret_cast<const bf16x8*>(kb + d0 * 2 * CS), b1 = *reinterpret_cast<const bf16x8*>(kb + d0 * 2 * CS + 32 * RS);
        p0 = __builtin_amdgcn_mfma_f32_32x32x16_bf16(b0, qr[d0], p0, 0, 0, 0);
        p1 = __builtin_amdgcn_mfma_f32_32x32x16_bf16(b1, qr[d0], p1, 0, 0, 0); }
}
__device__ __forceinline__ float max3f(float a, float b, float c) { float r; asm("v_max3_f32 %0, %1, %2, %3" : "=v"(r) : "v"(a), "v"(b), "v"(c)); return r; }

namespace mla {
constexpr int NTILE = SEQ / 64;
constexpr int KPITCH = 400, KSLOT = 64 * KPITCH  , NSLOT = 4;
constexpr int LDS_K = 0, LDS_WS = NSLOT * KSLOT, LDS_BYTES = LDS_WS + 8 * 256;
constexpr int OST_PITCH = 272, OST_WAVE = 32 * OST_PITCH;
static_assert(8 * OST_WAVE <= NSLOT * KSLOT, "o_lat staging fits the ring");
#ifndef MLA_XVALU
#define MLA_XVALU 0
#endif
constexpr float THR = 8.f;
template <bool FIRST> __device__ __forceinline__ void partialSM(f32x16& p0, f32x16& p1, f32x16& negm, float& alpha) {
    float a = max3f(p0[0], p0[1], p0[2]), b = max3f(p0[9], p0[10], p0[11]), c = max3f(p1[0], p1[1], p1[2]), e = max3f(p1[9], p1[10], p1[11]);
    a = max3f(a, p0[3], p0[4]); b = max3f(b, p0[12], p0[13]); c = max3f(c, p1[3], p1[4]); e = max3f(e, p1[12], p1[13]);
    a = max3f(a, p0[5], p0[6]); b = max3f(b, p0[14], p0[15]); c = max3f(c, p1[5], p1[6]); e = max3f(e, p1[14], p1[15]);
    a = max3f(a, p0[7], p0[8]); c = max3f(c, p1[7], p1[8]);
    float pmax = max3f(a, b, c);
    pmax = max3f(pmax, e, e);
    { auto rr = __builtin_amdgcn_permlane32_swap(__float_as_uint(pmax), __float_as_uint(pmax), false, false); pmax = max3f(__uint_as_float(rr[0]), __uint_as_float(rr[1]), __uint_as_float(rr[1])); }
    alpha = 1.f;
    if (FIRST || !__builtin_expect(__all(pmax <= THR), 1)) {
        const float dl = FIRST ? pmax : fmaxf(pmax, 0.f);
        if (!FIRST) alpha = __builtin_amdgcn_exp2f(-dl);
#pragma unroll
        for (int r = 0; r < 16; ++r) { p0[r] -= dl; p1[r] -= dl; negm[r] -= dl; }
        asm volatile("" : "+v"(negm));
    }
#pragma unroll
    for (int r = 0; r < 16; ++r) p0[r] = __builtin_amdgcn_exp2f(p0[r]);
}
__device__ __forceinline__ void finishSM(f32x16& p0, f32x16& p1, float alpha, float& l_reg, bf16x8& pa0, bf16x8& pa1, bf16x8& pa2, bf16x8& pa3) {
#pragma unroll
    for (int r = 0; r < 16; ++r) p1[r] = __builtin_amdgcn_exp2f(p1[r]);
    float s0 = p0[0] + p0[1], s1 = p0[2] + p0[3], s2 = p1[0] + p1[1], s3 = p1[2] + p1[3];
#pragma unroll
    for (int r = 4; r < 16; r += 4) { s0 += p0[r]; s0 += p0[r + 1]; s1 += p0[r + 2]; s1 += p0[r + 3]; s2 += p1[r]; s2 += p1[r + 1]; s3 += p1[r + 2]; s3 += p1[r + 3]; }
    float ps = (s0 + s1) + (s2 + s3);
    ps = half_sum(ps);
    l_reg = l_reg * alpha + ps;
#if MLA_OT
#define MLA_PK(P, B) (u32x4){cvtpk2(P[B], P[B + 1]), cvtpk2(P[B + 2], P[B + 3]), cvtpk2(P[B + 4], P[B + 5]), cvtpk2(P[B + 6], P[B + 7])}
    { u32x4 w0 = MLA_PK(p0, 0), w1 = MLA_PK(p0, 8), w2 = MLA_PK(p1, 0), w3 = MLA_PK(p1, 8);
      pa0 = *reinterpret_cast<bf16x8*>(&w0); pa1 = *reinterpret_cast<bf16x8*>(&w1); pa2 = *reinterpret_cast<bf16x8*>(&w2); pa3 = *reinterpret_cast<bf16x8*>(&w3); }
#undef MLA_PK
#else
    pack_p(p0, p1, pa0, pa1, pa2, pa3);
#endif
}
__device__ __forceinline__ int v_rm_base(int lane) { return (8 * (lane >> 5) + ((lane >> 2) & 3)) * KPITCH + 32 * ((lane >> 4) & 1) + 8 * (lane & 3); }
template <int D0> __device__ __forceinline__ void pvr_issue(PvFrag& f, int vb) {
    constexpr int KS = 16 * KPITCH, HF = 4 * KPITCH;
    f.l0 = tr_read<D0 * 64 + 0 * KS>(vb); f.h0 = tr_read<D0 * 64 + 0 * KS + HF>(vb); f.l1 = tr_read<D0 * 64 + 1 * KS>(vb); f.h1 = tr_read<D0 * 64 + 1 * KS + HF>(vb);
    f.l2 = tr_read<D0 * 64 + 2 * KS>(vb); f.h2 = tr_read<D0 * 64 + 2 * KS + HF>(vb); f.l3 = tr_read<D0 * 64 + 3 * KS>(vb); f.h3 = tr_read<D0 * 64 + 3 * KS + HF>(vb);
}
template <int D0> __device__ __forceinline__ void pvr_one(f32x16& od, int vb, bf16x8 pa0, bf16x8 pa1, bf16x8 pa2, bf16x8 pa3) { PvFrag f; pvr_issue<D0>(f, vb); pv_mma(od, f, pa0, pa1, pa2, pa3); }
#if MLA_OT
__device__ __forceinline__ int vt_rm_base(int lane) { return (4 * (lane >> 5) + ((lane >> 2) & 3)) * KPITCH + 32 * ((lane >> 4) & 1) + 8 * (lane & 3); }
template <int D0> __device__ __forceinline__ void pvt_issue(PvFrag& f, int vb) {
    constexpr int KS = 16 * KPITCH, HF = 8 * KPITCH;
    f.l0 = tr_read<D0 * 64 + 0 * KS>(vb); f.h0 = tr_read<D0 * 64 + 0 * KS + HF>(vb); f.l1 = tr_read<D0 * 64 + 1 * KS>(vb); f.h1 = tr_read<D0 * 64 + 1 * KS + HF>(vb);
    f.l2 = tr_read<D0 * 64 + 2 * KS>(vb); f.h2 = tr_read<D0 * 64 + 2 * KS + HF>(vb); f.l3 = tr_read<D0 * 64 + 3 * KS>(vb); f.h3 = tr_read<D0 * 64 + 3 * KS + HF>(vb);
}
__device__ __forceinline__ void pvt_mma(f32x16& od, const PvFrag& f, bf16x8 pa0, bf16x8 pa1, bf16x8 pa2, bf16x8 pa3) {
    asm volatile("s_waitcnt lgkmcnt(0)" ::: "memory"); SBAR();
#define PK(L, H) (bf16x8){L[0], L[1], L[2], L[3], H[0], H[1], H[2], H[3]}
    od = __builtin_amdgcn_mfma_f32_32x32x16_bf16(PK(f.l0, f.h0), pa0, od, 0, 0, 0);
    od = __builtin_amdgcn_mfma_f32_32x32x16_bf16(PK(f.l1, f.h1), pa1, od, 0, 0, 0);
    od = __builtin_amdgcn_mfma_f32_32x32x16_bf16(PK(f.l2, f.h2), pa2, od, 0, 0, 0);
    od = __builtin_amdgcn_mfma_f32_32x32x16_bf16(PK(f.l3, f.h3), pa3, od, 0, 0, 0);
#undef PK
}
template <int D0> __device__ __forceinline__ void pvt_one(f32x16& od, int vb, bf16x8 pa0, bf16x8 pa1, bf16x8 pa2, bf16x8 pa3) { PvFrag f; pvt_issue<D0>(f, vb); pvt_mma(od, f, pa0, pa1, pa2, pa3); }
#define MLA_PV_ISSUE pvt_issue
#define MLA_PV_MMA pvt_mma
#define MLA_PV_ONE pvt_one
#define MLA_V_BASE vt_rm_base
#else
#define MLA_PV_ISSUE pvr_issue
#define MLA_PV_MMA pv_mma
#define MLA_PV_ONE pvr_one
#define MLA_V_BASE v_rm_base
#endif
__device__ __forceinline__ void h1_qk_finish(f32x16& C0, f32x16& C1, f32x16& P0, f32x16& P1, const f32x16& negm, const char* Ks, const bf16x8* qr, int r32, int hi,
                                             float alP, float& l_reg, bf16x8& pa0, bf16x8& pa1, bf16x8& pa2, bf16x8& pa3) {
    const char* kb = Ks + hi * 16 + r32 * KPITCH;
    bf16x8 b0 = *reinterpret_cast<const bf16x8*>(kb), b1 = *reinterpret_cast<const bf16x8*>(kb + 32 * KPITCH);
    float a0 = 0.f, a1 = 0.f, c0 = 0.f, c1 = 0.f; unsigned w[16];
#pragma unroll
    for (int k = 0; k < 12; ++k) {
        bf16x8 n0 = b0, n1 = b1;
        if (k < 11) { n0 = *reinterpret_cast<const bf16x8*>(kb + (k + 1) * 32); n1 = *reinterpret_cast<const bf16x8*>(kb + (k + 1) * 32 + 32 * KPITCH); }
        if (k == 0) { C0 = __builtin_amdgcn_mfma_f32_32x32x16_bf16(b0, qr[0], negm, 0, 0, 0); C1 = __builtin_amdgcn_mfma_f32_32x32x16_bf16(b1, qr[0], negm, 0, 0, 0); }
        else { C0 = __builtin_amdgcn_mfma_f32_32x32x16_bf16(b0, qr[k], C0, 0, 0, 0); C1 = __builtin_amdgcn_mfma_f32_32x32x16_bf16(b1, qr[k], C1, 0, 0, 0); }
        if (k < 8) { float e0 = __builtin_amdgcn_exp2f(P1[2 * k]), e1 = __builtin_amdgcn_exp2f(P1[2 * k + 1]);
            if (k == 0) { a0 = P0[0]; a1 = P0[1]; } else { a0 += P0[2 * k]; a1 += P0[2 * k + 1]; }
            w[k] = cvtpk2(P0[2 * k], P0[2 * k + 1]);
            asm volatile("" : "+v"(e0), "+v"(e1), "+v"(a0), "+v"(a1), "+v"(w[k]));
            P1[2 * k] = e0; P1[2 * k + 1] = e1; }
        else { const int e = 4 * (k - 8);
            if (k == 8) { c0 = P1[0] + P1[2]; c1 = P1[1] + P1[3]; } else { c0 += P1[e]; c1 += P1[e + 1]; c0 += P1[e + 2]; c1 += P1[e + 3]; }
            w[8 + 2 * (k - 8)] = cvtpk2(P1[e], P1[e + 1]); w[9 + 2 * (k - 8)] = cvtpk2(P1[e + 2], P1[e + 3]);
            asm volatile("" : "+v"(c0), "+v"(c1), "+v"(w[8 + 2 * (k - 8)]), "+v"(w[9 + 2 * (k - 8)])); }
        SBAR();
        b0 = n0; b1 = n1;
    }
    l_reg = l_reg * alP + half_sum((a0 + a1) + (c0 + c1));
    { u32x4 w0 = {w[0], w[1], w[2], w[3]}, w1 = {w[4], w[5], w[6], w[7]}, w2 = {w[8], w[9], w[10], w[11]}, w3 = {w[12], w[13], w[14], w[15]};
      pa0 = *reinterpret_cast<bf16x8*>(&w0); pa1 = *reinterpret_cast<bf16x8*>(&w1); pa2 = *reinterpret_cast<bf16x8*>(&w2); pa3 = *reinterpret_cast<bf16x8*>(&w3); }
}
__device__ __forceinline__ void max_head(const f32x16& p0, const f32x16& p1, float& a, float& b, float& c, float& e) {
    a = max3f(p0[0], p0[1], p0[2]); b = max3f(p0[9], p0[10], p0[11]); c = max3f(p1[0], p1[1], p1[2]); e = max3f(p1[9], p1[10], p1[11]);
    a = max3f(a, p0[3], p0[4]); b = max3f(b, p0[12], p0[13]); c = max3f(c, p1[3], p1[4]); e = max3f(e, p1[12], p1[13]);
}
__device__ __forceinline__ float max_tail(const f32x16& p0, const f32x16& p1, float a, float b, float c, float e) {
    a = max3f(a, p0[5], p0[6]); b = max3f(b, p0[14], p0[15]); c = max3f(c, p1[5], p1[6]); e = max3f(e, p1[14], p1[15]);
    a = max3f(a, p0[7], p0[8]); c = max3f(c, p1[7], p1[8]);
    float pmax = max3f(a, b, c); pmax = max3f(pmax, e, e);
    auto rr = __builtin_amdgcn_permlane32_swap(__float_as_uint(pmax), __float_as_uint(pmax), false, false);
    return max3f(__uint_as_float(rr[0]), __uint_as_float(rr[1]), __uint_as_float(rr[1]));
}
struct Tensors { const bf16_t* QA; const bf16_t* KL; const bf16_t* WV; const bf16_t* GA; const bf16_t* OB; bf16_t* MIX; };
__device__ __forceinline__ void unit(int b, int h, int qb, const Tensors& T, char* shm, const int wave_id) {
    const int lane = pg8::lane_id_fresh(), wid = wave_id, r32 = lane & 31, hi = lane >> 5;
    const long rowbase = (long)b * SEQ; const int q0 = qb * 256;
    const unsigned lds0 = (unsigned)(uintptr_t)shm;
    float* wsf = (float*)(shm + LDS_WS) + wid * 64; float* al_l = wsf; float* li_l = wsf + 32;
    const char* klb = (const char*)(T.KL + rowbase * 192);
    unsigned koff0, koff1, koff2;
    { int s = 64 * wid + lane, row = s / 25, pos = s - 25 * row; koff0 = (unsigned)(row * 384 + (pos < 24 ? pos : 23) * 16);
      s += 512; row = s / 25; pos = s - 25 * row; koff1 = (unsigned)(row * 384 + (pos < 24 ? pos : 23) * 16);
      s += 512; row = s / 25; pos = s - 25 * row; koff2 = (unsigned)(row * 384 + (pos < 24 ? pos : 23) * 16); }
#define MLA_DMA(t) do { const unsigned kd_ = (unsigned)__builtin_amdgcn_readfirstlane(lds0 + LDS_K + ((t) & 3) * KSLOT + wid * 1024); const char* kb_ = klb + (size_t)(t) * 24576; \
        glds16s<0>(kb_, koff0, kd_); glds16s<0>(kb_, koff1, kd_ + 8192); glds16s<0>(kb_, koff2, kd_ + 16384); \
        if (wid == 0) { const int s_ = 1536 + lane, row_ = 61 + (lane >= 14) + (lane >= 39), pos_ = s_ - 25 * row_; glds16s<0>(kb_, (unsigned)(row_ * 384 + (pos_ < 24 ? pos_ : 23) * 16), kd_ + 24576); } } while (0)
    MLA_DMA(0); MLA_DMA(1);
    bf16x8 qr[12];
    { const bf16_t* Qw = T.QA + (rowbase + q0 + wid * 32 + r32) * 1536 + h * 192 + hi * 8;
#pragma unroll
      for (int d0 = 0; d0 < 12; ++d0) qr[d0] = *reinterpret_cast<const bf16x8*>(Qw + d0 * 16); }
    const int vb0 = (int)(lds0 + LDS_K) + MLA_V_BASE(lane);
    float l_reg = 0.f; f32x16 o[4] = {};
    f32x16 negm = {}; asm volatile("" : "+v"(negm));
    f32x16 pA0, pA1, pB0, pB1; float alA, alB; bf16x8 pa0, pa1, pa2, pa3;
#if MLA_OT
#define MLA_RESC(a) do { if (__any((a) < 1.f)) { _Pragma("unroll") for (int d = 0; d < 4; ++d) _Pragma("unroll") for (int r = 0; r < 16; ++r) o[d][r] *= (a); } } while (0)
#else
#define MLA_RESC(a) do { if (__any((a) < 1.f)) { if (hi == 0) al_l[r32] = (a); asm volatile("s_waitcnt lgkmcnt(0)" ::: "memory"); \
        _Pragma("unroll") for (int d = 0; d < 4; ++d) _Pragma("unroll") for (int r = 0; r < 16; ++r) o[d][r] *= al_l[crow(r, hi)]; } } while (0)
#endif
#define ATT_BAR_L() asm volatile("s_waitcnt lgkmcnt(0)\n\ts_barrier" ::: "memory")
    ATT_WAIT_BAR(0);
    if (wid >= 4) ATT_BAR_L();
    qkt<12, KPITCH, 16>(pA0, pA1, shm + LDS_K, qr, r32, hi); ATT_WAIT_BAR(0);
    MLA_DMA(2); partialSM<true>(pA0, pA1, negm, alA); ATT_BAR_L();
#define MLA_STEP(C0, C1, P0, P1, alC, alP, t, HASN) do { \
        h1_qk_finish(C0, C1, P0, P1, negm, shm + LDS_K + ((t) & 3) * KSLOT, qr, r32, hi, alP, l_reg, pa0, pa1, pa2, pa3); SBAR(); ATT_WAIT_BAR(0); \
        { const int vb_ = vb0 + (((t) - 1) & 3) * KSLOT; float ma_, mb_, mc_, me_, pmx_; \
          { PvFrag f_; MLA_PV_ISSUE<0>(f_, vb_); if (HASN) { MLA_DMA((t) + 2); } max_head(C0, C1, ma_, mb_, mc_, me_); SBAR(); MLA_PV_MMA(o[0], f_, pa0, pa1, pa2, pa3); } \
          { PvFrag f_; MLA_PV_ISSUE<1>(f_, vb_); pmx_ = max_tail(C0, C1, ma_, mb_, mc_, me_); SBAR(); MLA_PV_MMA(o[1], f_, pa0, pa1, pa2, pa3); } \
          alC = 1.f; \
          if (!__builtin_expect(__all(pmx_ <= THR), 1)) { const float dl_ = fmaxf(pmx_, 0.f); alC = __builtin_amdgcn_exp2f(-dl_); \
              _Pragma("unroll") for (int r_ = 0; r_ < 16; ++r_) { C0[r_] -= dl_; C1[r_] -= dl_; negm[r_] -= dl_; } asm volatile("" : "+v"(negm)); } \
          { PvFrag f_; MLA_PV_ISSUE<2>(f_, vb_); _Pragma("unroll") for (int r_ = 0; r_ < 8; ++r_) C0[r_] = __builtin_amdgcn_exp2f(C0[r_]); asm volatile("" : "+v"(C0)); SBAR(); MLA_PV_MMA(o[2], f_, pa0, pa1, pa2, pa3); } \
          { PvFrag f_; MLA_PV_ISSUE<3>(f_, vb_); _Pragma("unroll") for (int r_ = 8; r_ < 16; ++r_) C0[r_] = __builtin_amdgcn_exp2f(C0[r_]); asm volatile("" : "+v"(C0)); SBAR(); MLA_PV_MMA(o[3], f_, pa0, pa1, pa2, pa3); } } \
        SBAR(); ATT_BAR_L(); MLA_RESC(alC); } while (0)
    for (int t = 1; t + 1 < NTILE; t += 2) {
        MLA_STEP(pB0, pB1, pA0, pA1, alB, alA, t, true);
        MLA_STEP(pA0, pA1, pB0, pB1, alA, alB, t + 1, (t + 3 < NTILE));
    }
    { qkt_c<12, KPITCH, 16>(pB0, pB1, negm, shm + LDS_K + ((NTILE - 1) & 3) * KSLOT, qr, r32, hi);
      finishSM(pA0, pA1, alA, l_reg, pa0, pa1, pa2, pa3); SBAR(); ATT_WAIT_BAR(0);
      { const int vb_ = vb0 + ((NTILE - 2) & 3) * KSLOT; MLA_PV_ONE<0>(o[0], vb_, pa0, pa1, pa2, pa3); MLA_PV_ONE<1>(o[1], vb_, pa0, pa1, pa2, pa3); MLA_PV_ONE<2>(o[2], vb_, pa0, pa1, pa2, pa3); MLA_PV_ONE<3>(o[3], vb_, pa0, pa1, pa2, pa3); }
      partialSM<false>(pB0, pB1, negm, alB);
      ATT_BAR_L(); MLA_RESC(alB);
      finishSM(pB0, pB1, alB, l_reg, pa0, pa1, pa2, pa3); SBAR();
      { const int vb_ = vb0 + ((NTILE - 1) & 3) * KSLOT; MLA_PV_ONE<0>(o[0], vb_, pa0, pa1, pa2, pa3); MLA_PV_ONE<1>(o[1], vb_, pa0, pa1, pa2, pa3); MLA_PV_ONE<2>(o[2], vb_, pa0, pa1, pa2, pa3); MLA_PV_ONE<3>(o[3], vb_, pa0, pa1, pa2, pa3); } }
    if (wid < 4) ATT_BAR_L();
#if MLA_OT
    { const float rl = __builtin_amdgcn_rcpf(l_reg);
      bf16x8 pb[8];
#pragma unroll
      for (int ks = 0; ks < 8; ++ks) { const int bl = ks >> 1, b8 = (ks & 1) * 8;
          u32x4 w = {cvtpk(o[bl][b8 + 0] * rl, o[bl][b8 + 1] * rl), cvtpk(o[bl][b8 + 2] * rl, o[bl][b8 + 3] * rl), cvtpk(o[bl][b8 + 4] * rl, o[bl][b8 + 5] * rl), cvtpk(o[bl][b8 + 6] * rl, o[bl][b8 + 7] * rl)};
          pb[ks] = *reinterpret_cast<bf16x8*>(&w); }
      const bf16_t* wv = T.WV + ((size_t)(h * 128 + r32) * 128 + hi * 8);
      const size_t rowoff = (size_t)(rowbase + q0 + wid * 32 + r32) * 1024 + h * 128 + 4 * hi;
#pragma unroll
      for (int db = 0; db < 4; ++db) { f32x16 oa = f32x16{};
#pragma unroll
          for (int ks = 0; ks < 8; ++ks) { const bf16x8 bw = *reinterpret_cast<const bf16x8*>(wv + (size_t)db * 32 * 128 + ks * 16);
              oa = __builtin_amdgcn_mfma_f32_32x32x16_bf16(bw, pb[ks], oa, 0, 0, 0); }
#pragma unroll
          for (int g = 0; g < 4; ++g) { const size_t off = rowoff + db * 32 + 8 * g;
              const pg8::u32x2 ga = *reinterpret_cast<const pg8::u32x2*>(T.GA + off), ob = *reinterpret_cast<const pg8::u32x2*>(T.OB + off);
              const float v0 = oa[4 * g + 0] * __uint_as_float(ga.x << 16) + __uint_as_float(ob.x << 16), v1 = oa[4 * g + 1] * __uint_as_float(ga.x & 0xffff0000u) + __uint_as_float(ob.x & 0xffff0000u);
              const float v2 = oa[4 * g + 2] * __uint_as_float(ga.y << 16) + __uint_as_float(ob.y << 16), v3 = oa[4 * g + 3] * __uint_as_float(ga.y & 0xffff0000u) + __uint_as_float(ob.y & 0xffff0000u);
              pg8::u32x2 w; w.x = cvtpk(v0, v1); w.y = cvtpk(v2, v3); *reinterpret_cast<pg8::u32x2*>(T.MIX + off) = w; } } }
#else
    if (hi == 0) li_l[r32] = l_reg; asm volatile("s_waitcnt lgkmcnt(0)" ::: "memory");
    ATT_BAR_L();
    { char* stg = shm + LDS_K + wid * OST_WAVE;
#if MLA_OT
#pragma unroll
      for (int r = 0; r < 16; ++r) { const float rl = __builtin_amdgcn_rcpf(l_reg);
#pragma unroll
          for (int d0 = 0; d0 < 4; ++d0) *(bf16_t*)(stg + r32 * OST_PITCH + (d0 * 32 + crow(r, hi)) * 2) = f2bf(o[d0][r] * rl); }
#else
#pragma unroll
      for (int r = 0; r < 16; ++r) { const float rl = __builtin_amdgcn_rcpf(li_l[crow(r, hi)]);
#pragma unroll
          for (int d0 = 0; d0 < 4; ++d0) *(bf16_t*)(stg + crow(r, hi) * OST_PITCH + (d0 * 32 + r32) * 2) = f2bf(o[d0][r] * rl); }
#endif
      asm volatile("s_waitcnt lgkmcnt(0)" ::: "memory");
      bf16x8 af[8];
#pragma unroll
      for (int ks = 0; ks < 8; ++ks) af[ks] = *reinterpret_cast<const bf16x8*>(stg + r32 * OST_PITCH + ks * 32 + hi * 16);
      const bf16_t* wv = T.WV + ((size_t)(h * 128 + r32) * 128 + hi * 8);
#pragma unroll
      for (int d0 = 0; d0 < 4; ++d0) { o[d0] = f32x16{};
#pragma unroll
          for (int ks = 0; ks < 8; ++ks) { const bf16x8 bw = *reinterpret_cast<const bf16x8*>(wv + (size_t)d0 * 32 * 128 + ks * 16);
              o[d0] = __builtin_amdgcn_mfma_f32_32x32x16_bf16(af[ks], bw, o[d0], 0, 0, 0); } } }
    const long orow0 = rowbase + q0 + wid * 32;
#pragma unroll
    for (int r = 0; r < 16; ++r) { const long off = (orow0 + crow(r, hi)) * 1024 + h * 128 + r32;
#pragma unroll
        for (int d0 = 0; d0 < 4; ++d0) { const float v = o[d0][r] * bf2f(T.GA[off + d0 * 32]) + bf2f(T.OB[off + d0 * 32]); T.MIX[off + d0 * 32] = f2bf(v); } }
#endif
    asm volatile("s_waitcnt lgkmcnt(0)\n\ts_barrier" ::: "memory");
#undef MLA_DMA
#undef MLA_RESC
#undef ATT_BAR_L
#undef MLA_STEP
#undef MLA_PV_ISSUE
#undef MLA_PV_MMA
#undef MLA_PV_ONE
#undef MLA_V_BASE
}
}

namespace mla2 {
using mla::NTILE; using mla::KPITCH; using mla::KSLOT; using mla::THR; using mla::OST_PITCH; using mla::OST_WAVE;
constexpr int NSLOT = 3;
constexpr int LDS_K = 0, LDS_P = NSLOT * KSLOT  , LDS_X = LDS_P + 65536  , LDS_BYTES = LDS_X + 4096;
static_assert(8 * OST_WAVE <= NSLOT * KSLOT, "o_lat staging fits the ring");
using mla::Tensors;
__device__ __forceinline__ void softmax_block(f32x16& p0, f32x16& p1, float& m_reg, float& l_reg, float& alpha, bf16x8& pa0, bf16x8& pa1, bf16x8& pa2, bf16x8& pa3) {
    float pm0 = fmaxf(p0[0], p0[1]), pm1 = fmaxf(p0[2], p0[3]), pm2 = fmaxf(p1[0], p1[1]), pm3 = fmaxf(p1[2], p1[3]);
#pragma unroll
    for (int r = 4; r < 16; r += 4) { pm0 = fmaxf(fmaxf(pm0, p0[r]), p0[r + 1]); pm1 = fmaxf(fmaxf(pm1, p0[r + 2]), p0[r + 3]); pm2 = fmaxf(fmaxf(pm2, p1[r]), p1[r + 1]); pm3 = fmaxf(fmaxf(pm3, p1[r + 2]), p1[r + 3]); }
    const float pmax = half_max(fmaxf(fmaxf(pm0, pm1), fmaxf(pm2, pm3)));
    const bool keep = __all(pmax - m_reg <= THR);
    const float mn = keep ? m_reg : fmaxf(m_reg, pmax); alpha = __builtin_amdgcn_exp2f(m_reg - mn); m_reg = mn;
#pragma unroll
    for (int r = 0; r < 16; ++r) { p0[r] = __builtin_amdgcn_exp2f(p0[r] - mn); p1[r] = __builtin_amdgcn_exp2f(p1[r] - mn); }
    float s0 = p0[0] + p0[1], s1 = p0[2] + p0[3], s2 = p1[0] + p1[1], s3 = p1[2] + p1[3];
#pragma unroll
    for (int r = 4; r < 16; r += 4) { s0 += p0[r]; s0 += p0[r + 1]; s1 += p0[r + 2]; s1 += p0[r + 3]; s2 += p1[r]; s2 += p1[r + 1]; s3 += p1[r + 2]; s3 += p1[r + 3]; }
    l_reg = l_reg * alpha + half_sum((s0 + s1) + (s2 + s3));
    pack_p(p0, p1, pa0, pa1, pa2, pa3);
}
__device__ __forceinline__ void out_block(const char* stg, const Tensors& T, int h, long orow0, int r32, int hi) {
    bf16x8 af[8];
#pragma unroll
    for (int ks = 0; ks < 8; ++ks) af[ks] = *reinterpret_cast<const bf16x8*>(stg + r32 * OST_PITCH + ks * 32 + hi * 16);
    const bf16_t* wv = T.WV + ((size_t)(h * 128 + r32) * 128 + hi * 8);
    f32x16 oa[4];
#pragma unroll
    for (int d0 = 0; d0 < 4; ++d0) { oa[d0] = f32x16{};
#pragma unroll
        for (int ks = 0; ks < 8; ++ks) { const bf16x8 bw = *reinterpret_cast<const bf16x8*>(wv + (size_t)d0 * 32 * 128 + ks * 16);
            oa[d0] = __builtin_amdgcn_mfma_f32_32x32x16_bf16(af[ks], bw, oa[d0], 0, 0, 0); } }
#pragma unroll
    for (int r = 0; r < 16; ++r) { const long off = (orow0 + crow(r, hi)) * 1024 + h * 128 + r32;
#pragma unroll
        for (int d0 = 0; d0 < 4; ++d0) { const float v = oa[d0][r] * bf2f(T.GA[off + d0 * 32]) + bf2f(T.OB[off + d0 * 32]); T.MIX[off + d0 * 32] = f2bf(v); } }
}
__device__ __forceinline__ void unit(int b, int h, int qb, const Tensors& T, char* shm, const int wave_id) {
    const int lane = pg8::lane_id_fresh(), wid = wave_id, r32 = lane & 31, hi = lane >> 5;
    const bool is_qk = wid < 4; const int pair = wid & 3;
    const long rowbase = (long)b * SEQ; const int q0 = qb * 256;
    const unsigned lds0 = (unsigned)(uintptr_t)shm;
    char* Pp = shm + LDS_P + pair * 8192; char* Xp = shm + LDS_X + pair * 1024;
    float* alx = (float*)Xp; float* lx = (float*)(Xp + 512); unsigned* fx = (unsigned*)(Xp + 768);
#define M2_BAR() asm volatile("s_waitcnt vmcnt(0) lgkmcnt(0)\n\ts_barrier" ::: "memory")
    const char* klb = (const char*)(T.KL + rowbase * 192);
#define M2_PIECE(kb_, p_, dst_) do { const int s_ = 64 * (p_) + lane, row_ = (s_ * 1311) >> 15, pos_ = s_ - 25 * row_; \
        glds16s<0>(kb_, (unsigned)(row_ * 384 + (pos_ < 24 ? pos_ : 23) * 16), (unsigned)__builtin_amdgcn_readfirstlane(dst_ + (p_) * 1024)); } while (0)
#define M2_DMA(t) do { const unsigned sd_ = lds0 + LDS_K + ((t) % 3) * KSLOT; const char* kb_ = klb + (size_t)(t) * 24576; \
        _Pragma("unroll") for (int i_ = 0; i_ < 6; ++i_) M2_PIECE(kb_, pair + 4 * i_, sd_); if (pair == 0) M2_PIECE(kb_, 24, sd_); } while (0)
    const int vb0 = (int)(lds0 + LDS_K) + mla::v_rm_base(lane);
#define M2_BAR_L() asm volatile("s_waitcnt lgkmcnt(0)\n\ts_barrier" ::: "memory")
    if (is_qk) {
        bf16x8 qA[12], qB[12]; float mA = -1e30f, mB = -1e30f, lA = 0.f, lB = 0.f;
        { const bf16_t* Qw = T.QA + (rowbase + q0 + pair * 64 + r32) * 1536 + h * 192 + hi * 8;
#pragma unroll
          for (int d0 = 0; d0 < 12; ++d0) { qA[d0] = *reinterpret_cast<const bf16x8*>(Qw + d0 * 16); qB[d0] = *reinterpret_cast<const bf16x8*>(Qw + 32 * 1536 + d0 * 16); } }
        f32x16 pA0, pA1, pB0, pB1;
        char* pw = Pp + lane * 16;
#define M2_QK(P0, P1, Q, t) do { P0 = f32x16{}; P1 = f32x16{}; const char* kb_ = shm + LDS_K + ((t) % 3) * KSLOT + hi * 16 + r32 * KPITCH; \
        _Pragma("unroll") for (int d0 = 0; d0 < 12; ++d0) { const bf16x8 b0_ = *reinterpret_cast<const bf16x8*>(kb_ + d0 * 32), b1_ = *reinterpret_cast<const bf16x8*>(kb_ + d0 * 32 + 32 * KPITCH); \
            P0 = __builtin_amdgcn_mfma_f32_32x32x16_bf16(b0_, Q[d0], P0, 0, 0, 0); P1 = __builtin_amdgcn_mfma_f32_32x32x16_bf16(b1_, Q[d0], P1, 0, 0, 0); } } while (0)
#define M2_SM(P0, P1, M, L, BLK) do { bf16x8 a0_, a1_, a2_, a3_; float al_; softmax_block(P0, P1, M, L, al_, a0_, a1_, a2_, a3_); \
        *reinterpret_cast<bf16x8*>(pw + (BLK) * 4096) = a0_; *reinterpret_cast<bf16x8*>(pw + (BLK) * 4096 + 1024) = a1_; *reinterpret_cast<bf16x8*>(pw + (BLK) * 4096 + 2048) = a2_; *reinterpret_cast<bf16x8*>(pw + (BLK) * 4096 + 3072) = a3_; \
        const bool f_ = __any(al_ < 1.f); if (hi == 0) alx[(BLK) * 32 + r32] = al_; if (lane == 0) fx[BLK] = f_ ? 1u : 0u; } while (0)
        M2_BAR();
        M2_QK(pA0, pA1, qA, 0); M2_BAR_L();
        M2_QK(pB0, pB1, qB, 0); M2_SM(pA0, pA1, mA, lA, 0); M2_BAR_L();
        for (int t = 1; t < NTILE; ++t) {
            M2_QK(pA0, pA1, qA, t); M2_SM(pB0, pB1, mB, lB, 1); M2_BAR_L();
            M2_QK(pB0, pB1, qB, t); M2_SM(pA0, pA1, mA, lA, 0); M2_BAR_L();
        }
        M2_SM(pB0, pB1, mB, lB, 1); M2_BAR_L();
        M2_BAR_L();
        if (hi == 0) { lx[r32] = lA; lx[32 + r32] = lB; }
        M2_BAR();
        M2_BAR();
#undef M2_QK
#undef M2_SM
    } else {
        f32x16 oA[4] = {}, oB[4] = {};
        const char* pr = Pp + lane * 16;
#define M2_PVB(O, BLK, t1) do { const int vb_ = vb0 + ((t1) % 3) * KSLOT; \
        const bf16x8 a0_ = *reinterpret_cast<const bf16x8*>(pr + (BLK) * 4096), a1_ = *reinterpret_cast<const bf16x8*>(pr + (BLK) * 4096 + 1024), a2_ = *reinterpret_cast<const bf16x8*>(pr + (BLK) * 4096 + 2048), a3_ = *reinterpret_cast<const bf16x8*>(pr + (BLK) * 4096 + 3072); \
        if (fx[BLK] != 0u) { _Pragma("unroll") for (int d = 0; d < 4; ++d) _Pragma("unroll") for (int r = 0; r < 16; ++r) O[d][r] *= alx[(BLK) * 32 + crow(r, hi)]; } \
        mla::pvr_one<0>(O[0], vb_, a0_, a1_, a2_, a3_); mla::pvr_one<1>(O[1], vb_, a0_, a1_, a2_, a3_); mla::pvr_one<2>(O[2], vb_, a0_, a1_, a2_, a3_); mla::pvr_one<3>(O[3], vb_, a0_, a1_, a2_, a3_); } while (0)
        M2_DMA(0);
        M2_BAR();
        M2_DMA(1); M2_BAR_L();
        M2_BAR();
        for (int t = 1; t < NTILE; ++t) {
            if (t + 1 < NTILE) M2_DMA(t + 1);
            M2_PVB(oA, 0, t - 1); M2_BAR_L();
            M2_PVB(oB, 1, t - 1); M2_BAR();
        }
        M2_PVB(oA, 0, NTILE - 1); M2_BAR_L();
        M2_PVB(oB, 1, NTILE - 1); M2_BAR_L();
#undef M2_PVB
        M2_BAR();
        { char* stgA = shm + LDS_K + (2 * pair) * OST_WAVE; char* stgB = stgA + OST_WAVE;
#pragma unroll
          for (int r = 0; r < 16; ++r) { const float ra = __builtin_amdgcn_rcpf(lx[crow(r, hi)]), rb = __builtin_amdgcn_rcpf(lx[32 + crow(r, hi)]);
#pragma unroll
              for (int d0 = 0; d0 < 4; ++d0) { *(bf16_t*)(stgA + crow(r, hi) * OST_PITCH + (d0 * 32 + r32) * 2) = f2bf(oA[d0][r] * ra); *(bf16_t*)(stgB + crow(r, hi) * OST_PITCH + (d0 * 32 + r32) * 2) = f2bf(oB[d0][r] * rb); } } }
        M2_BAR();
    }
#undef M2_BAR_L
    { const char* stg = shm + LDS_K + (2 * pair + (is_qk ? 1 : 0)) * OST_WAVE;
      out_block(stg, T, h, rowbase + q0 + pair * 64 + (is_qk ? 32 : 0), r32, hi); }
    asm volatile("s_waitcnt lgkmcnt(0)\n\ts_barrier" ::: "memory");
#undef M2_BAR
#undef M2_PIECE
#undef M2_DMA
}
}

namespace swa {
constexpr int KP = 144  , KT = 64 * KP  ;
constexpr int LDS_K = 0;
struct Tensors { const bf16_t* QB; const bf16_t* KB; const bf16_t* VB; bf16_t* GOB; const float* BT2; const float* SINK2; };
__device__ __forceinline__ int vt_base64(int lane) { return ((lane & 3) << 3) | (((lane >> 2) & 3) << 6) | (((lane >> 4) & 1) << 5) | ((lane >> 5) << 10); }
template <int D0> __device__ __forceinline__ void pvt64(f32x16& od, int vb, bf16x8 pa0, bf16x8 pa1, bf16x8 pa2, bf16x8 pa3) {
    const s16x4 l0 = tr_read<D0 * 512 + 0 * 2048>(vb), h0 = tr_read<D0 * 512 + 0 * 2048 + 256>(vb), l1 = tr_read<D0 * 512 + 1 * 2048>(vb), h1 = tr_read<D0 * 512 + 1 * 2048 + 256>(vb);
    const s16x4 l2 = tr_read<D0 * 512 + 2 * 2048>(vb), h2 = tr_read<D0 * 512 + 2 * 2048 + 256>(vb), l3 = tr_read<D0 * 512 + 3 * 2048>(vb), h3 = tr_read<D0 * 512 + 3 * 2048 + 256>(vb);
    asm volatile("s_waitcnt lgkmcnt(0)" ::: "memory"); SBAR();
#define PK(L, H) (bf16x8){L[0], L[1], L[2], L[3], H[0], H[1], H[2], H[3]}
    od = __builtin_amdgcn_mfma_f32_32x32x16_bf16(PK(l0, h0), pa0, od, 0, 0, 0);
    od = __builtin_amdgcn_mfma_f32_32x32x16_bf16(PK(l1, h1), pa1, od, 0, 0, 0);
    od = __builtin_amdgcn_mfma_f32_32x32x16_bf16(PK(l2, h2), pa2, od, 0, 0, 0);
    od = __builtin_amdgcn_mfma_f32_32x32x16_bf16(PK(l3, h3), pa3, od, 0, 0, 0);
#undef PK
}
constexpr int NQB = 8, RING = 6;
constexpr int LDS_V = RING * KT, LDS_TAB = LDS_V + RING * 8192, LDS_BYTES = LDS_TAB + 4 * 4 * 384 * 4;
constexpr float THR = 8.f;
typedef float f32x8_t __attribute__((ext_vector_type(8)));
__device__ __forceinline__ f32x16 cat4(pg8::f32x4 a, pg8::f32x4 b, pg8::f32x4 c, pg8::f32x4 e) {
    const f32x8_t lo = __builtin_shufflevector(a, b, 0, 1, 2, 3, 4, 5, 6, 7), hi = __builtin_shufflevector(c, e, 0, 1, 2, 3, 4, 5, 6, 7);
    return __builtin_shufflevector(lo, hi, 0, 1, 2, 3, 4, 5, 6, 7, 8, 9, 10, 11, 12, 13, 14, 15); }
__device__ __forceinline__ void bias_init(f32x16& n0, f32x16& n1, const float* tb) { const pg8::f32x4* q = reinterpret_cast<const pg8::f32x4*>(tb);
    n0 = cat4(q[0], q[2], q[4], q[6]); n1 = cat4(q[8], q[10], q[12], q[14]); }
__device__ __forceinline__ void qk_acc(f32x16& n0, f32x16& n1, const char* Ks, const bf16x8* qr, int r32, int hi) {
    const char* kb = Ks + hi * 16 + r32 * KP;
#pragma unroll
    for (int d0 = 0; d0 < 4; ++d0) { const bf16x8 b0 = *reinterpret_cast<const bf16x8*>(kb + d0 * 32), b1 = *reinterpret_cast<const bf16x8*>(kb + d0 * 32 + 32 * KP);
        n0 = __builtin_amdgcn_mfma_f32_32x32x16_bf16(b0, qr[d0], n0, 0, 0, 0); n1 = __builtin_amdgcn_mfma_f32_32x32x16_bf16(b1, qr[d0], n1, 0, 0, 0); }
}
#ifdef TP_SWA
#define SWA_TSARG , unsigned long long (&ts)[6]
#else
#define SWA_TSARG
#endif
__device__ __forceinline__ void run(int b, int kvh, int j, const Tensors& T, char* shm, const int wave_id SWA_TSARG) {
    const int lane = pg8::lane_id_fresh(), wid = wave_id, tid = wid * 64 + lane, r32 = lane & 31, hi = lane >> 5;
    const int g = wid >> 1, rh = wid & 1, head = kvh * 4 + g;
    const long rowbase = (long)b * SEQ; const int qb0 = j * NQB;
    const unsigned lds0 = (unsigned)(uintptr_t)shm;
    unsigned vvoff, kvoff, kvoff8;
    { const int st = 2 * wid + (lane >> 5), kk = (st >> 1) * 8 + ((lane & 31) >> 2), k = swap23(kk), c = (st & 1) * 32 + (lane & 3) * 8;
      vvoff = (unsigned)((k * 256 + c) * 2);
      int s = 64 * wid + lane, row = s / 9, pos = s - 9 * row; kvoff = (unsigned)(row * 512 + (pos < 8 ? pos : 7) * 16); s = 512 + lane; row = s / 9; pos = s - 9 * row; kvoff8 = (unsigned)(row * 512 + (pos < 8 ? pos : 7) * 16); }
#define SWA_DMA(TT) do { const int s_ = (TT) % RING; const long kb_ = rowbase + 64 * (TT); \
        glds16s<0>((const char*)(T.KB + kb_ * 256 + kvh * 64), kvoff, (unsigned)__builtin_amdgcn_readfirstlane(lds0 + LDS_K + s_ * KT + wid * 1024)); \
        if (wid == 0) glds16s<0>((const char*)(T.KB + kb_ * 256 + kvh * 64), kvoff8, (unsigned)__builtin_amdgcn_readfirstlane(lds0 + LDS_K + s_ * KT + 8192)); \
        glds16s<0>((const char*)(T.VB + kb_ * 256 + kvh * 64), vvoff, (unsigned)__builtin_amdgcn_readfirstlane(lds0 + LDS_V + s_ * 8192 + wid * 1024)); } while (0)
#ifdef TP_SWA
#define SWA_TS(slot) do { ts[slot] = __builtin_amdgcn_s_memrealtime(); } while (0)
#else
#define SWA_TS(slot) do { } while (0)
#endif
    SWA_TS(0);
    for (int TT = qb0 - 2; TT <= qb0 + 2; ++TT) if (TT >= 0 && TT < SEQ / 64) SWA_DMA(TT);
    { float* tab = (float*)(shm + LDS_TAB); float tv[12];
#pragma unroll
      for (int x = 0; x < 12; ++x) { const int i = tid + 512 * x, gg = i / 1536, rel = i % 384 + ((i / 384) & 3) - 192; const int rc = rel < -128 ? -128 : (rel > 128 ? 128 : rel);
          tv[x] = T.BT2[(kvh * 4 + gg) * 264 + rc + 128]; }
#pragma unroll
      for (int x = 0; x < 12; ++x) { const int i = tid + 512 * x, rel = i % 384 + ((i / 384) & 3) - 192; tab[i] = (rel >= -128 && rel <= 128) ? tv[x] : -1e30f; } }
    bf16x8 qr[4];
    const bf16_t* Qw = T.QB + (rowbase + qb0 * 64 + rh * 32 + r32) * 1024 + head * 64 + hi * 8;
#pragma unroll
    for (int d0 = 0; d0 < 4; ++d0) qr[d0] = *reinterpret_cast<const bf16x8*>(Qw + d0 * 16);
    const float sink = T.SINK2[head];
    const int vb0 = (int)(lds0 + LDS_V) + vt_base64(lane);
    const float* tbl;
    { const int base = 64 - 32 * rh - r32 + 4 * hi, s = base & 3; tbl = (const float*)(shm + LDS_TAB) + (g * 4 + s) * 384 + (base - s); }
    ATT_WAIT_BAR(0);
    SWA_TS(1);
    for (int i = 0; i < NQB; ++i) {
        const int qb = qb0 + i;
        if (i == 4) SWA_TS(2);
        if (i + 1 < NQB && qb + 3 < SEQ / 64) SWA_DMA(qb + 3);
        bf16x8 qn[4];
        if (i + 1 < NQB) {
#pragma unroll
            for (int d0 = 0; d0 < 4; ++d0) qn[d0] = *reinterpret_cast<const bf16x8*>(Qw + (size_t)(i + 1) * 64 * 1024 + d0 * 16); }
        else {
#pragma unroll
            for (int d0 = 0; d0 < 4; ++d0) qn[d0] = qr[d0]; }
        bf16_t* orow = T.GOB + (size_t)(rowbase + qb * 64 + rh * 32 + r32) * 1024 + head * 64 + 4 * hi;
        pg8::u32x2 gt[8];
#pragma unroll
        for (int x = 0; x < 8; ++x) gt[x] = *reinterpret_cast<const pg8::u32x2*>(orow + (x >> 2) * 32 + 8 * (x & 3));
        float m_reg = sink, l_reg = 1.0f; f32x16 o[2] = {};
        const int t_lo = qb < 2 ? 2 - qb : 0, nt = (qb + 2 >= SEQ / 64 ? SEQ / 64 + 2 - qb : 5) - t_lo;
        f32x16 sa0, sa1, sb0, sb1;
        bias_init(sa0, sa1, tbl + 64 * t_lo); qk_acc(sa0, sa1, shm + LDS_K + ((qb - 2 + t_lo) % RING) * KT, qr, r32, hi);
#define SWA_TILE(C0, C1, N0, N1, k, HASN) do { const int t_ = t_lo + (k), sl_ = (qb - 2 + t_) % RING; const bool hasn_ = (HASN); \
            if (hasn_) bias_init(N0, N1, tbl + 64 * (t_ + 1)); \
            float pmax; { float a = max3f(C0[0], C0[1], C0[2]), b2 = max3f(C0[9], C0[10], C0[11]), c = max3f(C1[0], C1[1], C1[2]), e = max3f(C1[9], C1[10], C1[11]); \
              a = max3f(a, C0[3], C0[4]); b2 = max3f(b2, C0[12], C0[13]); c = max3f(c, C1[3], C1[4]); e = max3f(e, C1[12], C1[13]); \
              a = max3f(a, C0[5], C0[6]); b2 = max3f(b2, C0[14], C0[15]); c = max3f(c, C1[5], C1[6]); e = max3f(e, C1[14], C1[15]); \
              a = max3f(a, C0[7], C0[8]); c = max3f(c, C1[7], C1[8]); pmax = max3f(a, b2, c); pmax = max3f(pmax, e, e); \
              auto rr = __builtin_amdgcn_permlane32_swap(__float_as_uint(pmax), __float_as_uint(pmax), false, false); pmax = max3f(__uint_as_float(rr[0]), __uint_as_float(rr[1]), __uint_as_float(rr[1])); } \
            asm volatile("" : "+v"(pmax)); SBAR(); \
            if (hasn_) qk_acc(N0, N1, shm + LDS_K + ((qb - 1 + t_) % RING) * KT, qr, r32, hi); \
            SBAR(); \
            if (!__builtin_expect(__all(pmax - m_reg <= THR), 1)) { const float mn = fmaxf(m_reg, pmax), alpha = __builtin_amdgcn_exp2f(m_reg - mn); m_reg = mn; l_reg *= alpha; \
                _Pragma("unroll") for (int d_ = 0; d_ < 2; ++d_) _Pragma("unroll") for (int r_ = 0; r_ < 16; ++r_) o[d_][r_] *= alpha; } \
            bf16x8 pa0, pa1, pa2, pa3; \
            { float s0, s1, s2, s3; \
              _Pragma("unroll") for (int r_ = 0; r_ < 16; ++r_) { C0[r_] = __builtin_amdgcn_exp2f(C0[r_] - m_reg); C1[r_] = __builtin_amdgcn_exp2f(C1[r_] - m_reg); } \
              s0 = C0[0] + C0[1]; s1 = C0[2] + C0[3]; s2 = C1[0] + C1[1]; s3 = C1[2] + C1[3]; \
              _Pragma("unroll") for (int r_ = 4; r_ < 16; r_ += 4) { s0 += C0[r_]; s0 += C0[r_ + 1]; s1 += C0[r_ + 2]; s1 += C0[r_ + 3]; s2 += C1[r_]; s2 += C1[r_ + 1]; s3 += C1[r_ + 2]; s3 += C1[r_ + 3]; } \
              l_reg += half_sum((s0 + s1) + (s2 + s3)); } \
            { u32x4 w0 = SWA_PK(C0, 0), w1 = SWA_PK(C0, 8), w2 = SWA_PK(C1, 0), w3 = SWA_PK(C1, 8); \
              pa0 = *reinterpret_cast<bf16x8*>(&w0); pa1 = *reinterpret_cast<bf16x8*>(&w1); pa2 = *reinterpret_cast<bf16x8*>(&w2); pa3 = *reinterpret_cast<bf16x8*>(&w3); } \
            asm volatile("" : "+v"(pa0), "+v"(pa1), "+v"(pa2), "+v"(pa3), "+v"(l_reg)); SBAR(); \
            pvt64<0>(o[0], vb0 + sl_ * 8192, pa0, pa1, pa2, pa3); pvt64<1>(o[1], vb0 + sl_ * 8192, pa0, pa1, pa2, pa3); } while (0)
#define SWA_PK(P, B) (u32x4){cvtpk2(P[B], P[B + 1]), cvtpk2(P[B + 2], P[B + 3]), cvtpk2(P[B + 4], P[B + 5]), cvtpk2(P[B + 6], P[B + 7])}
        SWA_TILE(sa0, sa1, sb0, sb1, 0, true);
        SWA_TILE(sb0, sb1, sa0, sa1, 1, true);
        SWA_TILE(sa0, sa1, sb0, sb1, 2, nt > 3);
        if (nt > 3) { SWA_TILE(sb0, sb1, sa0, sa1, 3, nt > 4);
            if (nt > 4) SWA_TILE(sa0, sa1, sb0, sb1, 4, false); }
#undef SWA_PK
#undef SWA_TILE
        if (i == 4) SWA_TS(3);
        { const float rl = __builtin_amdgcn_rcpf(l_reg);
#pragma unroll
          for (int x = 0; x < 8; ++x) { const int d0 = x >> 2, gq = x & 3;
              const float v0 = o[d0][4 * gq + 0] * rl * __uint_as_float(gt[x].x << 16), v1 = o[d0][4 * gq + 1] * rl * __uint_as_float(gt[x].x & 0xffff0000u);
              const float v2 = o[d0][4 * gq + 2] * rl * __uint_as_float(gt[x].y << 16), v3 = o[d0][4 * gq + 3] * rl * __uint_as_float(gt[x].y & 0xffff0000u);
              pg8::u32x2 w; w.x = cvtpk(v0, v1); w.y = cvtpk(v2, v3); *reinterpret_cast<pg8::u32x2*>(orow + d0 * 32 + 8 * gq) = w; } }
#pragma unroll
        for (int d0 = 0; d0 < 4; ++d0) qr[d0] = qn[d0];
        asm volatile("s_waitcnt vmcnt(8) lgkmcnt(0)\n\ts_barrier" ::: "memory");
        if (i == 4) SWA_TS(4);
    }
    SWA_TS(5);
#undef SWA_DMA
#undef SWA_TS
}
}
#undef SBAR
#undef ATT_WAIT_BAR
}
constexpr int NWAVES = 8;
#ifndef MK_PER_PHASE
#define MK_PER_PHASE 0
#endif
constexpr int N_PHASES = 8;

constexpr size_t MiB = 1u << 20;
constexpr size_t WS_CTL = 0, CTL_ZERO_BYTES = 128 * 1024;
constexpr size_t WS_COS = 1 * MiB, WS_SIN = WS_COS + 512 * 1024;
constexpr size_t WS_BT2 = 2 * MiB, WS_SINK2 = WS_BT2 + 16 * 264 * 4;
constexpr size_t WS_SSQQ = 3 * MiB, WS_SSQKV = WS_SSQQ + 512 * 1024;
constexpr size_t WS_SSQ2 = 4 * MiB, WS_SSQ3 = 6 * MiB;
constexpr size_t WS_WIN = 8 * MiB, WS_WQB = 16 * MiB, WS_WVT = 17 * MiB, WS_WOUT = 18 * MiB, WS_WUP = 20 * MiB, WS_WDN = 31 * MiB;
constexpr size_t WS_A0 = 40 * MiB;
constexpr size_t WS_XN = WS_A0;
constexpr size_t WS_X1B = WS_A0;
constexpr size_t WS_QLAT = 104 * MiB, WS_KL = 120 * MiB  , WS_QB = 132 * MiB, WS_KB = 196 * MiB, WS_VB = 212 * MiB, WS_GA = 228 * MiB, WS_GB = 292 * MiB;
constexpr size_t WS_MIX = WS_QB;
constexpr size_t WS_HALO = 104 * MiB;
constexpr size_t WS_ACT = 296 * MiB;
constexpr size_t WS_END = 472 * MiB;
static_assert(WS_ACT + (size_t)MTOK * DFF * 2 <= WS_END && WS_HALO + (size_t)(MTOK / 64) * 4 * 5632 * 4 <= WS_ACT && WS_KL + (size_t)MTOK * 192 * 2 <= WS_QB, "d_ws map");
constexpr int CW_BAR = 4096;
static_assert((CW_BAR + 3456) * 4 <= 65536, "barrier words below the panel counters");
constexpr int CW_PANEL = 16384;

constexpr int RING_OFF = 0, RING_BYTES = 146432;
constexpr int LDSCTL_OFF = RING_BYTES, MISC_OFF = LDSCTL_OFF + 320;
constexpr int LDS_BYTES = 147456;
static_assert(att::mla::LDS_BYTES <= RING_BYTES && att::mla2::LDS_BYTES <= RING_BYTES && att::swa::LDS_BYTES <= RING_BYTES && pg8::STAGE_BYTES <= RING_BYTES && MISC_OFF + 64 <= LDS_BYTES, "LDS map");

#define GAS __attribute__((address_space(1)))
#define LAS __attribute__((address_space(3)))
typedef unsigned short bf16;
typedef unsigned v4u __attribute__((ext_vector_type(4)));
typedef float f32x4 __attribute__((ext_vector_type(4)));
typedef short bf16x8 __attribute__((ext_vector_type(8)));
typedef GAS unsigned gu32;
typedef GAS unsigned long long gu64;
#define RLX_AGENT __ATOMIC_RELAXED, __HIP_MEMORY_SCOPE_AGENT
#define LDS_WAIT() asm volatile("s_waitcnt lgkmcnt(0)" ::: "memory")
#define VM_WAIT() asm volatile("s_waitcnt vmcnt(0)" ::: "memory")
__device__ __forceinline__ unsigned long long rt() { return __builtin_amdgcn_s_memrealtime(); }
__device__ __forceinline__ unsigned f2bf(float f) { unsigned u = __builtin_bit_cast(unsigned, f); return (u + 0x7fffu + ((u >> 16) & 1u)) >> 16; }
__device__ __forceinline__ unsigned pk2(float lo, float hi) { return f2bf(lo) | (f2bf(hi) << 16); }

#define XB_TMO      128
#define XB_XCNT(j)  (256  + 64 * (j))
#define XB_XSUB(j)  (1280 + 64 * (j))
#define XB_XGEN(j)  (2304 + 64 * (j))
#define XB_TOP      3328
#define XB_TOPGEN   3392
#define XCD_BAR_WORDS 3456
#define XB_SPIN_CAP (1u << 18)

__device__ __forceinline__ unsigned xb_ld(unsigned* p)              { return __hip_atomic_load(p, __ATOMIC_RELAXED, __HIP_MEMORY_SCOPE_AGENT); }
__device__ __forceinline__ unsigned xb_add(unsigned* p, unsigned v) { return __hip_atomic_fetch_add(p, v, __ATOMIC_RELAXED, __HIP_MEMORY_SCOPE_AGENT); }
__device__ __forceinline__ unsigned xb_xcc_id() { return (unsigned)__builtin_amdgcn_s_getreg((3 << 11) | 20) & 0xFu; }
#define XB_SPIN(cond, bar) do { unsigned _sp = 0; while (cond) { __builtin_amdgcn_s_sleep(1); \
    if ((++_sp & 255u) == 0u) { if (xb_ld(&(bar)[XB_TMO])) break; if (_sp > XB_SPIN_CAP) { atomicAdd(&(bar)[XB_TMO], 1u); break; } } } } while (0)

struct XcdBarrier {
    unsigned* bar; unsigned x; int w;
    volatile LAS unsigned* st;
};

__device__ __forceinline__ XcdBarrier xcd_barrier_post(unsigned* bar, volatile LAS unsigned* st) {
    XcdBarrier b; b.bar = bar; b.x = xb_xcc_id(); b.st = st;
    if (threadIdx.x == 0) (void)xb_add(&bar[XB_XCNT(b.x)], 1u);
    return b;
}
__device__ __forceinline__ void xcd_barrier_complete(unsigned* bar, unsigned x, unsigned& nloc, unsigned& nx) {
    const unsigned G = gridDim.x * gridDim.y * gridDim.z;
    unsigned sum, cnt, mine, sp = 0u;
    for (;;) {
        sum = 0u; cnt = 0u; mine = 0u;
#pragma unroll
        for (unsigned j = 0; j < 16; ++j) { const unsigned c = xb_ld(&bar[XB_XCNT(j)]); sum += c; cnt += (c > 0u) ? 1u : 0u; mine = (j == x) ? c : mine; }
        if (sum == G) break;
        __builtin_amdgcn_s_sleep(1);
        if ((++sp & 255u) == 0u) { if (xb_ld(&bar[XB_TMO])) break; if (sp > XB_SPIN_CAP) { atomicAdd(&bar[XB_TMO], 1u); break; } }
    }
    nloc = mine > 0u ? mine : 1u; nx = cnt > 0u ? cnt : 1u;
}

__device__ __forceinline__ void xcd_barrier(const XcdBarrier& b) {
    asm volatile("s_waitcnt vmcnt(0)" ::: "memory");
    __syncthreads();
    if (b.w == 0 && pg8::lane_id_fresh() == 0) {
        unsigned* bar = b.bar;
        __builtin_amdgcn_s_waitcnt(0);
        unsigned nloc = b.st[0], nx = b.st[1];
        if (nloc == 0u) { xcd_barrier_complete(bar, b.x, nloc, nx); b.st[0] = nloc; b.st[1] = nx; }
        const unsigned old = xb_add(&bar[XB_XSUB(b.x)], 1u);
        const unsigned gen = old / nloc;
        if (old + 1u == (gen + 1u) * nloc) {
            __builtin_amdgcn_fence(__ATOMIC_RELEASE, "agent");
            asm volatile("s_waitcnt vmcnt(0)" ::: "memory");
            const unsigned og = xb_add(&bar[XB_TOP], 1u);
            const unsigned tg = og / nx;
            if (og + 1u == (tg + 1u) * nx) xb_add(&bar[XB_TOPGEN], 1u);
            else XB_SPIN(xb_ld(&bar[XB_TOPGEN]) == tg, bar);
            __builtin_amdgcn_fence(__ATOMIC_ACQUIRE, "agent");
            xb_add(&bar[XB_XGEN(b.x)], 1u);
            asm volatile("s_waitcnt vmcnt(0)" ::: "memory");
        } else {
            XB_SPIN(xb_ld(&bar[XB_XGEN(b.x)]) == gen, bar);
            __builtin_amdgcn_fence(__ATOMIC_ACQUIRE, "agent");
            asm volatile("s_waitcnt vmcnt(0)" ::: "memory");
        }
    }
    __syncthreads();
}

struct Frame {
    LAS unsigned char* lds; volatile LAS unsigned* MISC; gu32* ctl;
    int wave, vcu, G;
};
__device__ __forceinline__ float wave_sum(float v) {
#pragma unroll
    for (int o = 1; o < 64; o <<= 1) v += __shfl_xor(v, o);
    return v;
}
template <class RowMap>
__device__ __forceinline__ void p0_transpose_item(const float* W, int K, int N, bf16* WT, const float* kscale, const RowMap& rm, LAS float* scr, int item, int lane) {
    const int nblk = N / 32, kb = item / nblk, nb = item % nblk, k0 = 64 * kb, n0 = 32 * nb;
#pragma unroll 8
    for (int i = 0; i < 32; ++i) { const int kk = 2 * i + (lane >> 5); const float sc = kscale ? kscale[k0 + kk] : 1.0f; scr[kk * 33 + (lane & 31)] = W[(size_t)(k0 + kk) * N + n0 + (lane & 31)] * sc; }
    LDS_WAIT(); asm volatile("" ::: "memory");
    const int c = lane & 7;
#pragma unroll
    for (int j = 0; j < 4; ++j) { const int n = (lane >> 3) + 8 * j; const LAS float* s = scr + (8 * c) * 33 + n;
        v4u o; o.x = pk2(s[0 * 33], s[1 * 33]); o.y = pk2(s[2 * 33], s[3 * 33]); o.z = pk2(s[4 * 33], s[5 * 33]); o.w = pk2(s[6 * 33], s[7 * 33]);
        const int rr = rm(n0 + n); if (rr >= 0) *(GAS v4u*)(WT + (size_t)rr * K + k0 + 8 * c) = o; }
    LDS_WAIT(); asm volatile("" ::: "memory");
}
struct MapIdent { __device__ __forceinline__ int operator()(int n) const { return n; } };
struct MapWin { __device__ __forceinline__ int operator()(int n) const {
    if (n < 256) return n; if (n >= 448) return n + 64; const int j = n - 256; if (j < 128) return 256 + j; const int d = j - 128; return 384 + (d < 32 ? 2 * d : 2 * (d - 32) + 1); } };
struct MapWqb { __device__ __forceinline__ int operator()(int n) const {
    const int h = n / 192, d = n % 192; if (d < 128) return -1  ; const int r = d - 128; return 1024 + h * 64 + (r < 32 ? 2 * r : 2 * (r - 32) + 1); } };
struct MapWup { __device__ __forceinline__ int operator()(int n) const {
    const int v = n >= DFF, c = v ? n - DFF : n; return 256 * (c >> 7) + 128 * v + (c & 127); } };

__device__ __forceinline__ int t5_bucket(int rel) {
    const int n = rel < 0 ? -rel : rel; int bk;
    if (n < 8) bk = n; else { const int e = (31 - __builtin_clz((unsigned)(n * n))) - 6; bk = 8 + e; if (bk > 15) bk = 15; }
    return (rel > 0 ? 16 : 0) + bk;
}
#ifndef MLA_SPLIT
#define MLA_SPLIT 0
#endif
struct Args {
    const float* x; const int* positions; const float* norm1_g; const float* w_in; const float* q_a_norm_g; const float* w_q_b; const float* kv_a_norm_g; const float* w_kv_b;
    const float* rel_bias; const float* sinks; const float* w_out; const float* norm2_g; const float* w_up; const float* conv_w; const float* conv_b; const float* w_down; const float* final_norm_g;
    float* out; unsigned char* ws; int ph_lo, ph_hi;
};

__device__ __forceinline__ void p0_prologue(Frame& F, const Args& a) {
    unsigned char* ws = a.ws;
    LAS float* scr = (LAS float*)(F.lds + RING_OFF + F.wave * 16384);
    const int lane = pg8::lane_id_fresh();
    const int gw = F.vcu * NWAVES + F.wave, NGW = F.G * NWAVES;
    constexpr int I_IN = (1024 / 64) * (4032 / 32), I_QB = (256 / 64) * (1536 / 32), I_OUT = (1024 / 64) * (1024 / 32), I_UP = (1024 / 64) * (5632 / 32), I_DN = (DFF / 64) * (1024 / 32);
    constexpr int NITEMS = I_IN + I_QB + I_OUT + I_UP + I_DN;
#ifndef P0DUP
#define P0DUP 0
#endif
    for (int rp_ = 0; rp_ <= (P0DUP & 1); ++rp_)
    for (int it = gw; it < NITEMS; it += NGW) {
        int r = it;
        if (r < I_IN) { p0_transpose_item(a.w_in, 1024, 4032, (bf16*)(ws + WS_WIN), nullptr, MapWin(), scr, r, lane); continue; } r -= I_IN;
        if (r < I_QB) { p0_transpose_item(a.w_q_b, 256, 1536, (bf16*)(ws + WS_WQB), a.q_a_norm_g, MapWqb(), scr, r, lane); continue; } r -= I_QB;
        if (r < I_OUT) { p0_transpose_item(a.w_out, 1024, 1024, (bf16*)(ws + WS_WOUT), nullptr, MapIdent(), scr, r, lane); continue; } r -= I_OUT;
        if (r < I_UP) { p0_transpose_item(a.w_up, 1024, 5632, (bf16*)(ws + WS_WUP), a.norm2_g, MapWup(), scr, r, lane); continue; } r -= I_UP;
        p0_transpose_item(a.w_down, DFF, 1024, (bf16*)(ws + WS_WDN), nullptr, MapIdent(), scr, r, lane);
    }
    const int gt = gw * 64 + lane, NGT = NGW * 64;
    for (int rp_ = 0; rp_ <= ((P0DUP >> 2) & 1); ++rp_)
    for (int i = gt; i < 1024 * 256; i += NGT) { const int row = i >> 8, j = i & 255, hh = row >> 7, c = row & 127;
        const f32x4* qp = (const f32x4*)(a.w_q_b + (size_t)j * 1536 + hh * 192); const f32x4* kp = (const f32x4*)(a.w_kv_b + (size_t)c * 2048 + hh * 256);
        float s0 = 0.f, s1 = 0.f;
#pragma unroll 8
        for (int d4 = 0; d4 < 32; ++d4) { const f32x4 x = qp[d4], y = kp[d4]; s0 += x[0] * y[0] + x[1] * y[1]; s1 += x[2] * y[2] + x[3] * y[3]; }
        ((bf16*)(ws + WS_WQB))[i] = (bf16)f2bf((s0 + s1) * a.q_a_norm_g[j] * a.kv_a_norm_g[c]); }
    for (int i = gt; i < 8 * 128 * 128; i += NGT) { const int hh = i >> 14, dd = (i >> 7) & 127, cp = i & 127, c = MLA_OT ? ((cp & ~0xC) | ((cp & 4) << 1) | ((cp & 8) >> 1)) : cp;
        ((bf16*)(ws + WS_WVT))[i] = (bf16)f2bf(a.w_kv_b[(size_t)c * 2048 + hh * 256 + 128 + dd] * a.kv_a_norm_g[c]); }
    for (int i = gt; i < 64 * 1024 / 8; i += NGT) *(GAS v4u*)((bf16*)(ws + WS_WIN) + (size_t)448 * 1024 + (size_t)i * 8) = (v4u){0u, 0u, 0u, 0u};
    for (int rp_ = 0; rp_ <= ((P0DUP >> 3) & 1); ++rp_)
    for (int i = gt; i < SEQ * 32; i += NGT) { const int s = i >> 5, d = i & 31;
        const float invf = __builtin_amdgcn_exp2f(-(float)d * (13.287712379549449f / 32.0f));
        const float ang = (float)a.positions[s] * invf;
        const double rev = (double)ang * 0.15915494309189535; const float fr = (float)(rev - __builtin_rint(rev));
        ((float*)(ws + WS_COS))[i] = __builtin_amdgcn_cosf(fr); ((float*)(ws + WS_SIN))[i] = __builtin_amdgcn_sinf(fr); }
    for (int i = gt; i < 16 * 264; i += NGT) { const int h = i / 264, j = i % 264; float v = 0.f; if (j <= 256) v = a.rel_bias[t5_bucket(j - 128) * 16 + h] * LOG2E; ((float*)(ws + WS_BT2))[i] = v; }
    if (gt < 16) ((float*)(ws + WS_SINK2))[gt] = a.sinks[gt] * LOG2E;
    for (int rp_ = 0; rp_ <= ((P0DUP >> 1) & 1); ++rp_)
    for (int m = gw; m < MTOK; m += NGW) {
        const GAS f32x4* xr = (const GAS f32x4*)(a.x + (size_t)m * DM) + lane; const GAS f32x4* gr = (const GAS f32x4*)a.norm1_g + lane;
        f32x4 v[4]; float s = 0.f;
#pragma unroll
        for (int j = 0; j < 4; ++j) { v[j] = xr[64 * j]; s += (v[j].x * v[j].x + v[j].y * v[j].y) + (v[j].z * v[j].z + v[j].w * v[j].w); }
        const float rs = 1.0f / sqrtf(wave_sum(s) * (1.0f / DM) + RMS_EPS);
        GAS unsigned long long* o8 = (GAS unsigned long long*)((bf16*)(ws + WS_XN) + (size_t)m * DM) + lane;
#pragma unroll
        for (int j = 0; j < 4; ++j) { const f32x4 g = gr[64 * j]; o8[64 * j] = (unsigned long long)pk2(v[j].x * rs * g.x, v[j].y * rs * g.y) | ((unsigned long long)pk2(v[j].z * rs * g.z, v[j].w * rs * g.w) << 32); }
    }
}

__device__ __forceinline__ void p6_fixup(Frame& F, const Args& a) {
    const int lane = pg8::lane_id_fresh();
    const int gw = F.vcu * NWAVES + F.wave, NGW = F.G * NWAVES;
    const float* halo = (const float*)(a.ws + WS_HALO); bf16* ACT = (bf16*)(a.ws + WS_ACT);
    constexpr int NBLK = MTOK / 64, HROW = 2 * DFF, HBLK = 4 * HROW;
    for (int it = gw; it < NBLK * 2 * 11; it += NGW) {
        const int cg = it % 11, which = (it / 11) & 1, blk = it / 22;
        const int c = cg * 256 + lane * 4, cu = 256 * (c >> 7) + (c & 127);
        const int r = 64 * blk + (which ? 63 : 0);
        const float* hp = halo + (size_t)blk * HBLK + (2 + which) * HROW + cu;
        f32x4 G = *(const f32x4*)hp, V = *(const f32x4*)(hp + 128);
        const bool has = which ? (((r + 1) & (SEQ - 1)) != 0) : ((r & (SEQ - 1)) != 0);
        if (has) { const float* np = halo + (size_t)(which ? blk + 1 : blk - 1) * HBLK + (which ? 0 : 1) * HROW + cu;
            const f32x4 rg = *(const f32x4*)np, rv = *(const f32x4*)(np + 128);
            const f32x4 wg = *(const f32x4*)(a.conv_w + (which ? 4 : 0) * DFF + c), wv = *(const f32x4*)(a.conv_w + (which ? 5 : 1) * DFF + c);
            G = G + wg * rg; V = V + wv * rv; }
        f32x4 o;
#pragma unroll
        for (int e = 0; e < 4; ++e) o[e] = G[e] * pg8::fast_sigmoid(G[e]) * V[e];
        pg8::st4((pg8::bf16_t*)(ACT + (size_t)r * DFF + c), o);
    }
}

__device__ __forceinline__ void p8_final_norm(Frame& F, const Args& a) {
    const int gw = F.vcu * NWAVES + F.wave, NGW = F.G * NWAVES;
    const int lane = pg8::lane_id_fresh();
    const float* ssq = (const float*)(a.ws + WS_SSQ3);
    for (int m = gw; m < MTOK; m += NGW) {
        const f32x4* sp = (const f32x4*)(ssq + (size_t)m * 16); const f32x4 t = (sp[0] + sp[1]) + (sp[2] + sp[3]);
        const float rs = 1.0f / sqrtf(((t[0] + t[1]) + (t[2] + t[3])) * (1.0f / DM) + RMS_EPS);
        GAS f32x4* xr = (GAS f32x4*)(a.out + (size_t)m * DM) + lane; const GAS f32x4* gr = (const GAS f32x4*)a.final_norm_g + lane;
#pragma unroll
        for (int j = 0; j < 4; ++j) { const f32x4 v = xr[64 * j], g = gr[64 * j]; xr[64 * j] = v * rs * g; }
    }
}

__global__ void __launch_bounds__(NWAVES * 64, 2) enc_fwd(Args args) {
    extern __shared__ __attribute__((aligned(16))) unsigned char lds[];
    Frame F;
    F.lds = (LAS unsigned char*)lds; F.MISC = (volatile LAS unsigned*)(F.lds + MISC_OFF);
    F.wave = __builtin_amdgcn_readfirstlane(threadIdx.x >> 6);
    F.G = gridDim.x; { const int bx = blockIdx.x; F.vcu = (F.G % 8 == 0) ? (bx % 8) * (F.G / 8) + bx / 8 : bx; }
    unsigned char* ws = args.ws;
    F.ctl = (gu32*)(ws + WS_CTL);
    for (int u = threadIdx.x; u < (LDS_BYTES - LDSCTL_OFF) / 4; u += NWAVES * 64) ((LAS unsigned*)(F.lds + LDSCTL_OFF))[u] = 0u;
    __syncthreads();
    XcdBarrier bar; bar.bar = (unsigned*)(F.ctl + CW_BAR); bar.x = 0; bar.st = nullptr;
    if (!MK_PER_PHASE) bar = xcd_barrier_post((unsigned*)(F.ctl + CW_BAR), F.MISC + 8);
    bar.w = F.wave;
    const int lo = args.ph_lo, hi = args.ph_hi;
#ifndef PHMASK
#define PHMASK 0xff
#endif
#define IN(k) (((PHMASK >> (k)) & 1) && lo <= (k) && (k) < hi)
#ifndef DUPMASK
#define DUPMASK 0
#endif
#define REP(k) for (int rep_ = 0; rep_ <= ((DUPMASK >> (k)) & 1); ++rep_)
#define SEAM(k) do { if (IN(k) && IN((k) + 1)) xcd_barrier(bar); } while (0)
    bf16* const WIN = (bf16*)(ws + WS_WIN); bf16* const WQB = (bf16*)(ws + WS_WQB); bf16* const WOUT = (bf16*)(ws + WS_WOUT);
    bf16* const WUP = (bf16*)(ws + WS_WUP); bf16* const WDN = (bf16*)(ws + WS_WDN);
    const float* const COS = (const float*)(ws + WS_COS); const float* const SIN = (const float*)(ws + WS_SIN);
    bf16* const QA = (bf16*)args.out;

#ifdef TP_PHASE
    unsigned long long tp_r0 = 0, tp_r1 = 0, tp_c0 = 0, tp_c1 = 0;
#ifndef TP_END
#define TP_END (TP_PHASE + 1)
#endif
#ifdef TP_SWA
#define TP_MARK(k)
#else
#define TP_MARK(k) do { if ((k) == TP_PHASE) { tp_r0 = __builtin_amdgcn_s_memrealtime(); tp_c0 = __builtin_amdgcn_s_memtime(); } if ((k) == TP_END) { tp_r1 = __builtin_amdgcn_s_memrealtime(); tp_c1 = __builtin_amdgcn_s_memtime(); } } while (0)
#endif
#else
#define TP_MARK(k)
#endif
#ifdef TP_SWA
    unsigned long long tp_ts[6] = {};
#define TP_TSPASS , tp_ts
#else
#define TP_TSPASS
#endif
    TP_MARK(0);
    if (IN(0)) REP(0) { p0_prologue(F, args); } SEAM(0);
    TP_MARK(1);

    if (IN(1)) REP(1) {
        pg8::Gemm g{(bf16*)(ws + WS_XN), WIN, MTOK, 4096, 1024}; pg8::StaticOrder S; S.init(MTOK, 4096, F.G, (int)blockIdx.x);
        pg8::EpiInProj E{(bf16*)(ws + WS_QLAT), (bf16*)(ws + WS_KL), (bf16*)(ws + WS_QB), (bf16*)(ws + WS_KB), (bf16*)(ws + WS_VB), (bf16*)(ws + WS_GA), (bf16*)(ws + WS_GB),
                         (float*)(ws + WS_SSQQ), (float*)(ws + WS_SSQKV), COS, SIN};
        pg8::gemm_phase<pg8::EpiInProj, pg8::StaticOrder, PG8_ALIGN, PG8_SP2>(F.lds + RING_OFF, g, S, E, F.wave);
    } SEAM(1);

    TP_MARK(2);
    if (IN(2)) REP(2) {
#ifndef P2SUB
#define P2SUB 7
#endif
#ifndef P2DUPG
#define P2DUPG 0
#endif
        for (int rg_ = 0; rg_ <= P2DUPG; ++rg_) {
        if (P2SUB & 1) { pg8::Gemm g{(bf16*)(ws + WS_QLAT), WQB, MTOK, 1536, 256}; pg8::StaticOrder S; S.init(MTOK, 1536, F.G, (int)blockIdx.x);
          pg8::EpiQProj E{QA, (const float*)(ws + WS_SSQQ), COS, SIN};
          pg8::gemm_phase<pg8::EpiQProj, pg8::StaticOrder, PG8_ALIGN, PG8_SP2>(F.lds + RING_OFF, g, S, E, F.wave); }
        }
        TP_MARK(20);
        if (P2SUB & 4) { const att::swa::Tensors T{(const bf16*)(ws + WS_QB), (const bf16*)(ws + WS_KB), (const bf16*)(ws + WS_VB), (bf16*)(ws + WS_GB), (const float*)(ws + WS_BT2), (const float*)(ws + WS_SINK2)};
          for (int u = F.vcu; u < NBATCH * 4 * (SEQ / 64 / att::swa::NQB); u += F.G) { const int j = u % (SEQ / 64 / att::swa::NQB), bk = u / (SEQ / 64 / att::swa::NQB); att::swa::run(bk >> 2, bk & 3, j, T, (char*)lds + RING_OFF, F.wave TP_TSPASS); } }
#ifdef TP_SWA
        tp_r0 = tp_ts[TP_A]; tp_r1 = tp_ts[TP_B];
#endif
    } SEAM(2);

    TP_MARK(3);
    if (IN(3)) REP(3) {
        const att::mla::Tensors T{QA, (const bf16*)(ws + WS_KL), (const bf16*)(ws + WS_WVT), (const bf16*)(ws + WS_GA), (const bf16*)(ws + WS_GB), (bf16*)(ws + WS_MIX)};
        for (int u = F.vcu; u < NBATCH * 8 * (SEQ / 256); u += F.G) { const int qb = u & 15, bh = u >> 4;
#if MLA_SPLIT
            att::mla2::unit(bh >> 3, bh & 7, qb, T, (char*)lds + RING_OFF, F.wave);
#else
            att::mla::unit(bh >> 3, bh & 7, qb, T, (char*)lds + RING_OFF, F.wave);
#endif
        }
    } SEAM(3);

    TP_MARK(4);
    if (IN(4)) REP(4) {
        pg8::Gemm g{(bf16*)(ws + WS_MIX), WOUT, MTOK, 1024, 1024}; pg8::StaticOrder S; S.init(MTOK, 1024, F.G, (int)blockIdx.x);
        pg8::EpiResidual E{args.x, nullptr, (bf16*)(ws + WS_X1B), (float*)(ws + WS_SSQ2)};
        pg8::gemm_phase<pg8::EpiResidual, pg8::StaticOrder, PG8_ALIGN, PG8_SP2>(F.lds + RING_OFF, g, S, E, F.wave);
    } SEAM(4);

    TP_MARK(5);
    if (IN(5)) REP(5) {
        pg8::Gemm g{(bf16*)(ws + WS_X1B), WUP, MTOK, 2 * DFF, 1024}; pg8::StaticOrder S; S.init(MTOK, 2 * DFF, F.G, (int)blockIdx.x);
        pg8::EpiUpConv E{(bf16*)(ws + WS_ACT), (float*)(ws + WS_HALO), (const float*)(ws + WS_SSQ2), args.conv_w, args.conv_b};
        pg8::gemm_phase<pg8::EpiUpConv, pg8::StaticOrder, PG8_ALIGN, PG8_SP2>(F.lds + RING_OFF, g, S, E, F.wave);
    } SEAM(5);
    TP_MARK(6);
    if (IN(6)) REP(6) { p6_fixup(F, args); } SEAM(6);

    TP_MARK(7);
    if (IN(7)) REP(7) {
        pg8::Gemm g{(bf16*)(ws + WS_ACT), WDN, MTOK, 1024, DFF}; pg8::StaticOrder S; S.init(MTOK, 1024, F.G, (int)blockIdx.x);
        pg8::EpiFinal E{(const bf16*)(ws + WS_X1B), args.out, (float*)(ws + WS_SSQ3), (unsigned*)(F.ctl + CW_PANEL), args.final_norm_g};
        pg8::gemm_phase<pg8::EpiFinal, pg8::StaticOrder, PG8_ALIGN, PG8_SP2>(F.lds + RING_OFF, g, S, E, F.wave);
    }
#ifdef TP_PHASE
    TP_MARK(8);
#ifndef TP_CLK
#define TP_CLK 0
#endif
#ifndef TP_GAIN
#define TP_GAIN 4
#endif
    if (blockIdx.x == 0 && F.wave == 0) {
        const unsigned long long dr = tp_r1 - tp_r0, dc = tp_c1 - tp_c0;
        const unsigned long long ticks = (TP_CLK ? dc * 100ull / dr : dr) * (unsigned long long)TP_GAIN;
        const unsigned long long t0 = __builtin_amdgcn_s_memrealtime();
        while (__builtin_amdgcn_s_memrealtime() - t0 < ticks) __builtin_amdgcn_s_sleep(8); }
#endif
#undef IN
#undef SEAM
}

extern "C" void kernel_launch(void* const* d_in, const int* in_sizes, int n_in, void* d_out, int out_size, void* d_ws, size_t ws_size, hipStream_t stream) {
    static int grid = 0;
    if (grid == 0) {
        if (n_in != 17 || in_sizes[0] != MTOK * DM || out_size != MTOK * DM || ws_size < WS_END) { fprintf(stderr, "kernel_launch: unexpected shapes (n_in %d, in0 %d, out %d, ws %zu; need ws >= %zu); nothing launched\n", n_in, n_in > 0 ? in_sizes[0] : -1, out_size, ws_size, (size_t)WS_END); grid = -1; return; }
        int dev = 0, cus = 0, per_cu = 0;
        if (hipGetDevice(&dev) != hipSuccess || hipDeviceGetAttribute(&cus, hipDeviceAttributeMultiprocessorCount, dev) != hipSuccess) { fprintf(stderr, "kernel_launch: device query failed\n"); grid = -1; return; }
        if (hipFuncSetAttribute((const void*)enc_fwd, hipFuncAttributeMaxDynamicSharedMemorySize, LDS_BYTES) != hipSuccess) { fprintf(stderr, "kernel_launch: hipFuncSetAttribute failed\n"); grid = -1; return; }
        if (hipOccupancyMaxActiveBlocksPerMultiprocessor(&per_cu, (const void*)enc_fwd, NWAVES * 64, LDS_BYTES) != hipSuccess || per_cu < 1) { fprintf(stderr, "kernel_launch: occupancy query reports %d workgroups per CU\n", per_cu); }
        (void)hipGetLastError();
        grid = cus;
    }
    if (grid < 0) return;
    if (hipMemsetAsync((char*)d_ws + WS_CTL, 0, CTL_ZERO_BYTES, stream) != hipSuccess) { fprintf(stderr, "kernel_launch: hipMemsetAsync failed\n"); return; }
    Args a{};
    a.x = (const float*)d_in[0]; a.positions = (const int*)d_in[1]; a.norm1_g = (const float*)d_in[2]; a.w_in = (const float*)d_in[3]; a.q_a_norm_g = (const float*)d_in[4]; a.w_q_b = (const float*)d_in[5];
    a.kv_a_norm_g = (const float*)d_in[6]; a.w_kv_b = (const float*)d_in[7]; a.rel_bias = (const float*)d_in[8]; a.sinks = (const float*)d_in[9]; a.w_out = (const float*)d_in[10]; a.norm2_g = (const float*)d_in[11];
    a.w_up = (const float*)d_in[12]; a.conv_w = (const float*)d_in[13]; a.conv_b = (const float*)d_in[14]; a.w_down = (const float*)d_in[15]; a.final_norm_g = (const float*)d_in[16];
    a.out = (float*)d_out; a.ws = (unsigned char*)d_ws;
#if MK_PER_PHASE
    for (int p = 0; p < N_PHASES; ++p) { a.ph_lo = p; a.ph_hi = p + 1; hipLaunchKernelGGL(enc_fwd, dim3(grid), dim3(NWAVES * 64), LDS_BYTES, stream, a); }
#else
    a.ph_lo = 0; a.ph_hi = N_PHASES; hipLaunchKernelGGL(enc_fwd, dim3(grid), dim3(NWAVES * 64), LDS_BYTES, stream, a);
#endif
    const hipError_t le = hipPeekAtLastError();
    if (le != hipSuccess) fprintf(stderr, "kernel_launch: launch failed: %s (grid %d)\n", hipGetErrorName(le), grid);
}
```

```cpp
#include <hip/hip_runtime.h>
#include <cstdio>
#include <cstdint>
namespace pg8 {
#define PG8_LAS __attribute__((address_space(3)))
typedef unsigned short bf16_t;
typedef short bf16x8 __attribute__((ext_vector_type(8)));
typedef float f32x4 __attribute__((ext_vector_type(4)));
typedef unsigned u32x4 __attribute__((ext_vector_type(4)));
constexpr int BM = 256, BK = 64, HALF = 128, HTB = HALF * BK * 2  , STAGE_BYTES = 8 * HTB, NXCD = 8, WGM = 8;

__host__ __device__ __forceinline__ int lds_byte(int r, int c) { const int st = (r >> 4) * 2 + (c >> 5), rr = r & 15, cc = c & 31, ob = rr * 64 + cc * 2; return st * 1024 + (ob ^ (((ob >> 9) & 1) << 5)); }
__host__ __device__ __forceinline__ void stage_rc(int b, int& R, int& C) { const int st = b / 1024, sb = b % 1024, swz = sb ^ (((sb >> 9) & 1) << 5); R = (st >> 1) * 16 + swz / 64; C = (st & 1) * 32 + (swz % 64) / 2; }
__host__ __device__ __forceinline__ int perm32(int rho) { const int n = rho >> 4, i = rho & 15; return 8 * (i >> 2) + 4 * n + (i & 3); }

struct Unit { int pm, pn; };
struct Gemm { const bf16_t* A; const bf16_t* Bt; int M, N, K; };

struct StaticOrder {
    int nM, nN, nwg, G, c;
    __host__ __device__ void init(int M, int N, int G_, int c_) { nM = M / BM; nN = N / BM; nwg = nM * nN; G = G_; c = c_; }
    __host__ __device__ bool next(int i, Unit& u) const {
        const long L = (long)i * G + c; if (L >= nwg) return false;
        int wgid = (int)L; { const int q = nwg / NXCD, r = nwg % NXCD, xcd = wgid % NXCD, off = wgid / NXCD; wgid = (xcd < r ? xcd * (q + 1) : r * (q + 1) + (xcd - r) * q) + off; }
        const int nig = WGM * nN, gid = wgid / nig, fm = gid * WGM, gsz = (nM - fm) < WGM ? (nM - fm) : WGM;
        u.pm = fm + ((wgid % nig) % gsz); u.pn = (wgid % nig) / gsz; return true;
    }
    __device__ __forceinline__ void a_ready(const Unit&) const {}
    __device__ __forceinline__ void done(const Unit&) const {}
};

__device__ __forceinline__ unsigned cvt_pk_bf16(float lo, float hi) { unsigned r; asm volatile("v_cvt_pk_bf16_f32 %0, %1, %2" : "=v"(r) : "v"(lo), "v"(hi)); return r; }
constexpr int SEQ = 4096, NBATCH = 8, MTOK = NBATCH * SEQ, DM = 1024;
constexpr int DFF = 2816;
constexpr float RMS_EPS = 1e-6f;
constexpr float LOG2E = 1.4426950408889634f;
constexpr float C_MLA = 0.07216878364870322f * LOG2E;
constexpr float C_SWA = 0.125f * LOG2E;

typedef unsigned u32x2 __attribute__((ext_vector_type(2)));
__device__ __forceinline__ int lane_id_fresh() { int l; asm volatile("v_mbcnt_lo_u32_b32 %0, -1, 0\n\tv_mbcnt_hi_u32_b32 %0, -1, %0" : "=v"(l)); return l; }
__device__ __forceinline__ float fast_sigmoid(float v) { return __builtin_amdgcn_rcpf(1.0f + __builtin_amdgcn_exp2f(-LOG2E * v)); }
__device__ __forceinline__ void st8(bf16_t* p, f32x4 v0, f32x4 v1) {
    u32x4 w; w.x = cvt_pk_bf16(v0[0], v0[1]); w.y = cvt_pk_bf16(v0[2], v0[3]); w.z = cvt_pk_bf16(v1[0], v1[1]); w.w = cvt_pk_bf16(v1[2], v1[3]); *(u32x4*)p = w; }
__device__ __forceinline__ void st4(bf16_t* p, f32x4 v) { u32x2 w; w.x = cvt_pk_bf16(v[0], v[1]); w.y = cvt_pk_bf16(v[2], v[3]); *(u32x2*)p = w; }
__device__ __forceinline__ float sq4(f32x4 x) { return (x[0] * x[0] + x[1] * x[1]) + (x[2] * x[2] + x[3] * x[3]); }
__device__ __forceinline__ float fq_sum(float s) { s += __shfl_xor(s, 16); s += __shfl_xor(s, 32); return s; }

__device__ __forceinline__ void rope_store(bf16_t* dst  , int d, int srow, const float* cosT, const float* sinT, f32x4 a, f32x4 b, float sc) {
    const f32x4 c4 = *(const f32x4*)(cosT + srow * 32 + d), s4 = *(const f32x4*)(sinT + srow * 32 + d);
    const f32x4 x1 = {a[0] * sc, a[2] * sc, b[0] * sc, b[2] * sc}, x2 = {a[1] * sc, a[3] * sc, b[1] * sc, b[3] * sc};
    st4(dst + d, x1 * c4 - x2 * s4); st4(dst + 32 + d, x2 * c4 + x1 * s4);
}

struct EpiInProj {
    static constexpr bool PERM = true, AFTER_DRAIN = false;
    bf16_t *qlat, *kl, *qb, *kb, *vb, *ga, *gb; float *ssq_q, *ssq_kv; const float *cosT, *sinT;
    __device__ __forceinline__ void operator()(f32x4 (&acc)[2][2][4][2], const Unit& u, int wr, int wc, int fr, int fq) const {
        { const int l_ = lane_id_fresh(); fr = l_ & 15; fq = l_ >> 4; }
        const int pn = u.pn, row0 = u.pm * BM + wr * 64 + fr, cw = wc * 32 + 8 * fq;
        if (pn == 0) {
#pragma unroll
            for (int ai = 0; ai < 2; ++ai)
#pragma unroll
                for (int m = 0; m < 4; ++m) { const int row = row0 + ai * HALF + m * 16;
                    float s = (sq4(acc[ai][0][m][0]) + sq4(acc[ai][0][m][1])) + (sq4(acc[ai][1][m][0]) + sq4(acc[ai][1][m][1]));
                    s = fq_sum(s); if (fq == 0) ssq_q[(size_t)row * 4 + wc] = s;
                    st8(qlat + (size_t)row * 256 + cw, acc[ai][0][m][0], acc[ai][0][m][1]); st8(qlat + (size_t)row * 256 + HALF + cw, acc[ai][1][m][0], acc[ai][1][m][1]);
                    asm volatile("" ::: "memory"); }
        } else if (pn == 1) {
#pragma unroll
            for (int ai = 0; ai < 2; ++ai)
#pragma unroll
                for (int m = 0; m < 4; ++m) { const int row = row0 + ai * HALF + m * 16;
                    float s = sq4(acc[ai][0][m][0]) + sq4(acc[ai][0][m][1]);
                    s = fq_sum(s); if (fq == 0) __hip_atomic_store(ssq_kv + (unsigned)row * 4 + wc, s, __ATOMIC_RELAXED, __HIP_MEMORY_SCOPE_AGENT); }
            asm volatile("s_waitcnt vmcnt(0)" ::: "memory");
            __builtin_amdgcn_s_barrier(); asm volatile("" ::: "memory");
#pragma unroll
            for (int ai = 0; ai < 2; ++ai)
#pragma unroll
                for (int m = 0; m < 4; ++m) { const int row = row0 + ai * HALF + m * 16; const float* sp = ssq_kv + (unsigned)row * 4;
                    const float t = (__hip_atomic_load(sp, __ATOMIC_RELAXED, __HIP_MEMORY_SCOPE_AGENT) + __hip_atomic_load(sp + 1, __ATOMIC_RELAXED, __HIP_MEMORY_SCOPE_AGENT))
                                  + (__hip_atomic_load(sp + 2, __ATOMIC_RELAXED, __HIP_MEMORY_SCOPE_AGENT) + __hip_atomic_load(sp + 3, __ATOMIC_RELAXED, __HIP_MEMORY_SCOPE_AGENT));
                    const float rs = __builtin_amdgcn_rsqf(t * (1.0f / 128.0f) + RMS_EPS);
                    bf16_t* krow = kl + (size_t)row * 192;
                    st8(krow + cw, acc[ai][0][m][0] * rs, acc[ai][0][m][1] * rs);
                    if (wc < 2) rope_store(krow + 128, 16 * wc + 4 * fq, row & (SEQ - 1), cosT, sinT, acc[ai][1][m][0], acc[ai][1][m][1], 1.0f);
                    if (m == 1 || m == 3) asm volatile("" ::: "memory"); }
        } else {
            bf16_t* base; int ld, col0; float sc = 1.0f; bool sig = false;
            if (pn < 6) { base = qb; ld = 1024; col0 = (pn - 2) * 256; sc = C_SWA; }
            else if (pn == 6) { base = kb; ld = 256; col0 = 0; }
            else if (pn == 7) { base = vb; ld = 256; col0 = 0; }
            else if (pn < 12) { base = ga; ld = 1024; col0 = (pn - 8) * 256; sig = true; }
            else { base = gb; ld = 1024; col0 = (pn - 12) * 256; sig = true; }
            bf16_t* rowp = base + (size_t)row0 * ld + col0 + cw; const size_t rstep = (size_t)16 * ld;
#pragma unroll
            for (int ai = 0; ai < 2; ++ai)
#pragma unroll
                for (int m = 0; m < 4; ++m) { bf16_t* rp = rowp + (size_t)(ai * 8 + m) * rstep;
#pragma unroll
                    for (int bj = 0; bj < 2; ++bj) { f32x4 v0 = acc[ai][bj][m][0], v1 = acc[ai][bj][m][1];
                        if (sig) {
#pragma unroll
                            for (int e = 0; e < 4; ++e) { v0[e] = fast_sigmoid(v0[e]); v1[e] = fast_sigmoid(v1[e]); } }
                        else { v0 = v0 * sc; v1 = v1 * sc; }
                        st8(rp + bj * HALF, v0, v1); }
                    asm volatile("" ::: "memory"); }
        }
    }
};

struct EpiQProj {
    static constexpr bool PERM = true, AFTER_DRAIN = false;
    bf16_t* qa; const float* ssq; const float *cosT, *sinT;
    __device__ __forceinline__ void operator()(f32x4 (&acc)[2][2][4][2], const Unit& u, int wr, int wc, int fr, int fq) const {
        { const int l_ = lane_id_fresh(); fr = l_ & 15; fq = l_ >> 4; }
        const int pn = u.pn, row0 = u.pm * BM + wr * 64 + fr, cw = wc * 32 + 8 * fq;
        f32x4 sv[2][4];
#pragma unroll
        for (int ai = 0; ai < 2; ++ai)
#pragma unroll
            for (int m = 0; m < 4; ++m) sv[ai][m] = *(const f32x4*)(ssq + (unsigned)(row0 + ai * HALF + m * 16) * 4);
        asm volatile("" ::: "memory");
#pragma unroll
        for (int ai = 0; ai < 2; ++ai)
#pragma unroll
            for (int m = 0; m < 4; ++m) { const int row = row0 + ai * HALF + m * 16;
                const f32x4 s4 = sv[ai][m];
                const float rs = C_MLA * __builtin_amdgcn_rsqf(((s4[0] + s4[1]) + (s4[2] + s4[3])) * (1.0f / 256.0f) + RMS_EPS);
                bf16_t* qrow = qa + (size_t)row * 1536;
                if (pn < 4) {
#pragma unroll
                    for (int bj = 0; bj < 2; ++bj) st8(qrow + (2 * pn + bj) * 192 + cw, acc[ai][bj][m][0] * rs, acc[ai][bj][m][1] * rs);
                } else {
#pragma unroll
                    for (int bj = 0; bj < 2; ++bj) { const int head = 4 * (pn - 4) + 2 * bj + (wc >> 1);
                        rope_store(qrow + head * 192 + 128, 16 * (wc & 1) + 4 * fq, row & (SEQ - 1), cosT, sinT, acc[ai][bj][m][0], acc[ai][bj][m][1], rs); }
                }
                if (m == 1 || m == 3) asm volatile("" ::: "memory");
            }
    }
};

struct EpiResidual {
    static constexpr bool PERM = true, AFTER_DRAIN = false;
    const float* base; float* y; bf16_t* yb; float* ssq;
    __device__ __forceinline__ void operator()(f32x4 (&acc)[2][2][4][2], const Unit& u, int wr, int wc, int fr, int fq) const {
        { const int l_ = lane_id_fresh(); fr = l_ & 15; fq = l_ >> 4; }
        const int pn = u.pn, row0 = u.pm * BM + wr * 64 + fr, cw = wc * 32 + 8 * fq;
        const unsigned off0 = (unsigned)row0 * DM + pn * 256 + cw;
#pragma unroll
        for (int ai = 0; ai < 2; ++ai) {
            f32x4 xv[4][2][2];
#pragma unroll
            for (int m = 0; m < 4; ++m)
#pragma unroll
                for (int bj = 0; bj < 2; ++bj) { const unsigned off = off0 + (unsigned)((ai * HALF + m * 16) * DM + bj * HALF);
                    xv[m][bj][0] = *(const f32x4*)(base + off); xv[m][bj][1] = *(const f32x4*)(base + off + 4); }
            asm volatile("" ::: "memory");
#pragma unroll
            for (int m = 0; m < 4; ++m) { const int row = row0 + ai * HALF + m * 16; float s = 0.f;
#pragma unroll
                for (int bj = 0; bj < 2; ++bj) { const unsigned off = off0 + (unsigned)((ai * HALF + m * 16) * DM + bj * HALF);
                    const f32x4 v0 = xv[m][bj][0] + acc[ai][bj][m][0], v1 = xv[m][bj][1] + acc[ai][bj][m][1];
                    if (y) { *(f32x4*)(y + off) = v0; *(f32x4*)(y + off + 4) = v1; } if (yb) st8(yb + off, v0, v1);
                    s += sq4(v0) + sq4(v1); }
                s = fq_sum(s); if (fq == 0) ssq[(unsigned)row * 16 + pn * 4 + wc] = s; }
            asm volatile("" ::: "memory");
        }
    }
};

struct EpiUp {
    static constexpr bool PERM = true, AFTER_DRAIN = false;
    bf16_t* U; int ldu; const float* ssq;
    __device__ __forceinline__ void operator()(f32x4 (&acc)[2][2][4][2], const Unit& u, int wr, int wc, int fr, int fq) const {
        { const int l_ = lane_id_fresh(); fr = l_ & 15; fq = l_ >> 4; }
        const int pn = u.pn, row0 = u.pm * BM + wr * 64 + fr, cw = wc * 32 + 8 * fq;
#pragma unroll
        for (int ai = 0; ai < 2; ++ai)
#pragma unroll
            for (int m = 0; m < 4; ++m) { const int row = row0 + ai * HALF + m * 16;
                const f32x4* sp = (const f32x4*)(ssq + (size_t)row * 16); const f32x4 t = (sp[0] + sp[1]) + (sp[2] + sp[3]);
                const float rs = __builtin_amdgcn_rsqf(((t[0] + t[1]) + (t[2] + t[3])) * (1.0f / 1024.0f) + RMS_EPS);
#pragma unroll
                for (int bj = 0; bj < 2; ++bj) st8(U + (size_t)row * ldu + pn * 256 + bj * HALF + cw, acc[ai][bj][m][0] * rs, acc[ai][bj][m][1] * rs);
                asm volatile("" ::: "memory"); }
    }
};

__device__ __forceinline__ float dpp_prev(float x) { return __int_as_float(__builtin_amdgcn_update_dpp(__float_as_int(x), __float_as_int(x), 0x121, 0xf, 0xf, true)); }
__device__ __forceinline__ float dpp_next(float x) { return __int_as_float(__builtin_amdgcn_update_dpp(__float_as_int(x), __float_as_int(x), 0x12f, 0xf, 0xf, true)); }
struct EpiUpConv {
    static constexpr bool PERM = true, AFTER_DRAIN = false;
    bf16_t* act; float* halo; const float* ssq; const float* conv_w; const float* conv_b;
    __device__ __forceinline__ void operator()(f32x4 (&acc)[2][2][4][2], const Unit& u, int wr, int wc, int fr, int fq) const {
        { const int l_ = lane_id_fresh(); fr = l_ & 15; fq = l_ >> 4; }
        const int pn = u.pn, row0 = u.pm * BM + wr * 64 + fr, cw = wc * 32 + 8 * fq;
        { f32x4 tv[2][4];
#pragma unroll
        for (int ai = 0; ai < 2; ++ai)
#pragma unroll
            for (int m = 0; m < 4; ++m) tv[ai][m] = *(const f32x4*)(ssq + (unsigned)(row0 + ai * HALF + m * 16) * 16 + 4 * fq);
        asm volatile("" ::: "memory");
#pragma unroll
        for (int ai = 0; ai < 2; ++ai)
#pragma unroll
            for (int m = 0; m < 4; ++m) { const f32x4 t = tv[ai][m];
                const float rs = __builtin_amdgcn_rsqf(fq_sum((t[0] + t[1]) + (t[2] + t[3])) * (1.0f / 1024.0f) + RMS_EPS);
#pragma unroll
                for (int bj = 0; bj < 2; ++bj) { acc[ai][bj][m][0] = acc[ai][bj][m][0] * rs; acc[ai][bj][m][1] = acc[ai][bj][m][1] * rs; }
                if (m == 1 || m == 3) __builtin_amdgcn_sched_barrier(0); } }
        const bool first = fr == 0, last = fr == 15;
        u32x2 pk[2][4];
#pragma unroll
        for (int n = 0; n < 2; ++n) {
            const int c = pn * 128 + cw + 4 * n;
            const f32x4 wg0 = *(const f32x4*)(conv_w + c), wg1 = *(const f32x4*)(conv_w + 2 * DFF + c), wg2 = *(const f32x4*)(conv_w + 4 * DFF + c), bg = *(const f32x4*)(conv_b + c);
            const f32x4 wv0 = *(const f32x4*)(conv_w + DFF + c), wv1 = *(const f32x4*)(conv_w + 3 * DFF + c), wv2 = *(const f32x4*)(conv_w + 5 * DFF + c), bv = *(const f32x4*)(conv_b + DFF + c);
#pragma unroll
            for (int ai = 0; ai < 2; ++ai) {
                float* hb = halo + (unsigned)((4 * u.pm + 2 * ai + wr) * (4 * 2 * DFF) + pn * 256 + cw + 4 * n);
                f32x4 Apg = {0.f, 0.f, 0.f, 0.f}, Apv = Apg, Bcg, Bcv;
#pragma unroll
                for (int e = 0; e < 4; ++e) { Bcg[e] = dpp_next(acc[ai][0][0][n][e]); Bcv[e] = dpp_next(acc[ai][1][0][n][e]); }
#pragma unroll
                for (int m = 0; m < 4; ++m) { const int row = row0 + ai * HALF + m * 16;
                    const f32x4 ug = acc[ai][0][m][n], uv = acc[ai][1][m][n]; f32x4 G, V, Acg, Acv, Bng = {0.f, 0.f, 0.f, 0.f}, Bnv = Bng;
#pragma unroll
                    for (int e = 0; e < 4; ++e) { Acg[e] = dpp_prev(ug[e]); Acv[e] = dpp_prev(uv[e]);
                        if (m < 3) { Bng[e] = dpp_next(acc[ai][0][m < 3 ? m + 1 : 3][n][e]); Bnv[e] = dpp_next(acc[ai][1][m < 3 ? m + 1 : 3][n][e]); }
                        const float pg = first ? Apg[e] : Acg[e], pv = first ? Apv[e] : Acv[e], ng = last ? Bng[e] : Bcg[e], nv = last ? Bnv[e] : Bcv[e];
                        G[e] = wg0[e] * pg + wg1[e] * ug[e] + wg2[e] * ng + bg[e]; V[e] = wv0[e] * pv + wv1[e] * uv[e] + wv2[e] * nv + bv[e]; }
                    Apg = Acg; Apv = Acv; Bcg = Bng; Bcv = Bnv;
                    bool edge = false;
                    if (m == 0) { if (first) { edge = true; *(f32x4*)(hb) = ug; *(f32x4*)(hb + 128) = uv; *(f32x4*)(hb + 2 * 2 * DFF) = G; *(f32x4*)(hb + 2 * 2 * DFF + 128) = V; } }
                    if (m == 3) { if (last) { edge = true; *(f32x4*)(hb + 2 * DFF) = ug; *(f32x4*)(hb + 2 * DFF + 128) = uv; *(f32x4*)(hb + 3 * 2 * DFF) = G; *(f32x4*)(hb + 3 * 2 * DFF + 128) = V; } }
                    f32x4 o;
#pragma unroll
                    for (int e = 0; e < 4; ++e) o[e] = G[e] * fast_sigmoid(G[e]) * V[e];
                    u32x2 w; w.x = cvt_pk_bf16(o[0], o[1]); w.y = cvt_pk_bf16(o[2], o[3]);
                    if (n == 0) pk[ai][m] = w;
                    else if (!edge) { u32x4 w4; w4.x = pk[ai][m].x; w4.y = pk[ai][m].y; w4.z = w.x; w4.w = w.y; *(u32x4*)(act + ((unsigned)row * (unsigned)DFF + (unsigned)(c - 4))) = w4; }
                    __builtin_amdgcn_sched_barrier(0);
                }
                asm volatile("" ::: "memory");
            }
        }
    }
};

struct EpiFinal {
    static constexpr bool PERM = true, AFTER_DRAIN = false;
    const bf16_t* x1b; float* out; float* ssq; unsigned* cnt; const float* gf;
    __device__ __forceinline__ void operator()(f32x4 (&acc)[2][2][4][2], const Unit& u, int wr, int wc, int fr, int fq) const {
        const int l_ = lane_id_fresh(); fr = l_ & 15; fq = l_ >> 4;
        const int pn = u.pn, row0 = u.pm * BM + wr * 64 + fr, cw = wc * 32 + 8 * fq;
        const unsigned off0 = (unsigned)row0 * DM + pn * 256 + cw;
#pragma unroll
        for (int ai = 0; ai < 2; ++ai) {
            u32x4 xw[4][2];
#pragma unroll
            for (int m = 0; m < 4; ++m)
#pragma unroll
                for (int bj = 0; bj < 2; ++bj) xw[m][bj] = *(const u32x4*)(x1b + off0 + (unsigned)((ai * HALF + m * 16) * DM + bj * HALF));
            asm volatile("" ::: "memory");
#pragma unroll
            for (int m = 0; m < 4; ++m) { const int row = row0 + ai * HALF + m * 16; float s = 0.f;
#pragma unroll
                for (int bj = 0; bj < 2; ++bj) { const u32x4 w = xw[m][bj];
                    const f32x4 x0 = {__uint_as_float(w.x << 16), __uint_as_float(w.x & 0xffff0000u), __uint_as_float(w.y << 16), __uint_as_float(w.y & 0xffff0000u)};
                    const f32x4 x1v = {__uint_as_float(w.z << 16), __uint_as_float(w.z & 0xffff0000u), __uint_as_float(w.w << 16), __uint_as_float(w.w & 0xffff0000u)};
                    acc[ai][bj][m][0] = acc[ai][bj][m][0] + x0; acc[ai][bj][m][1] = acc[ai][bj][m][1] + x1v;
                    s += sq4(acc[ai][bj][m][0]) + sq4(acc[ai][bj][m][1]); }
                s = fq_sum(s); if (fq == 0) __hip_atomic_store(ssq + (unsigned)row * 16 + pn * 4 + wc, s, __ATOMIC_RELAXED, __HIP_MEMORY_SCOPE_AGENT); }
            asm volatile("" ::: "memory");
        }
        asm volatile("s_waitcnt vmcnt(0)" ::: "memory");
        __builtin_amdgcn_s_barrier(); asm volatile("" ::: "memory");
        if (wr == 0 && wc == 0) {
            unsigned* c = cnt + 64 * u.pm;
            if (l_ == 0) __hip_atomic_fetch_add(c, 1u, __ATOMIC_RELAXED, __HIP_MEMORY_SCOPE_AGENT);
            for (unsigned sp = 0; sp < (1u << 22); ++sp) {
                if ((unsigned)__builtin_amdgcn_readfirstlane(__hip_atomic_load(c, __ATOMIC_RELAXED, __HIP_MEMORY_SCOPE_AGENT)) >= 4u) break;
                __builtin_amdgcn_s_sleep(2); }
            __builtin_amdgcn_fence(__ATOMIC_ACQUIRE, "agent");
            asm volatile("s_waitcnt vmcnt(0)" ::: "memory");
        }
        __builtin_amdgcn_s_barrier(); asm volatile("" ::: "memory");
        f32x4 gv[2][2];
#pragma unroll
        for (int bj = 0; bj < 2; ++bj) { gv[bj][0] = *(const f32x4*)(gf + pn * 256 + bj * HALF + cw); gv[bj][1] = *(const f32x4*)(gf + pn * 256 + bj * HALF + cw + 4); }
        f32x4 tv[2][4];
#pragma unroll
        for (int ai = 0; ai < 2; ++ai)
#pragma unroll
            for (int m = 0; m < 4; ++m) tv[ai][m] = *(const f32x4*)(ssq + (unsigned)(row0 + ai * HALF + m * 16) * 16 + 4 * fq);
        asm volatile("" ::: "memory");
#pragma unroll
        for (int ai = 0; ai < 2; ++ai)
#pragma unroll
            for (int m = 0; m < 4; ++m) { const f32x4 t = tv[ai][m];
                const float rs = __builtin_amdgcn_rsqf(fq_sum((t[0] + t[1]) + (t[2] + t[3])) * (1.0f / 1024.0f) + RMS_EPS);
#pragma unroll
                for (int bj = 0; bj < 2; ++bj) { const unsigned off = off0 + (unsigned)((ai * HALF + m * 16) * DM + bj * HALF);
                    *(f32x4*)(out + off) = acc[ai][bj][m][0] * rs * gv[bj][0]; *(f32x4*)(out + off + 4) = acc[ai][bj][m][1] * rs * gv[bj][1]; }
                if (m == 1 || m == 3) __builtin_amdgcn_sched_barrier(0); }
    }
};
template <class Epi, class Sched, bool ALIGN_EPI = false, bool SP2 = false>
__device__ __forceinline__ void gemm_phase(PG8_LAS unsigned char* lds, const Gemm g, const Sched& S, const Epi& E, const int wave_id  ) {
    const int lane = lane_id_fresh(), wid = wave_id, tid = wid * 64 + lane,
              wr = wid >> 2, wc = wid & 3, fr = lane & 15, fq = lane >> 4;
    const int K = g.K, nt = K / BK;
    unsigned voffA[2], voffB[2]; int aoff, boff;
#define PG8_LANE_CONSTS() do { const int l_ = lane_id_fresh(), t_ = wid * 64 + l_, fr_ = l_ & 15, fq_ = l_ >> 4; \
        _Pragma("unroll") for (int i = 0; i < 2; ++i) { int R, C; stage_rc(t_ * 16 + i * 8192, R, C); const int Rb = Epi::PERM ? ((R & ~31) + perm32(R & 31)) : R; \
            voffA[i] = (unsigned)(R * K + C) * 2u; voffB[i] = (unsigned)(Rb * K + C) * 2u; } \
        aoff = lds_byte(wr * 64 + fr_, fq_ * 8); boff = lds_byte(wc * 32 + fr_, fq_ * 8); } while (0)
    PG8_LANE_CONSTS();
    const size_t kstep = (size_t)(BK * 2);
    const size_t hstep = (size_t)HALF * K * 2;
    const size_t tstep = 2 * hstep;
    const unsigned ldsw = (unsigned)wid * 1024u;
#define PG8_SA(b, h) (((b) * 2 + (h)) * HTB)
#define PG8_SB(b, h) ((4 + (b) * 2 + (h)) * HTB)
#define PG8_STAGE(bufoff, gbase, voff) do { _Pragma("unroll") for (int _i = 0; _i < 2; ++_i) \
        __builtin_amdgcn_global_load_lds((const unsigned*)((const char*)(gbase) + (voff)[_i]), (PG8_LAS unsigned*)(lds + (bufoff) + ldsw + _i * 8192), 16, 0, 0); } while (0)
#define PG8_LDA(dst, b, h) do { _Pragma("unroll") for (int m = 0; m < 4; ++m) _Pragma("unroll") for (int k = 0; k < 2; ++k) dst[m][k] = *(const PG8_LAS bf16x8*)(lds + PG8_SA(b, h) + aoff + m * 2048 + k * 1024); } while (0)
#define PG8_LDB(dst, b, h) do { _Pragma("unroll") for (int n = 0; n < 2; ++n) _Pragma("unroll") for (int k = 0; k < 2; ++k) dst[n][k] = *(const PG8_LAS bf16x8*)(lds + PG8_SB(b, h) + boff + n * 2048 + k * 1024); } while (0)
#define PG8_MMA(ai, bj, At, Bt) do { __builtin_amdgcn_s_setprio(1); _Pragma("unroll") for (int m = 0; m < 4; ++m) _Pragma("unroll") for (int n = 0; n < 2; ++n) _Pragma("unroll") for (int k = 0; k < 2; ++k) \
        acc[ai][bj][m][n] = __builtin_amdgcn_mfma_f32_16x16x32_bf16(Bt[n][k], At[m][k], acc[ai][bj][m][n], 0, 0, 0); __builtin_amdgcn_s_setprio(0); } while (0)
#define PG8_WAIT_V(n) asm volatile("s_waitcnt vmcnt(" #n ")" ::: "memory")
#define PG8_WAIT_L(n) asm volatile("s_waitcnt lgkmcnt(" #n ")" ::: "memory")
#define PG8_BAR __builtin_amdgcn_s_barrier()
#define PG8_SCHED __builtin_amdgcn_sched_barrier(0)
    Unit cur, nxt; int ui = 0;
    if (!S.next(0, cur)) return;
    f32x4 acc[2][2][4][2];
#pragma unroll
    for (int a = 0; a < 2; ++a)
#pragma unroll
        for (int b = 0; b < 2; ++b)
#pragma unroll
            for (int m = 0; m < 4; ++m)
#pragma unroll
                for (int n = 0; n < 2; ++n) acc[a][b][m][n] = (f32x4){0.f, 0.f, 0.f, 0.f};
    bf16x8 At[4][2], B0[2][2], B1[2][2];
    const char* cA = (const char*)g.A + (size_t)cur.pm * tstep; const char* cB = (const char*)g.Bt + (size_t)cur.pn * tstep;
    S.a_ready(cur);
    if constexpr (SP2) {
        PG8_STAGE(PG8_SB(0, 0), cB, voffB); PG8_STAGE(PG8_SB(0, 1), cB + hstep, voffB); PG8_STAGE(PG8_SA(0, 0), cA, voffA); PG8_STAGE(PG8_SA(0, 1), cA + hstep, voffA);
        if (wr == 1) PG8_BAR;
        PG8_WAIT_V(2); PG8_BAR;
        PG8_STAGE(PG8_SB(1, 0), cB + kstep, voffB); PG8_STAGE(PG8_SA(1, 0), cA + kstep, voffA); PG8_STAGE(PG8_SB(1, 1), cB + hstep + kstep, voffB);
        PG8_WAIT_V(6); PG8_BAR;
    } else {
        PG8_STAGE(PG8_SB(0, 0), cB, voffB); PG8_STAGE(PG8_SA(0, 0), cA, voffA); PG8_STAGE(PG8_SB(0, 1), cB + hstep, voffB); PG8_STAGE(PG8_SA(0, 1), cA + hstep, voffA);
        if (wr == 1) PG8_BAR;
        PG8_WAIT_V(4); PG8_BAR;
        PG8_STAGE(PG8_SB(1, 0), cB + kstep, voffB); PG8_STAGE(PG8_SA(1, 0), cA + kstep, voffA); PG8_STAGE(PG8_SB(1, 1), cB + hstep + kstep, voffB);
        PG8_WAIT_V(6); PG8_BAR;
    }
    for (;;) {
        const bool has_next = S.next(ui + 1, nxt);
        const char* nA = has_next ? (const char*)g.A + (size_t)nxt.pm * tstep : cA; const char* nB = has_next ? (const char*)g.Bt + (size_t)nxt.pn * tstep : cB;
        for (int t = 0; t < nt; t += 2) {
            const bool last = (t == nt - 2);
            const char* a1 = cA + (size_t)(t + 1) * kstep;
            const char* a2 = last ? nA : cA + (size_t)(t + 2) * kstep; const char* b2 = last ? nB : cB + (size_t)(t + 2) * kstep;
            const char* a3 = a2 + kstep; const char* b3 = b2 + kstep;
            if (last && has_next) S.a_ready(nxt);
            if constexpr (SP2) {
            PG8_LDB(B0, 0, 0); PG8_LDB(B1, 0, 1); PG8_SCHED; PG8_LDA(At, 0, 0); PG8_STAGE(PG8_SA(1, 1), a1 + hstep, voffA);
            PG8_WAIT_V(8); PG8_WAIT_L(0); PG8_BAR; PG8_MMA(0, 0, At, B0); PG8_MMA(0, 1, At, B1); PG8_BAR; PG8_SCHED;
            PG8_LDA(At, 0, 1); PG8_STAGE(PG8_SB(0, 0), b2, voffB); PG8_STAGE(PG8_SB(0, 1), b2 + hstep, voffB); PG8_STAGE(PG8_SA(0, 0), a2, voffA);
            PG8_WAIT_V(8); PG8_WAIT_L(0); PG8_BAR; PG8_MMA(1, 0, At, B0); PG8_MMA(1, 1, At, B1); PG8_BAR; PG8_SCHED;
            PG8_LDB(B0, 1, 0); PG8_LDB(B1, 1, 1); PG8_SCHED; PG8_LDA(At, 1, 0); PG8_STAGE(PG8_SA(0, 1), a2 + hstep, voffA);
            PG8_WAIT_V(8); PG8_WAIT_L(0); PG8_BAR; PG8_MMA(0, 0, At, B0); PG8_MMA(0, 1, At, B1); PG8_BAR; PG8_SCHED;
            PG8_LDA(At, 1, 1); PG8_STAGE(PG8_SB(1, 0), b3, voffB); PG8_STAGE(PG8_SB(1, 1), b3 + hstep, voffB); PG8_STAGE(PG8_SA(1, 0), a3, voffA);
            PG8_WAIT_V(8); PG8_WAIT_L(0); PG8_BAR; PG8_MMA(1, 0, At, B0); PG8_MMA(1, 1, At, B1); PG8_BAR; PG8_SCHED;
            } else {
            PG8_LDB(B0, 0, 0); PG8_SCHED; PG8_LDA(At, 0, 0); PG8_STAGE(PG8_SA(1, 1), a1 + hstep, voffA);
            PG8_WAIT_L(8); PG8_BAR; PG8_WAIT_L(0); PG8_MMA(0, 0, At, B0); PG8_BAR; PG8_SCHED;
            PG8_LDB(B1, 0, 1); PG8_STAGE(PG8_SB(0, 0), b2, voffB);
            PG8_BAR; PG8_WAIT_L(0); PG8_MMA(0, 1, At, B1); PG8_BAR;
            PG8_LDA(At, 0, 1); PG8_STAGE(PG8_SA(0, 0), a2, voffA);
            PG8_BAR; PG8_WAIT_L(0); PG8_MMA(1, 0, At, B0); PG8_BAR; PG8_SCHED;
            PG8_STAGE(PG8_SB(0, 1), b2 + hstep, voffB);
            PG8_WAIT_V(6); PG8_BAR; PG8_MMA(1, 1, At, B1); PG8_BAR;
            PG8_LDB(B0, 1, 0); PG8_SCHED; PG8_LDA(At, 1, 0); PG8_STAGE(PG8_SA(0, 1), a2 + hstep, voffA);
            PG8_WAIT_L(8); PG8_BAR; PG8_WAIT_L(0); PG8_MMA(0, 0, At, B0); PG8_BAR; PG8_SCHED;
            PG8_LDB(B1, 1, 1); PG8_STAGE(PG8_SB(1, 0), b3, voffB);
            PG8_BAR; PG8_WAIT_L(0); PG8_MMA(0, 1, At, B1); PG8_BAR;
            PG8_LDA(At, 1, 1); PG8_STAGE(PG8_SA(1, 0), a3, voffA);
            PG8_BAR; PG8_WAIT_L(0); PG8_MMA(1, 0, At, B0); PG8_BAR; PG8_SCHED;
            PG8_STAGE(PG8_SB(1, 1), b3 + hstep, voffB);
            PG8_WAIT_V(6); PG8_BAR; PG8_MMA(1, 1, At, B1); PG8_BAR;
            }
        }
        if constexpr (ALIGN_EPI) { if (wr == 0) PG8_BAR; }
        if constexpr (!Epi::AFTER_DRAIN) { E(acc, cur, wr, wc, fr, fq); S.done(cur); PG8_LANE_CONSTS(); }
        if (!has_next) break;
#pragma unroll
        for (int a = 0; a < 2; ++a)
#pragma unroll
            for (int b = 0; b < 2; ++b)
#pragma unroll
                for (int m = 0; m < 4; ++m)
#pragma unroll
                    for (int n = 0; n < 2; ++n) acc[a][b][m][n] = (f32x4){0.f, 0.f, 0.f, 0.f};
        cur = nxt; cA = nA; cB = nB; ++ui;
        if constexpr (ALIGN_EPI) { if (wr == 1) PG8_BAR; }
    }
    PG8_WAIT_V(0);
    if constexpr (!ALIGN_EPI) { if (wr == 0) PG8_BAR; }
    PG8_BAR;
    if constexpr (Epi::AFTER_DRAIN) { E.fused(acc, cur, wr, wc, fr, fq, lds, wid, lane); S.done(cur); }
#undef PG8_LANE_CONSTS
#undef PG8_SA
#undef PG8_SB
#undef PG8_STAGE
#undef PG8_LDA
#undef PG8_LDB
#undef PG8_MMA
#undef PG8_WAIT_V
#undef PG8_WAIT_L
#undef PG8_BAR
#undef PG8_SCHED
}
}
using pg8::SEQ; using pg8::NBATCH; using pg8::MTOK; using pg8::DM; using pg8::DFF; using pg8::RMS_EPS; using pg8::LOG2E;
#ifndef PG8_SP2
#define PG8_SP2 true
#endif
#ifndef PG8_ALIGN
#define PG8_ALIGN true
#endif
#ifndef MLA_OT
#define MLA_OT 1
#endif
namespace att {
using bf16x8 = __attribute__((ext_vector_type(8))) short;
using s16x4  = __attribute__((ext_vector_type(4))) short;
using f32x16 = __attribute__((ext_vector_type(16))) float;
using u32x4  = __attribute__((ext_vector_type(4))) unsigned;
typedef unsigned short bf16_t;
#define SBAR() __builtin_amdgcn_sched_barrier(0)
#define ATT_WAIT_BAR(N) asm volatile("s_waitcnt vmcnt(" #N ") lgkmcnt(0)\n\ts_barrier" ::: "memory")
__device__ __forceinline__ int crow(int r, int hi) { return (r & 3) + 8 * (r >> 2) + 4 * hi; }
__device__ __forceinline__ unsigned cvtpk(float lo, float hi) { unsigned r; asm volatile("v_cvt_pk_bf16_f32 %0, %1, %2" : "=v"(r) : "v"(lo), "v"(hi)); return r; }
__device__ __forceinline__ float bf2f(bf16_t b) { return __uint_as_float((unsigned)b << 16); }
typedef float f32x2_t __attribute__((ext_vector_type(2))); typedef __bf16 bf16x2_t __attribute__((ext_vector_type(2)));
__device__ __forceinline__ unsigned cvtpk2(float lo, float hi) { f32x2_t v = {lo, hi}; bf16x2_t r = __builtin_convertvector(v, bf16x2_t); return __builtin_bit_cast(unsigned, r); }
__device__ __forceinline__ bf16_t f2bf(float f) { return (bf16_t)(cvtpk(f, f) & 0xffffu); }
__device__ __forceinline__ void glds16(const void* gsrc, unsigned lds_dst) { unsigned keep;
    asm volatile("s_mov_b32 %0, m0\n\ts_mov_b32 m0, %2\n\ts_nop 0\n\tglobal_load_lds_dwordx4 %1, off\n\ts_mov_b32 m0, %0" : "=&s"(keep) : "v"(gsrc), "s"(lds_dst) : "memory"); }
template <int IMM> __device__ __forceinline__ void glds16s(const void* sbase, unsigned voff, unsigned lds_dst) { unsigned keep;
    asm volatile("s_mov_b32 %0, m0\n\ts_mov_b32 m0, %3\n\ts_nop 4\n\tglobal_load_lds_dwordx4 %1, %2 offset:%4\n\ts_mov_b32 m0, %0" : "=&s"(keep) : "v"(voff), "s"(sbase), "s"(lds_dst), "i"(IMM) : "memory"); }
__device__ __forceinline__ int swap23(int k) { return (k & ~0xC) | ((k & 4) << 1) | ((k & 8) >> 1); }
__device__ __forceinline__ int v_rd_base(int lane) { return ((lane & 3) << 3) | (((lane >> 2) & 3) << 6) | (((lane >> 4) & 1) << 5) | (((lane >> 5) & 1) << 8); }
template <int OFF> __device__ __forceinline__ s16x4 tr_read(int vb) { s16x4 r; asm volatile("ds_read_b64_tr_b16 %0, %1 offset:%2" : "=&v"(r) : "v"(vb), "i"(OFF) : "memory"); return r; }
__device__ __forceinline__ void pack_p(const f32x16& p0, const f32x16& p1, bf16x8& pa0, bf16x8& pa1, bf16x8& pa2, bf16x8& pa3) {
#define PK4(P, BASE, OUT) do { unsigned a0 = cvtpk(P[BASE + 0], P[BASE + 1]), a1 = cvtpk(P[BASE + 2], P[BASE + 3]);   \
    unsigned b0 = cvtpk(P[BASE + 4], P[BASE + 5]), b1 = cvtpk(P[BASE + 6], P[BASE + 7]);                              \
    auto r0 = __builtin_amdgcn_permlane32_swap(a0, b0, false, false); auto r1 = __builtin_amdgcn_permlane32_swap(a1, b1, false, false); \
    u32x4 w = {r0[0], r1[0], r0[1], r1[1]}; OUT = *reinterpret_cast<bf16x8*>(&w); } while (0)
    PK4(p0, 0, pa0); PK4(p0, 8, pa1); PK4(p1, 0, pa2); PK4(p1, 8, pa3);
#undef PK4
}
__device__ __forceinline__ float half_max(float v) { auto rr = __builtin_amdgcn_permlane32_swap(__float_as_uint(v), __float_as_uint(v), false, false); return fmaxf(__uint_as_float(rr[0]), __uint_as_float(rr[1])); }
__device__ __forceinline__ float half_sum(float v) { auto rr = __builtin_amdgcn_permlane32_swap(__float_as_uint(v), __float_as_uint(v), false, false); return __uint_as_float(rr[0]) + __uint_as_float(rr[1]); }
template <int ND0, int D0> __device__ __forceinline__ void pv_one(f32x16& od, int vb, bf16x8 pa0, bf16x8 pa1, bf16x8 pa2, bf16x8 pa3) {
    constexpr int KS = 1024 * ND0, HF = 512 * ND0;
    const s16x4 l0 = tr_read<D0 * 512 + 0 * KS>(vb), h0 = tr_read<D0 * 512 + 0 * KS + HF>(vb), l1 = tr_read<D0 * 512 + 1 * KS>(vb), h1 = tr_read<D0 * 512 + 1 * KS + HF>(vb);
    const s16x4 l2 = tr_read<D0 * 512 + 2 * KS>(vb), h2 = tr_read<D0 * 512 + 2 * KS + HF>(vb), l3 = tr_read<D0 * 512 + 3 * KS>(vb), h3 = tr_read<D0 * 512 + 3 * KS + HF>(vb);
    asm volatile("s_waitcnt lgkmcnt(0)" ::: "memory"); SBAR();
#define PK(L, H) (bf16x8){L[0], L[1], L[2], L[3], H[0], H[1], H[2], H[3]}
    od = __builtin_amdgcn_mfma_f32_32x32x16_bf16(pa0, PK(l0, h0), od, 0, 0, 0);
    od = __builtin_amdgcn_mfma_f32_32x32x16_bf16(pa1, PK(l1, h1), od, 0, 0, 0);
    od = __builtin_amdgcn_mfma_f32_32x32x16_bf16(pa2, PK(l2, h2), od, 0, 0, 0);
    od = __builtin_amdgcn_mfma_f32_32x32x16_bf16(pa3, PK(l3, h3), od, 0, 0, 0);
#undef PK
}
struct PvFrag { s16x4 l0, h0, l1, h1, l2, h2, l3, h3; };
template <int ND0, int D0> __device__ __forceinline__ void pv_issue(PvFrag& f, int vb) {
    constexpr int KS = 1024 * ND0, HF = 512 * ND0;
    f.l0 = tr_read<D0 * 512 + 0 * KS>(vb); f.h0 = tr_read<D0 * 512 + 0 * KS + HF>(vb); f.l1 = tr_read<D0 * 512 + 1 * KS>(vb); f.h1 = tr_read<D0 * 512 + 1 * KS + HF>(vb);
    f.l2 = tr_read<D0 * 512 + 2 * KS>(vb); f.h2 = tr_read<D0 * 512 + 2 * KS + HF>(vb); f.l3 = tr_read<D0 * 512 + 3 * KS>(vb); f.h3 = tr_read<D0 * 512 + 3 * KS + HF>(vb);
}
__device__ __forceinline__ void pv_mma(f32x16& od, const PvFrag& f, bf16x8 pa0, bf16x8 pa1, bf16x8 pa2, bf16x8 pa3) {
    asm volatile("s_waitcnt lgkmcnt(0)" ::: "memory"); SBAR();
#define PK(L, H) (bf16x8){L[0], L[1], L[2], L[3], H[0], H[1], H[2], H[3]}
    od = __builtin_amdgcn_mfma_f32_32x32x16_bf16(pa0, PK(f.l0, f.h0), od, 0, 0, 0);
    od = __builtin_amdgcn_mfma_f32_32x32x16_bf16(pa1, PK(f.l1, f.h1), od, 0, 0, 0);
    od = __builtin_amdgcn_mfma_f32_32x32x16_bf16(pa2, PK(f.l2, f.h2), od, 0, 0, 0);
    od = __builtin_amdgcn_mfma_f32_32x32x16_bf16(pa3, PK(f.l3, f.h3), od, 0, 0, 0);
#undef PK
}
template <int NK16, int RS, int CS> __device__ __forceinline__ void qkt(f32x16& p0, f32x16& p1, const char* Ks, const bf16x8* qr, int r32, int hi) {
    p0 = f32x16{}; p1 = f32x16{};
    const char* kb = Ks + hi * CS + r32 * RS;
#pragma unroll
    for (int d0 = 0; d0 < NK16; ++d0) {
        const bf16x8 b0 = *reinterpret_cast<const bf16x8*>(kb + d0 * 2 * CS), b1 = *reinterpret_cast<const bf16x8*>(kb + d0 * 2 * CS + 32 * RS);
        p0 = __builtin_amdgcn_mfma_f32_32x32x16_bf16(b0, qr[d0], p0, 0, 0, 0);
        p1 = __builtin_amdgcn_mfma_f32_32x32x16_bf16(b1, qr[d0], p1, 0, 0, 0); }
}

template <int NK16, int RS, int CS> __device__ __forceinline__ void qkt_c(f32x16& p0, f32x16& p1, const f32x16& c, const char* Ks, const bf16x8* qr, int r32, int hi) {
    const char* kb = Ks + hi * CS + r32 * RS;
    { const bf16x8 b0 = *reinterpret_cast<const bf16x8*>(kb), b1 = *reinterpret_cast<const bf16x8*>(kb + 32 * RS);
      p0 = __builtin_amdgcn_mfma_f32_32x32x16_bf16(b0, qr[0], c, 0, 0, 0);
      p1 = __builtin_amdgcn_mfma_f32_32x32x16_bf16(b1, qr[0], c, 0, 0, 0); }
#pragma unroll
    for (int d0 = 1; d0 < NK16; ++d0) {
        const bf16x8 b0 = *reinterpret_cast<const bf16x8*>(kb + d0 * 2 * CS), b1 = *reinterpret_cast<const bf16x8*>(kb + d0 * 2 * CS + 32 * RS);
        p0 = __builtin_amdgcn_mfma_f32_32x32x16_bf16(b0, qr[d0], p0, 0, 0, 0);
        p1 = __builtin_amdgcn_mfma_f32_32x32x16_bf16(b1, qr[d0], p1, 0, 0, 0); }
}
__device__ __forceinline__ float max3f(float a, float b, float c) { float r; asm("v_max3_f32 %0, %1, %2, %3" : "=v"(r) : "v"(a), "v"(b), "v"(c)); return r; }

namespace mla {
constexpr int NTILE = SEQ / 64;
constexpr int KPITCH = 400, KSLOT = 64 * KPITCH  , NSLOT = 4;
constexpr int LDS_K = 0, LDS_WS = NSLOT * KSLOT, LDS_BYTES = LDS_WS + 8 * 256;
constexpr int OST_PITCH = 272, OST_WAVE = 32 * OST_PITCH;
static_assert(8 * OST_WAVE <= NSLOT * KSLOT, "o_lat staging fits the ring");
#ifndef MLA_XVALU
#define MLA_XVALU 0
#endif
constexpr float THR = 8.f;
template <bool FIRST> __device__ __forceinline__ void partialSM(f32x16& p0, f32x16& p1, f32x16& negm, float& alpha) {
    float a = max3f(p0[0], p0[1], p0[2]), b = max3f(p0[9], p0[10], p0[11]), c = max3f(p1[0], p1[1], p1[2]), e = max3f(p1[9], p1[10], p1[11]);
    a = max3f(a, p0[3], p0[4]); b = max3f(b, p0[12], p0[13]); c = max3f(c, p1[3], p1[4]); e = max3f(e, p1[12], p1[13]);
    a = max3f(a, p0[5], p0[6]); b = max3f(b, p0[14], p0[15]); c = max3f(c, p1[5], p1[6]); e = max3f(e, p1[14], p1[15]);
    a = max3f(a, p0[7], p0[8]); c = max3f(c, p1[7], p1[8]);
    float pmax = max3f(a, b, c);
    pmax = max3f(pmax, e, e);
    { auto rr = __builtin_amdgcn_permlane32_swap(__float_as_uint(pmax), __float_as_uint(pmax), false, false); pmax = max3f(__uint_as_float(rr[0]), __uint_as_float(rr[1]), __uint_as_float(rr[1])); }
    alpha = 1.f;
    if (FIRST || !__builtin_expect(__all(pmax <= THR), 1)) {
        const float dl = FIRST ? pmax : fmaxf(pmax, 0.f);
        if (!FIRST) alpha = __builtin_amdgcn_exp2f(-dl);
#pragma unroll
        for (int r = 0; r < 16; ++r) { p0[r] -= dl; p1[r] -= dl; negm[r] -= dl; }
        asm volatile("" : "+v"(negm));
    }
#pragma unroll
    for (int r = 0; r < 16; ++r) p0[r] = __builtin_amdgcn_exp2f(p0[r]);
}
__device__ __forceinline__ void finishSM(f32x16& p0, f32x16& p1, float alpha, float& l_reg, bf16x8& pa0, bf16x8& pa1, bf16x8& pa2, bf16x8& pa3) {
#pragma unroll
    for (int r = 0; r < 16; ++r) p1[r] = __builtin_amdgcn_exp2f(p1[r]);
    float s0 = p0[0] + p0[1], s1 = p0[2] + p0[3], s2 = p1[0] + p1[1], s3 = p1[2] + p1[3];
#pragma unroll
    for (int r = 4; r < 16; r += 4) { s0 += p0[r]; s0 += p0[r + 1]; s1 += p0[r + 2]; s1 += p0[r + 3]; s2 += p1[r]; s2 += p1[r + 1]; s3 += p1[r + 2]; s3 += p1[r + 3]; }
    float ps = (s0 + s1) + (s2 + s3);
    ps = half_sum(ps);
    l_reg = l_reg * alpha + ps;
#if MLA_OT
#define MLA_PK(P, B) (u32x4){cvtpk2(P[B], P[B + 1]), cvtpk2(P[B + 2], P[B + 3]), cvtpk2(P[B + 4], P[B + 5]), cvtpk2(P[B + 6], P[B + 7])}
    { u32x4 w0 = MLA_PK(p0, 0), w1 = MLA_PK(p0, 8), w2 = MLA_PK(p1, 0), w3 = MLA_PK(p1, 8);
      pa0 = *reinterpret_cast<bf16x8*>(&w0); pa1 = *reinterpret_cast<bf16x8*>(&w1); pa2 = *reinterpret_cast<bf16x8*>(&w2); pa3 = *reinterpret_cast<bf16x8*>(&w3); }
#undef MLA_PK
#else
    pack_p(p0, p1, pa0, pa1, pa2, pa3);
#endif
}
__device__ __forceinline__ int v_rm_base(int lane) { return (8 * (lane >> 5) + ((lane >> 2) & 3)) * KPITCH + 32 * ((lane >> 4) & 1) + 8 * (lane & 3); }
template <int D0> __device__ __forceinline__ void pvr_issue(PvFrag& f, int vb) {
    constexpr int KS = 16 * KPITCH, HF = 4 * KPITCH;
    f.l0 = tr_read<D0 * 64 + 0 * KS>(vb); f.h0 = tr_read<D0 * 64 + 0 * KS + HF>(vb); f.l1 = tr_read<D0 * 64 + 1 * KS>(vb); f.h1 = tr_read<D0 * 64 + 1 * KS + HF>(vb);
    f.l2 = tr_read<D0 * 64 + 2 * KS>(vb); f.h2 = tr_read<D0 * 64 + 2 * KS + HF>(vb); f.l3 = tr_read<D0 * 64 + 3 * KS>(vb); f.h3 = tr_read<D0 * 64 + 3 * KS + HF>(vb);
}
template <int D0> __device__ __forceinline__ void pvr_one(f32x16& od, int vb, bf16x8 pa0, bf16x8 pa1, bf16x8 pa2, bf16x8 pa3) { PvFrag f; pvr_issue<D0>(f, vb); pv_mma(od, f, pa0, pa1, pa2, pa3); }
#if MLA_OT
__device__ __forceinline__ int vt_rm_base(int lane) { return (4 * (lane >> 5) + ((lane >> 2) & 3)) * KPITCH + 32 * ((lane >> 4) & 1) + 8 * (lane & 3); }
template <int D0> __device__ __forceinline__ void pvt_issue(PvFrag& f, int vb) {
    constexpr int KS = 16 * KPITCH, HF = 8 * KPITCH;
    f.l0 = tr_read<D0 * 64 + 0 * KS>(vb); f.h0 = tr_read<D0 * 64 + 0 * KS + HF>(vb); f.l1 = tr_read<D0 * 64 + 1 * KS>(vb); f.h1 = tr_read<D0 * 64 + 1 * KS + HF>(vb);
    f.l2 = tr_read<D0 * 64 + 2 * KS>(vb); f.h2 = tr_read<D0 * 64 + 2 * KS + HF>(vb); f.l3 = tr_read<D0 * 64 + 3 * KS>(vb); f.h3 = tr_read<D0 * 64 + 3 * KS + HF>(vb);
}
__device__ __forceinline__ void pvt_mma(f32x16& od, const PvFrag& f, bf16x8 pa0, bf16x8 pa1, bf16x8 pa2, bf16x8 pa3) {
    asm volatile("s_waitcnt lgkmcnt(0)" ::: "memory"); SBAR();
#define PK(L, H) (bf16x8){L[0], L[1], L[2], L[3], H[0], H[1], H[2], H[3]}
    od = __builtin_amdgcn_mfma_f32_32x32x16_bf16(PK(f.l0, f.h0), pa0, od, 0, 0, 0);
    od = __builtin_amdgcn_mfma_f32_32x32x16_bf16(PK(f.l1, f.h1), pa1, od, 0, 0, 0);
    od = __builtin_amdgcn_mfma_f32_32x32x16_bf16(PK(f.l2, f.h2), pa2, od, 0, 0, 0);
    od = __builtin_amdgcn_mfma_f32_32x32x16_bf16(PK(f.l3, f.h3), pa3, od, 0, 0, 0);
#undef PK
}
template <int D0> __device__ __forceinline__ void pvt_one(f32x16& od, int vb, bf16x8 pa0, bf16x8 pa1, bf16x8 pa2, bf16x8 pa3) { PvFrag f; pvt_issue<D0>(f, vb); pvt_mma(od, f, pa0, pa1, pa2, pa3); }
#define MLA_PV_ISSUE pvt_issue
#define MLA_PV_MMA pvt_mma
#define MLA_PV_ONE pvt_one
#define MLA_V_BASE vt_rm_base
#else
#define MLA_PV_ISSUE pvr_issue
#define MLA_PV_MMA pv_mma
#define MLA_PV_ONE pvr_one
#define MLA_V_BASE v_rm_base
#endif
__device__ __forceinline__ void h1_qk_finish(f32x16& C0, f32x16& C1, f32x16& P0, f32x16& P1, const f32x16& negm, const char* Ks, const bf16x8* qr, int r32, int hi,
                                             float alP, float& l_reg, bf16x8& pa0, bf16x8& pa1, bf16x8& pa2, bf16x8& pa3) {
    const char* kb = Ks + hi * 16 + r32 * KPITCH;
    bf16x8 b0 = *reinterpret_cast<const bf16x8*>(kb), b1 = *reinterpret_cast<const bf16x8*>(kb + 32 * KPITCH);
    float a0 = 0.f, a1 = 0.f, c0 = 0.f, c1 = 0.f; unsigned w[16];
#pragma unroll
    for (int k = 0; k < 12; ++k) {
        bf16x8 n0 = b0, n1 = b1;
        if (k < 11) { n0 = *reinterpret_cast<const bf16x8*>(kb + (k + 1) * 32); n1 = *reinterpret_cast<const bf16x8*>(kb + (k + 1) * 32 + 32 * KPITCH); }
        if (k == 0) { C0 = __builtin_amdgcn_mfma_f32_32x32x16_bf16(b0, qr[0], negm, 0, 0, 0); C1 = __builtin_amdgcn_mfma_f32_32x32x16_bf16(b1, qr[0], negm, 0, 0, 0); }
        else { C0 = __builtin_amdgcn_mfma_f32_32x32x16_bf16(b0, qr[k], C0, 0, 0, 0); C1 = __builtin_amdgcn_mfma_f32_32x32x16_bf16(b1, qr[k], C1, 0, 0, 0); }
        if (k < 8) { float e0 = __builtin_amdgcn_exp2f(P1[2 * k]), e1 = __builtin_amdgcn_exp2f(P1[2 * k + 1]);
            if (k == 0) { a0 = P0[0]; a1 = P0[1]; } else { a0 += P0[2 * k]; a1 += P0[2 * k + 1]; }
            w[k] = cvtpk2(P0[2 * k], P0[2 * k + 1]);
            asm volatile("" : "+v"(e0), "+v"(e1), "+v"(a0), "+v"(a1), "+v"(w[k]));
            P1[2 * k] = e0; P1[2 * k + 1] = e1; }
        else { const int e = 4 * (k - 8);
            if (k == 8) { c0 = P1[0] + P1[2]; c1 = P1[1] + P1[3]; } else { c0 += P1[e]; c1 += P1[e + 1]; c0 += P1[e + 2]; c1 += P1[e + 3]; }
            w[8 + 2 * (k - 8)] = cvtpk2(P1[e], P1[e + 1]); w[9 + 2 * (k - 8)] = cvtpk2(P1[e + 2], P1[e + 3]);
            asm volatile("" : "+v"(c0), "+v"(c1), "+v"(w[8 + 2 * (k - 8)]), "+v"(w[9 + 2 * (k - 8)])); }
        SBAR();
        b0 = n0; b1 = n1;
    }
    l_reg = l_reg * alP + half_sum((a0 + a1) + (c0 + c1));
    { u32x4 w0 = {w[0], w[1], w[2], w[3]}, w1 = {w[4], w[5], w[6], w[7]}, w2 = {w[8], w[9], w[10], w[11]}, w3 = {w[12], w[13], w[14], w[15]};
      pa0 = *reinterpret_cast<bf16x8*>(&w0); pa1 = *reinterpret_cast<bf16x8*>(&w1); pa2 = *reinterpret_cast<bf16x8*>(&w2); pa3 = *reinterpret_cast<bf16x8*>(&w3); }
}
__device__ __forceinline__ void max_head(const f32x16& p0, const f32x16& p1, float& a, float& b, float& c, float& e) {
    a = max3f(p0[0], p0[1], p0[2]); b = max3f(p0[9], p0[10], p0[11]); c = max3f(p1[0], p1[1], p1[2]); e = max3f(p1[9], p1[10], p1[11]);
    a = max3f(a, p0[3], p0[4]); b = max3f(b, p0[12], p0[13]); c = max3f(c, p1[3], p1[4]); e = max3f(e, p1[12], p1[13]);
}
__device__ __forceinline__ float max_tail(const f32x16& p0, const f32x16& p1, float a, float b, float c, float e) {
    a = max3f(a, p0[5], p0[6]); b = max3f(b, p0[14], p0[15]); c = max3f(c, p1[5], p1[6]); e = max3f(e, p1[14], p1[15]);
    a = max3f(a, p0[7], p0[8]); c = max3f(c, p1[7], p1[8]);
    float pmax = max3f(a, b, c); pmax = max3f(pmax, e, e);
    auto rr = __builtin_amdgcn_permlane32_swap(__float_as_uint(pmax), __float_as_uint(pmax), false, false);
    return max3f(__uint_as_float(rr[0]), __uint_as_float(rr[1]), __uint_as_float(rr[1]));
}
struct Tensors { const bf16_t* QA; const bf16_t* KL; const bf16_t* WV; const bf16_t* GA; const bf16_t* OB; bf16_t* MIX; };
__device__ __forceinline__ void unit(int b, int h, int qb, const Tensors& T, char* shm, const int wave_id) {
    const int lane = pg8::lane_id_fresh(), wid = wave_id, r32 = lane & 31, hi = lane >> 5;
    const long rowbase = (long)b * SEQ; const int q0 = qb * 256;
    const unsigned lds0 = (unsigned)(uintptr_t)shm;
    float* wsf = (float*)(shm + LDS_WS) + wid * 64; float* al_l = wsf; float* li_l = wsf + 32;
    const char* klb = (const char*)(T.KL + rowbase * 192);
    unsigned koff0, koff1, koff2;
    { int s = 64 * wid + lane, row = s / 25, pos = s - 25 * row; koff0 = (unsigned)(row * 384 + (pos < 24 ? pos : 23) * 16);
      s += 512; row = s / 25; pos = s - 25 * row; koff1 = (unsigned)(row * 384 + (pos < 24 ? pos : 23) * 16);
      s += 512; row = s / 25; pos = s - 25 * row; koff2 = (unsigned)(row * 384 + (pos < 24 ? pos : 23) * 16); }
#define MLA_DMA(t) do { const unsigned kd_ = (unsigned)__builtin_amdgcn_readfirstlane(lds0 + LDS_K + ((t) & 3) * KSLOT + wid * 1024); const char* kb_ = klb + (size_t)(t) * 24576; \
        glds16s<0>(kb_, koff0, kd_); glds16s<0>(kb_, koff1, kd_ + 8192); glds16s<0>(kb_, koff2, kd_ + 16384); \
        if (wid == 0) { const int s_ = 1536 + lane, row_ = 61 + (lane >= 14) + (lane >= 39), pos_ = s_ - 25 * row_; glds16s<0>(kb_, (unsigned)(row_ * 384 + (pos_ < 24 ? pos_ : 23) * 16), kd_ + 24576); } } while (0)
    MLA_DMA(0); MLA_DMA(1);
    bf16x8 qr[12];
    { const bf16_t* Qw = T.QA + (rowbase + q0 + wid * 32 + r32) * 1536 + h * 192 + hi * 8;
#pragma unroll
      for (int d0 = 0; d0 < 12; ++d0) qr[d0] = *reinterpret_cast<const bf16x8*>(Qw + d0 * 16); }
    const int vb0 = (int)(lds0 + LDS_K) + MLA_V_BASE(lane);
    float l_reg = 0.f; f32x16 o[4] = {};
    f32x16 negm = {}; asm volatile("" : "+v"(negm));
    f32x16 pA0, pA1, pB0, pB1; float alA, alB; bf16x8 pa0, pa1, pa2, pa3;
#if MLA_OT
#define MLA_RESC(a) do { if (__any((a) < 1.f)) { _Pragma("unroll") for (int d = 0; d < 4; ++d) _Pragma("unroll") for (int r = 0; r < 16; ++r) o[d][r] *= (a); } } while (0)
#else
#define MLA_RESC(a) do { if (__any((a) < 1.f)) { if (hi == 0) al_l[r32] = (a); asm volatile("s_waitcnt lgkmcnt(0)" ::: "memory"); \
        _Pragma("unroll") for (int d = 0; d < 4; ++d) _Pragma("unroll") for (int r = 0; r < 16; ++r) o[d][r] *= al_l[crow(r, hi)]; } } while (0)
#endif
#define ATT_BAR_L() asm volatile("s_waitcnt lgkmcnt(0)\n\ts_barrier" ::: "memory")
    ATT_WAIT_BAR(0);
    if (wid >= 4) ATT_BAR_L();
    qkt<12, KPITCH, 16>(pA0, pA1, shm + LDS_K, qr, r32, hi); ATT_WAIT_BAR(0);
    MLA_DMA(2); partialSM<true>(pA0, pA1, negm, alA); ATT_BAR_L();
#define MLA_STEP(C0, C1, P0, P1, alC, alP, t, HASN) do { \
        h1_qk_finish(C0, C1, P0, P1, negm, shm + LDS_K + ((t) & 3) * KSLOT, qr, r32, hi, alP, l_reg, pa0, pa1, pa2, pa3); SBAR(); ATT_WAIT_BAR(0); \
        { const int vb_ = vb0 + (((t) - 1) & 3) * KSLOT; float ma_, mb_, mc_, me_, pmx_; \
          { PvFrag f_; MLA_PV_ISSUE<0>(f_, vb_); if (HASN) { MLA_DMA((t) + 2); } max_head(C0, C1, ma_, mb_, mc_, me_); SBAR(); MLA_PV_MMA(o[0], f_, pa0, pa1, pa2, pa3); } \
          { PvFrag f_; MLA_PV_ISSUE<1>(f_, vb_); pmx_ = max_tail(C0, C1, ma_, mb_, mc_, me_); SBAR(); MLA_PV_MMA(o[1], f_, pa0, pa1, pa2, pa3); } \
          alC = 1.f; \
          if (!__builtin_expect(__all(pmx_ <= THR), 1)) { const float dl_ = fmaxf(pmx_, 0.f); alC = __builtin_amdgcn_exp2f(-dl_); \
              _Pragma("unroll") for (int r_ = 0; r_ < 16; ++r_) { C0[r_] -= dl_; C1[r_] -= dl_; negm[r_] -= dl_; } asm volatile("" : "+v"(negm)); } \
          { PvFrag f_; MLA_PV_ISSUE<2>(f_, vb_); _Pragma("unroll") for (int r_ = 0; r_ < 8; ++r_) C0[r_] = __builtin_amdgcn_exp2f(C0[r_]); asm volatile("" : "+v"(C0)); SBAR(); MLA_PV_MMA(o[2], f_, pa0, pa1, pa2, pa3); } \
          { PvFrag f_; MLA_PV_ISSUE<3>(f_, vb_); _Pragma("unroll") for (int r_ = 8; r_ < 16; ++r_) C0[r_] = __builtin_amdgcn_exp2f(C0[r_]); asm volatile("" : "+v"(C0)); SBAR(); MLA_PV_MMA(o[3], f_, pa0, pa1, pa2, pa3); } } \
        SBAR(); ATT_BAR_L(); MLA_RESC(alC); } while (0)
    for (int t = 1; t + 1 < NTILE; t += 2) {
        MLA_STEP(pB0, pB1, pA0, pA1, alB, alA, t, true);
        MLA_STEP(pA0, pA1, pB0, pB1, alA, alB, t + 1, (t + 3 < NTILE));
    }
    { qkt_c<12, KPITCH, 16>(pB0, pB1, negm, shm + LDS_K + ((NTILE - 1) & 3) * KSLOT, qr, r32, hi);
      finishSM(pA0, pA1, alA, l_reg, pa0, pa1, pa2, pa3); SBAR(); ATT_WAIT_BAR(0);
      { const int vb_ = vb0 + ((NTILE - 2) & 3) * KSLOT; MLA_PV_ONE<0>(o[0], vb_, pa0, pa1, pa2, pa3); MLA_PV_ONE<1>(o[1], vb_, pa0, pa1, pa2, pa3); MLA_PV_ONE<2>(o[2], vb_, pa0, pa1, pa2, pa3); MLA_PV_ONE<3>(o[3], vb_, pa0, pa1, pa2, pa3); }
      partialSM<false>(pB0, pB1, negm, alB);
      ATT_BAR_L(); MLA_RESC(alB);
      finishSM(pB0, pB1, alB, l_reg, pa0, pa1, pa2, pa3); SBAR();
      { const int vb_ = vb0 + ((NTILE - 1) & 3) * KSLOT; MLA_PV_ONE<0>(o[0], vb_, pa0, pa1, pa2, pa3); MLA_PV_ONE<1>(o[1], vb_, pa0, pa1, pa2, pa3); MLA_PV_ONE<2>(o[2], vb_, pa0, pa1, pa2, pa3); MLA_PV_ONE<3>(o[3], vb_, pa0, pa1, pa2, pa3); } }
    if (wid < 4) ATT_BAR_L();
#if MLA_OT
    { const float rl = __builtin_amdgcn_rcpf(l_reg);
      bf16x8 pb[8];
#pragma unroll
      for (int ks = 0; ks < 8; ++ks) { const int bl = ks >> 1, b8 = (ks & 1) * 8;
          u32x4 w = {cvtpk(o[bl][b8 + 0] * rl, o[bl][b8 + 1] * rl), cvtpk(o[bl][b8 + 2] * rl, o[bl][b8 + 3] * rl), cvtpk(o[bl][b8 + 4] * rl, o[bl][b8 + 5] * rl), cvtpk(o[bl][b8 + 6] * rl, o[bl][b8 + 7] * rl)};
          pb[ks] = *reinterpret_cast<bf16x8*>(&w); }
      const bf16_t* wv = T.WV + ((size_t)(h * 128 + r32) * 128 + hi * 8);
      char* stg = shm + LDS_K + wid * (32 * 272);
      const int srow = lane >> 3, sc8 = (lane & 7) * 8;
#pragma unroll
      for (int half = 0; half < 2; ++half) {
#pragma unroll
          for (int db2 = 0; db2 < 2; ++db2) { const int db = 2 * half + db2; f32x16 oa = f32x16{};
#pragma unroll
              for (int ks = 0; ks < 8; ++ks) { const bf16x8 bw = *reinterpret_cast<const bf16x8*>(wv + (size_t)db * 32 * 128 + ks * 16);
                  oa = __builtin_amdgcn_mfma_f32_32x32x16_bf16(bw, pb[ks], oa, 0, 0, 0); }
#pragma unroll
              for (int g = 0; g < 4; ++g) *reinterpret_cast<pg8::f32x4*>(stg + r32 * 272 + (db2 * 32 + 8 * g + 4 * hi) * 4) = pg8::f32x4{oa[4 * g], oa[4 * g + 1], oa[4 * g + 2], oa[4 * g + 3]}; }
#pragma unroll
          for (int it = 0; it < 4; ++it) { const int row = it * 8 + srow;
              const pg8::f32x4 x0 = *reinterpret_cast<const pg8::f32x4*>(stg + row * 272 + sc8 * 4), x1 = *reinterpret_cast<const pg8::f32x4*>(stg + row * 272 + sc8 * 4 + 16);
              const size_t off = (size_t)(rowbase + q0 + wid * 32 + row) * 1024 + h * 128 + half * 64 + sc8;
              const u32x4 ga = *reinterpret_cast<const u32x4*>(T.GA + off), ob = *reinterpret_cast<const u32x4*>(T.OB + off);
              u32x4 w;
#define MIX2(X, A, B, GW, OW) cvtpk2(X[A] * __uint_as_float((GW) << 16) + __uint_as_float((OW) << 16), X[B] * __uint_as_float((GW) & 0xffff0000u) + __uint_as_float((OW) & 0xffff0000u))
              w[0] = MIX2(x0, 0, 1, ga[0], ob[0]); w[1] = MIX2(x0, 2, 3, ga[1], ob[1]); w[2] = MIX2(x1, 0, 1, ga[2], ob[2]); w[3] = MIX2(x1, 2, 3, ga[3], ob[3]);
#undef MIX2
              *reinterpret_cast<u32x4*>(T.MIX + off) = w; } } }
#else
    if (hi == 0) li_l[r32] = l_reg; asm volatile("s_waitcnt lgkmcnt(0)" ::: "memory");
    ATT_BAR_L();
    { char* stg = shm + LDS_K + wid * OST_WAVE;
#if MLA_OT
#pragma unroll
      for (int r = 0; r < 16; ++r) { const float rl = __builtin_amdgcn_rcpf(l_reg);
#pragma unroll
          for (int d0 = 0; d0 < 4; ++d0) *(bf16_t*)(stg + r32 * OST_PITCH + (d0 * 32 + crow(r, hi)) * 2) = f2bf(o[d0][r] * rl); }
#else
#pragma unroll
      for (int r = 0; r < 16; ++r) { const float rl = __builtin_amdgcn_rcpf(li_l[crow(r, hi)]);
#pragma unroll
          for (int d0 = 0; d0 < 4; ++d0) *(bf16_t*)(stg + crow(r, hi) * OST_PITCH + (d0 * 32 + r32) * 2) = f2bf(o[d0][r] * rl); }
#endif
      asm volatile("s_waitcnt lgkmcnt(0)" ::: "memory");
      bf16x8 af[8];
#pragma unroll
      for (int ks = 0; ks < 8; ++ks) af[ks] = *reinterpret_cast<const bf16x8*>(stg + r32 * OST_PITCH + ks * 32 + hi * 16);
      const bf16_t* wv = T.WV + ((size_t)(h * 128 + r32) * 128 + hi * 8);
#pragma unroll
      for (int d0 = 0; d0 < 4; ++d0) { o[d0] = f32x16{};
#pragma unroll
          for (int ks = 0; ks < 8; ++ks) { const bf16x8 bw = *reinterpret_cast<const bf16x8*>(wv + (size_t)d0 * 32 * 128 + ks * 16);
              o[d0] = __builtin_amdgcn_mfma_f32_32x32x16_bf16(af[ks], bw, o[d0], 0, 0, 0); } } }
    const long orow0 = rowbase + q0 + wid * 32;
#pragma unroll
    for (int r = 0; r < 16; ++r) { const long off = (orow0 + crow(r, hi)) * 1024 + h * 128 + r32;
#pragma unroll
        for (int d0 = 0; d0 < 4; ++d0) { const float v = o[d0][r] * bf2f(T.GA[off + d0 * 32]) + bf2f(T.OB[off + d0 * 32]); T.MIX[off + d0 * 32] = f2bf(v); } }
#endif
    asm volatile("s_waitcnt lgkmcnt(0)\n\ts_barrier" ::: "memory");
#undef MLA_DMA
#undef MLA_RESC
#undef ATT_BAR_L
#undef MLA_STEP
#undef MLA_PV_ISSUE
#undef MLA_PV_MMA
#undef MLA_PV_ONE
#undef MLA_V_BASE
}
}

namespace mla2 {
using mla::NTILE; using mla::KPITCH; using mla::KSLOT; using mla::THR; using mla::OST_PITCH; using mla::OST_WAVE;
constexpr int NSLOT = 3;
constexpr int LDS_K = 0, LDS_P = NSLOT * KSLOT  , LDS_X = LDS_P + 65536  , LDS_BYTES = LDS_X + 4096;
static_assert(8 * OST_WAVE <= NSLOT * KSLOT, "o_lat staging fits the ring");
using mla::Tensors;
__device__ __forceinline__ void softmax_block(f32x16& p0, f32x16& p1, float& m_reg, float& l_reg, float& alpha, bf16x8& pa0, bf16x8& pa1, bf16x8& pa2, bf16x8& pa3) {
    float pm0 = fmaxf(p0[0], p0[1]), pm1 = fmaxf(p0[2], p0[3]), pm2 = fmaxf(p1[0], p1[1]), pm3 = fmaxf(p1[2], p1[3]);
#pragma unroll
    for (int r = 4; r < 16; r += 4) { pm0 = fmaxf(fmaxf(pm0, p0[r]), p0[r + 1]); pm1 = fmaxf(fmaxf(pm1, p0[r + 2]), p0[r + 3]); pm2 = fmaxf(fmaxf(pm2, p1[r]), p1[r + 1]); pm3 = fmaxf(fmaxf(pm3, p1[r + 2]), p1[r + 3]); }
    const float pmax = half_max(fmaxf(fmaxf(pm0, pm1), fmaxf(pm2, pm3)));
    const bool keep = __all(pmax - m_reg <= THR);
    const float mn = keep ? m_reg : fmaxf(m_reg, pmax); alpha = __builtin_amdgcn_exp2f(m_reg - mn); m_reg = mn;
#pragma unroll
    for (int r = 0; r < 16; ++r) { p0[r] = __builtin_amdgcn_exp2f(p0[r] - mn); p1[r] = __builtin_amdgcn_exp2f(p1[r] - mn); }
    float s0 = p0[0] + p0[1], s1 = p0[2] + p0[3], s2 = p1[0] + p1[1], s3 = p1[2] + p1[3];
#pragma unroll
    for (int r = 4; r < 16; r += 4) { s0 += p0[r]; s0 += p0[r + 1]; s1 += p0[r + 2]; s1 += p0[r + 3]; s2 += p1[r]; s2 += p1[r + 1]; s3 += p1[r + 2]; s3 += p1[r + 3]; }
    l_reg = l_reg * alpha + half_sum((s0 + s1) + (s2 + s3));
    pack_p(p0, p1, pa0, pa1, pa2, pa3);
}
__device__ __forceinline__ void out_block(const char* stg, const Tensors& T, int h, long orow0, int r32, int hi) {
    bf16x8 af[8];
#pragma unroll
    for (int ks = 0; ks < 8; ++ks) af[ks] = *reinterpret_cast<const bf16x8*>(stg + r32 * OST_PITCH + ks * 32 + hi * 16);
    const bf16_t* wv = T.WV + ((size_t)(h * 128 + r32) * 128 + hi * 8);
    f32x16 oa[4];
#pragma unroll
    for (int d0 = 0; d0 < 4; ++d0) { oa[d0] = f32x16{};
#pragma unroll
        for (int ks = 0; ks < 8; ++ks) { const bf16x8 bw = *reinterpret_cast<const bf16x8*>(wv + (size_t)d0 * 32 * 128 + ks * 16);
            oa[d0] = __builtin_amdgcn_mfma_f32_32x32x16_bf16(af[ks], bw, oa[d0], 0, 0, 0); } }
#pragma unroll
    for (int r = 0; r < 16; ++r) { const long off = (orow0 + crow(r, hi)) * 1024 + h * 128 + r32;
#pragma unroll
        for (int d0 = 0; d0 < 4; ++d0) { const float v = oa[d0][r] * bf2f(T.GA[off + d0 * 32]) + bf2f(T.OB[off + d0 * 32]); T.MIX[off + d0 * 32] = f2bf(v); } }
}
__device__ __forceinline__ void unit(int b, int h, int qb, const Tensors& T, char* shm, const int wave_id) {
    const int lane = pg8::lane_id_fresh(), wid = wave_id, r32 = lane & 31, hi = lane >> 5;
    const bool is_qk = wid < 4; const int pair = wid & 3;
    const long rowbase = (long)b * SEQ; const int q0 = qb * 256;
    const unsigned lds0 = (unsigned)(uintptr_t)shm;
    char* Pp = shm + LDS_P + pair * 8192; char* Xp = shm + LDS_X + pair * 1024;
    float* alx = (float*)Xp; float* lx = (float*)(Xp + 512); unsigned* fx = (unsigned*)(Xp + 768);
#define M2_BAR() asm volatile("s_waitcnt vmcnt(0) lgkmcnt(0)\n\ts_barrier" ::: "memory")
    const char* klb = (const char*)(T.KL + rowbase * 192);
#define M2_PIECE(kb_, p_, dst_) do { const int s_ = 64 * (p_) + lane, row_ = (s_ * 1311) >> 15, pos_ = s_ - 25 * row_; \
        glds16s<0>(kb_, (unsigned)(row_ * 384 + (pos_ < 24 ? pos_ : 23) * 16), (unsigned)__builtin_amdgcn_readfirstlane(dst_ + (p_) * 1024)); } while (0)
#define M2_DMA(t) do { const unsigned sd_ = lds0 + LDS_K + ((t) % 3) * KSLOT; const char* kb_ = klb + (size_t)(t) * 24576; \
        _Pragma("unroll") for (int i_ = 0; i_ < 6; ++i_) M2_PIECE(kb_, pair + 4 * i_, sd_); if (pair == 0) M2_PIECE(kb_, 24, sd_); } while (0)
    const int vb0 = (int)(lds0 + LDS_K) + mla::v_rm_base(lane);
#define M2_BAR_L() asm volatile("s_waitcnt lgkmcnt(0)\n\ts_barrier" ::: "memory")
    if (is_qk) {
        bf16x8 qA[12], qB[12]; float mA = -1e30f, mB = -1e30f, lA = 0.f, lB = 0.f;
        { const bf16_t* Qw = T.QA + (rowbase + q0 + pair * 64 + r32) * 1536 + h * 192 + hi * 8;
#pragma unroll
          for (int d0 = 0; d0 < 12; ++d0) { qA[d0] = *reinterpret_cast<const bf16x8*>(Qw + d0 * 16); qB[d0] = *reinterpret_cast<const bf16x8*>(Qw + 32 * 1536 + d0 * 16); } }
        f32x16 pA0, pA1, pB0, pB1;
        char* pw = Pp + lane * 16;
#define M2_QK(P0, P1, Q, t) do { P0 = f32x16{}; P1 = f32x16{}; const char* kb_ = shm + LDS_K + ((t) % 3) * KSLOT + hi * 16 + r32 * KPITCH; \
        _Pragma("unroll") for (int d0 = 0; d0 < 12; ++d0) { const bf16x8 b0_ = *reinterpret_cast<const bf16x8*>(kb_ + d0 * 32), b1_ = *reinterpret_cast<const bf16x8*>(kb_ + d0 * 32 + 32 * KPITCH); \
            P0 = __builtin_amdgcn_mfma_f32_32x32x16_bf16(b0_, Q[d0], P0, 0, 0, 0); P1 = __builtin_amdgcn_mfma_f32_32x32x16_bf16(b1_, Q[d0], P1, 0, 0, 0); } } while (0)
#define M2_SM(P0, P1, M, L, BLK) do { bf16x8 a0_, a1_, a2_, a3_; float al_; softmax_block(P0, P1, M, L, al_, a0_, a1_, a2_, a3_); \
        *reinterpret_cast<bf16x8*>(pw + (BLK) * 4096) = a0_; *reinterpret_cast<bf16x8*>(pw + (BLK) * 4096 + 1024) = a1_; *reinterpret_cast<bf16x8*>(pw + (BLK) * 4096 + 2048) = a2_; *reinterpret_cast<bf16x8*>(pw + (BLK) * 4096 + 3072) = a3_; \
        const bool f_ = __any(al_ < 1.f); if (hi == 0) alx[(BLK) * 32 + r32] = al_; if (lane == 0) fx[BLK] = f_ ? 1u : 0u; } while (0)
        M2_BAR();
        M2_QK(pA0, pA1, qA, 0); M2_BAR_L();
        M2_QK(pB0, pB1, qB, 0); M2_SM(pA0, pA1, mA, lA, 0); M2_BAR_L();
        for (int t = 1; t < NTILE; ++t) {
            M2_QK(pA0, pA1, qA, t); M2_SM(pB0, pB1, mB, lB, 1); M2_BAR_L();
            M2_QK(pB0, pB1, qB, t); M2_SM(pA0, pA1, mA, lA, 0); M2_BAR_L();
        }
        M2_SM(pB0, pB1, mB, lB, 1); M2_BAR_L();
        M2_BAR_L();
        if (hi == 0) { lx[r32] = lA; lx[32 + r32] = lB; }
        M2_BAR();
        M2_BAR();
#undef M2_QK
#undef M2_SM
    } else {
        f32x16 oA[4] = {}, oB[4] = {};
        const char* pr = Pp + lane * 16;
#define M2_PVB(O, BLK, t1) do { const int vb_ = vb0 + ((t1) % 3) * KSLOT; \
        const bf16x8 a0_ = *reinterpret_cast<const bf16x8*>(pr + (BLK) * 4096), a1_ = *reinterpret_cast<const bf16x8*>(pr + (BLK) * 4096 + 1024), a2_ = *reinterpret_cast<const bf16x8*>(pr + (BLK) * 4096 + 2048), a3_ = *reinterpret_cast<const bf16x8*>(pr + (BLK) * 4096 + 3072); \
        if (fx[BLK] != 0u) { _Pragma("unroll") for (int d = 0; d < 4; ++d) _Pragma("unroll") for (int r = 0; r < 16; ++r) O[d][r] *= alx[(BLK) * 32 + crow(r, hi)]; } \
        mla::pvr_one<0>(O[0], vb_, a0_, a1_, a2_, a3_); mla::pvr_one<1>(O[1], vb_, a0_, a1_, a2_, a3_); mla::pvr_one<2>(O[2], vb_, a0_, a1_, a2_, a3_); mla::pvr_one<3>(O[3], vb_, a0_, a1_, a2_, a3_); } while (0)
        M2_DMA(0);
        M2_BAR();
        M2_DMA(1); M2_BAR_L();
        M2_BAR();
        for (int t = 1; t < NTILE; ++t) {
            if (t + 1 < NTILE) M2_DMA(t + 1);
            M2_PVB(oA, 0, t - 1); M2_BAR_L();
            M2_PVB(oB, 1, t - 1); M2_BAR();
        }
        M2_PVB(oA, 0, NTILE - 1); M2_BAR_L();
        M2_PVB(oB, 1, NTILE - 1); M2_BAR_L();
#undef M2_PVB
        M2_BAR();
        { char* stgA = shm + LDS_K + (2 * pair) * OST_WAVE; char* stgB = stgA + OST_WAVE;
#pragma unroll
          for (int r = 0; r < 16; ++r) { const float ra = __builtin_amdgcn_rcpf(lx[crow(r, hi)]), rb = __builtin_amdgcn_rcpf(lx[32 + crow(r, hi)]);
#pragma unroll
              for (int d0 = 0; d0 < 4; ++d0) { *(bf16_t*)(stgA + crow(r, hi) * OST_PITCH + (d0 * 32 + r32) * 2) = f2bf(oA[d0][r] * ra); *(bf16_t*)(stgB + crow(r, hi) * OST_PITCH + (d0 * 32 + r32) * 2) = f2bf(oB[d0][r] * rb); } } }
        M2_BAR();
    }
#undef M2_BAR_L
    { const char* stg = shm + LDS_K + (2 * pair + (is_qk ? 1 : 0)) * OST_WAVE;
      out_block(stg, T, h, rowbase + q0 + pair * 64 + (is_qk ? 32 : 0), r32, hi); }
    asm volatile("s_waitcnt lgkmcnt(0)\n\ts_barrier" ::: "memory");
#undef M2_BAR
#undef M2_PIECE
#undef M2_DMA
}
}

namespace swa {
constexpr int KP = 144  , KT = 64 * KP  ;
constexpr int LDS_K = 0;
struct Tensors { const bf16_t* QB; const bf16_t* KB; const bf16_t* VB; bf16_t* GOB; const float* BT2; const float* SINK2; };
__device__ __forceinline__ int vt_base64(int lane) { return ((lane & 3) << 3) | (((lane >> 2) & 3) << 6) | (((lane >> 4) & 1) << 5) | ((lane >> 5) << 10); }
template <int D0> __device__ __forceinline__ void pvt64(f32x16& od, int vb, bf16x8 pa0, bf16x8 pa1, bf16x8 pa2, bf16x8 pa3) {
    const s16x4 l0 = tr_read<D0 * 512 + 0 * 2048>(vb), h0 = tr_read<D0 * 512 + 0 * 2048 + 256>(vb), l1 = tr_read<D0 * 512 + 1 * 2048>(vb), h1 = tr_read<D0 * 512 + 1 * 2048 + 256>(vb);
    const s16x4 l2 = tr_read<D0 * 512 + 2 * 2048>(vb), h2 = tr_read<D0 * 512 + 2 * 2048 + 256>(vb), l3 = tr_read<D0 * 512 + 3 * 2048>(vb), h3 = tr_read<D0 * 512 + 3 * 2048 + 256>(vb);
    asm volatile("s_waitcnt lgkmcnt(0)" ::: "memory"); SBAR();
#define PK(L, H) (bf16x8){L[0], L[1], L[2], L[3], H[0], H[1], H[2], H[3]}
    od = __builtin_amdgcn_mfma_f32_32x32x16_bf16(PK(l0, h0), pa0, od, 0, 0, 0);
    od = __builtin_amdgcn_mfma_f32_32x32x16_bf16(PK(l1, h1), pa1, od, 0, 0, 0);
    od = __builtin_amdgcn_mfma_f32_32x32x16_bf16(PK(l2, h2), pa2, od, 0, 0, 0);
    od = __builtin_amdgcn_mfma_f32_32x32x16_bf16(PK(l3, h3), pa3, od, 0, 0, 0);
#undef PK
}
constexpr int NQB = 8, RING = 6;
constexpr int LDS_V = RING * KT, LDS_TAB = LDS_V + RING * 8192, LDS_BYTES = LDS_TAB + 4 * 4 * 384 * 4;
constexpr float THR = 8.f;
typedef float f32x8_t __attribute__((ext_vector_type(8)));
__device__ __forceinline__ f32x16 cat4(pg8::f32x4 a, pg8::f32x4 b, pg8::f32x4 c, pg8::f32x4 e) {
    const f32x8_t lo = __builtin_shufflevector(a, b, 0, 1, 2, 3, 4, 5, 6, 7), hi = __builtin_shufflevector(c, e, 0, 1, 2, 3, 4, 5, 6, 7);
    return __builtin_shufflevector(lo, hi, 0, 1, 2, 3, 4, 5, 6, 7, 8, 9, 10, 11, 12, 13, 14, 15); }
__device__ __forceinline__ void bias_init(f32x16& n0, f32x16& n1, const float* tb) { const pg8::f32x4* q = reinterpret_cast<const pg8::f32x4*>(tb);
    n0 = cat4(q[0], q[2], q[4], q[6]); n1 = cat4(q[8], q[10], q[12], q[14]); }
__device__ __forceinline__ void qk_acc(f32x16& n0, f32x16& n1, const char* Ks, const bf16x8* qr, int r32, int hi) {
    const char* kb = Ks + hi * 16 + r32 * KP;
#pragma unroll
    for (int d0 = 0; d0 < 4; ++d0) { const bf16x8 b0 = *reinterpret_cast<const bf16x8*>(kb + d0 * 32), b1 = *reinterpret_cast<const bf16x8*>(kb + d0 * 32 + 32 * KP);
        n0 = __builtin_amdgcn_mfma_f32_32x32x16_bf16(b0, qr[d0], n0, 0, 0, 0); n1 = __builtin_amdgcn_mfma_f32_32x32x16_bf16(b1, qr[d0], n1, 0, 0, 0); }
}
#ifdef TP_SWA
#define SWA_TSARG , unsigned long long (&ts)[6]
#else
#define SWA_TSARG
#endif
__device__ __forceinline__ void run(int b, int kvh, int j, const Tensors& T, char* shm, const int wave_id SWA_TSARG) {
    const int lane = pg8::lane_id_fresh(), wid = wave_id, tid = wid * 64 + lane, r32 = lane & 31, hi = lane >> 5;
    const int g = wid >> 1, rh = wid & 1, head = kvh * 4 + g;
    const long rowbase = (long)b * SEQ; const int qb0 = j * NQB;
    const unsigned lds0 = (unsigned)(uintptr_t)shm;
    unsigned vvoff, kvoff, kvoff8;
    { const int st = 2 * wid + (lane >> 5), kk = (st >> 1) * 8 + ((lane & 31) >> 2), k = swap23(kk), c = (st & 1) * 32 + (lane & 3) * 8;
      vvoff = (unsigned)((k * 256 + c) * 2);
      int s = 64 * wid + lane, row = s / 9, pos = s - 9 * row; kvoff = (unsigned)(row * 512 + (pos < 8 ? pos : 7) * 16); s = 512 + lane; row = s / 9; pos = s - 9 * row; kvoff8 = (unsigned)(row * 512 + (pos < 8 ? pos : 7) * 16); }
#define SWA_DMA(TT) do { const int s_ = (TT) % RING; const long kb_ = rowbase + 64 * (TT); \
        glds16s<0>((const char*)(T.KB + kb_ * 256 + kvh * 64), kvoff, (unsigned)__builtin_amdgcn_readfirstlane(lds0 + LDS_K + s_ * KT + wid * 1024)); \
        if (wid == 0) glds16s<0>((const char*)(T.KB + kb_ * 256 + kvh * 64), kvoff8, (unsigned)__builtin_amdgcn_readfirstlane(lds0 + LDS_K + s_ * KT + 8192)); \
        glds16s<0>((const char*)(T.VB + kb_ * 256 + kvh * 64), vvoff, (unsigned)__builtin_amdgcn_readfirstlane(lds0 + LDS_V + s_ * 8192 + wid * 1024)); } while (0)
#ifdef TP_SWA
#define SWA_TS(slot) do { ts[slot] = __builtin_amdgcn_s_memrealtime(); } while (0)
#else
#define SWA_TS(slot) do { } while (0)
#endif
    SWA_TS(0);
    for (int TT = qb0 - 2; TT <= qb0 + 2; ++TT) if (TT >= 0 && TT < SEQ / 64) SWA_DMA(TT);
    { float* tab = (float*)(shm + LDS_TAB); float tv[12];
#pragma unroll
      for (int x = 0; x < 12; ++x) { const int i = tid + 512 * x, gg = i / 1536, rel = i % 384 + ((i / 384) & 3) - 192; const int rc = rel < -128 ? -128 : (rel > 128 ? 128 : rel);
          tv[x] = T.BT2[(kvh * 4 + gg) * 264 + rc + 128]; }
#pragma unroll
      for (int x = 0; x < 12; ++x) { const int i = tid + 512 * x, rel = i % 384 + ((i / 384) & 3) - 192; tab[i] = (rel >= -128 && rel <= 128) ? tv[x] : -1e30f; } }
    bf16x8 qr[4];
    const bf16_t* Qw = T.QB + (rowbase + qb0 * 64 + rh * 32 + r32) * 1024 + head * 64 + hi * 8;
#pragma unroll
    for (int d0 = 0; d0 < 4; ++d0) qr[d0] = *reinterpret_cast<const bf16x8*>(Qw + d0 * 16);
    const float sink = T.SINK2[head];
    const int vb0 = (int)(lds0 + LDS_V) + vt_base64(lane);
    const float* tbl;
    { const int base = 64 - 32 * rh - r32 + 4 * hi, s = base & 3; tbl = (const float*)(shm + LDS_TAB) + (g * 4 + s) * 384 + (base - s); }
    ATT_WAIT_BAR(0);
    SWA_TS(1);
    for (int i = 0; i < NQB; ++i) {
        const int qb = qb0 + i;
        if (i == 4) SWA_TS(2);
        if (i + 1 < NQB && qb + 3 < SEQ / 64) SWA_DMA(qb + 3);
        bf16x8 qn[4];
        if (i + 1 < NQB) {
#pragma unroll
            for (int d0 = 0; d0 < 4; ++d0) qn[d0] = *reinterpret_cast<const bf16x8*>(Qw + (size_t)(i + 1) * 64 * 1024 + d0 * 16); }
        else {
#pragma unroll
            for (int d0 = 0; d0 < 4; ++d0) qn[d0] = qr[d0]; }
        bf16_t* orow = T.GOB + (size_t)(rowbase + qb * 64 + rh * 32 + r32) * 1024 + head * 64 + 4 * hi;
        pg8::u32x2 gt[8];
#pragma unroll
        for (int x = 0; x < 8; ++x) gt[x] = *reinterpret_cast<const pg8::u32x2*>(orow + (x >> 2) * 32 + 8 * (x & 3));
        float m_reg = sink, l_reg = 1.0f; f32x16 o[2] = {};
        const int t_lo = qb < 2 ? 2 - qb : 0, nt = (qb + 2 >= SEQ / 64 ? SEQ / 64 + 2 - qb : 5) - t_lo;
        f32x16 sa0, sa1, sb0, sb1;
        bias_init(sa0, sa1, tbl + 64 * t_lo); qk_acc(sa0, sa1, shm + LDS_K + ((qb - 2 + t_lo) % RING) * KT, qr, r32, hi);
#define SWA_TILE(C0, C1, N0, N1, k, HASN) do { const int t_ = t_lo + (k), sl_ = (qb - 2 + t_) % RING; const bool hasn_ = (HASN); \
            if (hasn_) bias_init(N0, N1, tbl + 64 * (t_ + 1)); \
            float pmax; { float a = max3f(C0[0], C0[1], C0[2]), b2 = max3f(C0[9], C0[10], C0[11]), c = max3f(C1[0], C1[1], C1[2]), e = max3f(C1[9], C1[10], C1[11]); \
              a = max3f(a, C0[3], C0[4]); b2 = max3f(b2, C0[12], C0[13]); c = max3f(c, C1[3], C1[4]); e = max3f(e, C1[12], C1[13]); \
              a = max3f(a, C0[5], C0[6]); b2 = max3f(b2, C0[14], C0[15]); c = max3f(c, C1[5], C1[6]); e = max3f(e, C1[14], C1[15]); \
              a = max3f(a, C0[7], C0[8]); c = max3f(c, C1[7], C1[8]); pmax = max3f(a, b2, c); pmax = max3f(pmax, e, e); \
              auto rr = __builtin_amdgcn_permlane32_swap(__float_as_uint(pmax), __float_as_uint(pmax), false, false); pmax = max3f(__uint_as_float(rr[0]), __uint_as_float(rr[1]), __uint_as_float(rr[1])); } \
            asm volatile("" : "+v"(pmax)); SBAR(); \
            if (hasn_) qk_acc(N0, N1, shm + LDS_K + ((qb - 1 + t_) % RING) * KT, qr, r32, hi); \
            SBAR(); \
            if (!__builtin_expect(__all(pmax - m_reg <= THR), 1)) { const float mn = fmaxf(m_reg, pmax), alpha = __builtin_amdgcn_exp2f(m_reg - mn); m_reg = mn; l_reg *= alpha; \
                _Pragma("unroll") for (int d_ = 0; d_ < 2; ++d_) _Pragma("unroll") for (int r_ = 0; r_ < 16; ++r_) o[d_][r_] *= alpha; } \
            bf16x8 pa0, pa1, pa2, pa3; \
            { float s0, s1, s2, s3; \
              _Pragma("unroll") for (int r_ = 0; r_ < 16; ++r_) { C0[r_] = __builtin_amdgcn_exp2f(C0[r_] - m_reg); C1[r_] = __builtin_amdgcn_exp2f(C1[r_] - m_reg); } \
              s0 = C0[0] + C0[1]; s1 = C0[2] + C0[3]; s2 = C1[0] + C1[1]; s3 = C1[2] + C1[3]; \
              _Pragma("unroll") for (int r_ = 4; r_ < 16; r_ += 4) { s0 += C0[r_]; s0 += C0[r_ + 1]; s1 += C0[r_ + 2]; s1 += C0[r_ + 3]; s2 += C1[r_]; s2 += C1[r_ + 1]; s3 += C1[r_ + 2]; s3 += C1[r_ + 3]; } \
              l_reg += half_sum((s0 + s1) + (s2 + s3)); } \
            { u32x4 w0 = SWA_PK(C0, 0), w1 = SWA_PK(C0, 8), w2 = SWA_PK(C1, 0), w3 = SWA_PK(C1, 8); \
              pa0 = *reinterpret_cast<bf16x8*>(&w0); pa1 = *reinterpret_cast<bf16x8*>(&w1); pa2 = *reinterpret_cast<bf16x8*>(&w2); pa3 = *reinterpret_cast<bf16x8*>(&w3); } \
            asm volatile("" : "+v"(pa0), "+v"(pa1), "+v"(pa2), "+v"(pa3), "+v"(l_reg)); SBAR(); \
            pvt64<0>(o[0], vb0 + sl_ * 8192, pa0, pa1, pa2, pa3); pvt64<1>(o[1], vb0 + sl_ * 8192, pa0, pa1, pa2, pa3); } while (0)
#define SWA_PK(P, B) (u32x4){cvtpk2(P[B], P[B + 1]), cvtpk2(P[B + 2], P[B + 3]), cvtpk2(P[B + 4], P[B + 5]), cvtpk2(P[B + 6], P[B + 7])}
        SWA_TILE(sa0, sa1, sb0, sb1, 0, true);
        SWA_TILE(sb0, sb1, sa0, sa1, 1, true);
        SWA_TILE(sa0, sa1, sb0, sb1, 2, nt > 3);
        if (nt > 3) { SWA_TILE(sb0, sb1, sa0, sa1, 3, nt > 4);
            if (nt > 4) SWA_TILE(sa0, sa1, sb0, sb1, 4, false); }
#undef SWA_PK
#undef SWA_TILE
        if (i == 4) SWA_TS(3);
        { const float rl = __builtin_amdgcn_rcpf(l_reg);
#pragma unroll
          for (int x = 0; x < 8; ++x) { const int d0 = x >> 2, gq = x & 3;
              const float v0 = o[d0][4 * gq + 0] * rl * __uint_as_float(gt[x].x << 16), v1 = o[d0][4 * gq + 1] * rl * __uint_as_float(gt[x].x & 0xffff0000u);
              const float v2 = o[d0][4 * gq + 2] * rl * __uint_as_float(gt[x].y << 16), v3 = o[d0][4 * gq + 3] * rl * __uint_as_float(gt[x].y & 0xffff0000u);
              pg8::u32x2 w; w.x = cvtpk(v0, v1); w.y = cvtpk(v2, v3); *reinterpret_cast<pg8::u32x2*>(orow + d0 * 32 + 8 * gq) = w; } }
#pragma unroll
        for (int d0 = 0; d0 < 4; ++d0) qr[d0] = qn[d0];
        asm volatile("s_waitcnt vmcnt(8) lgkmcnt(0)\n\ts_barrier" ::: "memory");
        if (i == 4) SWA_TS(4);
    }
    SWA_TS(5);
#undef SWA_DMA
#undef SWA_TS
}
}
#undef SBAR
#undef ATT_WAIT_BAR
}
constexpr int NWAVES = 8;
#ifndef MK_PER_PHASE
#define MK_PER_PHASE 0
#endif
constexpr int N_PHASES = 8;

constexpr size_t MiB = 1u << 20;
constexpr size_t WS_CTL = 0, CTL_ZERO_BYTES = 128 * 1024;
constexpr size_t WS_COS = 1 * MiB, WS_SIN = WS_COS + 512 * 1024;
constexpr size_t WS_BT2 = 2 * MiB, WS_SINK2 = WS_BT2 + 16 * 264 * 4;
constexpr size_t WS_SSQQ = 3 * MiB, WS_SSQKV = WS_SSQQ + 512 * 1024;
constexpr size_t WS_SSQ2 = 4 * MiB, WS_SSQ3 = 6 * MiB;
constexpr size_t WS_WIN = 8 * MiB, WS_WQB = 16 * MiB, WS_WVT = 17 * MiB, WS_WOUT = 18 * MiB, WS_WUP = 20 * MiB, WS_WDN = 31 * MiB;
constexpr size_t WS_A0 = 40 * MiB;
constexpr size_t WS_XN = WS_A0;
constexpr size_t WS_X1B = WS_A0;
constexpr size_t WS_QLAT = 104 * MiB, WS_KL = 120 * MiB  , WS_QB = 132 * MiB, WS_KB = 196 * MiB, WS_VB = 212 * MiB, WS_GA = 228 * MiB, WS_GB = 292 * MiB;
constexpr size_t WS_MIX = WS_QB;
constexpr size_t WS_HALO = 104 * MiB;
constexpr size_t WS_ACT = 296 * MiB;
constexpr size_t WS_END = 472 * MiB;
static_assert(WS_ACT + (size_t)MTOK * DFF * 2 <= WS_END && WS_HALO + (size_t)(MTOK / 64) * 4 * 5632 * 4 <= WS_ACT && WS_KL + (size_t)MTOK * 192 * 2 <= WS_QB, "d_ws map");
constexpr int CW_BAR = 4096;
static_assert((CW_BAR + 3456) * 4 <= 65536, "barrier words below the panel counters");
constexpr int CW_PANEL = 16384;

constexpr int RING_OFF = 0, RING_BYTES = 146432;
constexpr int LDSCTL_OFF = RING_BYTES, MISC_OFF = LDSCTL_OFF + 320;
constexpr int LDS_BYTES = 147456;
static_assert(att::mla::LDS_BYTES <= RING_BYTES && att::mla2::LDS_BYTES <= RING_BYTES && att::swa::LDS_BYTES <= RING_BYTES && pg8::STAGE_BYTES <= RING_BYTES && MISC_OFF + 64 <= LDS_BYTES, "LDS map");

#define GAS __attribute__((address_space(1)))
#define LAS __attribute__((address_space(3)))
typedef unsigned short bf16;
typedef unsigned v4u __attribute__((ext_vector_type(4)));
typedef float f32x4 __attribute__((ext_vector_type(4)));
typedef short bf16x8 __attribute__((ext_vector_type(8)));
typedef GAS unsigned gu32;
typedef GAS unsigned long long gu64;
#define RLX_AGENT __ATOMIC_RELAXED, __HIP_MEMORY_SCOPE_AGENT
#define LDS_WAIT() asm volatile("s_waitcnt lgkmcnt(0)" ::: "memory")
#define VM_WAIT() asm volatile("s_waitcnt vmcnt(0)" ::: "memory")
__device__ __forceinline__ unsigned long long rt() { return __builtin_amdgcn_s_memrealtime(); }
__device__ __forceinline__ unsigned f2bf(float f) { unsigned u = __builtin_bit_cast(unsigned, f); return (u + 0x7fffu + ((u >> 16) & 1u)) >> 16; }
__device__ __forceinline__ unsigned pk2(float lo, float hi) { return f2bf(lo) | (f2bf(hi) << 16); }

#define XB_TMO      128
#define XB_XCNT(j)  (256  + 64 * (j))
#define XB_XSUB(j)  (1280 + 64 * (j))
#define XB_XGEN(j)  (2304 + 64 * (j))
#define XB_TOP      3328
#define XB_TOPGEN   3392
#define XCD_BAR_WORDS 3456
#define XB_SPIN_CAP (1u << 18)

__device__ __forceinline__ unsigned xb_ld(unsigned* p)              { return __hip_atomic_load(p, __ATOMIC_RELAXED, __HIP_MEMORY_SCOPE_AGENT); }
__device__ __forceinline__ unsigned xb_add(unsigned* p, unsigned v) { return __hip_atomic_fetch_add(p, v, __ATOMIC_RELAXED, __HIP_MEMORY_SCOPE_AGENT); }
__device__ __forceinline__ unsigned xb_xcc_id() { return (unsigned)__builtin_amdgcn_s_getreg((3 << 11) | 20) & 0xFu; }
#define XB_SPIN(cond, bar) do { unsigned _sp = 0; while (cond) { __builtin_amdgcn_s_sleep(1); \
    if ((++_sp & 255u) == 0u) { if (xb_ld(&(bar)[XB_TMO])) break; if (_sp > XB_SPIN_CAP) { atomicAdd(&(bar)[XB_TMO], 1u); break; } } } } while (0)

struct XcdBarrier {
    unsigned* bar; unsigned x; int w;
    volatile LAS unsigned* st;
};

__device__ __forceinline__ XcdBarrier xcd_barrier_post(unsigned* bar, volatile LAS unsigned* st) {
    XcdBarrier b; b.bar = bar; b.x = xb_xcc_id(); b.st = st;
    if (threadIdx.x == 0) (void)xb_add(&bar[XB_XCNT(b.x)], 1u);
    return b;
}
__device__ __forceinline__ void xcd_barrier_complete(unsigned* bar, unsigned x, unsigned& nloc, unsigned& nx) {
    const unsigned G = gridDim.x * gridDim.y * gridDim.z;
    unsigned sum, cnt, mine, sp = 0u;
    for (;;) {
        sum = 0u; cnt = 0u; mine = 0u;
#pragma unroll
        for (unsigned j = 0; j < 16; ++j) { const unsigned c = xb_ld(&bar[XB_XCNT(j)]); sum += c; cnt += (c > 0u) ? 1u : 0u; mine = (j == x) ? c : mine; }
        if (sum == G) break;
        __builtin_amdgcn_s_sleep(1);
        if ((++sp & 255u) == 0u) { if (xb_ld(&bar[XB_TMO])) break; if (sp > XB_SPIN_CAP) { atomicAdd(&bar[XB_TMO], 1u); break; } }
    }
    nloc = mine > 0u ? mine : 1u; nx = cnt > 0u ? cnt : 1u;
}

__device__ __forceinline__ void xcd_barrier(const XcdBarrier& b) {
    asm volatile("s_waitcnt vmcnt(0)" ::: "memory");
    __syncthreads();
    if (b.w == 0 && pg8::lane_id_fresh() == 0) {
        unsigned* bar = b.bar;
        __builtin_amdgcn_s_waitcnt(0);
        unsigned nloc = b.st[0], nx = b.st[1];
        if (nloc == 0u) { xcd_barrier_complete(bar, b.x, nloc, nx); b.st[0] = nloc; b.st[1] = nx; }
        const unsigned old = xb_add(&bar[XB_XSUB(b.x)], 1u);
        const unsigned gen = old / nloc;
        if (old + 1u == (gen + 1u) * nloc) {
            __builtin_amdgcn_fence(__ATOMIC_RELEASE, "agent");
            asm volatile("s_waitcnt vmcnt(0)" ::: "memory");
            const unsigned og = xb_add(&bar[XB_TOP], 1u);
            const unsigned tg = og / nx;
            if (og + 1u == (tg + 1u) * nx) xb_add(&bar[XB_TOPGEN], 1u);
            else XB_SPIN(xb_ld(&bar[XB_TOPGEN]) == tg, bar);
            __builtin_amdgcn_fence(__ATOMIC_ACQUIRE, "agent");
            xb_add(&bar[XB_XGEN(b.x)], 1u);
            asm volatile("s_waitcnt vmcnt(0)" ::: "memory");
        } else {
            XB_SPIN(xb_ld(&bar[XB_XGEN(b.x)]) == gen, bar);
            __builtin_amdgcn_fence(__ATOMIC_ACQUIRE, "agent");
            asm volatile("s_waitcnt vmcnt(0)" ::: "memory");
        }
    }
    __syncthreads();
}

struct Frame {
    LAS unsigned char* lds; volatile LAS unsigned* MISC; gu32* ctl;
    int wave, vcu, G;
};
__device__ __forceinline__ float wave_sum(float v) {
#pragma unroll
    for (int o = 1; o < 64; o <<= 1) v += __shfl_xor(v, o);
    return v;
}
template <class RowMap>
__device__ __forceinline__ void p0_transpose_item(const float* W, int K, int N, bf16* WT, const float* kscale, const RowMap& rm, LAS float* scr, int item, int lane) {
    const int nblk = N / 32, kb = item / nblk, nb = item % nblk, k0 = 64 * kb, n0 = 32 * nb;
#pragma unroll 8
    for (int i = 0; i < 32; ++i) { const int kk = 2 * i + (lane >> 5); const float sc = kscale ? kscale[k0 + kk] : 1.0f; scr[kk * 33 + (lane & 31)] = W[(size_t)(k0 + kk) * N + n0 + (lane & 31)] * sc; }
    LDS_WAIT(); asm volatile("" ::: "memory");
    const int c = lane & 7;
#pragma unroll
    for (int j = 0; j < 4; ++j) { const int n = (lane >> 3) + 8 * j; const LAS float* s = scr + (8 * c) * 33 + n;
        v4u o; o.x = pk2(s[0 * 33], s[1 * 33]); o.y = pk2(s[2 * 33], s[3 * 33]); o.z = pk2(s[4 * 33], s[5 * 33]); o.w = pk2(s[6 * 33], s[7 * 33]);
        const int rr = rm(n0 + n); if (rr >= 0) *(GAS v4u*)(WT + (size_t)rr * K + k0 + 8 * c) = o; }
    LDS_WAIT(); asm volatile("" ::: "memory");
}
struct MapIdent { __device__ __forceinline__ int operator()(int n) const { return n; } };
struct MapWin { __device__ __forceinline__ int operator()(int n) const {
    if (n < 256) return n; if (n >= 448) return n + 64; const int j = n - 256; if (j < 128) return 256 + j; const int d = j - 128; return 384 + (d < 32 ? 2 * d : 2 * (d - 32) + 1); } };
struct MapWqb { __device__ __forceinline__ int operator()(int n) const {
    const int h = n / 192, d = n % 192; if (d < 128) return -1  ; const int r = d - 128; return 1024 + h * 64 + (r < 32 ? 2 * r : 2 * (r - 32) + 1); } };
struct MapWup { __device__ __forceinline__ int operator()(int n) const {
    const int v = n >= DFF, c = v ? n - DFF : n; return 256 * (c >> 7) + 128 * v + (c & 127); } };

__device__ __forceinline__ int t5_bucket(int rel) {
    const int n = rel < 0 ? -rel : rel; int bk;
    if (n < 8) bk = n; else { const int e = (31 - __builtin_clz((unsigned)(n * n))) - 6; bk = 8 + e; if (bk > 15) bk = 15; }
    return (rel > 0 ? 16 : 0) + bk;
}
#ifndef MLA_SPLIT
#define MLA_SPLIT 0
#endif
struct Args {
    const float* x; const int* positions; const float* norm1_g; const float* w_in; const float* q_a_norm_g; const float* w_q_b; const float* kv_a_norm_g; const float* w_kv_b;
    const float* rel_bias; const float* sinks; const float* w_out; const float* norm2_g; const float* w_up; const float* conv_w; const float* conv_b; const float* w_down; const float* final_norm_g;
    float* out; unsigned char* ws; int ph_lo, ph_hi;
};

__device__ __forceinline__ void p0_prologue(Frame& F, const Args& a) {
    unsigned char* ws = a.ws;
    LAS float* scr = (LAS float*)(F.lds + RING_OFF + F.wave * 16384);
    const int lane = pg8::lane_id_fresh();
    const int gw = F.vcu * NWAVES + F.wave, NGW = F.G * NWAVES;
    constexpr int I_IN = (1024 / 64) * (4032 / 32), I_QB = (256 / 64) * (1536 / 32), I_OUT = (1024 / 64) * (1024 / 32), I_UP = (1024 / 64) * (5632 / 32), I_DN = (DFF / 64) * (1024 / 32);
    constexpr int NITEMS = I_IN + I_QB + I_OUT + I_UP + I_DN;
#ifndef P0DUP
#define P0DUP 0
#endif
    for (int rp_ = 0; rp_ <= (P0DUP & 1); ++rp_)
    for (int it = gw; it < NITEMS; it += NGW) {
        int r = it;
        if (r < I_IN) { p0_transpose_item(a.w_in, 1024, 4032, (bf16*)(ws + WS_WIN), nullptr, MapWin(), scr, r, lane); continue; } r -= I_IN;
        if (r < I_QB) { p0_transpose_item(a.w_q_b, 256, 1536, (bf16*)(ws + WS_WQB), a.q_a_norm_g, MapWqb(), scr, r, lane); continue; } r -= I_QB;
        if (r < I_OUT) { p0_transpose_item(a.w_out, 1024, 1024, (bf16*)(ws + WS_WOUT), nullptr, MapIdent(), scr, r, lane); continue; } r -= I_OUT;
        if (r < I_UP) { p0_transpose_item(a.w_up, 1024, 5632, (bf16*)(ws + WS_WUP), a.norm2_g, MapWup(), scr, r, lane); continue; } r -= I_UP;
        p0_transpose_item(a.w_down, DFF, 1024, (bf16*)(ws + WS_WDN), nullptr, MapIdent(), scr, r, lane);
    }
    const int gt = gw * 64 + lane, NGT = NGW * 64;
    for (int rp_ = 0; rp_ <= ((P0DUP >> 2) & 1); ++rp_)
    for (int i = gt; i < 1024 * 256; i += NGT) { const int row = i >> 8, j = i & 255, hh = row >> 7, c = row & 127;
        const f32x4* qp = (const f32x4*)(a.w_q_b + (size_t)j * 1536 + hh * 192); const f32x4* kp = (const f32x4*)(a.w_kv_b + (size_t)c * 2048 + hh * 256);
        float s0 = 0.f, s1 = 0.f;
#pragma unroll 8
        for (int d4 = 0; d4 < 32; ++d4) { const f32x4 x = qp[d4], y = kp[d4]; s0 += x[0] * y[0] + x[1] * y[1]; s1 += x[2] * y[2] + x[3] * y[3]; }
        ((bf16*)(ws + WS_WQB))[i] = (bf16)f2bf((s0 + s1) * a.q_a_norm_g[j] * a.kv_a_norm_g[c]); }
    for (int i = gt; i < 8 * 128 * 128; i += NGT) { const int hh = i >> 14, dd = (i >> 7) & 127, cp = i & 127, c = MLA_OT ? ((cp & ~0xC) | ((cp & 4) << 1) | ((cp & 8) >> 1)) : cp;
        ((bf16*)(ws + WS_WVT))[i] = (bf16)f2bf(a.w_kv_b[(size_t)c * 2048 + hh * 256 + 128 + dd] * a.kv_a_norm_g[c]); }
    for (int i = gt; i < 64 * 1024 / 8; i += NGT) *(GAS v4u*)((bf16*)(ws + WS_WIN) + (size_t)448 * 1024 + (size_t)i * 8) = (v4u){0u, 0u, 0u, 0u};
    for (int rp_ = 0; rp_ <= ((P0DUP >> 3) & 1); ++rp_)
    for (int i = gt; i < SEQ * 32; i += NGT) { const int s = i >> 5, d = i & 31;
        const float invf = __builtin_amdgcn_exp2f(-(float)d * (13.287712379549449f / 32.0f));
        const float ang = (float)a.positions[s] * invf;
        const double rev = (double)ang * 0.15915494309189535; const float fr = (float)(rev - __builtin_rint(rev));
        ((float*)(ws + WS_COS))[i] = __builtin_amdgcn_cosf(fr); ((float*)(ws + WS_SIN))[i] = __builtin_amdgcn_sinf(fr); }
    for (int i = gt; i < 16 * 264; i += NGT) { const int h = i / 264, j = i % 264; float v = 0.f; if (j <= 256) v = a.rel_bias[t5_bucket(j - 128) * 16 + h] * LOG2E; ((float*)(ws + WS_BT2))[i] = v; }
    if (gt < 16) ((float*)(ws + WS_SINK2))[gt] = a.sinks[gt] * LOG2E;
    for (int rp_ = 0; rp_ <= ((P0DUP >> 1) & 1); ++rp_)
    for (int m = gw; m < MTOK; m += NGW) {
        const GAS f32x4* xr = (const GAS f32x4*)(a.x + (size_t)m * DM) + lane; const GAS f32x4* gr = (const GAS f32x4*)a.norm1_g + lane;
        f32x4 v[4]; float s = 0.f;
#pragma unroll
        for (int j = 0; j < 4; ++j) { v[j] = xr[64 * j]; s += (v[j].x * v[j].x + v[j].y * v[j].y) + (v[j].z * v[j].z + v[j].w * v[j].w); }
        const float rs = 1.0f / sqrtf(wave_sum(s) * (1.0f / DM) + RMS_EPS);
        GAS unsigned long long* o8 = (GAS unsigned long long*)((bf16*)(ws + WS_XN) + (size_t)m * DM) + lane;
#pragma unroll
        for (int j = 0; j < 4; ++j) { const f32x4 g = gr[64 * j]; o8[64 * j] = (unsigned long long)pk2(v[j].x * rs * g.x, v[j].y * rs * g.y) | ((unsigned long long)pk2(v[j].z * rs * g.z, v[j].w * rs * g.w) << 32); }
    }
}

__device__ __forceinline__ void p6_fixup(Frame& F, const Args& a) {
    const int lane = pg8::lane_id_fresh();
    const int gw = F.vcu * NWAVES + F.wave, NGW = F.G * NWAVES;
    const float* halo = (const float*)(a.ws + WS_HALO); bf16* ACT = (bf16*)(a.ws + WS_ACT);
    constexpr int NBLK = MTOK / 64, HROW = 2 * DFF, HBLK = 4 * HROW;
    for (int it = gw; it < NBLK * 2 * 11; it += NGW) {
        const int cg = it % 11, which = (it / 11) & 1, blk = it / 22;
        const int c = cg * 256 + lane * 4, cu = 256 * (c >> 7) + (c & 127);
        const int r = 64 * blk + (which ? 63 : 0);
        const float* hp = halo + (size_t)blk * HBLK + (2 + which) * HROW + cu;
        f32x4 G = *(const f32x4*)hp, V = *(const f32x4*)(hp + 128);
        const bool has = which ? (((r + 1) & (SEQ - 1)) != 0) : ((r & (SEQ - 1)) != 0);
        if (has) { const float* np = halo + (size_t)(which ? blk + 1 : blk - 1) * HBLK + (which ? 0 : 1) * HROW + cu;
            const f32x4 rg = *(const f32x4*)np, rv = *(const f32x4*)(np + 128);
            const f32x4 wg = *(const f32x4*)(a.conv_w + (which ? 4 : 0) * DFF + c), wv = *(const f32x4*)(a.conv_w + (which ? 5 : 1) * DFF + c);
            G = G + wg * rg; V = V + wv * rv; }
        f32x4 o;
#pragma unroll
        for (int e = 0; e < 4; ++e) o[e] = G[e] * pg8::fast_sigmoid(G[e]) * V[e];
        pg8::st4((pg8::bf16_t*)(ACT + (size_t)r * DFF + c), o);
    }
}

__device__ __forceinline__ void p8_final_norm(Frame& F, const Args& a) {
    const int gw = F.vcu * NWAVES + F.wave, NGW = F.G * NWAVES;
    const int lane = pg8::lane_id_fresh();
    const float* ssq = (const float*)(a.ws + WS_SSQ3);
    for (int m = gw; m < MTOK; m += NGW) {
        const f32x4* sp = (const f32x4*)(ssq + (size_t)m * 16); const f32x4 t = (sp[0] + sp[1]) + (sp[2] + sp[3]);
        const float rs = 1.0f / sqrtf(((t[0] + t[1]) + (t[2] + t[3])) * (1.0f / DM) + RMS_EPS);
        GAS f32x4* xr = (GAS f32x4*)(a.out + (size_t)m * DM) + lane; const GAS f32x4* gr = (const GAS f32x4*)a.final_norm_g + lane;
#pragma unroll
        for (int j = 0; j < 4; ++j) { const f32x4 v = xr[64 * j], g = gr[64 * j]; xr[64 * j] = v * rs * g; }
    }
}

__global__ void __launch_bounds__(NWAVES * 64, 2) enc_fwd(Args args) {
    extern __shared__ __attribute__((aligned(16))) unsigned char lds[];
    Frame F;
    F.lds = (LAS unsigned char*)lds; F.MISC = (volatile LAS unsigned*)(F.lds + MISC_OFF);
    F.wave = __builtin_amdgcn_readfirstlane(threadIdx.x >> 6);
    F.G = gridDim.x; { const int bx = blockIdx.x; F.vcu = (F.G % 8 == 0) ? (bx % 8) * (F.G / 8) + bx / 8 : bx; }
    unsigned char* ws = args.ws;
    F.ctl = (gu32*)(ws + WS_CTL);
    for (int u = threadIdx.x; u < (LDS_BYTES - LDSCTL_OFF) / 4; u += NWAVES * 64) ((LAS unsigned*)(F.lds + LDSCTL_OFF))[u] = 0u;
    __syncthreads();
    XcdBarrier bar; bar.bar = (unsigned*)(F.ctl + CW_BAR); bar.x = 0; bar.st = nullptr;
    if (!MK_PER_PHASE) bar = xcd_barrier_post((unsigned*)(F.ctl + CW_BAR), F.MISC + 8);
    bar.w = F.wave;
    const int lo = args.ph_lo, hi = args.ph_hi;
#ifndef PHMASK
#define PHMASK 0xff
#endif
#define IN(k) (((PHMASK >> (k)) & 1) && lo <= (k) && (k) < hi)
#ifndef DUPMASK
#define DUPMASK 0
#endif
#define REP(k) for (int rep_ = 0; rep_ <= ((DUPMASK >> (k)) & 1); ++rep_)
#define SEAM(k) do { if (IN(k) && IN((k) + 1)) xcd_barrier(bar); } while (0)
    bf16* const WIN = (bf16*)(ws + WS_WIN); bf16* const WQB = (bf16*)(ws + WS_WQB); bf16* const WOUT = (bf16*)(ws + WS_WOUT);
    bf16* const WUP = (bf16*)(ws + WS_WUP); bf16* const WDN = (bf16*)(ws + WS_WDN);
    const float* const COS = (const float*)(ws + WS_COS); const float* const SIN = (const float*)(ws + WS_SIN);
    bf16* const QA = (bf16*)args.out;

#ifdef TP_PHASE
    unsigned long long tp_r0 = 0, tp_r1 = 0, tp_c0 = 0, tp_c1 = 0;
#ifndef TP_END
#define TP_END (TP_PHASE + 1)
#endif
#ifdef TP_SWA
#define TP_MARK(k)
#else
#define TP_MARK(k) do { if ((k) == TP_PHASE) { tp_r0 = __builtin_amdgcn_s_memrealtime(); tp_c0 = __builtin_amdgcn_s_memtime(); } if ((k) == TP_END) { tp_r1 = __builtin_amdgcn_s_memrealtime(); tp_c1 = __builtin_amdgcn_s_memtime(); } } while (0)
#endif
#else
#define TP_MARK(k)
#endif
#ifdef TP_SWA
    unsigned long long tp_ts[6] = {};
#define TP_TSPASS , tp_ts
#else
#define TP_TSPASS
#endif
    TP_MARK(0);
    if (IN(0)) REP(0) { p0_prologue(F, args); } SEAM(0);
    TP_MARK(1);

    if (IN(1)) REP(1) {
        pg8::Gemm g{(bf16*)(ws + WS_XN), WIN, MTOK, 4096, 1024}; pg8::StaticOrder S; S.init(MTOK, 4096, F.G, (int)blockIdx.x);
        pg8::EpiInProj E{(bf16*)(ws + WS_QLAT), (bf16*)(ws + WS_KL), (bf16*)(ws + WS_QB), (bf16*)(ws + WS_KB), (bf16*)(ws + WS_VB), (bf16*)(ws + WS_GA), (bf16*)(ws + WS_GB),
                         (float*)(ws + WS_SSQQ), (float*)(ws + WS_SSQKV), COS, SIN};
        pg8::gemm_phase<pg8::EpiInProj, pg8::StaticOrder, PG8_ALIGN, PG8_SP2>(F.lds + RING_OFF, g, S, E, F.wave);
    } SEAM(1);

    TP_MARK(2);
    if (IN(2)) REP(2) {
#ifndef P2SUB
#define P2SUB 7
#endif
#ifndef P2DUPG
#define P2DUPG 0
#endif
        for (int rg_ = 0; rg_ <= P2DUPG; ++rg_) {
        if (P2SUB & 1) { pg8::Gemm g{(bf16*)(ws + WS_QLAT), WQB, MTOK, 1536, 256}; pg8::StaticOrder S; S.init(MTOK, 1536, F.G, (int)blockIdx.x);
          pg8::EpiQProj E{QA, (const float*)(ws + WS_SSQQ), COS, SIN};
          pg8::gemm_phase<pg8::EpiQProj, pg8::StaticOrder, PG8_ALIGN, PG8_SP2>(F.lds + RING_OFF, g, S, E, F.wave); }
        }
        TP_MARK(20);
        if (P2SUB & 4) { const att::swa::Tensors T{(const bf16*)(ws + WS_QB), (const bf16*)(ws + WS_KB), (const bf16*)(ws + WS_VB), (bf16*)(ws + WS_GB), (const float*)(ws + WS_BT2), (const float*)(ws + WS_SINK2)};
          for (int u = F.vcu; u < NBATCH * 4 * (SEQ / 64 / att::swa::NQB); u += F.G) { const int j = u % (SEQ / 64 / att::swa::NQB), bk = u / (SEQ / 64 / att::swa::NQB); att::swa::run(bk >> 2, bk & 3, j, T, (char*)lds + RING_OFF, F.wave TP_TSPASS); } }
#ifdef TP_SWA
        tp_r0 = tp_ts[TP_A]; tp_r1 = tp_ts[TP_B];
#endif
    } SEAM(2);

    TP_MARK(3);
    if (IN(3)) REP(3) {
        const att::mla::Tensors T{QA, (const bf16*)(ws + WS_KL), (const bf16*)(ws + WS_WVT), (const bf16*)(ws + WS_GA), (const bf16*)(ws + WS_GB), (bf16*)(ws + WS_MIX)};
        for (int u = F.vcu; u < NBATCH * 8 * (SEQ / 256); u += F.G) { const int qb = u & 15, bh = u >> 4;
#if MLA_SPLIT
            att::mla2::unit(bh >> 3, bh & 7, qb, T, (char*)lds + RING_OFF, F.wave);
#else
            att::mla::unit(bh >> 3, bh & 7, qb, T, (char*)lds + RING_OFF, F.wave);
#endif
        }
    } SEAM(3);

    TP_MARK(4);
    if (IN(4)) REP(4) {
        pg8::Gemm g{(bf16*)(ws + WS_MIX), WOUT, MTOK, 1024, 1024}; pg8::StaticOrder S; S.init(MTOK, 1024, F.G, (int)blockIdx.x);
        pg8::EpiResidual E{args.x, nullptr, (bf16*)(ws + WS_X1B), (float*)(ws + WS_SSQ2)};
        pg8::gemm_phase<pg8::EpiResidual, pg8::StaticOrder, PG8_ALIGN, PG8_SP2>(F.lds + RING_OFF, g, S, E, F.wave);
    } SEAM(4);

    TP_MARK(5);
    if (IN(5)) REP(5) {
        pg8::Gemm g{(bf16*)(ws + WS_X1B), WUP, MTOK, 2 * DFF, 1024}; pg8::StaticOrder S; S.init(MTOK, 2 * DFF, F.G, (int)blockIdx.x);
        pg8::EpiUpConv E{(bf16*)(ws + WS_ACT), (float*)(ws + WS_HALO), (const float*)(ws + WS_SSQ2), args.conv_w, args.conv_b};
        pg8::gemm_phase<pg8::EpiUpConv, pg8::StaticOrder, PG8_ALIGN, PG8_SP2>(F.lds + RING_OFF, g, S, E, F.wave);
    } SEAM(5);
    TP_MARK(6);
    if (IN(6)) REP(6) { p6_fixup(F, args); } SEAM(6);

    TP_MARK(7);
    if (IN(7)) REP(7) {
        pg8::Gemm g{(bf16*)(ws + WS_ACT), WDN, MTOK, 1024, DFF}; pg8::StaticOrder S; S.init(MTOK, 1024, F.G, (int)blockIdx.x);
        pg8::EpiFinal E{(const bf16*)(ws + WS_X1B), args.out, (float*)(ws + WS_SSQ3), (unsigned*)(F.ctl + CW_PANEL), args.final_norm_g};
        pg8::gemm_phase<pg8::EpiFinal, pg8::StaticOrder, PG8_ALIGN, PG8_SP2>(F.lds + RING_OFF, g, S, E, F.wave);
    }
#ifdef TP_PHASE
    TP_MARK(8);
#ifndef TP_CLK
#define TP_CLK 0
#endif
#ifndef TP_GAIN
#define TP_GAIN 4
#endif
    if (blockIdx.x == 0 && F.wave == 0) {
        const unsigned long long dr = tp_r1 - tp_r0, dc = tp_c1 - tp_c0;
        const unsigned long long ticks = (TP_CLK ? dc * 100ull / dr : dr) * (unsigned long long)TP_GAIN;
        const unsigned long long t0 = __builtin_amdgcn_s_memrealtime();
        while (__builtin_amdgcn_s_memrealtime() - t0 < ticks) __builtin_amdgcn_s_sleep(8); }
#endif
#undef IN
#undef SEAM
}

extern "C" void kernel_launch(void* const* d_in, const int* in_sizes, int n_in, void* d_out, int out_size, void* d_ws, size_t ws_size, hipStream_t stream) {
    static int grid = 0;
    if (grid == 0) {
        if (n_in != 17 || in_sizes[0] != MTOK * DM || out_size != MTOK * DM || ws_size < WS_END) { fprintf(stderr, "kernel_launch: unexpected shapes (n_in %d, in0 %d, out %d, ws %zu; need ws >= %zu); nothing launched\n", n_in, n_in > 0 ? in_sizes[0] : -1, out_size, ws_size, (size_t)WS_END); grid = -1; return; }
        int dev = 0, cus = 0, per_cu = 0;
        if (hipGetDevice(&dev) != hipSuccess || hipDeviceGetAttribute(&cus, hipDeviceAttributeMultiprocessorCount, dev) != hipSuccess) { fprintf(stderr, "kernel_launch: device query failed\n"); grid = -1; return; }
        if (hipFuncSetAttribute((const void*)enc_fwd, hipFuncAttributeMaxDynamicSharedMemorySize, LDS_BYTES) != hipSuccess) { fprintf(stderr, "kernel_launch: hipFuncSetAttribute failed\n"); grid = -1; return; }
        if (hipOccupancyMaxActiveBlocksPerMultiprocessor(&per_cu, (const void*)enc_fwd, NWAVES * 64, LDS_BYTES) != hipSuccess || per_cu < 1) { fprintf(stderr, "kernel_launch: occupancy query reports %d workgroups per CU\n", per_cu); }
        (void)hipGetLastError();
        grid = cus;
    }
    if (grid < 0) return;
    if (hipMemsetAsync((char*)d_ws + WS_CTL, 0, CTL_ZERO_BYTES, stream) != hipSuccess) { fprintf(stderr, "kernel_launch: hipMemsetAsync failed\n"); return; }
    Args a{};
    a.x = (const float*)d_in[0]; a.positions = (const int*)d_in[1]; a.norm1_g = (const float*)d_in[2]; a.w_in = (const float*)d_in[3]; a.q_a_norm_g = (const float*)d_in[4]; a.w_q_b = (const float*)d_in[5];
    a.kv_a_norm_g = (const float*)d_in[6]; a.w_kv_b = (const float*)d_in[7]; a.rel_bias = (const float*)d_in[8]; a.sinks = (const float*)d_in[9]; a.w_out = (const float*)d_in[10]; a.norm2_g = (const float*)d_in[11];
    a.w_up = (const float*)d_in[12]; a.conv_w = (const float*)d_in[13]; a.conv_b = (const float*)d_in[14]; a.w_down = (const float*)d_in[15]; a.final_norm_g = (const float*)d_in[16];
    a.out = (float*)d_out; a.ws = (unsigned char*)d_ws;
#if MK_PER_PHASE
    for (int p = 0; p < N_PHASES; ++p) { a.ph_lo = p; a.ph_hi = p + 1; hipLaunchKernelGGL(enc_fwd, dim3(grid), dim3(NWAVES * 64), LDS_BYTES, stream, a); }
#else
    a.ph_lo = 0; a.ph_hi = N_PHASES; hipLaunchKernelGGL(enc_fwd, dim3(grid), dim3(NWAVES * 64), LDS_BYTES, stream, a);
#endif
    const hipError_t le = hipPeekAtLastError();
    if (le != hipSuccess) fprintf(stderr, "kernel_launch: launch failed: %s (grid %d)\n", hipGetErrorName(le), grid);
}
```

```cpp
#include <hip/hip_runtime.h>
#include <cstdio>
#include <cstdint>
namespace pg8 {
#define PG8_LAS __attribute__((address_space(3)))
typedef unsigned short bf16_t;
typedef short bf16x8 __attribute__((ext_vector_type(8)));
typedef float f32x4 __attribute__((ext_vector_type(4)));
typedef unsigned u32x4 __attribute__((ext_vector_type(4)));
constexpr int BM = 256, BK = 64, HALF = 128, HTB = HALF * BK * 2  , STAGE_BYTES = 8 * HTB, NXCD = 8, WGM = 8;

__host__ __device__ __forceinline__ int lds_byte(int r, int c) { const int st = (r >> 4) * 2 + (c >> 5), rr = r & 15, cc = c & 31, ob = rr * 64 + cc * 2; return st * 1024 + (ob ^ (((ob >> 9) & 1) << 5)); }
__host__ __device__ __forceinline__ void stage_rc(int b, int& R, int& C) { const int st = b / 1024, sb = b % 1024, swz = sb ^ (((sb >> 9) & 1) << 5); R = (st >> 1) * 16 + swz / 64; C = (st & 1) * 32 + (swz % 64) / 2; }
__host__ __device__ __forceinline__ int perm32(int rho) { const int n = rho >> 4, i = rho & 15; return 8 * (i >> 2) + 4 * n + (i & 3); }

struct Unit { int pm, pn; };
struct Gemm { const bf16_t* A; const bf16_t* Bt; int M, N, K; };

struct StaticOrder {
    int nM, nN, nwg, G, c;
    __host__ __device__ void init(int M, int N, int G_, int c_) { nM = M / BM; nN = N / BM; nwg = nM * nN; G = G_; c = c_; }
    __host__ __device__ bool next(int i, Unit& u) const {
        const long L = (long)i * G + c; if (L >= nwg) return false;
        int wgid = (int)L; { const int q = nwg / NXCD, r = nwg % NXCD, xcd = wgid % NXCD, off = wgid / NXCD; wgid = (xcd < r ? xcd * (q + 1) : r * (q + 1) + (xcd - r) * q) + off; }
        const int nig = WGM * nN, gid = wgid / nig, fm = gid * WGM, gsz = (nM - fm) < WGM ? (nM - fm) : WGM;
        u.pm = fm + ((wgid % nig) % gsz); u.pn = (wgid % nig) / gsz; return true;
    }
    __device__ __forceinline__ void a_ready(const Unit&) const {}
    __device__ __forceinline__ void done(const Unit&) const {}
};

__device__ __forceinline__ unsigned cvt_pk_bf16(float lo, float hi) { unsigned r; asm volatile("v_cvt_pk_bf16_f32 %0, %1, %2" : "=v"(r) : "v"(lo), "v"(hi)); return r; }
constexpr int SEQ = 4096, NBATCH = 8, MTOK = NBATCH * SEQ, DM = 1024;
constexpr int DFF = 2816;
constexpr float RMS_EPS = 1e-6f;
constexpr float LOG2E = 1.4426950408889634f;
constexpr float C_MLA = 0.07216878364870322f * LOG2E;
constexpr float C_SWA = 0.125f * LOG2E;

typedef unsigned u32x2 __attribute__((ext_vector_type(2)));
__device__ __forceinline__ int lane_id_fresh() { int l; asm volatile("v_mbcnt_lo_u32_b32 %0, -1, 0\n\tv_mbcnt_hi_u32_b32 %0, -1, %0" : "=v"(l)); return l; }
__device__ __forceinline__ float fast_sigmoid(float v) { return __builtin_amdgcn_rcpf(1.0f + __builtin_amdgcn_exp2f(-LOG2E * v)); }
__device__ __forceinline__ void st8(bf16_t* p, f32x4 v0, f32x4 v1) {
    u32x4 w; w.x = cvt_pk_bf16(v0[0], v0[1]); w.y = cvt_pk_bf16(v0[2], v0[3]); w.z = cvt_pk_bf16(v1[0], v1[1]); w.w = cvt_pk_bf16(v1[2], v1[3]); *(u32x4*)p = w; }
__device__ __forceinline__ void st4(bf16_t* p, f32x4 v) { u32x2 w; w.x = cvt_pk_bf16(v[0], v[1]); w.y = cvt_pk_bf16(v[2], v[3]); *(u32x2*)p = w; }
__device__ __forceinline__ float sq4(f32x4 x) { return (x[0] * x[0] + x[1] * x[1]) + (x[2] * x[2] + x[3] * x[3]); }
__device__ __forceinline__ float fq_sum(float s) { s += __shfl_xor(s, 16); s += __shfl_xor(s, 32); return s; }

__device__ __forceinline__ void rope_store(bf16_t* dst  , int d, int srow, const float* cosT, const float* sinT, f32x4 a, f32x4 b, float sc) {
    const f32x4 c4 = *(const f32x4*)(cosT + srow * 32 + d), s4 = *(const f32x4*)(sinT + srow * 32 + d);
    const f32x4 x1 = {a[0] * sc, a[2] * sc, b[0] * sc, b[2] * sc}, x2 = {a[1] * sc, a[3] * sc, b[1] * sc, b[3] * sc};
    st4(dst + d, x1 * c4 - x2 * s4); st4(dst + 32 + d, x2 * c4 + x1 * s4);
}

struct EpiInProj {
    static constexpr bool PERM = true, AFTER_DRAIN = false;
    bf16_t *qlat, *kl, *qb, *kb, *vb, *ga, *gb; float *ssq_q, *ssq_kv; const float *cosT, *sinT;
    __device__ __forceinline__ void operator()(f32x4 (&acc)[2][2][4][2], const Unit& u, int wr, int wc, int fr, int fq) const {
        { const int l_ = lane_id_fresh(); fr = l_ & 15; fq = l_ >> 4; }
        const int pn = u.pn, row0 = u.pm * BM + wr * 64 + fr, cw = wc * 32 + 8 * fq;
        if (pn == 0) {
#pragma unroll
            for (int ai = 0; ai < 2; ++ai)
#pragma unroll
                for (int m = 0; m < 4; ++m) { const int row = row0 + ai * HALF + m * 16;
                    float s = (sq4(acc[ai][0][m][0]) + sq4(acc[ai][0][m][1])) + (sq4(acc[ai][1][m][0]) + sq4(acc[ai][1][m][1]));
                    s = fq_sum(s); if (fq == 0) ssq_q[(size_t)row * 4 + wc] = s;
                    st8(qlat + (size_t)row * 256 + cw, acc[ai][0][m][0], acc[ai][0][m][1]); st8(qlat + (size_t)row * 256 + HALF + cw, acc[ai][1][m][0], acc[ai][1][m][1]);
                    asm volatile("" ::: "memory"); }
        } else if (pn == 1) {
#pragma unroll
            for (int ai = 0; ai < 2; ++ai)
#pragma unroll
                for (int m = 0; m < 4; ++m) { const int row = row0 + ai * HALF + m * 16;
                    float s = sq4(acc[ai][0][m][0]) + sq4(acc[ai][0][m][1]);
                    s = fq_sum(s); if (fq == 0) __hip_atomic_store(ssq_kv + (unsigned)row * 4 + wc, s, __ATOMIC_RELAXED, __HIP_MEMORY_SCOPE_AGENT); }
            asm volatile("s_waitcnt vmcnt(0)" ::: "memory");
            __builtin_amdgcn_s_barrier(); asm volatile("" ::: "memory");
#pragma unroll
            for (int ai = 0; ai < 2; ++ai)
#pragma unroll
                for (int m = 0; m < 4; ++m) { const int row = row0 + ai * HALF + m * 16; const float* sp = ssq_kv + (unsigned)row * 4;
                    const float t = (__hip_atomic_load(sp, __ATOMIC_RELAXED, __HIP_MEMORY_SCOPE_AGENT) + __hip_atomic_load(sp + 1, __ATOMIC_RELAXED, __HIP_MEMORY_SCOPE_AGENT))
                                  + (__hip_atomic_load(sp + 2, __ATOMIC_RELAXED, __HIP_MEMORY_SCOPE_AGENT) + __hip_atomic_load(sp + 3, __ATOMIC_RELAXED, __HIP_MEMORY_SCOPE_AGENT));
                    const float rs = __builtin_amdgcn_rsqf(t * (1.0f / 128.0f) + RMS_EPS);
                    bf16_t* krow = kl + (size_t)row * 192;
                    st8(krow + cw, acc[ai][0][m][0] * rs, acc[ai][0][m][1] * rs);
                    if (wc < 2) rope_store(krow + 128, 16 * wc + 4 * fq, row & (SEQ - 1), cosT, sinT, acc[ai][1][m][0], acc[ai][1][m][1], 1.0f);
                    if (m == 1 || m == 3) asm volatile("" ::: "memory"); }
        } else {
            bf16_t* base; int ld, col0; float sc = 1.0f; bool sig = false;
            if (pn < 6) { base = qb; ld = 1024; col0 = (pn - 2) * 256; sc = C_SWA; }
            else if (pn == 6) { base = kb; ld = 256; col0 = 0; }
            else if (pn == 7) { base = vb; ld = 256; col0 = 0; }
            else if (pn < 12) { base = ga; ld = 1024; col0 = (pn - 8) * 256; sig = true; }
            else { base = gb; ld = 1024; col0 = (pn - 12) * 256; sig = true; }
            bf16_t* rowp = base + (size_t)row0 * ld + col0 + cw; const size_t rstep = (size_t)16 * ld;
#pragma unroll
            for (int ai = 0; ai < 2; ++ai)
#pragma unroll
                for (int m = 0; m < 4; ++m) { bf16_t* rp = rowp + (size_t)(ai * 8 + m) * rstep;
#pragma unroll
                    for (int bj = 0; bj < 2; ++bj) { f32x4 v0 = acc[ai][bj][m][0], v1 = acc[ai][bj][m][1];
                        if (sig) {
#pragma unroll
                            for (int e = 0; e < 4; ++e) { v0[e] = fast_sigmoid(v0[e]); v1[e] = fast_sigmoid(v1[e]); } }
                        else { v0 = v0 * sc; v1 = v1 * sc; }
                        st8(rp + bj * HALF, v0, v1); }
                    asm volatile("" ::: "memory"); }
        }
    }
};

struct EpiQProj {
    static constexpr bool PERM = true, AFTER_DRAIN = false;
    bf16_t* qa; const float* ssq; const float *cosT, *sinT;
    __device__ __forceinline__ void operator()(f32x4 (&acc)[2][2][4][2], const Unit& u, int wr, int wc, int fr, int fq) const {
        { const int l_ = lane_id_fresh(); fr = l_ & 15; fq = l_ >> 4; }
        const int pn = u.pn, row0 = u.pm * BM + wr * 64 + fr, cw = wc * 32 + 8 * fq;
        f32x4 sv[2][4];
#pragma unroll
        for (int ai = 0; ai < 2; ++ai)
#pragma unroll
            for (int m = 0; m < 4; ++m) sv[ai][m] = *(const f32x4*)(ssq + (unsigned)(row0 + ai * HALF + m * 16) * 4);
        asm volatile("" ::: "memory");
#pragma unroll
        for (int ai = 0; ai < 2; ++ai)
#pragma unroll
            for (int m = 0; m < 4; ++m) { const int row = row0 + ai * HALF + m * 16;
                const f32x4 s4 = sv[ai][m];
                const float rs = C_MLA * __builtin_amdgcn_rsqf(((s4[0] + s4[1]) + (s4[2] + s4[3])) * (1.0f / 256.0f) + RMS_EPS);
                bf16_t* qrow = qa + (size_t)row * 1536;
                if (pn < 4) {
#pragma unroll
                    for (int bj = 0; bj < 2; ++bj) st8(qrow + (2 * pn + bj) * 192 + cw, acc[ai][bj][m][0] * rs, acc[ai][bj][m][1] * rs);
                } else {
#pragma unroll
                    for (int bj = 0; bj < 2; ++bj) { const int head = 4 * (pn - 4) + 2 * bj + (wc >> 1);
                        rope_store(qrow + head * 192 + 128, 16 * (wc & 1) + 4 * fq, row & (SEQ - 1), cosT, sinT, acc[ai][bj][m][0], acc[ai][bj][m][1], rs); }
                }
                if (m == 1 || m == 3) asm volatile("" ::: "memory");
            }
    }
};

struct EpiResidual {
    static constexpr bool PERM = true, AFTER_DRAIN = false;
    const float* base; float* y; bf16_t* yb; float* ssq;
    __device__ __forceinline__ void operator()(f32x4 (&acc)[2][2][4][2], const Unit& u, int wr, int wc, int fr, int fq) const {
        { const int l_ = lane_id_fresh(); fr = l_ & 15; fq = l_ >> 4; }
        const int pn = u.pn, row0 = u.pm * BM + wr * 64 + fr, cw = wc * 32 + 8 * fq;
        const unsigned off0 = (unsigned)row0 * DM + pn * 256 + cw;
#pragma unroll
        for (int ai = 0; ai < 2; ++ai) {
            f32x4 xv[4][2][2];
#pragma unroll
            for (int m = 0; m < 4; ++m)
#pragma unroll
                for (int bj = 0; bj < 2; ++bj) { const unsigned off = off0 + (unsigned)((ai * HALF + m * 16) * DM + bj * HALF);
                    xv[m][bj][0] = *(const f32x4*)(base + off); xv[m][bj][1] = *(const f32x4*)(base + off + 4); }
            asm volatile("" ::: "memory");
#pragma unroll
            for (int m = 0; m < 4; ++m) { const int row = row0 + ai * HALF + m * 16; float s = 0.f;
#pragma unroll
                for (int bj = 0; bj < 2; ++bj) { const unsigned off = off0 + (unsigned)((ai * HALF + m * 16) * DM + bj * HALF);
                    const f32x4 v0 = xv[m][bj][0] + acc[ai][bj][m][0], v1 = xv[m][bj][1] + acc[ai][bj][m][1];
                    if (y) { *(f32x4*)(y + off) = v0; *(f32x4*)(y + off + 4) = v1; } if (yb) st8(yb + off, v0, v1);
                    s += sq4(v0) + sq4(v1); }
                s = fq_sum(s); if (fq == 0) ssq[(unsigned)row * 16 + pn * 4 + wc] = s; }
            asm volatile("" ::: "memory");
        }
    }
};

struct EpiUp {
    static constexpr bool PERM = true, AFTER_DRAIN = false;
    bf16_t* U; int ldu; const float* ssq;
    __device__ __forceinline__ void operator()(f32x4 (&acc)[2][2][4][2], const Unit& u, int wr, int wc, int fr, int fq) const {
        { const int l_ = lane_id_fresh(); fr = l_ & 15; fq = l_ >> 4; }
        const int pn = u.pn, row0 = u.pm * BM + wr * 64 + fr, cw = wc * 32 + 8 * fq;
#pragma unroll
        for (int ai = 0; ai < 2; ++ai)
#pragma unroll
            for (int m = 0; m < 4; ++m) { const int row = row0 + ai * HALF + m * 16;
                const f32x4* sp = (const f32x4*)(ssq + (size_t)row * 16); const f32x4 t = (sp[0] + sp[1]) + (sp[2] + sp[3]);
                const float rs = __builtin_amdgcn_rsqf(((t[0] + t[1]) + (t[2] + t[3])) * (1.0f / 1024.0f) + RMS_EPS);
#pragma unroll
                for (int bj = 0; bj < 2; ++bj) st8(U + (size_t)row * ldu + pn * 256 + bj * HALF + cw, acc[ai][bj][m][0] * rs, acc[ai][bj][m][1] * rs);
                asm volatile("" ::: "memory"); }
    }
};

__device__ __forceinline__ float dpp_prev(float x) { return __int_as_float(__builtin_amdgcn_update_dpp(__float_as_int(x), __float_as_int(x), 0x121, 0xf, 0xf, true)); }
__device__ __forceinline__ float dpp_next(float x) { return __int_as_float(__builtin_amdgcn_update_dpp(__float_as_int(x), __float_as_int(x), 0x12f, 0xf, 0xf, true)); }
struct EpiUpConv {
    static constexpr bool PERM = true, AFTER_DRAIN = false;
    bf16_t* act; float* halo; const float* ssq; const float* conv_w; const float* conv_b;
    __device__ __forceinline__ void operator()(f32x4 (&acc)[2][2][4][2], const Unit& u, int wr, int wc, int fr, int fq) const {
        { const int l_ = lane_id_fresh(); fr = l_ & 15; fq = l_ >> 4; }
        const int pn = u.pn, row0 = u.pm * BM + wr * 64 + fr, cw = wc * 32 + 8 * fq;
        { f32x4 tv[2][4];
#pragma unroll
        for (int ai = 0; ai < 2; ++ai)
#pragma unroll
            for (int m = 0; m < 4; ++m) tv[ai][m] = *(const f32x4*)(ssq + (unsigned)(row0 + ai * HALF + m * 16) * 16 + 4 * fq);
        asm volatile("" ::: "memory");
#pragma unroll
        for (int ai = 0; ai < 2; ++ai)
#pragma unroll
            for (int m = 0; m < 4; ++m) { const f32x4 t = tv[ai][m];
                const float rs = __builtin_amdgcn_rsqf(fq_sum((t[0] + t[1]) + (t[2] + t[3])) * (1.0f / 1024.0f) + RMS_EPS);
#pragma unroll
                for (int bj = 0; bj < 2; ++bj) { acc[ai][bj][m][0] = acc[ai][bj][m][0] * rs; acc[ai][bj][m][1] = acc[ai][bj][m][1] * rs; }
                if (m == 1 || m == 3) __builtin_amdgcn_sched_barrier(0); } }
        const bool first = fr == 0, last = fr == 15;
        u32x2 pk[2][4];
#pragma unroll
        for (int n = 0; n < 2; ++n) {
            const int c = pn * 128 + cw + 4 * n;
            const f32x4 wg0 = *(const f32x4*)(conv_w + c), wg1 = *(const f32x4*)(conv_w + 2 * DFF + c), wg2 = *(const f32x4*)(conv_w + 4 * DFF + c), bg = *(const f32x4*)(conv_b + c);
            const f32x4 wv0 = *(const f32x4*)(conv_w + DFF + c), wv1 = *(const f32x4*)(conv_w + 3 * DFF + c), wv2 = *(const f32x4*)(conv_w + 5 * DFF + c), bv = *(const f32x4*)(conv_b + DFF + c);
#pragma unroll
            for (int ai = 0; ai < 2; ++ai) {
                float* hb = halo + (unsigned)((4 * u.pm + 2 * ai + wr) * (4 * 2 * DFF) + pn * 256 + cw + 4 * n);
                f32x4 Apg = {0.f, 0.f, 0.f, 0.f}, Apv = Apg, Bcg, Bcv;
#pragma unroll
                for (int e = 0; e < 4; ++e) { Bcg[e] = dpp_next(acc[ai][0][0][n][e]); Bcv[e] = dpp_next(acc[ai][1][0][n][e]); }
#pragma unroll
                for (int m = 0; m < 4; ++m) { const int row = row0 + ai * HALF + m * 16;
                    const f32x4 ug = acc[ai][0][m][n], uv = acc[ai][1][m][n]; f32x4 G, V, Acg, Acv, Bng = {0.f, 0.f, 0.f, 0.f}, Bnv = Bng;
#pragma unroll
                    for (int e = 0; e < 4; ++e) { Acg[e] = dpp_prev(ug[e]); Acv[e] = dpp_prev(uv[e]);
                        if (m < 3) { Bng[e] = dpp_next(acc[ai][0][m < 3 ? m + 1 : 3][n][e]); Bnv[e] = dpp_next(acc[ai][1][m < 3 ? m + 1 : 3][n][e]); }
                        const float pg = first ? Apg[e] : Acg[e], pv = first ? Apv[e] : Acv[e], ng = last ? Bng[e] : Bcg[e], nv = last ? Bnv[e] : Bcv[e];
                        G[e] = wg0[e] * pg + wg1[e] * ug[e] + wg2[e] * ng + bg[e]; V[e] = wv0[e] * pv + wv1[e] * uv[e] + wv2[e] * nv + bv[e]; }
                    Apg = Acg; Apv = Acv; Bcg = Bng; Bcv = Bnv;
                    bool edge = false;
                    if (m == 0) { if (first) { edge = true; *(f32x4*)(hb) = ug; *(f32x4*)(hb + 128) = uv; *(f32x4*)(hb + 2 * 2 * DFF) = G; *(f32x4*)(hb + 2 * 2 * DFF + 128) = V; } }
                    if (m == 3) { if (last) { edge = true; *(f32x4*)(hb + 2 * DFF) = ug; *(f32x4*)(hb + 2 * DFF + 128) = uv; *(f32x4*)(hb + 3 * 2 * DFF) = G; *(f32x4*)(hb + 3 * 2 * DFF + 128) = V; } }
                    f32x4 o;
#pragma unroll
                    for (int e = 0; e < 4; ++e) o[e] = G[e] * fast_sigmoid(G[e]) * V[e];
                    u32x2 w; w.x = cvt_pk_bf16(o[0], o[1]); w.y = cvt_pk_bf16(o[2], o[3]);
                    if (n == 0) pk[ai][m] = w;
                    else if (!edge) { u32x4 w4; w4.x = pk[ai][m].x; w4.y = pk[ai][m].y; w4.z = w.x; w4.w = w.y; *(u32x4*)(act + ((unsigned)row * (unsigned)DFF + (unsigned)(c - 4))) = w4; }
                    __builtin_amdgcn_sched_barrier(0);
                }
                asm volatile("" ::: "memory");
            }
        }
    }
};

struct EpiFinal {
    static constexpr bool PERM = true, AFTER_DRAIN = false;
    const bf16_t* x1b; float* out; float* ssq; unsigned* cnt; const float* gf;
    __device__ __forceinline__ void operator()(f32x4 (&acc)[2][2][4][2], const Unit& u, int wr, int wc, int fr, int fq) const {
        const int l_ = lane_id_fresh(); fr = l_ & 15; fq = l_ >> 4;
        const int pn = u.pn, row0 = u.pm * BM + wr * 64 + fr, cw = wc * 32 + 8 * fq;
        const unsigned off0 = (unsigned)row0 * DM + pn * 256 + cw;
#pragma unroll
        for (int ai = 0; ai < 2; ++ai) {
            u32x4 xw[4][2];
#pragma unroll
            for (int m = 0; m < 4; ++m)
#pragma unroll
                for (int bj = 0; bj < 2; ++bj) xw[m][bj] = *(const u32x4*)(x1b + off0 + (unsigned)((ai * HALF + m * 16) * DM + bj * HALF));
            asm volatile("" ::: "memory");
#pragma unroll
            for (int m = 0; m < 4; ++m) { const int row = row0 + ai * HALF + m * 16; float s = 0.f;
#pragma unroll
                for (int bj = 0; bj < 2; ++bj) { const u32x4 w = xw[m][bj];
                    const f32x4 x0 = {__uint_as_float(w.x << 16), __uint_as_float(w.x & 0xffff0000u), __uint_as_float(w.y << 16), __uint_as_float(w.y & 0xffff0000u)};
                    const f32x4 x1v = {__uint_as_float(w.z << 16), __uint_as_float(w.z & 0xffff0000u), __uint_as_float(w.w << 16), __uint_as_float(w.w & 0xffff0000u)};
                    acc[ai][bj][m][0] = acc[ai][bj][m][0] + x0; acc[ai][bj][m][1] = acc[ai][bj][m][1] + x1v;
                    s += sq4(acc[ai][bj][m][0]) + sq4(acc[ai][bj][m][1]); }
                s = fq_sum(s); if (fq == 0) __hip_atomic_store(ssq + (unsigned)row * 16 + pn * 4 + wc, s, __ATOMIC_RELAXED, __HIP_MEMORY_SCOPE_AGENT); }
            asm volatile("" ::: "memory");
        }
        asm volatile("s_waitcnt vmcnt(0)" ::: "memory");
        __builtin_amdgcn_s_barrier(); asm volatile("" ::: "memory");
        if (wr == 0 && wc == 0) {
            unsigned* c = cnt + 64 * u.pm;
            if (l_ == 0) __hip_atomic_fetch_add(c, 1u, __ATOMIC_RELAXED, __HIP_MEMORY_SCOPE_AGENT);
            for (unsigned sp = 0; sp < (1u << 22); ++sp) {
                if ((unsigned)__builtin_amdgcn_readfirstlane(__hip_atomic_load(c, __ATOMIC_RELAXED, __HIP_MEMORY_SCOPE_AGENT)) >= 4u) break;
                __builtin_amdgcn_s_sleep(2); }
            __builtin_amdgcn_fence(__ATOMIC_ACQUIRE, "agent");
            asm volatile("s_waitcnt vmcnt(0)" ::: "memory");
        }
        __builtin_amdgcn_s_barrier(); asm volatile("" ::: "memory");
        f32x4 gv[2][2];
#pragma unroll
        for (int bj = 0; bj < 2; ++bj) { gv[bj][0] = *(const f32x4*)(gf + pn * 256 + bj * HALF + cw); gv[bj][1] = *(const f32x4*)(gf + pn * 256 + bj * HALF + cw + 4); }
        f32x4 tv[2][4];
#pragma unroll
        for (int ai = 0; ai < 2; ++ai)
#pragma unroll
            for (int m = 0; m < 4; ++m) tv[ai][m] = *(const f32x4*)(ssq + (unsigned)(row0 + ai * HALF + m * 16) * 16 + 4 * fq);
        asm volatile("" ::: "memory");
#pragma unroll
        for (int ai = 0; ai < 2; ++ai)
#pragma unroll
            for (int m = 0; m < 4; ++m) { const f32x4 t = tv[ai][m];
                const float rs = __builtin_amdgcn_rsqf(fq_sum((t[0] + t[1]) + (t[2] + t[3])) * (1.0f / 1024.0f) + RMS_EPS);
#pragma unroll
                for (int bj = 0; bj < 2; ++bj) { const unsigned off = off0 + (unsigned)((ai * HALF + m * 16) * DM + bj * HALF);
                    *(f32x4*)(out + off) = acc[ai][bj][m][0] * rs * gv[bj][0]; *(f32x4*)(out + off + 4) = acc[ai][bj][m][1] * rs * gv[bj][1]; }
                if (m == 1 || m == 3) __builtin_amdgcn_sched_barrier(0); }
    }
};
template <class Epi, class Sched, bool ALIGN_EPI = false, bool SP2 = false>
__device__ __forceinline__ void gemm_phase(PG8_LAS unsigned char* lds, const Gemm g, const Sched& S, const Epi& E, const int wave_id  ) {
    const int lane = lane_id_fresh(), wid = wave_id, tid = wid * 64 + lane,
              wr = wid >> 2, wc = wid & 3, fr = lane & 15, fq = lane >> 4;
    const int K = g.K, nt = K / BK;
    unsigned voffA[2], voffB[2]; int aoff, boff;
#define PG8_LANE_CONSTS() do { const int l_ = lane_id_fresh(), t_ = wid * 64 + l_, fr_ = l_ & 15, fq_ = l_ >> 4; \
        _Pragma("unroll") for (int i = 0; i < 2; ++i) { int R, C; stage_rc(t_ * 16 + i * 8192, R, C); const int Rb = Epi::PERM ? ((R & ~31) + perm32(R & 31)) : R; \
            voffA[i] = (unsigned)(R * K + C) * 2u; voffB[i] = (unsigned)(Rb * K + C) * 2u; } \
        aoff = lds_byte(wr * 64 + fr_, fq_ * 8); boff = lds_byte(wc * 32 + fr_, fq_ * 8); } while (0)
    PG8_LANE_CONSTS();
    const size_t kstep = (size_t)(BK * 2);
    const size_t hstep = (size_t)HALF * K * 2;
    const size_t tstep = 2 * hstep;
    const unsigned ldsw = (unsigned)wid * 1024u;
#define PG8_SA(b, h) (((b) * 2 + (h)) * HTB)
#define PG8_SB(b, h) ((4 + (b) * 2 + (h)) * HTB)
#define PG8_STAGE(bufoff, gbase, voff) do { _Pragma("unroll") for (int _i = 0; _i < 2; ++_i) \
        __builtin_amdgcn_global_load_lds((const unsigned*)((const char*)(gbase) + (voff)[_i]), (PG8_LAS unsigned*)(lds + (bufoff) + ldsw + _i * 8192), 16, 0, 0); } while (0)
#define PG8_LDA(dst, b, h) do { _Pragma("unroll") for (int m = 0; m < 4; ++m) _Pragma("unroll") for (int k = 0; k < 2; ++k) dst[m][k] = *(const PG8_LAS bf16x8*)(lds + PG8_SA(b, h) + aoff + m * 2048 + k * 1024); } while (0)
#define PG8_LDB(dst, b, h) do { _Pragma("unroll") for (int n = 0; n < 2; ++n) _Pragma("unroll") for (int k = 0; k < 2; ++k) dst[n][k] = *(const PG8_LAS bf16x8*)(lds + PG8_SB(b, h) + boff + n * 2048 + k * 1024); } while (0)
#define PG8_MMA(ai, bj, At, Bt) do { __builtin_amdgcn_s_setprio(1); _Pragma("unroll") for (int m = 0; m < 4; ++m) _Pragma("unroll") for (int n = 0; n < 2; ++n) _Pragma("unroll") for (int k = 0; k < 2; ++k) \
        acc[ai][bj][m][n] = __builtin_amdgcn_mfma_f32_16x16x32_bf16(Bt[n][k], At[m][k], acc[ai][bj][m][n], 0, 0, 0); __builtin_amdgcn_s_setprio(0); } while (0)
#define PG8_WAIT_V(n) asm volatile("s_waitcnt vmcnt(" #n ")" ::: "memory")
#define PG8_WAIT_L(n) asm volatile("s_waitcnt lgkmcnt(" #n ")" ::: "memory")
#define PG8_BAR __builtin_amdgcn_s_barrier()
#define PG8_SCHED __builtin_amdgcn_sched_barrier(0)
    Unit cur, nxt; int ui = 0;
    if (!S.next(0, cur)) return;
    f32x4 acc[2][2][4][2];
#pragma unroll
    for (int a = 0; a < 2; ++a)
#pragma unroll
        for (int b = 0; b < 2; ++b)
#pragma unroll
            for (int m = 0; m < 4; ++m)
#pragma unroll
                for (int n = 0; n < 2; ++n) acc[a][b][m][n] = (f32x4){0.f, 0.f, 0.f, 0.f};
    bf16x8 At[4][2], B0[2][2], B1[2][2];
    const char* cA = (const char*)g.A + (size_t)cur.pm * tstep; const char* cB = (const char*)g.Bt + (size_t)cur.pn * tstep;
    S.a_ready(cur);
    if constexpr (SP2) {
        PG8_STAGE(PG8_SB(0, 0), cB, voffB); PG8_STAGE(PG8_SB(0, 1), cB + hstep, voffB); PG8_STAGE(PG8_SA(0, 0), cA, voffA); PG8_STAGE(PG8_SA(0, 1), cA + hstep, voffA);
        if (wr == 1) PG8_BAR;
        PG8_WAIT_V(2); PG8_BAR;
        PG8_STAGE(PG8_SB(1, 0), cB + kstep, voffB); PG8_STAGE(PG8_SA(1, 0), cA + kstep, voffA); PG8_STAGE(PG8_SB(1, 1), cB + hstep + kstep, voffB);
        PG8_WAIT_V(6); PG8_BAR;
    } else {
        PG8_STAGE(PG8_SB(0, 0), cB, voffB); PG8_STAGE(PG8_SA(0, 0), cA, voffA); PG8_STAGE(PG8_SB(0, 1), cB + hstep, voffB); PG8_STAGE(PG8_SA(0, 1), cA + hstep, voffA);
        if (wr == 1) PG8_BAR;
        PG8_WAIT_V(4); PG8_BAR;
        PG8_STAGE(PG8_SB(1, 0), cB + kstep, voffB); PG8_STAGE(PG8_SA(1, 0), cA + kstep, voffA); PG8_STAGE(PG8_SB(1, 1), cB + hstep + kstep, voffB);
        PG8_WAIT_V(6); PG8_BAR;
    }
    for (;;) {
        const bool has_next = S.next(ui + 1, nxt);
        const char* nA = has_next ? (const char*)g.A + (size_t)nxt.pm * tstep : cA; const char* nB = has_next ? (const char*)g.Bt + (size_t)nxt.pn * tstep : cB;
        for (int t = 0; t < nt; t += 2) {
            const bool last = (t == nt - 2);
            const char* a1 = cA + (size_t)(t + 1) * kstep;
            const char* a2 = last ? nA : cA + (size_t)(t + 2) * kstep; const char* b2 = last ? nB : cB + (size_t)(t + 2) * kstep;
            const char* a3 = a2 + kstep; const char* b3 = b2 + kstep;
            if (last && has_next) S.a_ready(nxt);
            if constexpr (SP2) {
            PG8_LDB(B0, 0, 0); PG8_LDB(B1, 0, 1); PG8_SCHED; PG8_LDA(At, 0, 0); PG8_STAGE(PG8_SA(1, 1), a1 + hstep, voffA);
            PG8_WAIT_V(8); PG8_WAIT_L(0); PG8_BAR; PG8_MMA(0, 0, At, B0); PG8_MMA(0, 1, At, B1); PG8_BAR; PG8_SCHED;
            PG8_LDA(At, 0, 1); PG8_STAGE(PG8_SB(0, 0), b2, voffB); PG8_STAGE(PG8_SB(0, 1), b2 + hstep, voffB); PG8_STAGE(PG8_SA(0, 0), a2, voffA);
            PG8_WAIT_V(8); PG8_WAIT_L(0); PG8_BAR; PG8_MMA(1, 0, At, B0); PG8_MMA(1, 1, At, B1); PG8_BAR; PG8_SCHED;
            PG8_LDB(B0, 1, 0); PG8_LDB(B1, 1, 1); PG8_SCHED; PG8_LDA(At, 1, 0); PG8_STAGE(PG8_SA(0, 1), a2 + hstep, voffA);
            PG8_WAIT_V(8); PG8_WAIT_L(0); PG8_BAR; PG8_MMA(0, 0, At, B0); PG8_MMA(0, 1, At, B1); PG8_BAR; PG8_SCHED;
            PG8_LDA(At, 1, 1); PG8_STAGE(PG8_SB(1, 0), b3, voffB); PG8_STAGE(PG8_SB(1, 1), b3 + hstep, voffB); PG8_STAGE(PG8_SA(1, 0), a3, voffA);
            PG8_WAIT_V(8); PG8_WAIT_L(0); PG8_BAR; PG8_MMA(1, 0, At, B0); PG8_MMA(1, 1, At, B1); PG8_BAR; PG8_SCHED;
            } else {
            PG8_LDB(B0, 0, 0); PG8_SCHED; PG8_LDA(At, 0, 0); PG8_STAGE(PG8_SA(1, 1), a1 + hstep, voffA);
            PG8_WAIT_L(8); PG8_BAR; PG8_WAIT_L(0); PG8_MMA(0, 0, At, B0); PG8_BAR; PG8_SCHED;
            PG8_LDB(B1, 0, 1); PG8_STAGE(PG8_SB(0, 0), b2, voffB);
            PG8_BAR; PG8_WAIT_L(0); PG8_MMA(0, 1, At, B1); PG8_BAR;
            PG8_LDA(At, 0, 1); PG8_STAGE(PG8_SA(0, 0), a2, voffA);
            PG8_BAR; PG8_WAIT_L(0); PG8_MMA(1, 0, At, B0); PG8_BAR; PG8_SCHED;
            PG8_STAGE(PG8_SB(0, 1), b2 + hstep, voffB);
            PG8_WAIT_V(6); PG8_BAR; PG8_MMA(1, 1, At, B1); PG8_BAR;
            PG8_LDB(B0, 1, 0); PG8_SCHED; PG8_LDA(At, 1, 0); PG8_STAGE(PG8_SA(0, 1), a2 + hstep, voffA);
            PG8_WAIT_L(8); PG8_BAR; PG8_WAIT_L(0); PG8_MMA(0, 0, At, B0); PG8_BAR; PG8_SCHED;
            PG8_LDB(B1, 1, 1); PG8_STAGE(PG8_SB(1, 0), b3, voffB);
            PG8_BAR; PG8_WAIT_L(0); PG8_MMA(0, 1, At, B1); PG8_BAR;
            PG8_LDA(At, 1, 1); PG8_STAGE(PG8_SA(1, 0), a3, voffA);
            PG8_BAR; PG8_WAIT_L(0); PG8_MMA(1, 0, At, B0); PG8_BAR; PG8_SCHED;
            PG8_STAGE(PG8_SB(1, 1), b3 + hstep, voffB);
            PG8_WAIT_V(6); PG8_BAR; PG8_MMA(1, 1, At, B1); PG8_BAR;
            }
        }
        if constexpr (ALIGN_EPI) { if (wr == 0) PG8_BAR; }
        if constexpr (!Epi::AFTER_DRAIN) { E(acc, cur, wr, wc, fr, fq); S.done(cur); PG8_LANE_CONSTS(); }
        if (!has_next) break;
#pragma unroll
        for (int a = 0; a < 2; ++a)
#pragma unroll
            for (int b = 0; b < 2; ++b)
#pragma unroll
                for (int m = 0; m < 4; ++m)
#pragma unroll
                    for (int n = 0; n < 2; ++n) acc[a][b][m][n] = (f32x4){0.f, 0.f, 0.f, 0.f};
        cur = nxt; cA = nA; cB = nB; ++ui;
        if constexpr (ALIGN_EPI) { if (wr == 1) PG8_BAR; }
    }
    PG8_WAIT_V(0);
    if constexpr (!ALIGN_EPI) { if (wr == 0) PG8_BAR; }
    PG8_BAR;
    if constexpr (Epi::AFTER_DRAIN) { E.fused(acc, cur, wr, wc, fr, fq, lds, wid, lane); S.done(cur); }
#undef PG8_LANE_CONSTS
#undef PG8_SA
#undef PG8_SB
#undef PG8_STAGE
#undef PG8_LDA
#undef PG8_LDB
#undef PG8_MMA
#undef PG8_WAIT_V
#undef PG8_WAIT_L
#undef PG8_BAR
#undef PG8_SCHED
}
}
using pg8::SEQ; using pg8::NBATCH; using pg8::MTOK; using pg8::DM; using pg8::DFF; using pg8::RMS_EPS; using pg8::LOG2E;
#ifndef PG8_SP2
#define PG8_SP2 true
#endif
#ifndef PG8_ALIGN
#define PG8_ALIGN true
#endif
#ifndef MLA_OT
#define MLA_OT 1
#endif
namespace att {
using bf16x8 = __attribute__((ext_vector_type(8))) short;
using s16x4  = __attribute__((ext_vector_type(4))) short;
using f32x16 = __attribute__((ext_vector_type(16))) float;
using u32x4  = __attribute__((ext_vector_type(4))) unsigned;
typedef unsigned short bf16_t;
#define SBAR() __builtin_amdgcn_sched_barrier(0)
#define ATT_WAIT_BAR(N) asm volatile("s_waitcnt vmcnt(" #N ") lgkmcnt(0)\n\ts_barrier" ::: "memory")
__device__ __forceinline__ int crow(int r, int hi) { return (r & 3) + 8 * (r >> 2) + 4 * hi; }
__device__ __forceinline__ unsigned cvtpk(float lo, float hi) { unsigned r; asm volatile("v_cvt_pk_bf16_f32 %0, %1, %2" : "=v"(r) : "v"(lo), "v"(hi)); return r; }
__device__ __forceinline__ float bf2f(bf16_t b) { return __uint_as_float((unsigned)b << 16); }
typedef float f32x2_t __attribute__((ext_vector_type(2))); typedef __bf16 bf16x2_t __attribute__((ext_vector_type(2)));
__device__ __forceinline__ unsigned cvtpk2(float lo, float hi) { f32x2_t v = {lo, hi}; bf16x2_t r = __builtin_convertvector(v, bf16x2_t); return __builtin_bit_cast(unsigned, r); }
__device__ __forceinline__ bf16_t f2bf(float f) { return (bf16_t)(cvtpk(f, f) & 0xffffu); }
__device__ __forceinline__ void glds16(const void* gsrc, unsigned lds_dst) { unsigned keep;
    asm volatile("s_mov_b32 %0, m0\n\ts_mov_b32 m0, %2\n\ts_nop 0\n\tglobal_load_lds_dwordx4 %1, off\n\ts_mov_b32 m0, %0" : "=&s"(keep) : "v"(gsrc), "s"(lds_dst) : "memory"); }
template <int IMM> __device__ __forceinline__ void glds16s(const void* sbase, unsigned voff, unsigned lds_dst) { unsigned keep;
    asm volatile("s_mov_b32 %0, m0\n\ts_mov_b32 m0, %3\n\ts_nop 4\n\tglobal_load_lds_dwordx4 %1, %2 offset:%4\n\ts_mov_b32 m0, %0" : "=&s"(keep) : "v"(voff), "s"(sbase), "s"(lds_dst), "i"(IMM) : "memory"); }
__device__ __forceinline__ int swap23(int k) { return (k & ~0xC) | ((k & 4) << 1) | ((k & 8) >> 1); }
__device__ __forceinline__ int v_rd_base(int lane) { return ((lane & 3) << 3) | (((lane >> 2) & 3) << 6) | (((lane >> 4) & 1) << 5) | (((lane >> 5) & 1) << 8); }
template <int OFF> __device__ __forceinline__ s16x4 tr_read(int vb) { s16x4 r; asm volatile("ds_read_b64_tr_b16 %0, %1 offset:%2" : "=&v"(r) : "v"(vb), "i"(OFF) : "memory"); return r; }
__device__ __forceinline__ void pack_p(const f32x16& p0, const f32x16& p1, bf16x8& pa0, bf16x8& pa1, bf16x8& pa2, bf16x8& pa3) {
#define PK4(P, BASE, OUT) do { unsigned a0 = cvtpk(P[BASE + 0], P[BASE + 1]), a1 = cvtpk(P[BASE + 2], P[BASE + 3]);   \
    unsigned b0 = cvtpk(P[BASE + 4], P[BASE + 5]), b1 = cvtpk(P[BASE + 6], P[BASE + 7]);                              \
    auto r0 = __builtin_amdgcn_permlane32_swap(a0, b0, false, false); auto r1 = __builtin_amdgcn_permlane32_swap(a1, b1, false, false); \
    u32x4 w = {r0[0], r1[0], r0[1], r1[1]}; OUT = *reinterpret_cast<bf16x8*>(&w); } while (0)
    PK4(p0, 0, pa0); PK4(p0, 8, pa1); PK4(p1, 0, pa2); PK4(p1, 8, pa3);
#undef PK4
}
__device__ __forceinline__ float half_max(float v) { auto rr = __builtin_amdgcn_permlane32_swap(__float_as_uint(v), __float_as_uint(v), false, false); return fmaxf(__uint_as_float(rr[0]), __uint_as_float(rr[1])); }
__device__ __forceinline__ float half_sum(float v) { auto rr = __builtin_amdgcn_permlane32_swap(__float_as_uint(v), __float_as_uint(v), false, false); return __uint_as_float(rr[0]) + __uint_as_float(rr[1]); }
template <int ND0, int D0> __device__ __forceinline__ void pv_one(f32x16& od, int vb, bf16x8 pa0, bf16x8 pa1, bf16x8 pa2, bf16x8 pa3) {
    constexpr int KS = 1024 * ND0, HF = 512 * ND0;
    const s16x4 l0 = tr_read<D0 * 512 + 0 * KS>(vb), h0 = tr_read<D0 * 512 + 0 * KS + HF>(vb), l1 = tr_read<D0 * 512 + 1 * KS>(vb), h1 = tr_read<D0 * 512 + 1 * KS + HF>(vb);
    const s16x4 l2 = tr_read<D0 * 512 + 2 * KS>(vb), h2 = tr_read<D0 * 512 + 2 * KS + HF>(vb), l3 = tr_read<D0 * 512 + 3 * KS>(vb), h3 = tr_read<D0 * 512 + 3 * KS + HF>(vb);
    asm volatile("s_waitcnt lgkmcnt(0)" ::: "memory"); SBAR();
#define PK(L, H) (bf16x8){L[0], L[1], L[2], L[3], H[0], H[1], H[2], H[3]}
    od = __builtin_amdgcn_mfma_f32_32x32x16_bf16(pa0, PK(l0, h0), od, 0, 0, 0);
    od = __builtin_amdgcn_mfma_f32_32x32x16_bf16(pa1, PK(l1, h1), od, 0, 0, 0);
    od = __builtin_amdgcn_mfma_f32_32x32x16_bf16(pa2, PK(l2, h2), od, 0, 0, 0);
    od = __builtin_amdgcn_mfma_f32_32x32x16_bf16(pa3, PK(l3, h3), od, 0, 0, 0);
#undef PK
}
struct PvFrag { s16x4 l0, h0, l1, h1, l2, h2, l3, h3; };
template <int ND0, int D0> __device__ __forceinline__ void pv_issue(PvFrag& f, int vb) {
    constexpr int KS = 1024 * ND0, HF = 512 * ND0;
    f.l0 = tr_read<D0 * 512 + 0 * KS>(vb); f.h0 = tr_read<D0 * 512 + 0 * KS + HF>(vb); f.l1 = tr_read<D0 * 512 + 1 * KS>(vb); f.h1 = tr_read<D0 * 512 + 1 * KS + HF>(vb);
    f.l2 = tr_read<D0 * 512 + 2 * KS>(vb); f.h2 = tr_read<D0 * 512 + 2 * KS + HF>(vb); f.l3 = tr_read<D0 * 512 + 3 * KS>(vb); f.h3 = tr_read<D0 * 512 + 3 * KS + HF>(vb);
}
__device__ __forceinline__ void pv_mma(f32x16& od, const PvFrag& f, bf16x8 pa0, bf16x8 pa1, bf16x8 pa2, bf16x8 pa3) {
    asm volatile("s_waitcnt lgkmcnt(0)" ::: "memory"); SBAR();
#define PK(L, H) (bf16x8){L[0], L[1], L[2], L[3], H[0], H[1], H[2], H[3]}
    od = __builtin_amdgcn_mfma_f32_32x32x16_bf16(pa0, PK(f.l0, f.h0), od, 0, 0, 0);
    od = __builtin_amdgcn_mfma_f32_32x32x16_bf16(pa1, PK(f.l1, f.h1), od, 0, 0, 0);
    od = __builtin_amdgcn_mfma_f32_32x32x16_bf16(pa2, PK(f.l2, f.h2), od, 0, 0, 0);
    od = __builtin_amdgcn_mfma_f32_32x32x16_bf16(pa3, PK(f.l3, f.h3), od, 0, 0, 0);
#undef PK
}
template <int NK16, int RS, int CS> __device__ __forceinline__ void qkt(f32x16& p0, f32x16& p1, const char* Ks, const bf16x8* qr, int r32, int hi) {
    p0 = f32x16{}; p1 = f32x16{};
    const char* kb = Ks + hi * CS + r32 * RS;
#pragma unroll
    for (int d0 = 0; d0 < NK16; ++d0) {
        const bf16x8 b0 = *reinterpret_cast<const bf16x8*>(kb + d0 * 2 * CS), b1 = *reinterpret_cast<const bf16x8*>(kb + d0 * 2 * CS + 32 * RS);
        p0 = __builtin_amdgcn_mfma_f32_32x32x16_bf16(b0, qr[d0], p0, 0, 0, 0);
        p1 = __builtin_amdgcn_mfma_f32_32x32x16_bf16(b1, qr[d0], p1, 0, 0, 0); }
}

template <int NK16, int RS, int CS> __device__ __forceinline__ void qkt_c(f32x16& p0, f32x16& p1, const f32x16& c, const char* Ks, const bf16x8* qr, int r32, int hi) {
    const char* kb = Ks + hi * CS + r32 * RS;
    { const bf16x8 b0 = *reinterpret_cast<const bf16x8*>(kb), b1 = *reinterpret_cast<const bf16x8*>(kb + 32 * RS);
      p0 = __builtin_amdgcn_mfma_f32_32x32x16_bf16(b0, qr[0], c, 0, 0, 0);
      p1 = __builtin_amdgcn_mfma_f32_32x32x16_bf16(b1, qr[0], c, 0, 0, 0); }
#pragma unroll
    for (int d0 = 1; d0 < NK16; ++d0) {
        const bf16x8 b0 = *reinterpret_cast<const bf16x8*>(kb + d0 * 2 * CS), b1 = *reinterpret_cast<const bf16x8*>(kb + d0 * 2 * CS + 32 * RS);
        p0 = __builtin_amdgcn_mfma_f32_32x32x16_bf16(b0, qr[d0], p0, 0, 0, 0);
        p1 = __builtin_amdgcn_mfma_f32_32x32x16_bf16(b1, qr[d0], p1, 0, 0, 0); }
}
__device__ __forceinline__ float max3f(float a, float b, float c) { float r; asm("v_max3_f32 %0, %1, %2, %3" : "=v"(r) : "v"(a), "v"(b), "v"(c)); return r; }

namespace mla {
constexpr int NTILE = SEQ / 64;
constexpr int KPITCH = 400, KSLOT = 64 * KPITCH  , NSLOT = 4;
constexpr int LDS_K = 0, LDS_WS = NSLOT * KSLOT, LDS_BYTES = LDS_WS + 8 * 256;
constexpr int OST_PITCH = 272, OST_WAVE = 32 * OST_PITCH;
static_assert(8 * OST_WAVE <= NSLOT * KSLOT, "o_lat staging fits the ring");
#ifndef MLA_XVALU
#define MLA_XVALU 0
#endif
constexpr float THR = 8.f;
template <bool FIRST> __device__ __forceinline__ void partialSM(f32x16& p0, f32x16& p1, f32x16& negm, float& alpha) {
    float a = max3f(p0[0], p0[1], p0[2]), b = max3f(p0[9], p0[10], p0[11]), c = max3f(p1[0], p1[1], p1[2]), e = max3f(p1[9], p1[10], p1[11]);
    a = max3f(a, p0[3], p0[4]); b = max3f(b, p0[12], p0[13]); c = max3f(c, p1[3], p1[4]); e = max3f(e, p1[12], p1[13]);
    a = max3f(a, p0[5], p0[6]); b = max3f(b, p0[14], p0[15]); c = max3f(c, p1[5], p1[6]); e = max3f(e, p1[14], p1[15]);
    a = max3f(a, p0[7], p0[8]); c = max3f(c, p1[7], p1[8]);
    float pmax = max3f(a, b, c);
    pmax = max3f(pmax, e, e);
    { auto rr = __builtin_amdgcn_permlane32_swap(__float_as_uint(pmax), __float_as_uint(pmax), false, false); pmax = max3f(__uint_as_float(rr[0]), __uint_as_float(rr[1]), __uint_as_float(rr[1])); }
    alpha = 1.f;
    if (FIRST || !__builtin_expect(__all(pmax <= THR), 1)) {
        const float dl = FIRST ? pmax : fmaxf(pmax, 0.f);
        if (!FIRST) alpha = __builtin_amdgcn_exp2f(-dl);
#pragma unroll
        for (int r = 0; r < 16; ++r) { p0[r] -= dl; p1[r] -= dl; negm[r] -= dl; }
        asm volatile("" : "+v"(negm));
    }
#pragma unroll
    for (int r = 0; r < 16; ++r) p0[r] = __builtin_amdgcn_exp2f(p0[r]);
}
__device__ __forceinline__ void finishSM(f32x16& p0, f32x16& p1, float alpha, float& l_reg, bf16x8& pa0, bf16x8& pa1, bf16x8& pa2, bf16x8& pa3) {
#pragma unroll
    for (int r = 0; r < 16; ++r) p1[r] = __builtin_amdgcn_exp2f(p1[r]);
    float s0 = p0[0] + p0[1], s1 = p0[2] + p0[3], s2 = p1[0] + p1[1], s3 = p1[2] + p1[3];
#pragma unroll
    for (int r = 4; r < 16; r += 4) { s0 += p0[r]; s0 += p0[r + 1]; s1 += p0[r + 2]; s1 += p0[r + 3]; s2 += p1[r]; s2 += p1[r + 1]; s3 += p1[r + 2]; s3 += p1[r + 3]; }
    float ps = (s0 + s1) + (s2 + s3);
    ps = half_sum(ps);
    l_reg = l_reg * alpha + ps;
#if MLA_OT
#define MLA_PK(P, B) (u32x4){cvtpk2(P[B], P[B + 1]), cvtpk2(P[B + 2], P[B + 3]), cvtpk2(P[B + 4], P[B + 5]), cvtpk2(P[B + 6], P[B + 7])}
    { u32x4 w0 = MLA_PK(p0, 0), w1 = MLA_PK(p0, 8), w2 = MLA_PK(p1, 0), w3 = MLA_PK(p1, 8);
      pa0 = *reinterpret_cast<bf16x8*>(&w0); pa1 = *reinterpret_cast<bf16x8*>(&w1); pa2 = *reinterpret_cast<bf16x8*>(&w2); pa3 = *reinterpret_cast<bf16x8*>(&w3); }
#undef MLA_PK
#else
    pack_p(p0, p1, pa0, pa1, pa2, pa3);
#endif
}
__device__ __forceinline__ int v_rm_base(int lane) { return (8 * (lane >> 5) + ((lane >> 2) & 3)) * KPITCH + 32 * ((lane >> 4) & 1) + 8 * (lane & 3); }
template <int D0> __device__ __forceinline__ void pvr_issue(PvFrag& f, int vb) {
    constexpr int KS = 16 * KPITCH, HF = 4 * KPITCH;
    f.l0 = tr_read<D0 * 64 + 0 * KS>(vb); f.h0 = tr_read<D0 * 64 + 0 * KS + HF>(vb); f.l1 = tr_read<D0 * 64 + 1 * KS>(vb); f.h1 = tr_read<D0 * 64 + 1 * KS + HF>(vb);
    f.l2 = tr_read<D0 * 64 + 2 * KS>(vb); f.h2 = tr_read<D0 * 64 + 2 * KS + HF>(vb); f.l3 = tr_read<D0 * 64 + 3 * KS>(vb); f.h3 = tr_read<D0 * 64 + 3 * KS + HF>(vb);
}
template <int D0> __device__ __forceinline__ void pvr_one(f32x16& od, int vb, bf16x8 pa0, bf16x8 pa1, bf16x8 pa2, bf16x8 pa3) { PvFrag f; pvr_issue<D0>(f, vb); pv_mma(od, f, pa0, pa1, pa2, pa3); }
#if MLA_OT
__device__ __forceinline__ int vt_rm_base(int lane) { return (4 * (lane >> 5) + ((lane >> 2) & 3)) * KPITCH + 32 * ((lane >> 4) & 1) + 8 * (lane & 3); }
template <int D0> __device__ __forceinline__ void pvt_issue(PvFrag& f, int vb) {
    constexpr int KS = 16 * KPITCH, HF = 8 * KPITCH;
    f.l0 = tr_read<D0 * 64 + 0 * KS>(vb); f.h0 = tr_read<D0 * 64 + 0 * KS + HF>(vb); f.l1 = tr_read<D0 * 64 + 1 * KS>(vb); f.h1 = tr_read<D0 * 64 + 1 * KS + HF>(vb);
    f.l2 = tr_read<D0 * 64 + 2 * KS>(vb); f.h2 = tr_read<D0 * 64 + 2 * KS + HF>(vb); f.l3 = tr_read<D0 * 64 + 3 * KS>(vb); f.h3 = tr_read<D0 * 64 + 3 * KS + HF>(vb);
}
__device__ __forceinline__ void pvt_mma(f32x16& od, const PvFrag& f, bf16x8 pa0, bf16x8 pa1, bf16x8 pa2, bf16x8 pa3) {
    asm volatile("s_waitcnt lgkmcnt(0)" ::: "memory"); SBAR();
#define PK(L, H) (bf16x8){L[0], L[1], L[2], L[3], H[0], H[1], H[2], H[3]}
    od = __builtin_amdgcn_mfma_f32_32x32x16_bf16(PK(f.l0, f.h0), pa0, od, 0, 0, 0);
    od = __builtin_amdgcn_mfma_f32_32x32x16_bf16(PK(f.l1, f.h1), pa1, od, 0, 0, 0);
    od = __builtin_amdgcn_mfma_f32_32x32x16_bf16(PK(f.l2, f.h2), pa2, od, 0, 0, 0);
    od = __builtin_amdgcn_mfma_f32_32x32x16_bf16(PK(f.l3, f.h3), pa3, od, 0, 0, 0);
#undef PK
}
template <int D0> __device__ __forceinline__ void pvt_one(f32x16& od, int vb, bf16x8 pa0, bf16x8 pa1, bf16x8 pa2, bf16x8 pa3) { PvFrag f; pvt_issue<D0>(f, vb); pvt_mma(od, f, pa0, pa1, pa2, pa3); }
#define MLA_PV_ISSUE pvt_issue
#define MLA_PV_MMA pvt_mma
#define MLA_PV_ONE pvt_one
#define MLA_V_BASE vt_rm_base
#else
#define MLA_PV_ISSUE pvr_issue
#define MLA_PV_MMA pv_mma
#define MLA_PV_ONE pvr_one
#define MLA_V_BASE v_rm_base
#endif
__device__ __forceinline__ void h1_qk_finish(f32x16& C0, f32x16& C1, f32x16& P0, f32x16& P1, const f32x16& negm, const char* Ks, const bf16x8* qr, int r32, int hi,
                                             float alP, float& l_reg, bf16x8& pa0, bf16x8& pa1, bf16x8& pa2, bf16x8& pa3) {
    const char* kb = Ks + hi * 16 + r32 * KPITCH;
    bf16x8 b0 = *reinterpret_cast<const bf16x8*>(kb), b1 = *reinterpret_cast<const bf16x8*>(kb + 32 * KPITCH);
    float a0 = 0.f, a1 = 0.f, c0 = 0.f, c1 = 0.f; unsigned w[16];
#pragma unroll
    for (int k = 0; k < 12; ++k) {
        bf16x8 n0 = b0, n1 = b1;
        if (k < 11) { n0 = *reinterpret_cast<const bf16x8*>(kb + (k + 1) * 32); n1 = *reinterpret_cast<const bf16x8*>(kb + (k + 1) * 32 + 32 * KPITCH); }
        if (k == 0) { C0 = __builtin_amdgcn_mfma_f32_32x32x16_bf16(b0, qr[0], negm, 0, 0, 0); C1 = __builtin_amdgcn_mfma_f32_32x32x16_bf16(b1, qr[0], negm, 0, 0, 0); }
        else { C0 = __builtin_amdgcn_mfma_f32_32x32x16_bf16(b0, qr[k], C0, 0, 0, 0); C1 = __builtin_amdgcn_mfma_f32_32x32x16_bf16(b1, qr[k], C1, 0, 0, 0); }
        if (k < 8) { float e0 = __builtin_amdgcn_exp2f(P1[2 * k]), e1 = __builtin_amdgcn_exp2f(P1[2 * k + 1]);
            if (k == 0) { a0 = P0[0]; a1 = P0[1]; } else { a0 += P0[2 * k]; a1 += P0[2 * k + 1]; }
            w[k] = cvtpk2(P0[2 * k], P0[2 * k + 1]);
            asm volatile("" : "+v"(e0), "+v"(e1), "+v"(a0), "+v"(a1), "+v"(w[k]));
            P1[2 * k] = e0; P1[2 * k + 1] = e1; }
        else { const int e = 4 * (k - 8);
            if (k == 8) { c0 = P1[0] + P1[2]; c1 = P1[1] + P1[3]; } else { c0 += P1[e]; c1 += P1[e + 1]; c0 += P1[e + 2]; c1 += P1[e + 3]; }
            w[8 + 2 * (k - 8)] = cvtpk2(P1[e], P1[e + 1]); w[9 + 2 * (k - 8)] = cvtpk2(P1[e + 2], P1[e + 3]);
            asm volatile("" : "+v"(c0), "+v"(c1), "+v"(w[8 + 2 * (k - 8)]), "+v"(w[9 + 2 * (k - 8)])); }
        SBAR();
        b0 = n0; b1 = n1;
    }
    l_reg = l_reg * alP + half_sum((a0 + a1) + (c0 + c1));
    { u32x4 w0 = {w[0], w[1], w[2], w[3]}, w1 = {w[4], w[5], w[6], w[7]}, w2 = {w[8], w[9], w[10], w[11]}, w3 = {w[12], w[13], w[14], w[15]};
      pa0 = *reinterpret_cast<bf16x8*>(&w0); pa1 = *reinterpret_cast<bf16x8*>(&w1); pa2 = *reinterpret_cast<bf16x8*>(&w2); pa3 = *reinterpret_cast<bf16x8*>(&w3); }
}
__device__ __forceinline__ void max_head(const f32x16& p0, const f32x16& p1, float& a, float& b, float& c, float& e) {
    a = max3f(p0[0], p0[1], p0[2]); b = max3f(p0[9], p0[10], p0[11]); c = max3f(p1[0], p1[1], p1[2]); e = max3f(p1[9], p1[10], p1[11]);
    a = max3f(a, p0[3], p0[4]); b = max3f(b, p0[12], p0[13]); c = max3f(c, p1[3], p1[4]); e = max3f(e, p1[12], p1[13]);
}
__device__ __forceinline__ float max_tail(const f32x16& p0, const f32x16& p1, float a, float b, float c, float e) {
    a = max3f(a, p0[5], p0[6]); b = max3f(b, p0[14], p0[15]); c = max3f(c, p1[5], p1[6]); e = max3f(e, p1[14], p1[15]);
    a = max3f(a, p0[7], p0[8]); c = max3f(c, p1[7], p1[8]);
    float pmax = max3f(a, b, c); pmax = max3f(pmax, e, e);
    auto rr = __builtin_amdgcn_permlane32_swap(__float_as_uint(pmax), __float_as_uint(pmax), false, false);
    return max3f(__uint_as_float(rr[0]), __uint_as_float(rr[1]), __uint_as_float(rr[1]));
}
struct Tensors { const bf16_t* QA; const bf16_t* KL; const bf16_t* WV; const bf16_t* GA; const bf16_t* OB; bf16_t* MIX; };
__device__ __forceinline__ void unit(int b, int h, int qb, const Tensors& T, char* shm, const int wave_id) {
    const int lane = pg8::lane_id_fresh(), wid = wave_id, r32 = lane & 31, hi = lane >> 5;
    const long rowbase = (long)b * SEQ; const int q0 = qb * 256;
    const unsigned lds0 = (unsigned)(uintptr_t)shm;
    float* wsf = (float*)(shm + LDS_WS) + wid * 64; float* al_l = wsf; float* li_l = wsf + 32;
    const char* klb = (const char*)(T.KL + rowbase * 192);
    unsigned koff0, koff1, koff2;
    { int s = 64 * wid + lane, row = s / 25, pos = s - 25 * row; koff0 = (unsigned)(row * 384 + (pos < 24 ? pos : 23) * 16);
      s += 512; row = s / 25; pos = s - 25 * row; koff1 = (unsigned)(row * 384 + (pos < 24 ? pos : 23) * 16);
      s += 512; row = s / 25; pos = s - 25 * row; koff2 = (unsigned)(row * 384 + (pos < 24 ? pos : 23) * 16); }
#define MLA_DMA(t) do { const unsigned kd_ = (unsigned)__builtin_amdgcn_readfirstlane(lds0 + LDS_K + ((t) & 3) * KSLOT + wid * 1024); const char* kb_ = klb + (size_t)(t) * 24576; \
        glds16s<0>(kb_, koff0, kd_); glds16s<0>(kb_, koff1, kd_ + 8192); glds16s<0>(kb_, koff2, kd_ + 16384); \
        if (wid == 0) { const int s_ = 1536 + lane, row_ = 61 + (lane >= 14) + (lane >= 39), pos_ = s_ - 25 * row_; glds16s<0>(kb_, (unsigned)(row_ * 384 + (pos_ < 24 ? pos_ : 23) * 16), kd_ + 24576); } } while (0)
    MLA_DMA(0); MLA_DMA(1);
    bf16x8 qr[12];
    { const bf16_t* Qw = T.QA + (rowbase + q0 + wid * 32 + r32) * 1536 + h * 192 + hi * 8;
#pragma unroll
      for (int d0 = 0; d0 < 12; ++d0) qr[d0] = *reinterpret_cast<const bf16x8*>(Qw + d0 * 16); }
    const int vb0 = (int)(lds0 + LDS_K) + MLA_V_BASE(lane);
    float l_reg = 0.f; f32x16 o[4] = {};
    f32x16 negm = {}; asm volatile("" : "+v"(negm));
    f32x16 pA0, pA1, pB0, pB1; float alA, alB; bf16x8 pa0, pa1, pa2, pa3;
#if MLA_OT
#define MLA_RESC(a) do { if (__any((a) < 1.f)) { _Pragma("unroll") for (int d = 0; d < 4; ++d) _Pragma("unroll") for (int r = 0; r < 16; ++r) o[d][r] *= (a); } } while (0)
#else
#define MLA_RESC(a) do { if (__any((a) < 1.f)) { if (hi == 0) al_l[r32] = (a); asm volatile("s_waitcnt lgkmcnt(0)" ::: "memory"); \
        _Pragma("unroll") for (int d = 0; d < 4; ++d) _Pragma("unroll") for (int r = 0; r < 16; ++r) o[d][r] *= al_l[crow(r, hi)]; } } while (0)
#endif
#define ATT_BAR_L() asm volatile("s_waitcnt lgkmcnt(0)\n\ts_barrier" ::: "memory")
    ATT_WAIT_BAR(0);
    if (wid >= 4) ATT_BAR_L();
    qkt<12, KPITCH, 16>(pA0, pA1, shm + LDS_K, qr, r32, hi); ATT_WAIT_BAR(0);
    MLA_DMA(2); partialSM<true>(pA0, pA1, negm, alA); ATT_BAR_L();
#define MLA_STEP(C0, C1, P0, P1, alC, alP, t, HASN) do { \
        h1_qk_finish(C0, C1, P0, P1, negm, shm + LDS_K + ((t) & 3) * KSLOT, qr, r32, hi, alP, l_reg, pa0, pa1, pa2, pa3); SBAR(); ATT_WAIT_BAR(0); \
        { const int vb_ = vb0 + (((t) - 1) & 3) * KSLOT; float ma_, mb_, mc_, me_, pmx_; \
          { PvFrag f_; MLA_PV_ISSUE<0>(f_, vb_); if (HASN) { MLA_DMA((t) + 2); } max_head(C0, C1, ma_, mb_, mc_, me_); SBAR(); MLA_PV_MMA(o[0], f_, pa0, pa1, pa2, pa3); } \
          { PvFrag f_; MLA_PV_ISSUE<1>(f_, vb_); pmx_ = max_tail(C0, C1, ma_, mb_, mc_, me_); SBAR(); MLA_PV_MMA(o[1], f_, pa0, pa1, pa2, pa3); } \
          alC = 1.f; \
          if (!__builtin_expect(__all(pmx_ <= THR), 1)) { const float dl_ = fmaxf(pmx_, 0.f); alC = __builtin_amdgcn_exp2f(-dl_); \
              _Pragma("unroll") for (int r_ = 0; r_ < 16; ++r_) { C0[r_] -= dl_; C1[r_] -= dl_; negm[r_] -= dl_; } asm volatile("" : "+v"(negm)); } \
          { PvFrag f_; MLA_PV_ISSUE<2>(f_, vb_); _Pragma("unroll") for (int r_ = 0; r_ < 8; ++r_) C0[r_] = __builtin_amdgcn_exp2f(C0[r_]); asm volatile("" : "+v"(C0)); SBAR(); MLA_PV_MMA(o[2], f_, pa0, pa1, pa2, pa3); } \
          { PvFrag f_; MLA_PV_ISSUE<3>(f_, vb_); _Pragma("unroll") for (int r_ = 8; r_ < 16; ++r_) C0[r_] = __builtin_amdgcn_exp2f(C0[r_]); asm volatile("" : "+v"(C0)); SBAR(); MLA_PV_MMA(o[3], f_, pa0, pa1, pa2, pa3); } } \
        SBAR(); ATT_BAR_L(); MLA_RESC(alC); } while (0)
    for (int t = 1; t + 1 < NTILE; t += 2) {
        MLA_STEP(pB0, pB1, pA0, pA1, alB, alA, t, true);
        MLA_STEP(pA0, pA1, pB0, pB1, alA, alB, t + 1, (t + 3 < NTILE));
    }
    { qkt_c<12, KPITCH, 16>(pB0, pB1, negm, shm + LDS_K + ((NTILE - 1) & 3) * KSLOT, qr, r32, hi);
      finishSM(pA0, pA1, alA, l_reg, pa0, pa1, pa2, pa3); SBAR(); ATT_WAIT_BAR(0);
      { const int vb_ = vb0 + ((NTILE - 2) & 3) * KSLOT; MLA_PV_ONE<0>(o[0], vb_, pa0, pa1, pa2, pa3); MLA_PV_ONE<1>(o[1], vb_, pa0, pa1, pa2, pa3); MLA_PV_ONE<2>(o[2], vb_, pa0, pa1, pa2, pa3); MLA_PV_ONE<3>(o[3], vb_, pa0, pa1, pa2, pa3); }
      partialSM<false>(pB0, pB1, negm, alB);
      ATT_BAR_L(); MLA_RESC(alB);
      finishSM(pB0, pB1, alB, l_reg, pa0, pa1, pa2, pa3); SBAR();
      { const int vb_ = vb0 + ((NTILE - 1) & 3) * KSLOT; MLA_PV_ONE<0>(o[0], vb_, pa0, pa1, pa2, pa3); MLA_PV_ONE<1>(o[1], vb_, pa0, pa1, pa2, pa3); MLA_PV_ONE<2>(o[2], vb_, pa0, pa1, pa2, pa3); MLA_PV_ONE<3>(o[3], vb_, pa0, pa1, pa2, pa3); } }
    if (wid < 4) ATT_BAR_L();
#if MLA_OT
    { const float rl = __builtin_amdgcn_rcpf(l_reg);
      bf16x8 pb[8];
#pragma unroll
      for (int ks = 0; ks < 8; ++ks) { const int bl = ks >> 1, b8 = (ks & 1) * 8;
          u32x4 w = {cvtpk(o[bl][b8 + 0] * rl, o[bl][b8 + 1] * rl), cvtpk(o[bl][b8 + 2] * rl, o[bl][b8 + 3] * rl), cvtpk(o[bl][b8 + 4] * rl, o[bl][b8 + 5] * rl), cvtpk(o[bl][b8 + 6] * rl, o[bl][b8 + 7] * rl)};
          pb[ks] = *reinterpret_cast<bf16x8*>(&w); }
      const bf16_t* wv = T.WV + ((size_t)(h * 128 + r32) * 128 + hi * 8);
      char* stg = shm + LDS_K + wid * (32 * 272);
      const int srow = lane >> 3, sc8 = (lane & 7) * 8;
#pragma unroll
      for (int half = 0; half < 2; ++half) {
#pragma unroll
          for (int db2 = 0; db2 < 2; ++db2) { const int db = 2 * half + db2; f32x16 oa = f32x16{};
#pragma unroll
              for (int ks = 0; ks < 8; ++ks) { const bf16x8 bw = *reinterpret_cast<const bf16x8*>(wv + (size_t)db * 32 * 128 + ks * 16);
                  oa = __builtin_amdgcn_mfma_f32_32x32x16_bf16(bw, pb[ks], oa, 0, 0, 0); }
#pragma unroll
              for (int g = 0; g < 4; ++g) *reinterpret_cast<pg8::f32x4*>(stg + r32 * 272 + (db2 * 32 + 8 * g + 4 * hi) * 4) = pg8::f32x4{oa[4 * g], oa[4 * g + 1], oa[4 * g + 2], oa[4 * g + 3]}; }
#pragma unroll
          for (int it = 0; it < 4; ++it) { const int row = it * 8 + srow;
              const pg8::f32x4 x0 = *reinterpret_cast<const pg8::f32x4*>(stg + row * 272 + sc8 * 4), x1 = *reinterpret_cast<const pg8::f32x4*>(stg + row * 272 + sc8 * 4 + 16);
              const size_t off = (size_t)(rowbase + q0 + wid * 32 + row) * 1024 + h * 128 + half * 64 + sc8;
              const u32x4 ga = *reinterpret_cast<const u32x4*>(T.GA + off), ob = *reinterpret_cast<const u32x4*>(T.OB + off);
              u32x4 w;
#define MIX2(X, A, B, GW, OW) cvtpk2(X[A] * __uint_as_float((GW) << 16) + __uint_as_float((OW) << 16), X[B] * __uint_as_float((GW) & 0xffff0000u) + __uint_as_float((OW) & 0xffff0000u))
              w[0] = MIX2(x0, 0, 1, ga[0], ob[0]); w[1] = MIX2(x0, 2, 3, ga[1], ob[1]); w[2] = MIX2(x1, 0, 1, ga[2], ob[2]); w[3] = MIX2(x1, 2, 3, ga[3], ob[3]);
#undef MIX2
              *reinterpret_cast<u32x4*>(T.MIX + off) = w; } } }
#else
    if (hi == 0) li_l[r32] = l_reg; asm volatile("s_waitcnt lgkmcnt(0)" ::: "memory");
    ATT_BAR_L();
    { char* stg = shm + LDS_K + wid * OST_WAVE;
#if MLA_OT
#pragma unroll
      for (int r = 0; r < 16; ++r) { const float rl = __builtin_amdgcn_rcpf(l_reg);
#pragma unroll
          for (int d0 = 0; d0 < 4; ++d0) *(bf16_t*)(stg + r32 * OST_PITCH + (d0 * 32 + crow(r, hi)) * 2) = f2bf(o[d0][r] * rl); }
#else
#pragma unroll
      for (int r = 0; r < 16; ++r) { const float rl = __builtin_amdgcn_rcpf(li_l[crow(r, hi)]);
#pragma unroll
          for (int d0 = 0; d0 < 4; ++d0) *(bf16_t*)(stg + crow(r, hi) * OST_PITCH + (d0 * 32 + r32) * 2) = f2bf(o[d0][r] * rl); }
#endif
      asm volatile("s_waitcnt lgkmcnt(0)" ::: "memory");
      bf16x8 af[8];
#pragma unroll
      for (int ks = 0; ks < 8; ++ks) af[ks] = *reinterpret_cast<const bf16x8*>(stg + r32 * OST_PITCH + ks * 32 + hi * 16);
      const bf16_t* wv = T.WV + ((size_t)(h * 128 + r32) * 128 + hi * 8);
#pragma unroll
      for (int d0 = 0; d0 < 4; ++d0) { o[d0] = f32x16{};
#pragma unroll
          for (int ks = 0; ks < 8; ++ks) { const bf16x8 bw = *reinterpret_cast<const bf16x8*>(wv + (size_t)d0 * 32 * 128 + ks * 16);
              o[d0] = __builtin_amdgcn_mfma_f32_32x32x16_bf16(af[ks], bw, o[d0], 0, 0, 0); } } }
    const long orow0 = rowbase + q0 + wid * 32;
#pragma unroll
    for (int r = 0; r < 16; ++r) { const long off = (orow0 + crow(r, hi)) * 1024 + h * 128 + r32;
#pragma unroll
        for (int d0 = 0; d0 < 4; ++d0) { const float v = o[d0][r] * bf2f(T.GA[off + d0 * 32]) + bf2f(T.OB[off + d0 * 32]); T.MIX[off + d0 * 32] = f2bf(v); } }
#endif
    asm volatile("s_waitcnt lgkmcnt(0)\n\ts_barrier" ::: "memory");
#undef MLA_DMA
#undef MLA_RESC
#undef ATT_BAR_L
#undef MLA_STEP
#undef MLA_PV_ISSUE
#undef MLA_PV_MMA
#undef MLA_PV_ONE
#undef MLA_V_BASE
}
}

namespace mla2 {
using mla::NTILE; using mla::KPITCH; using mla::KSLOT; using mla::THR; using mla::OST_PITCH; using mla::OST_WAVE;
constexpr int NSLOT = 3;
constexpr int LDS_K = 0, LDS_P = NSLOT * KSLOT  , LDS_X = LDS_P + 65536  , LDS_BYTES = LDS_X + 4096;
static_assert(8 * OST_WAVE <= NSLOT * KSLOT, "o_lat staging fits the ring");
using mla::Tensors;
__device__ __forceinline__ void softmax_block(f32x16& p0, f32x16& p1, float& m_reg, float& l_reg, float& alpha, bf16x8& pa0, bf16x8& pa1, bf16x8& pa2, bf16x8& pa3) {
    float pm0 = fmaxf(p0[0], p0[1]), pm1 = fmaxf(p0[2], p0[3]), pm2 = fmaxf(p1[0], p1[1]), pm3 = fmaxf(p1[2], p1[3]);
#pragma unroll
    for (int r = 4; r < 16; r += 4) { pm0 = fmaxf(fmaxf(pm0, p0[r]), p0[r + 1]); pm1 = fmaxf(fmaxf(pm1, p0[r + 2]), p0[r + 3]); pm2 = fmaxf(fmaxf(pm2, p1[r]), p1[r + 1]); pm3 = fmaxf(fmaxf(pm3, p1[r + 2]), p1[r + 3]); }
    const float pmax = half_max(fmaxf(fmaxf(pm0, pm1), fmaxf(pm2, pm3)));
    const bool keep = __all(pmax - m_reg <= THR);
    const float mn = keep ? m_reg : fmaxf(m_reg, pmax); alpha = __builtin_amdgcn_exp2f(m_reg - mn); m_reg = mn;
#pragma unroll
    for (int r = 0; r < 16; ++r) { p0[r] = __builtin_amdgcn_exp2f(p0[r] - mn); p1[r] = __builtin_amdgcn_exp2f(p1[r] - mn); }
    float s0 = p0[0] + p0[1], s1 = p0[2] + p0[3], s2 = p1[0] + p1[1], s3 = p1[2] + p1[3];
#pragma unroll
    for (int r = 4; r < 16; r += 4) { s0 += p0[r]; s0 += p0[r + 1]; s1 += p0[r + 2]; s1 += p0[r + 3]; s2 += p1[r]; s2 += p1[r + 1]; s3 += p1[r + 2]; s3 += p1[r + 3]; }
    l_reg = l_reg * alpha + half_sum((s0 + s1) + (s2 + s3));
    pack_p(p0, p1, pa0, pa1, pa2, pa3);
}
__device__ __forceinline__ void out_block(const char* stg, const Tensors& T, int h, long orow0, int r32, int hi) {
    bf16x8 af[8];
#pragma unroll
    for (int ks = 0; ks < 8; ++ks) af[ks] = *reinterpret_cast<const bf16x8*>(stg + r32 * OST_PITCH + ks * 32 + hi * 16);
    const bf16_t* wv = T.WV + ((size_t)(h * 128 + r32) * 128 + hi * 8);
    f32x16 oa[4];
#pragma unroll
    for (int d0 = 0; d0 < 4; ++d0) { oa[d0] = f32x16{};
#pragma unroll
        for (int ks = 0; ks < 8; ++ks) { const bf16x8 bw = *reinterpret_cast<const bf16x8*>(wv + (size_t)d0 * 32 * 128 + ks * 16);
            oa[d0] = __builtin_amdgcn_mfma_f32_32x32x16_bf16(af[ks], bw, oa[d0], 0, 0, 0); } }
#pragma unroll
    for (int r = 0; r < 16; ++r) { const long off = (orow0 + crow(r, hi)) * 1024 + h * 128 + r32;
#pragma unroll
        for (int d0 = 0; d0 < 4; ++d0) { const float v = oa[d0][r] * bf2f(T.GA[off + d0 * 32]) + bf2f(T.OB[off + d0 * 32]); T.MIX[off + d0 * 32] = f2bf(v); } }
}
__device__ __forceinline__ void unit(int b, int h, int qb, const Tensors& T, char* shm, const int wave_id) {
    const int lane = pg8::lane_id_fresh(), wid = wave_id, r32 = lane & 31, hi = lane >> 5;
    const bool is_qk = wid < 4; const int pair = wid & 3;
    const long rowbase = (long)b * SEQ; const int q0 = qb * 256;
    const unsigned lds0 = (unsigned)(uintptr_t)shm;
    char* Pp = shm + LDS_P + pair * 8192; char* Xp = shm + LDS_X + pair * 1024;
    float* alx = (float*)Xp; float* lx = (float*)(Xp + 512); unsigned* fx = (unsigned*)(Xp + 768);
#define M2_BAR() asm volatile("s_waitcnt vmcnt(0) lgkmcnt(0)\n\ts_barrier" ::: "memory")
    const char* klb = (const char*)(T.KL + rowbase * 192);
#define M2_PIECE(kb_, p_, dst_) do { const int s_ = 64 * (p_) + lane, row_ = (s_ * 1311) >> 15, pos_ = s_ - 25 * row_; \
        glds16s<0>(kb_, (unsigned)(row_ * 384 + (pos_ < 24 ? pos_ : 23) * 16), (unsigned)__builtin_amdgcn_readfirstlane(dst_ + (p_) * 1024)); } while (0)
#define M2_DMA(t) do { const unsigned sd_ = lds0 + LDS_K + ((t) % 3) * KSLOT; const char* kb_ = klb + (size_t)(t) * 24576; \
        _Pragma("unroll") for (int i_ = 0; i_ < 6; ++i_) M2_PIECE(kb_, pair + 4 * i_, sd_); if (pair == 0) M2_PIECE(kb_, 24, sd_); } while (0)
    const int vb0 = (int)(lds0 + LDS_K) + mla::v_rm_base(lane);
#define M2_BAR_L() asm volatile("s_waitcnt lgkmcnt(0)\n\ts_barrier" ::: "memory")
    if (is_qk) {
        bf16x8 qA[12], qB[12]; float mA = -1e30f, mB = -1e30f, lA = 0.f, lB = 0.f;
        { const bf16_t* Qw = T.QA + (rowbase + q0 + pair * 64 + r32) * 1536 + h * 192 + hi * 8;
#pragma unroll
          for (int d0 = 0; d0 < 12; ++d0) { qA[d0] = *reinterpret_cast<const bf16x8*>(Qw + d0 * 16); qB[d0] = *reinterpret_cast<const bf16x8*>(Qw + 32 * 1536 + d0 * 16); } }
        f32x16 pA0, pA1, pB0, pB1;
        char* pw = Pp + lane * 16;
#define M2_QK(P0, P1, Q, t) do { P0 = f32x16{}; P1 = f32x16{}; const char* kb_ = shm + LDS_K + ((t) % 3) * KSLOT + hi * 16 + r32 * KPITCH; \
        _Pragma("unroll") for (int d0 = 0; d0 < 12; ++d0) { const bf16x8 b0_ = *reinterpret_cast<const bf16x8*>(kb_ + d0 * 32), b1_ = *reinterpret_cast<const bf16x8*>(kb_ + d0 * 32 + 32 * KPITCH); \
            P0 = __builtin_amdgcn_mfma_f32_32x32x16_bf16(b0_, Q[d0], P0, 0, 0, 0); P1 = __builtin_amdgcn_mfma_f32_32x32x16_bf16(b1_, Q[d0], P1, 0, 0, 0); } } while (0)
#define M2_SM(P0, P1, M, L, BLK) do { bf16x8 a0_, a1_, a2_, a3_; float al_; softmax_block(P0, P1, M, L, al_, a0_, a1_, a2_, a3_); \
        *reinterpret_cast<bf16x8*>(pw + (BLK) * 4096) = a0_; *reinterpret_cast<bf16x8*>(pw + (BLK) * 4096 + 1024) = a1_; *reinterpret_cast<bf16x8*>(pw + (BLK) * 4096 + 2048) = a2_; *reinterpret_cast<bf16x8*>(pw + (BLK) * 4096 + 3072) = a3_; \
        const bool f_ = __any(al_ < 1.f); if (hi == 0) alx[(BLK) * 32 + r32] = al_; if (lane == 0) fx[BLK] = f_ ? 1u : 0u; } while (0)
        M2_BAR();
        M2_QK(pA0, pA1, qA, 0); M2_BAR_L();
        M2_QK(pB0, pB1, qB, 0); M2_SM(pA0, pA1, mA, lA, 0); M2_BAR_L();
        for (int t = 1; t < NTILE; ++t) {
            M2_QK(pA0, pA1, qA, t); M2_SM(pB0, pB1, mB, lB, 1); M2_BAR_L();
            M2_QK(pB0, pB1, qB, t); M2_SM(pA0, pA1, mA, lA, 0); M2_BAR_L();
        }
        M2_SM(pB0, pB1, mB, lB, 1); M2_BAR_L();
        M2_BAR_L();
        if (hi == 0) { lx[r32] = lA; lx[32 + r32] = lB; }
        M2_BAR();
        M2_BAR();
#undef M2_QK
#undef M2_SM
    } else {
        f32x16 oA[4] = {}, oB[4] = {};
        const char* pr = Pp + lane * 16;
#define M2_PVB(O, BLK, t1) do { const int vb_ = vb0 + ((t1) % 3) * KSLOT; \
        const bf16x8 a0_ = *reinterpret_cast<const bf16x8*>(pr + (BLK) * 4096), a1_ = *reinterpret_cast<const bf16x8*>(pr + (BLK) * 4096 + 1024), a2_ = *reinterpret_cast<const bf16x8*>(pr + (BLK) * 4096 + 2048), a3_ = *reinterpret_cast<const bf16x8*>(pr + (BLK) * 4096 + 3072); \
        if (fx[BLK] != 0u) { _Pragma("unroll") for (int d = 0; d < 4; ++d) _Pragma("unroll") for (int r = 0; r < 16; ++r) O[d][r] *= alx[(BLK) * 32 + crow(r, hi)]; } \
        mla::pvr_one<0>(O[0], vb_, a0_, a1_, a2_, a3_); mla::pvr_one<1>(O[1], vb_, a0_, a1_, a2_, a3_); mla::pvr_one<2>(O[2], vb_, a0_, a1_, a2_, a3_); mla::pvr_one<3>(O[3], vb_, a0_, a1_, a2_, a3_); } while (0)
        M2_DMA(0);
        M2_BAR();
        M2_DMA(1); M2_BAR_L();
        M2_BAR();
        for (int t = 1; t < NTILE; ++t) {
            if (t + 1 < NTILE) M2_DMA(t + 1);
            M2_PVB(oA, 0, t - 1); M2_BAR_L();
            M2_PVB(oB, 1, t - 1); M2_BAR();
        }
        M2_PVB(oA, 0, NTILE - 1); M2_BAR_L();
        M2_PVB(oB, 1, NTILE - 1); M2_BAR_L();
#undef M2_PVB
        M2_BAR();
        { char* stgA = shm + LDS_K + (2 * pair) * OST_WAVE; char* stgB = stgA + OST_WAVE;
#pragma unroll
          for (int r = 0; r < 16; ++r) { const float ra = __builtin_amdgcn_rcpf(lx[crow(r, hi)]), rb = __builtin_amdgcn_rcpf(lx[32 + crow(r, hi)]);
#pragma unroll
              for (int d0 = 0; d0 < 4; ++d0) { *(bf16_t*)(stgA + crow(r, hi) * OST_PITCH + (d0 * 32 + r32) * 2) = f2bf(oA[d0][r] * ra); *(bf16_t*)(stgB + crow(r, hi) * OST_PITCH + (d0 * 32 + r32) * 2) = f2bf(oB[d0][r] * rb); } } }
        M2_BAR();
    }
#undef M2_BAR_L
    { const char* stg = shm + LDS_K + (2 * pair + (is_qk ? 1 : 0)) * OST_WAVE;
      out_block(stg, T, h, rowbase + q0 + pair * 64 + (is_qk ? 32 : 0), r32, hi); }
    asm volatile("s_waitcnt lgkmcnt(0)\n\ts_barrier" ::: "memory");
#undef M2_BAR
#undef M2_PIECE
#undef M2_DMA
}
}

namespace swa {
constexpr int KP = 144  , KT = 64 * KP  ;
constexpr int LDS_K = 0;
struct Tensors { const bf16_t* QB; const bf16_t* KB; const bf16_t* VB; bf16_t* GOB; const float* BT2; const float* SINK2; };
__device__ __forceinline__ int vt_base64(int lane) { return ((lane & 3) << 3) | (((lane >> 2) & 3) << 6) | (((lane >> 4) & 1) << 5) | ((lane >> 5) << 10); }
template <int D0> __device__ __forceinline__ void pvt64(f32x16& od, int vb, bf16x8 pa0, bf16x8 pa1, bf16x8 pa2, bf16x8 pa3) {
    const s16x4 l0 = tr_read<D0 * 512 + 0 * 2048>(vb), h0 = tr_read<D0 * 512 + 0 * 2048 + 256>(vb), l1 = tr_read<D0 * 512 + 1 * 2048>(vb), h1 = tr_read<D0 * 512 + 1 * 2048 + 256>(vb);
    const s16x4 l2 = tr_read<D0 * 512 + 2 * 2048>(vb), h2 = tr_read<D0 * 512 + 2 * 2048 + 256>(vb), l3 = tr_read<D0 * 512 + 3 * 2048>(vb), h3 = tr_read<D0 * 512 + 3 * 2048 + 256>(vb);
    asm volatile("s_waitcnt lgkmcnt(0)" ::: "memory"); SBAR();
#define PK(L, H) (bf16x8){L[0], L[1], L[2], L[3], H[0], H[1], H[2], H[3]}
    od = __builtin_amdgcn_mfma_f32_32x32x16_bf16(PK(l0, h0), pa0, od, 0, 0, 0);
    od = __builtin_amdgcn_mfma_f32_32x32x16_bf16(PK(l1, h1), pa1, od, 0, 0, 0);
    od = __builtin_amdgcn_mfma_f32_32x32x16_bf16(PK(l2, h2), pa2, od, 0, 0, 0);
    od = __builtin_amdgcn_mfma_f32_32x32x16_bf16(PK(l3, h3), pa3, od, 0, 0, 0);
#undef PK
}
constexpr int NQB = 8, RING = 6;
constexpr int LDS_V = RING * KT, LDS_TAB = LDS_V + RING * 8192, LDS_BYTES = LDS_TAB + 4 * 4 * 384 * 4;
constexpr float THR = 8.f;
typedef float f32x8_t __attribute__((ext_vector_type(8)));
__device__ __forceinline__ f32x16 cat4(pg8::f32x4 a, pg8::f32x4 b, pg8::f32x4 c, pg8::f32x4 e) {
    const f32x8_t lo = __builtin_shufflevector(a, b, 0, 1, 2, 3, 4, 5, 6, 7), hi = __builtin_shufflevector(c, e, 0, 1, 2, 3, 4, 5, 6, 7);
    return __builtin_shufflevector(lo, hi, 0, 1, 2, 3, 4, 5, 6, 7, 8, 9, 10, 11, 12, 13, 14, 15); }
__device__ __forceinline__ void bias_init(f32x16& n0, f32x16& n1, const float* tb) { const pg8::f32x4* q = reinterpret_cast<const pg8::f32x4*>(tb);
    n0 = cat4(q[0], q[2], q[4], q[6]); n1 = cat4(q[8], q[10], q[12], q[14]); }
__device__ __forceinline__ void qk_acc(f32x16& n0, f32x16& n1, const char* Ks, const bf16x8* qr, int r32, int hi) {
    const char* kb = Ks + hi * 16 + r32 * KP;
#pragma unroll
    for (int d0 = 0; d0 < 4; ++d0) { const bf16x8 b0 = *reinterpret_cast<const bf16x8*>(kb + d0 * 32), b1 = *reinterpret_cast<const bf16x8*>(kb + d0 * 32 + 32 * KP);
        n0 = __builtin_amdgcn_mfma_f32_32x32x16_bf16(b0, qr[d0], n0, 0, 0, 0); n1 = __builtin_amdgcn_mfma_f32_32x32x16_bf16(b1, qr[d0], n1, 0, 0, 0); }
}
#ifdef TP_SWA
#define SWA_TSARG , unsigned long long (&ts)[6]
#else
#define SWA_TSARG
#endif
__device__ __forceinline__ void run(int b, int kvh, int j, const Tensors& T, char* shm, const int wave_id SWA_TSARG) {
    const int lane = pg8::lane_id_fresh(), wid = wave_id, tid = wid * 64 + lane, r32 = lane & 31, hi = lane >> 5;
    const int g = wid >> 1, rh = wid & 1, head = kvh * 4 + g;
    const long rowbase = (long)b * SEQ; const int qb0 = j * NQB;
    const unsigned lds0 = (unsigned)(uintptr_t)shm;
    unsigned vvoff, kvoff, kvoff8;
    { const int st = 2 * wid + (lane >> 5), kk = (st >> 1) * 8 + ((lane & 31) >> 2), k = swap23(kk), c = (st & 1) * 32 + (lane & 3) * 8;
      vvoff = (unsigned)((k * 256 + c) * 2);
      int s = 64 * wid + lane, row = s / 9, pos = s - 9 * row; kvoff = (unsigned)(row * 512 + (pos < 8 ? pos : 7) * 16); s = 512 + lane; row = s / 9; pos = s - 9 * row; kvoff8 = (unsigned)(row * 512 + (pos < 8 ? pos : 7) * 16); }
#define SWA_DMA(TT) do { const int s_ = (TT) % RING; const long kb_ = rowbase + 64 * (TT); \
        glds16s<0>((const char*)(T.KB + kb_ * 256 + kvh * 64), kvoff, (unsigned)__builtin_amdgcn_readfirstlane(lds0 + LDS_K + s_ * KT + wid * 1024)); \
        if (wid == 0) glds16s<0>((const char*)(T.KB + kb_ * 256 + kvh * 64), kvoff8, (unsigned)__builtin_amdgcn_readfirstlane(lds0 + LDS_K + s_ * KT + 8192)); \
        glds16s<0>((const char*)(T.VB + kb_ * 256 + kvh * 64), vvoff, (unsigned)__builtin_amdgcn_readfirstlane(lds0 + LDS_V + s_ * 8192 + wid * 1024)); } while (0)
#ifdef TP_SWA
#define SWA_TS(slot) do { ts[slot] = __builtin_amdgcn_s_memrealtime(); } while (0)
#else
#define SWA_TS(slot) do { } while (0)
#endif
    SWA_TS(0);
    for (int TT = qb0 - 2; TT <= qb0 + 2; ++TT) if (TT >= 0 && TT < SEQ / 64) SWA_DMA(TT);
    { float* tab = (float*)(shm + LDS_TAB); float tv[12];
#pragma unroll
      for (int x = 0; x < 12; ++x) { const int i = tid + 512 * x, gg = i / 1536, rel = i % 384 + ((i / 384) & 3) - 192; const int rc = rel < -128 ? -128 : (rel > 128 ? 128 : rel);
          tv[x] = T.BT2[(kvh * 4 + gg) * 264 + rc + 128]; }
#pragma unroll
      for (int x = 0; x < 12; ++x) { const int i = tid + 512 * x, rel = i % 384 + ((i / 384) & 3) - 192; tab[i] = (rel >= -128 && rel <= 128) ? tv[x] : -1e30f; } }
    bf16x8 qr[4];
    const bf16_t* Qw = T.QB + (rowbase + qb0 * 64 + rh * 32 + r32) * 1024 + head * 64 + hi * 8;
#pragma unroll
    for (int d0 = 0; d0 < 4; ++d0) qr[d0] = *reinterpret_cast<const bf16x8*>(Qw + d0 * 16);
    const float sink = T.SINK2[head];
    const int vb0 = (int)(lds0 + LDS_V) + vt_base64(lane);
    const float* tbl;
    { const int base = 64 - 32 * rh - r32 + 4 * hi, s = base & 3; tbl = (const float*)(shm + LDS_TAB) + (g * 4 + s) * 384 + (base - s); }
    ATT_WAIT_BAR(0);
    SWA_TS(1);
    for (int i = 0; i < NQB; ++i) {
        const int qb = qb0 + i;
        if (i == 4) SWA_TS(2);
        if (i + 1 < NQB && qb + 3 < SEQ / 64) SWA_DMA(qb + 3);
        bf16x8 qn[4];
        if (i + 1 < NQB) {
#pragma unroll
            for (int d0 = 0; d0 < 4; ++d0) qn[d0] = *reinterpret_cast<const bf16x8*>(Qw + (size_t)(i + 1) * 64 * 1024 + d0 * 16); }
        else {
#pragma unroll
            for (int d0 = 0; d0 < 4; ++d0) qn[d0] = qr[d0]; }
        bf16_t* orow = T.GOB + (size_t)(rowbase + qb * 64 + rh * 32 + r32) * 1024 + head * 64 + 4 * hi;
        pg8::u32x2 gt[8];
#pragma unroll
        for (int x = 0; x < 8; ++x) gt[x] = *reinterpret_cast<const pg8::u32x2*>(orow + (x >> 2) * 32 + 8 * (x & 3));
        float m_reg = sink, l_reg = 1.0f; f32x16 o[2] = {};
        const int t_lo = qb < 2 ? 2 - qb : 0, nt = (qb + 2 >= SEQ / 64 ? SEQ / 64 + 2 - qb : 5) - t_lo;
        f32x16 sa0, sa1, sb0, sb1;
        bias_init(sa0, sa1, tbl + 64 * t_lo); qk_acc(sa0, sa1, shm + LDS_K + ((qb - 2 + t_lo) % RING) * KT, qr, r32, hi);
#define SWA_TILE(C0, C1, N0, N1, k, HASN) do { const int t_ = t_lo + (k), sl_ = (qb - 2 + t_) % RING; const bool hasn_ = (HASN); \
            if (hasn_) bias_init(N0, N1, tbl + 64 * (t_ + 1)); \
            float pmax; { float a = max3f(C0[0], C0[1], C0[2]), b2 = max3f(C0[9], C0[10], C0[11]), c = max3f(C1[0], C1[1], C1[2]), e = max3f(C1[9], C1[10], C1[11]); \
              a = max3f(a, C0[3], C0[4]); b2 = max3f(b2, C0[12], C0[13]); c = max3f(c, C1[3], C1[4]); e = max3f(e, C1[12], C1[13]); \
              a = max3f(a, C0[5], C0[6]); b2 = max3f(b2, C0[14], C0[15]); c = max3f(c, C1[5], C1[6]); e = max3f(e, C1[14], C1[15]); \
              a = max3f(a, C0[7], C0[8]); c = max3f(c, C1[7], C1[8]); pmax = max3f(a, b2, c); pmax = max3f(pmax, e, e); \
              auto rr = __builtin_amdgcn_permlane32_swap(__float_as_uint(pmax), __float_as_uint(pmax), false, false); pmax = max3f(__uint_as_float(rr[0]), __uint_as_float(rr[1]), __uint_as_float(rr[1])); } \
            asm volatile("" : "+v"(pmax)); SBAR(); \
            if (hasn_) qk_acc(N0, N1, shm + LDS_K + ((qb - 1 + t_) % RING) * KT, qr, r32, hi); \
            SBAR(); \
            if (!__builtin_expect(__all(pmax - m_reg <= THR), 1)) { const float mn = fmaxf(m_reg, pmax), alpha = __builtin_amdgcn_exp2f(m_reg - mn); m_reg = mn; l_reg *= alpha; \
                _Pragma("unroll") for (int d_ = 0; d_ < 2; ++d_) _Pragma("unroll") for (int r_ = 0; r_ < 16; ++r_) o[d_][r_] *= alpha; } \
            bf16x8 pa0, pa1, pa2, pa3; \
            { float s0, s1, s2, s3; \
              _Pragma("unroll") for (int r_ = 0; r_ < 16; ++r_) { C0[r_] = __builtin_amdgcn_exp2f(C0[r_] - m_reg); C1[r_] = __builtin_amdgcn_exp2f(C1[r_] - m_reg); } \
              s0 = C0[0] + C0[1]; s1 = C0[2] + C0[3]; s2 = C1[0] + C1[1]; s3 = C1[2] + C1[3]; \
              _Pragma("unroll") for (int r_ = 4; r_ < 16; r_ += 4) { s0 += C0[r_]; s0 += C0[r_ + 1]; s1 += C0[r_ + 2]; s1 += C0[r_ + 3]; s2 += C1[r_]; s2 += C1[r_ + 1]; s3 += C1[r_ + 2]; s3 += C1[r_ + 3]; } \
              l_reg += half_sum((s0 + s1) + (s2 + s3)); } \
            { u32x4 w0 = SWA_PK(C0, 0), w1 = SWA_PK(C0, 8), w2 = SWA_PK(C1, 0), w3 = SWA_PK(C1, 8); \
              pa0 = *reinterpret_cast<bf16x8*>(&w0); pa1 = *reinterpret_cast<bf16x8*>(&w1); pa2 = *reinterpret_cast<bf16x8*>(&w2); pa3 = *reinterpret_cast<bf16x8*>(&w3); } \
            asm volatile("" : "+v"(pa0), "+v"(pa1), "+v"(pa2), "+v"(pa3), "+v"(l_reg)); SBAR(); \
            pvt64<0>(o[0], vb0 + sl_ * 8192, pa0, pa1, pa2, pa3); pvt64<1>(o[1], vb0 + sl_ * 8192, pa0, pa1, pa2, pa3); } while (0)
#define SWA_PK(P, B) (u32x4){cvtpk2(P[B], P[B + 1]), cvtpk2(P[B + 2], P[B + 3]), cvtpk2(P[B + 4], P[B + 5]), cvtpk2(P[B + 6], P[B + 7])}
        SWA_TILE(sa0, sa1, sb0, sb1, 0, true);
        SWA_TILE(sb0, sb1, sa0, sa1, 1, true);
        SWA_TILE(sa0, sa1, sb0, sb1, 2, nt > 3);
        if (nt > 3) { SWA_TILE(sb0, sb1, sa0, sa1, 3, nt > 4);
            if (nt > 4) SWA_TILE(sa0, sa1, sb0, sb1, 4, false); }
#undef SWA_PK
#undef SWA_TILE
        if (i == 4) SWA_TS(3);
        { const float rl = __builtin_amdgcn_rcpf(l_reg);
#pragma unroll
          for (int x = 0; x < 8; ++x) { const int d0 = x >> 2, gq = x & 3;
              const float v0 = o[d0][4 * gq + 0] * rl * __uint_as_float(gt[x].x << 16), v1 = o[d0][4 * gq + 1] * rl * __uint_as_float(gt[x].x & 0xffff0000u);
              const float v2 = o[d0][4 * gq + 2] * rl * __uint_as_float(gt[x].y << 16), v3 = o[d0][4 * gq + 3] * rl * __uint_as_float(gt[x].y & 0xffff0000u);
              pg8::u32x2 w; w.x = cvtpk(v0, v1); w.y = cvtpk(v2, v3); *reinterpret_cast<pg8::u32x2*>(orow + d0 * 32 + 8 * gq) = w; } }
#pragma unroll
        for (int d0 = 0; d0 < 4; ++d0) qr[d0] = qn[d0];
        asm volatile("s_waitcnt vmcnt(8) lgkmcnt(0)\n\ts_barrier" ::: "memory");
        if (i == 4) SWA_TS(4);
    }
    SWA_TS(5);
#undef SWA_DMA
#undef SWA_TS
}
}
#undef SBAR
#undef ATT_WAIT_BAR
}
constexpr int NWAVES = 8;
#ifndef MK_PER_PHASE
#define MK_PER_PHASE 0
#endif
constexpr int N_PHASES = 8;

constexpr size_t MiB = 1u << 20;
constexpr size_t WS_CTL = 0, CTL_ZERO_BYTES = 128 * 1024;
constexpr size_t WS_COS = 1 * MiB, WS_SIN = WS_COS + 512 * 1024;
constexpr size_t WS_BT2 = 2 * MiB, WS_SINK2 = WS_BT2 + 16 * 264 * 4;
constexpr size_t WS_SSQQ = 3 * MiB, WS_SSQKV = WS_SSQQ + 512 * 1024;
constexpr size_t WS_SSQ2 = 4 * MiB, WS_SSQ3 = 6 * MiB;
constexpr size_t WS_WIN = 8 * MiB, WS_WQB = 16 * MiB, WS_WVT = 17 * MiB, WS_WOUT = 18 * MiB, WS_WUP = 20 * MiB, WS_WDN = 31 * MiB;
constexpr size_t WS_A0 = 40 * MiB;
constexpr size_t WS_XN = WS_A0;
constexpr size_t WS_X1B = WS_A0;
constexpr size_t WS_QLAT = 104 * MiB, WS_KL = 120 * MiB  , WS_QB = 132 * MiB, WS_KB = 196 * MiB, WS_VB = 212 * MiB, WS_GA = 228 * MiB, WS_GB = 292 * MiB;
constexpr size_t WS_MIX = WS_QB;
constexpr size_t WS_HALO = 104 * MiB;
constexpr size_t WS_ACT = 296 * MiB;
constexpr size_t WS_END = 472 * MiB;
static_assert(WS_ACT + (size_t)MTOK * DFF * 2 <= WS_END && WS_HALO + (size_t)(MTOK / 64) * 4 * 5632 * 4 <= WS_ACT && WS_KL + (size_t)MTOK * 192 * 2 <= WS_QB, "d_ws map");
constexpr int CW_BAR = 4096;
static_assert((CW_BAR + 3456) * 4 <= 65536, "barrier words below the panel counters");
constexpr int CW_PANEL = 16384;

constexpr int RING_OFF = 0, RING_BYTES = 146432;
constexpr int LDSCTL_OFF = RING_BYTES, MISC_OFF = LDSCTL_OFF + 320;
constexpr int LDS_BYTES = 147456;
static_assert(att::mla::LDS_BYTES <= RING_BYTES && att::mla2::LDS_BYTES <= RING_BYTES && att::swa::LDS_BYTES <= RING_BYTES && pg8::STAGE_BYTES <= RING_BYTES && MISC_OFF + 64 <= LDS_BYTES, "LDS map");

#define GAS __attribute__((address_space(1)))
#define LAS __attribute__((address_space(3)))
typedef unsigned short bf16;
typedef unsigned v4u __attribute__((ext_vector_type(4)));
typedef float f32x4 __attribute__((ext_vector_type(4)));
typedef short bf16x8 __attribute__((ext_vector_type(8)));
typedef GAS unsigned gu32;
typedef GAS unsigned long long gu64;
#define RLX_AGENT __ATOMIC_RELAXED, __HIP_MEMORY_SCOPE_AGENT
#define LDS_WAIT() asm volatile("s_waitcnt lgkmcnt(0)" ::: "memory")
#define VM_WAIT() asm volatile("s_waitcnt vmcnt(0)" ::: "memory")
__device__ __forceinline__ unsigned long long rt() { return __builtin_amdgcn_s_memrealtime(); }
__device__ __forceinline__ unsigned f2bf(float f) { unsigned u = __builtin_bit_cast(unsigned, f); return (u + 0x7fffu + ((u >> 16) & 1u)) >> 16; }
__device__ __forceinline__ unsigned pk2(float lo, float hi) { return f2bf(lo) | (f2bf(hi) << 16); }

#define XB_TMO      128
#define XB_XCNT(j)  (256  + 64 * (j))
#define XB_XSUB(j)  (1280 + 64 * (j))
#define XB_XGEN(j)  (2304 + 64 * (j))
#define XB_TOP      3328
#define XB_TOPGEN   3392
#define XCD_BAR_WORDS 3456
#define XB_SPIN_CAP (1u << 18)

__device__ __forceinline__ unsigned xb_ld(unsigned* p)              { return __hip_atomic_load(p, __ATOMIC_RELAXED, __HIP_MEMORY_SCOPE_AGENT); }
__device__ __forceinline__ unsigned xb_add(unsigned* p, unsigned v) { return __hip_atomic_fetch_add(p, v, __ATOMIC_RELAXED, __HIP_MEMORY_SCOPE_AGENT); }
__device__ __forceinline__ unsigned xb_xcc_id() { return (unsigned)__builtin_amdgcn_s_getreg((3 << 11) | 20) & 0xFu; }
#define XB_SPIN(cond, bar) do { unsigned _sp = 0; while (cond) { __builtin_amdgcn_s_sleep(1); \
    if ((++_sp & 255u) == 0u) { if (xb_ld(&(bar)[XB_TMO])) break; if (_sp > XB_SPIN_CAP) { atomicAdd(&(bar)[XB_TMO], 1u); break; } } } } while (0)

struct XcdBarrier {
    unsigned* bar; unsigned x; int w;
    volatile LAS unsigned* st;
};

__device__ __forceinline__ XcdBarrier xcd_barrier_post(unsigned* bar, volatile LAS unsigned* st) {
    XcdBarrier b; b.bar = bar; b.x = xb_xcc_id(); b.st = st;
    if (threadIdx.x == 0) (void)xb_add(&bar[XB_XCNT(b.x)], 1u);
    return b;
}
__device__ __forceinline__ void xcd_barrier_complete(unsigned* bar, unsigned x, unsigned& nloc, unsigned& nx) {
    const unsigned G = gridDim.x * gridDim.y * gridDim.z;
    unsigned sum, cnt, mine, sp = 0u;
    for (;;) {
        sum = 0u; cnt = 0u; mine = 0u;
#pragma unroll
        for (unsigned j = 0; j < 16; ++j) { const unsigned c = xb_ld(&bar[XB_XCNT(j)]); sum += c; cnt += (c > 0u) ? 1u : 0u; mine = (j == x) ? c : mine; }
        if (sum == G) break;
        __builtin_amdgcn_s_sleep(1);
        if ((++sp & 255u) == 0u) { if (xb_ld(&bar[XB_TMO])) break; if (sp > XB_SPIN_CAP) { atomicAdd(&bar[XB_TMO], 1u); break; } }
    }
    nloc = mine > 0u ? mine : 1u; nx = cnt > 0u ? cnt : 1u;
}

__device__ __forceinline__ void xcd_barrier(const XcdBarrier& b) {
    asm volatile("s_waitcnt vmcnt(0)" ::: "memory");
    __syncthreads();
    if (b.w == 0 && pg8::lane_id_fresh() == 0) {
        unsigned* bar = b.bar;
        __builtin_amdgcn_s_waitcnt(0);
        unsigned nloc = b.st[0], nx = b.st[1];
        if (nloc == 0u) { xcd_barrier_complete(bar, b.x, nloc, nx); b.st[0] = nloc; b.st[1] = nx; }
        const unsigned old = xb_add(&bar[XB_XSUB(b.x)], 1u);
        const unsigned gen = old / nloc;
        if (old + 1u == (gen + 1u) * nloc) {
            __builtin_amdgcn_fence(__ATOMIC_RELEASE, "agent");
            asm volatile("s_waitcnt vmcnt(0)" ::: "memory");
            const unsigned og = xb_add(&bar[XB_TOP], 1u);
            const unsigned tg = og / nx;
            if (og + 1u == (tg + 1u) * nx) xb_add(&bar[XB_TOPGEN], 1u);
            else XB_SPIN(xb_ld(&bar[XB_TOPGEN]) == tg, bar);
            __builtin_amdgcn_fence(__ATOMIC_ACQUIRE, "agent");
            xb_add(&bar[XB_XGEN(b.x)], 1u);
            asm volatile("s_waitcnt vmcnt(0)" ::: "memory");
        } else {
            XB_SPIN(xb_ld(&bar[XB_XGEN(b.x)]) == gen, bar);
            __builtin_amdgcn_fence(__ATOMIC_ACQUIRE, "agent");
            asm volatile("s_waitcnt vmcnt(0)" ::: "memory");
        }
    }
    __syncthreads();
}

struct Frame {
    LAS unsigned char* lds; volatile LAS unsigned* MISC; gu32* ctl;
    int wave, vcu, G;
};
__device__ __forceinline__ float wave_sum(float v) {
#pragma unroll
    for (int o = 1; o < 64; o <<= 1) v += __shfl_xor(v, o);
    return v;
}
template <class RowMap>
__device__ __forceinline__ void p0_transpose_item(const float* W, int K, int N, bf16* WT, const float* kscale, const RowMap& rm, LAS float* scr, int item, int lane) {
    const int nblk = N / 32, kb = item / nblk, nb = item % nblk, k0 = 64 * kb, n0 = 32 * nb;
    float tv[32];
#pragma unroll
    for (int i = 0; i < 32; ++i) { const int kk = 2 * i + (lane >> 5); tv[i] = W[(size_t)(k0 + kk) * N + n0 + (lane & 31)]; }
#pragma unroll
    for (int i = 0; i < 32; ++i) { const int kk = 2 * i + (lane >> 5); const float sc = kscale ? kscale[k0 + kk] : 1.0f; scr[kk * 33 + (lane & 31)] = tv[i] * sc; }
    LDS_WAIT(); asm volatile("" ::: "memory");
    const int c = lane & 7;
#pragma unroll
    for (int j = 0; j < 4; ++j) { const int n = (lane >> 3) + 8 * j; const LAS float* s = scr + (8 * c) * 33 + n;
        v4u o; o.x = pk2(s[0 * 33], s[1 * 33]); o.y = pk2(s[2 * 33], s[3 * 33]); o.z = pk2(s[4 * 33], s[5 * 33]); o.w = pk2(s[6 * 33], s[7 * 33]);
        const int rr = rm(n0 + n); if (rr >= 0) *(GAS v4u*)(WT + (size_t)rr * K + k0 + 8 * c) = o; }
    LDS_WAIT(); asm volatile("" ::: "memory");
}
struct MapIdent { __device__ __forceinline__ int operator()(int n) const { return n; } };
struct MapWin { __device__ __forceinline__ int operator()(int n) const {
    if (n < 256) return n; if (n >= 448) return n + 64; const int j = n - 256; if (j < 128) return 256 + j; const int d = j - 128; return 384 + (d < 32 ? 2 * d : 2 * (d - 32) + 1); } };
struct MapWqb { __device__ __forceinline__ int operator()(int n) const {
    const int h = n / 192, d = n % 192; if (d < 128) return -1  ; const int r = d - 128; return 1024 + h * 64 + (r < 32 ? 2 * r : 2 * (r - 32) + 1); } };
struct MapWup { __device__ __forceinline__ int operator()(int n) const {
    const int v = n >= DFF, c = v ? n - DFF : n; return 256 * (c >> 7) + 128 * v + (c & 127); } };

__device__ __forceinline__ int t5_bucket(int rel) {
    const int n = rel < 0 ? -rel : rel; int bk;
    if (n < 8) bk = n; else { const int e = (31 - __builtin_clz((unsigned)(n * n))) - 6; bk = 8 + e; if (bk > 15) bk = 15; }
    return (rel > 0 ? 16 : 0) + bk;
}
#ifndef MLA_SPLIT
#define MLA_SPLIT 0
#endif
struct Args {
    const float* x; const int* positions; const float* norm1_g; const float* w_in; const float* q_a_norm_g; const float* w_q_b; const float* kv_a_norm_g; const float* w_kv_b;
    const float* rel_bias; const float* sinks; const float* w_out; const float* norm2_g; const float* w_up; const float* conv_w; const float* conv_b; const float* w_down; const float* final_norm_g;
    float* out; unsigned char* ws; int ph_lo, ph_hi;
};

__device__ __forceinline__ void p0_prologue(Frame& F, const Args& a) {
    unsigned char* ws = a.ws;
    LAS float* scr = (LAS float*)(F.lds + RING_OFF + F.wave * 16384);
    const int lane = pg8::lane_id_fresh();
    const int gw = F.vcu * NWAVES + F.wave, NGW = F.G * NWAVES;
    constexpr int I_IN = (1024 / 64) * (4032 / 32), I_QB = (256 / 64) * (1536 / 32), I_OUT = (1024 / 64) * (1024 / 32), I_UP = (1024 / 64) * (5632 / 32), I_DN = (DFF / 64) * (1024 / 32);
    constexpr int NITEMS = I_IN + I_QB + I_OUT + I_UP + I_DN;
#ifndef P0DUP
#define P0DUP 0
#endif
    for (int rp_ = 0; rp_ <= (P0DUP & 1); ++rp_)
    for (int it = gw; it < NITEMS; it += NGW) {
        int r = it;
        if (r < I_IN) { p0_transpose_item(a.w_in, 1024, 4032, (bf16*)(ws + WS_WIN), nullptr, MapWin(), scr, r, lane); continue; } r -= I_IN;
        if (r < I_QB) { p0_transpose_item(a.w_q_b, 256, 1536, (bf16*)(ws + WS_WQB), a.q_a_norm_g, MapWqb(), scr, r, lane); continue; } r -= I_QB;
        if (r < I_OUT) { p0_transpose_item(a.w_out, 1024, 1024, (bf16*)(ws + WS_WOUT), nullptr, MapIdent(), scr, r, lane); continue; } r -= I_OUT;
        if (r < I_UP) { p0_transpose_item(a.w_up, 1024, 5632, (bf16*)(ws + WS_WUP), a.norm2_g, MapWup(), scr, r, lane); continue; } r -= I_UP;
        p0_transpose_item(a.w_down, DFF, 1024, (bf16*)(ws + WS_WDN), nullptr, MapIdent(), scr, r, lane);
    }
    const int gt = gw * 64 + lane, NGT = NGW * 64;
    for (int rp_ = 0; rp_ <= ((P0DUP >> 2) & 1); ++rp_)
    if (F.wave == 0) for (int blk = F.vcu; blk < 256; blk += F.G) { const int hh = blk >> 5, cb = (blk >> 3) & 3, jb = blk & 7, r32 = lane & 31, hi = lane >> 5;
        const f32x4* qp = (const f32x4*)(a.w_q_b + (size_t)(jb * 32 + r32) * 1536 + hh * 192) + hi; const f32x4* kp = (const f32x4*)(a.w_kv_b + (size_t)(cb * 32 + r32) * 2048 + hh * 256) + hi;
        att::f32x16 acc = {};
#pragma unroll 8
        for (int s = 0; s < 16; ++s) { const f32x4 x = qp[2 * s], y = kp[2 * s];
            acc = __builtin_amdgcn_mfma_f32_32x32x2f32(x[0], y[0], acc, 0, 0, 0); acc = __builtin_amdgcn_mfma_f32_32x32x2f32(x[1], y[1], acc, 0, 0, 0);
            acc = __builtin_amdgcn_mfma_f32_32x32x2f32(x[2], y[2], acc, 0, 0, 0); acc = __builtin_amdgcn_mfma_f32_32x32x2f32(x[3], y[3], acc, 0, 0, 0); }
        const float gk = a.kv_a_norm_g[cb * 32 + r32];
        bf16* dst = (bf16*)(ws + WS_WQB) + (size_t)(hh * 128 + cb * 32 + r32) * 256 + jb * 32 + 4 * hi;
#pragma unroll
        for (int g = 0; g < 4; ++g) { const f32x4 gq = *(const f32x4*)(a.q_a_norm_g + jb * 32 + 8 * g + 4 * hi);
            *(GAS unsigned long long*)(dst + 8 * g) = (unsigned long long)pk2(acc[4 * g] * gq[0] * gk, acc[4 * g + 1] * gq[1] * gk) | ((unsigned long long)pk2(acc[4 * g + 2] * gq[2] * gk, acc[4 * g + 3] * gq[3] * gk) << 32); } }
    for (int i = gt; i < 8 * 128 * 128; i += NGT) { const int hh = i >> 14, dd = (i >> 7) & 127, cp = i & 127, c = MLA_OT ? ((cp & ~0xC) | ((cp & 4) << 1) | ((cp & 8) >> 1)) : cp;
        ((bf16*)(ws + WS_WVT))[i] = (bf16)f2bf(a.w_kv_b[(size_t)c * 2048 + hh * 256 + 128 + dd] * a.kv_a_norm_g[c]); }
    for (int i = gt; i < 64 * 1024 / 8; i += NGT) *(GAS v4u*)((bf16*)(ws + WS_WIN) + (size_t)448 * 1024 + (size_t)i * 8) = (v4u){0u, 0u, 0u, 0u};
    for (int rp_ = 0; rp_ <= ((P0DUP >> 3) & 1); ++rp_)
    for (int i = gt; i < SEQ * 32; i += NGT) { const int s = i >> 5, d = i & 31;
        const float invf = __builtin_amdgcn_exp2f(-(float)d * (13.287712379549449f / 32.0f));
        const float ang = (float)a.positions[s] * invf;
        const double rev = (double)ang * 0.15915494309189535; const float fr = (float)(rev - __builtin_rint(rev));
        ((float*)(ws + WS_COS))[i] = __builtin_amdgcn_cosf(fr); ((float*)(ws + WS_SIN))[i] = __builtin_amdgcn_sinf(fr); }
    for (int i = gt; i < 16 * 264; i += NGT) { const int h = i / 264, j = i % 264; float v = 0.f; if (j <= 256) v = a.rel_bias[t5_bucket(j - 128) * 16 + h] * LOG2E; ((float*)(ws + WS_BT2))[i] = v; }
    if (gt < 16) ((float*)(ws + WS_SINK2))[gt] = a.sinks[gt] * LOG2E;
    for (int rp_ = 0; rp_ <= ((P0DUP >> 1) & 1); ++rp_)
    for (int m = gw; m < MTOK; m += 2 * NGW) {
        const GAS f32x4* xr = (const GAS f32x4*)(a.x + (size_t)m * DM) + lane; const GAS f32x4* xr2 = xr + (size_t)NGW * (DM / 4); const GAS f32x4* gr = (const GAS f32x4*)a.norm1_g + lane;
        f32x4 v[4], u[4]; float s = 0.f, s2 = 0.f;
#pragma unroll
        for (int j = 0; j < 4; ++j) { v[j] = xr[64 * j]; u[j] = xr2[64 * j]; }
#pragma unroll
        for (int j = 0; j < 4; ++j) { s += (v[j].x * v[j].x + v[j].y * v[j].y) + (v[j].z * v[j].z + v[j].w * v[j].w); s2 += (u[j].x * u[j].x + u[j].y * u[j].y) + (u[j].z * u[j].z + u[j].w * u[j].w); }
        const float rs = 1.0f / sqrtf(wave_sum(s) * (1.0f / DM) + RMS_EPS), rs2 = 1.0f / sqrtf(wave_sum(s2) * (1.0f / DM) + RMS_EPS);
        GAS unsigned long long* o8 = (GAS unsigned long long*)((bf16*)(ws + WS_XN) + (size_t)m * DM) + lane; GAS unsigned long long* o82 = o8 + (size_t)NGW * (DM / 4);
#pragma unroll
        for (int j = 0; j < 4; ++j) { const f32x4 g = gr[64 * j];
            o8[64 * j] = (unsigned long long)pk2(v[j].x * rs * g.x, v[j].y * rs * g.y) | ((unsigned long long)pk2(v[j].z * rs * g.z, v[j].w * rs * g.w) << 32);
            o82[64 * j] = (unsigned long long)pk2(u[j].x * rs2 * g.x, u[j].y * rs2 * g.y) | ((unsigned long long)pk2(u[j].z * rs2 * g.z, u[j].w * rs2 * g.w) << 32); }
    }
}

__device__ __forceinline__ void p6_fixup(Frame& F, const Args& a) {
    const int lane = pg8::lane_id_fresh();
    const int gw = F.vcu * NWAVES + F.wave, NGW = F.G * NWAVES;
    const float* halo = (const float*)(a.ws + WS_HALO); bf16* ACT = (bf16*)(a.ws + WS_ACT);
    constexpr int NBLK = MTOK / 64, HROW = 2 * DFF, HBLK = 4 * HROW;
    for (int it = gw; it < NBLK * 2 * 11; it += NGW) {
        const int cg = it % 11, which = (it / 11) & 1, blk = it / 22;
        const int c = cg * 256 + lane * 4, cu = 256 * (c >> 7) + (c & 127);
        const int r = 64 * blk + (which ? 63 : 0);
        const float* hp = halo + (size_t)blk * HBLK + (2 + which) * HROW + cu;
        f32x4 G = *(const f32x4*)hp, V = *(const f32x4*)(hp + 128);
        const bool has = which ? (((r + 1) & (SEQ - 1)) != 0) : ((r & (SEQ - 1)) != 0);
        if (has) { const float* np = halo + (size_t)(which ? blk + 1 : blk - 1) * HBLK + (which ? 0 : 1) * HROW + cu;
            const f32x4 rg = *(const f32x4*)np, rv = *(const f32x4*)(np + 128);
            const f32x4 wg = *(const f32x4*)(a.conv_w + (which ? 4 : 0) * DFF + c), wv = *(const f32x4*)(a.conv_w + (which ? 5 : 1) * DFF + c);
            G = G + wg * rg; V = V + wv * rv; }
        f32x4 o;
#pragma unroll
        for (int e = 0; e < 4; ++e) o[e] = G[e] * pg8::fast_sigmoid(G[e]) * V[e];
        pg8::st4((pg8::bf16_t*)(ACT + (size_t)r * DFF + c), o);
    }
}

__device__ __forceinline__ void p8_final_norm(Frame& F, const Args& a) {
    const int gw = F.vcu * NWAVES + F.wave, NGW = F.G * NWAVES;
    const int lane = pg8::lane_id_fresh();
    const float* ssq = (const float*)(a.ws + WS_SSQ3);
    for (int m = gw; m < MTOK; m += NGW) {
        const f32x4* sp = (const f32x4*)(ssq + (size_t)m * 16); const f32x4 t = (sp[0] + sp[1]) + (sp[2] + sp[3]);
        const float rs = 1.0f / sqrtf(((t[0] + t[1]) + (t[2] + t[3])) * (1.0f / DM) + RMS_EPS);
        GAS f32x4* xr = (GAS f32x4*)(a.out + (size_t)m * DM) + lane; const GAS f32x4* gr = (const GAS f32x4*)a.final_norm_g + lane;
#pragma unroll
        for (int j = 0; j < 4; ++j) { const f32x4 v = xr[64 * j], g = gr[64 * j]; xr[64 * j] = v * rs * g; }
    }
}

__global__ void __launch_bounds__(NWAVES * 64, 2) enc_fwd(Args args) {
    extern __shared__ __attribute__((aligned(16))) unsigned char lds[];
    Frame F;
    F.lds = (LAS unsigned char*)lds; F.MISC = (volatile LAS unsigned*)(F.lds + MISC_OFF);
    F.wave = __builtin_amdgcn_readfirstlane(threadIdx.x >> 6);
    F.G = gridDim.x; { const int bx = blockIdx.x; F.vcu = (F.G % 8 == 0) ? (bx % 8) * (F.G / 8) + bx / 8 : bx; }
    unsigned char* ws = args.ws;
    F.ctl = (gu32*)(ws + WS_CTL);
    for (int u = threadIdx.x; u < (LDS_BYTES - LDSCTL_OFF) / 4; u += NWAVES * 64) ((LAS unsigned*)(F.lds + LDSCTL_OFF))[u] = 0u;
    __syncthreads();
    XcdBarrier bar; bar.bar = (unsigned*)(F.ctl + CW_BAR); bar.x = 0; bar.st = nullptr;
    if (!MK_PER_PHASE) bar = xcd_barrier_post((unsigned*)(F.ctl + CW_BAR), F.MISC + 8);
    bar.w = F.wave;
    const int lo = args.ph_lo, hi = args.ph_hi;
#ifndef PHMASK
#define PHMASK 0xff
#endif
#define IN(k) (((PHMASK >> (k)) & 1) && lo <= (k) && (k) < hi)
#ifndef DUPMASK
#define DUPMASK 0
#endif
#define REP(k) for (int rep_ = 0; rep_ <= ((DUPMASK >> (k)) & 1); ++rep_)
#define SEAM(k) do { if (IN(k) && IN((k) + 1)) xcd_barrier(bar); } while (0)
    bf16* const WIN = (bf16*)(ws + WS_WIN); bf16* const WQB = (bf16*)(ws + WS_WQB); bf16* const WOUT = (bf16*)(ws + WS_WOUT);
    bf16* const WUP = (bf16*)(ws + WS_WUP); bf16* const WDN = (bf16*)(ws + WS_WDN);
    const float* const COS = (const float*)(ws + WS_COS); const float* const SIN = (const float*)(ws + WS_SIN);
    bf16* const QA = (bf16*)args.out;

#ifdef TP_PHASE
    unsigned long long tp_r0 = 0, tp_r1 = 0, tp_c0 = 0, tp_c1 = 0;
#ifndef TP_END
#define TP_END (TP_PHASE + 1)
#endif
#ifdef TP_SWA
#define TP_MARK(k)
#else
#define TP_MARK(k) do { if ((k) == TP_PHASE) { tp_r0 = __builtin_amdgcn_s_memrealtime(); tp_c0 = __builtin_amdgcn_s_memtime(); } if ((k) == TP_END) { tp_r1 = __builtin_amdgcn_s_memrealtime(); tp_c1 = __builtin_amdgcn_s_memtime(); } } while (0)
#endif
#else
#define TP_MARK(k)
#endif
#ifdef TP_SWA
    unsigned long long tp_ts[6] = {};
#define TP_TSPASS , tp_ts
#else
#define TP_TSPASS
#endif
    TP_MARK(0);
    if (IN(0)) REP(0) { p0_prologue(F, args); } SEAM(0);
    TP_MARK(1);

    if (IN(1)) REP(1) {
        pg8::Gemm g{(bf16*)(ws + WS_XN), WIN, MTOK, 4096, 1024}; pg8::StaticOrder S; S.init(MTOK, 4096, F.G, (int)blockIdx.x);
        pg8::EpiInProj E{(bf16*)(ws + WS_QLAT), (bf16*)(ws + WS_KL), (bf16*)(ws + WS_QB), (bf16*)(ws + WS_KB), (bf16*)(ws + WS_VB), (bf16*)(ws + WS_GA), (bf16*)(ws + WS_GB),
                         (float*)(ws + WS_SSQQ), (float*)(ws + WS_SSQKV), COS, SIN};
        pg8::gemm_phase<pg8::EpiInProj, pg8::StaticOrder, PG8_ALIGN, PG8_SP2>(F.lds + RING_OFF, g, S, E, F.wave);
    } SEAM(1);

    TP_MARK(2);
    if (IN(2)) REP(2) {
#ifndef P2SUB
#define P2SUB 7
#endif
#ifndef P2DUPG
#define P2DUPG 0
#endif
        for (int rg_ = 0; rg_ <= P2DUPG; ++rg_) {
        if (P2SUB & 1) { pg8::Gemm g{(bf16*)(ws + WS_QLAT), WQB, MTOK, 1536, 256}; pg8::StaticOrder S; S.init(MTOK, 1536, F.G, (int)blockIdx.x);
          pg8::EpiQProj E{QA, (const float*)(ws + WS_SSQQ), COS, SIN};
          pg8::gemm_phase<pg8::EpiQProj, pg8::StaticOrder, PG8_ALIGN, PG8_SP2>(F.lds + RING_OFF, g, S, E, F.wave); }
        }
        TP_MARK(20);
        if (P2SUB & 4) { const att::swa::Tensors T{(const bf16*)(ws + WS_QB), (const bf16*)(ws + WS_KB), (const bf16*)(ws + WS_VB), (bf16*)(ws + WS_GB), (const float*)(ws + WS_BT2), (const float*)(ws + WS_SINK2)};
          for (int u = F.vcu; u < NBATCH * 4 * (SEQ / 64 / att::swa::NQB); u += F.G) { const int j = u % (SEQ / 64 / att::swa::NQB), bk = u / (SEQ / 64 / att::swa::NQB); att::swa::run(bk >> 2, bk & 3, j, T, (char*)lds + RING_OFF, F.wave TP_TSPASS); } }
#ifdef TP_SWA
        tp_r0 = tp_ts[TP_A]; tp_r1 = tp_ts[TP_B];
#endif
    } SEAM(2);

    TP_MARK(3);
    if (IN(3)) REP(3) {
        const att::mla::Tensors T{QA, (const bf16*)(ws + WS_KL), (const bf16*)(ws + WS_WVT), (const bf16*)(ws + WS_GA), (const bf16*)(ws + WS_GB), (bf16*)(ws + WS_MIX)};
        for (int u = F.vcu; u < NBATCH * 8 * (SEQ / 256); u += F.G) { const int qb = u & 15, bh = u >> 4;
#if MLA_SPLIT
            att::mla2::unit(bh >> 3, bh & 7, qb, T, (char*)lds + RING_OFF, F.wave);
#else
            att::mla::unit(bh >> 3, bh & 7, qb, T, (char*)lds + RING_OFF, F.wave);
#endif
        }
    } SEAM(3);

    TP_MARK(4);
    if (IN(4)) REP(4) {
        pg8::Gemm g{(bf16*)(ws + WS_MIX), WOUT, MTOK, 1024, 1024}; pg8::StaticOrder S; S.init(MTOK, 1024, F.G, (int)blockIdx.x);
        pg8::EpiResidual E{args.x, nullptr, (bf16*)(ws + WS_X1B), (float*)(ws + WS_SSQ2)};
        pg8::gemm_phase<pg8::EpiResidual, pg8::StaticOrder, PG8_ALIGN, PG8_SP2>(F.lds + RING_OFF, g, S, E, F.wave);
    } SEAM(4);

    TP_MARK(5);
    if (IN(5)) REP(5) {
        pg8::Gemm g{(bf16*)(ws + WS_X1B), WUP, MTOK, 2 * DFF, 1024}; pg8::StaticOrder S; S.init(MTOK, 2 * DFF, F.G, (int)blockIdx.x);
        pg8::EpiUpConv E{(bf16*)(ws + WS_ACT), (float*)(ws + WS_HALO), (const float*)(ws + WS_SSQ2), args.conv_w, args.conv_b};
        pg8::gemm_phase<pg8::EpiUpConv, pg8::StaticOrder, PG8_ALIGN, PG8_SP2>(F.lds + RING_OFF, g, S, E, F.wave);
    } SEAM(5);
    TP_MARK(6);
    if (IN(6)) REP(6) { p6_fixup(F, args); } SEAM(6);

    TP_MARK(7);
    if (IN(7)) REP(7) {
        pg8::Gemm g{(bf16*)(ws + WS_ACT), WDN, MTOK, 1024, DFF}; pg8::StaticOrder S; S.init(MTOK, 1024, F.G, (int)blockIdx.x);
        pg8::EpiFinal E{(const bf16*)(ws + WS_X1B), args.out, (float*)(ws + WS_SSQ3), (unsigned*)(F.ctl + CW_PANEL), args.final_norm_g};
        pg8::gemm_phase<pg8::EpiFinal, pg8::StaticOrder, PG8_ALIGN, PG8_SP2>(F.lds + RING_OFF, g, S, E, F.wave);
    }
#ifdef TP_PHASE
    TP_MARK(8);
#ifndef TP_CLK
#define TP_CLK 0
#endif
#ifndef TP_GAIN
#define TP_GAIN 4
#endif
    if (blockIdx.x == 0 && F.wave == 0) {
        const unsigned long long dr = tp_r1 - tp_r0, dc = tp_c1 - tp_c0;
        const unsigned long long ticks = (TP_CLK ? dc * 100ull / dr : dr) * (unsigned long long)TP_GAIN;
        const unsigned long long t0 = __builtin_amdgcn_s_memrealtime();
        while (__builtin_amdgcn_s_memrealtime() - t0 < ticks) __builtin_amdgcn_s_sleep(8); }
#endif
#undef IN
#undef SEAM
}

extern "C" void kernel_launch(void* const* d_in, const int* in_sizes, int n_in, void* d_out, int out_size, void* d_ws, size_t ws_size, hipStream_t stream) {
    static int grid = 0;
    if (grid == 0) {
        if (n_in != 17 || in_sizes[0] != MTOK * DM || out_size != MTOK * DM || ws_size < WS_END) { fprintf(stderr, "kernel_launch: unexpected shapes (n_in %d, in0 %d, out %d, ws %zu; need ws >= %zu); nothing launched\n", n_in, n_in > 0 ? in_sizes[0] : -1, out_size, ws_size, (size_t)WS_END); grid = -1; return; }
        int dev = 0, cus = 0, per_cu = 0;
        if (hipGetDevice(&dev) != hipSuccess || hipDeviceGetAttribute(&cus, hipDeviceAttributeMultiprocessorCount, dev) != hipSuccess) { fprintf(stderr, "kernel_launch: device query failed\n"); grid = -1; return; }
        if (hipFuncSetAttribute((const void*)enc_fwd, hipFuncAttributeMaxDynamicSharedMemorySize, LDS_BYTES) != hipSuccess) { fprintf(stderr, "kernel_launch: hipFuncSetAttribute failed\n"); grid = -1; return; }
        if (hipOccupancyMaxActiveBlocksPerMultiprocessor(&per_cu, (const void*)enc_fwd, NWAVES * 64, LDS_BYTES) != hipSuccess || per_cu < 1) { fprintf(stderr, "kernel_launch: occupancy query reports %d workgroups per CU\n", per_cu); }
        (void)hipGetLastError();
        grid = cus;
    }
    if (grid < 0) return;
    if (hipMemsetAsync((char*)d_ws + WS_CTL, 0, CTL_ZERO_BYTES, stream) != hipSuccess) { fprintf(stderr, "kernel_launch: hipMemsetAsync failed\n"); return; }
    Args a{};
    a.x = (const float*)d_in[0]; a.positions = (const int*)d_in[1]; a.norm1_g = (const float*)d_in[2]; a.w_in = (const float*)d_in[3]; a.q_a_norm_g = (const float*)d_in[4]; a.w_q_b = (const float*)d_in[5];
    a.kv_a_norm_g = (const float*)d_in[6]; a.w_kv_b = (const float*)d_in[7]; a.rel_bias = (const float*)d_in[8]; a.sinks = (const float*)d_in[9]; a.w_out = (const float*)d_in[10]; a.norm2_g = (const float*)d_in[11];
    a.w_up = (const float*)d_in[12]; a.conv_w = (const float*)d_in[13]; a.conv_b = (const float*)d_in[14]; a.w_down = (const float*)d_in[15]; a.final_norm_g = (const float*)d_in[16];
    a.out = (float*)d_out; a.ws = (unsigned char*)d_ws;
#if MK_PER_PHASE
    for (int p = 0; p < N_PHASES; ++p) { a.ph_lo = p; a.ph_hi = p + 1; hipLaunchKernelGGL(enc_fwd, dim3(grid), dim3(NWAVES * 64), LDS_BYTES, stream, a); }
#else
    a.ph_lo = 0; a.ph_hi = N_PHASES; hipLaunchKernelGGL(enc_fwd, dim3(grid), dim3(NWAVES * 64), LDS_BYTES, stream, a);
#endif
    const hipError_t le = hipPeekAtLastError();
    if (le != hipSuccess) fprintf(stderr, "kernel_launch: launch failed: %s (grid %d)\n", hipGetErrorName(le), grid);
}
```

```cpp
#include <hip/hip_runtime.h>
#include <cstdio>
#include <cstdint>
namespace pg8 {
#define PG8_LAS __attribute__((address_space(3)))
typedef unsigned short bf16_t;
typedef short bf16x8 __attribute__((ext_vector_type(8)));
typedef float f32x4 __attribute__((ext_vector_type(4)));
typedef unsigned u32x4 __attribute__((ext_vector_type(4)));
constexpr int BM = 256, BK = 64, HALF = 128, HTB = HALF * BK * 2  , STAGE_BYTES = 8 * HTB, NXCD = 8, WGM = 8;

__host__ __device__ __forceinline__ int lds_byte(int r, int c) { const int st = (r >> 4) * 2 + (c >> 5), rr = r & 15, cc = c & 31, ob = rr * 64 + cc * 2; return st * 1024 + (ob ^ (((ob >> 9) & 1) << 5)); }
__host__ __device__ __forceinline__ void stage_rc(int b, int& R, int& C) { const int st = b / 1024, sb = b % 1024, swz = sb ^ (((sb >> 9) & 1) << 5); R = (st >> 1) * 16 + swz / 64; C = (st & 1) * 32 + (swz % 64) / 2; }
__host__ __device__ __forceinline__ int perm32(int rho) { const int n = rho >> 4, i = rho & 15; return 8 * (i >> 2) + 4 * n + (i & 3); }

struct Unit { int pm, pn; };
struct Gemm { const bf16_t* A; const bf16_t* Bt; int M, N, K; };

struct StaticOrder {
    int nM, nN, nwg, G, c;
    __host__ __device__ void init(int M, int N, int G_, int c_) { nM = M / BM; nN = N / BM; nwg = nM * nN; G = G_; c = c_; }
    __host__ __device__ bool next(int i, Unit& u) const {
        const long L = (long)i * G + c; if (L >= nwg) return false;
        int wgid = (int)L; { const int q = nwg / NXCD, r = nwg % NXCD, xcd = wgid % NXCD, off = wgid / NXCD; wgid = (xcd < r ? xcd * (q + 1) : r * (q + 1) + (xcd - r) * q) + off; }
        const int nig = WGM * nN, gid = wgid / nig, fm = gid * WGM, gsz = (nM - fm) < WGM ? (nM - fm) : WGM;
        u.pm = fm + ((wgid % nig) % gsz); u.pn = (wgid % nig) / gsz; return true;
    }
    __device__ __forceinline__ void a_ready(const Unit&) const {}
    __device__ __forceinline__ void done(const Unit&) const {}
};

__device__ __forceinline__ unsigned cvt_pk_bf16(float lo, float hi) { unsigned r; asm volatile("v_cvt_pk_bf16_f32 %0, %1, %2" : "=v"(r) : "v"(lo), "v"(hi)); return r; }
constexpr int SEQ = 4096, NBATCH = 8, MTOK = NBATCH * SEQ, DM = 1024;
constexpr int DFF = 2816;
constexpr float RMS_EPS = 1e-6f;
constexpr float LOG2E = 1.4426950408889634f;
constexpr float C_MLA = 0.07216878364870322f * LOG2E;
constexpr float C_SWA = 0.125f * LOG2E;

typedef unsigned u32x2 __attribute__((ext_vector_type(2)));
__device__ __forceinline__ int lane_id_fresh() { int l; asm volatile("v_mbcnt_lo_u32_b32 %0, -1, 0\n\tv_mbcnt_hi_u32_b32 %0, -1, %0" : "=v"(l)); return l; }
__device__ __forceinline__ float fast_sigmoid(float v) { return __builtin_amdgcn_rcpf(1.0f + __builtin_amdgcn_exp2f(-LOG2E * v)); }
__device__ __forceinline__ void st8(bf16_t* p, f32x4 v0, f32x4 v1) {
    u32x4 w; w.x = cvt_pk_bf16(v0[0], v0[1]); w.y = cvt_pk_bf16(v0[2], v0[3]); w.z = cvt_pk_bf16(v1[0], v1[1]); w.w = cvt_pk_bf16(v1[2], v1[3]); *(u32x4*)p = w; }
__device__ __forceinline__ void st4(bf16_t* p, f32x4 v) { u32x2 w; w.x = cvt_pk_bf16(v[0], v[1]); w.y = cvt_pk_bf16(v[2], v[3]); *(u32x2*)p = w; }
__device__ __forceinline__ float sq4(f32x4 x) { return (x[0] * x[0] + x[1] * x[1]) + (x[2] * x[2] + x[3] * x[3]); }
__device__ __forceinline__ float fq_sum(float s) { s += __shfl_xor(s, 16); s += __shfl_xor(s, 32); return s; }

__device__ __forceinline__ void rope_store(bf16_t* dst  , int d, int srow, const float* cosT, const float* sinT, f32x4 a, f32x4 b, float sc) {
    const f32x4 c4 = *(const f32x4*)(cosT + srow * 32 + d), s4 = *(const f32x4*)(sinT + srow * 32 + d);
    const f32x4 x1 = {a[0] * sc, a[2] * sc, b[0] * sc, b[2] * sc}, x2 = {a[1] * sc, a[3] * sc, b[1] * sc, b[3] * sc};
    st4(dst + d, x1 * c4 - x2 * s4); st4(dst + 32 + d, x2 * c4 + x1 * s4);
}

struct EpiInProj {
    static constexpr bool PERM = true, AFTER_DRAIN = false;
    bf16_t *qlat, *kl, *qb, *kb, *vb, *ga, *gb; float *ssq_q, *ssq_kv; const float *cosT, *sinT;
    __device__ __forceinline__ void operator()(f32x4 (&acc)[2][2][4][2], const Unit& u, int wr, int wc, int fr, int fq) const {
        { const int l_ = lane_id_fresh(); fr = l_ & 15; fq = l_ >> 4; }
        const int pn = u.pn, row0 = u.pm * BM + wr * 64 + fr, cw = wc * 32 + 8 * fq;
        if (pn == 0) {
#pragma unroll
            for (int ai = 0; ai < 2; ++ai)
#pragma unroll
                for (int m = 0; m < 4; ++m) { const int row = row0 + ai * HALF + m * 16;
                    float s = (sq4(acc[ai][0][m][0]) + sq4(acc[ai][0][m][1])) + (sq4(acc[ai][1][m][0]) + sq4(acc[ai][1][m][1]));
                    s = fq_sum(s); if (fq == 0) ssq_q[(size_t)row * 4 + wc] = s;
                    st8(qlat + (size_t)row * 256 + cw, acc[ai][0][m][0], acc[ai][0][m][1]); st8(qlat + (size_t)row * 256 + HALF + cw, acc[ai][1][m][0], acc[ai][1][m][1]);
                    asm volatile("" ::: "memory"); }
        } else if (pn == 1) {
#pragma unroll
            for (int ai = 0; ai < 2; ++ai)
#pragma unroll
                for (int m = 0; m < 4; ++m) { const int row = row0 + ai * HALF + m * 16;
                    float s = sq4(acc[ai][0][m][0]) + sq4(acc[ai][0][m][1]);
                    s = fq_sum(s); if (fq == 0) __hip_atomic_store(ssq_kv + (unsigned)row * 4 + wc, s, __ATOMIC_RELAXED, __HIP_MEMORY_SCOPE_AGENT); }
            asm volatile("s_waitcnt vmcnt(0)" ::: "memory");
            __builtin_amdgcn_s_barrier(); asm volatile("" ::: "memory");
#pragma unroll
            for (int ai = 0; ai < 2; ++ai)
#pragma unroll
                for (int m = 0; m < 4; ++m) { const int row = row0 + ai * HALF + m * 16; const float* sp = ssq_kv + (unsigned)row * 4;
                    const float t = (__hip_atomic_load(sp, __ATOMIC_RELAXED, __HIP_MEMORY_SCOPE_AGENT) + __hip_atomic_load(sp + 1, __ATOMIC_RELAXED, __HIP_MEMORY_SCOPE_AGENT))
                                  + (__hip_atomic_load(sp + 2, __ATOMIC_RELAXED, __HIP_MEMORY_SCOPE_AGENT) + __hip_atomic_load(sp + 3, __ATOMIC_RELAXED, __HIP_MEMORY_SCOPE_AGENT));
                    const float rs = __builtin_amdgcn_rsqf(t * (1.0f / 128.0f) + RMS_EPS);
                    bf16_t* krow = kl + (size_t)row * 192;
                    st8(krow + cw, acc[ai][0][m][0] * rs, acc[ai][0][m][1] * rs);
                    if (wc < 2) rope_store(krow + 128, 16 * wc + 4 * fq, row & (SEQ - 1), cosT, sinT, acc[ai][1][m][0], acc[ai][1][m][1], 1.0f);
                    if (m == 1 || m == 3) asm volatile("" ::: "memory"); }
        } else {
            bf16_t* base; int ld, col0; float sc = 1.0f; bool sig = false;
            if (pn < 6) { base = qb; ld = 1024; col0 = (pn - 2) * 256; sc = C_SWA; }
            else if (pn == 6) { base = kb; ld = 256; col0 = 0; }
            else if (pn == 7) { base = vb; ld = 256; col0 = 0; }
            else if (pn < 12) { base = ga; ld = 1024; col0 = (pn - 8) * 256; sig = true; }
            else { base = gb; ld = 1024; col0 = (pn - 12) * 256; sig = true; }
            bf16_t* rowp = base + (size_t)row0 * ld + col0 + cw; const size_t rstep = (size_t)16 * ld;
#pragma unroll
            for (int ai = 0; ai < 2; ++ai)
#pragma unroll
                for (int m = 0; m < 4; ++m) { bf16_t* rp = rowp + (size_t)(ai * 8 + m) * rstep;
#pragma unroll
                    for (int bj = 0; bj < 2; ++bj) { f32x4 v0 = acc[ai][bj][m][0], v1 = acc[ai][bj][m][1];
                        if (sig) {
#pragma unroll
                            for (int e = 0; e < 4; ++e) { v0[e] = fast_sigmoid(v0[e]); v1[e] = fast_sigmoid(v1[e]); } }
                        else { v0 = v0 * sc; v1 = v1 * sc; }
                        st8(rp + bj * HALF, v0, v1); }
                    asm volatile("" ::: "memory"); }
        }
    }
};

struct EpiQProj {
    static constexpr bool PERM = true, AFTER_DRAIN = false;
    bf16_t* qa; const float* ssq; const float *cosT, *sinT;
    __device__ __forceinline__ void operator()(f32x4 (&acc)[2][2][4][2], const Unit& u, int wr, int wc, int fr, int fq) const {
        { const int l_ = lane_id_fresh(); fr = l_ & 15; fq = l_ >> 4; }
        const int pn = u.pn, row0 = u.pm * BM + wr * 64 + fr, cw = wc * 32 + 8 * fq;
        f32x4 sv[2][4];
#pragma unroll
        for (int ai = 0; ai < 2; ++ai)
#pragma unroll
            for (int m = 0; m < 4; ++m) sv[ai][m] = *(const f32x4*)(ssq + (unsigned)(row0 + ai * HALF + m * 16) * 4);
        asm volatile("" ::: "memory");
#pragma unroll
        for (int ai = 0; ai < 2; ++ai)
#pragma unroll
            for (int m = 0; m < 4; ++m) { const int row = row0 + ai * HALF + m * 16;
                const f32x4 s4 = sv[ai][m];
                const float rs = C_MLA * __builtin_amdgcn_rsqf(((s4[0] + s4[1]) + (s4[2] + s4[3])) * (1.0f / 256.0f) + RMS_EPS);
                bf16_t* qrow = qa + (size_t)row * 1536;
                if (pn < 4) {
#pragma unroll
                    for (int bj = 0; bj < 2; ++bj) st8(qrow + (2 * pn + bj) * 192 + cw, acc[ai][bj][m][0] * rs, acc[ai][bj][m][1] * rs);
                } else {
#pragma unroll
                    for (int bj = 0; bj < 2; ++bj) { const int head = 4 * (pn - 4) + 2 * bj + (wc >> 1);
                        rope_store(qrow + head * 192 + 128, 16 * (wc & 1) + 4 * fq, row & (SEQ - 1), cosT, sinT, acc[ai][bj][m][0], acc[ai][bj][m][1], rs); }
                }
                if (m == 1 || m == 3) asm volatile("" ::: "memory");
            }
    }
};

struct EpiResidual {
    static constexpr bool PERM = true, AFTER_DRAIN = false;
    const float* base; float* y; bf16_t* yb; float* ssq;
    __device__ __forceinline__ void operator()(f32x4 (&acc)[2][2][4][2], const Unit& u, int wr, int wc, int fr, int fq) const {
        { const int l_ = lane_id_fresh(); fr = l_ & 15; fq = l_ >> 4; }
        const int pn = u.pn, row0 = u.pm * BM + wr * 64 + fr, cw = wc * 32 + 8 * fq;
        const unsigned off0 = (unsigned)row0 * DM + pn * 256 + cw;
#pragma unroll
        for (int ai = 0; ai < 2; ++ai) {
            f32x4 xv[4][2][2];
#pragma unroll
            for (int m = 0; m < 4; ++m)
#pragma unroll
                for (int bj = 0; bj < 2; ++bj) { const unsigned off = off0 + (unsigned)((ai * HALF + m * 16) * DM + bj * HALF);
                    xv[m][bj][0] = *(const f32x4*)(base + off); xv[m][bj][1] = *(const f32x4*)(base + off + 4); }
            asm volatile("" ::: "memory");
#pragma unroll
            for (int m = 0; m < 4; ++m) { const int row = row0 + ai * HALF + m * 16; float s = 0.f;
#pragma unroll
                for (int bj = 0; bj < 2; ++bj) { const unsigned off = off0 + (unsigned)((ai * HALF + m * 16) * DM + bj * HALF);
                    const f32x4 v0 = xv[m][bj][0] + acc[ai][bj][m][0], v1 = xv[m][bj][1] + acc[ai][bj][m][1];
                    if (y) { *(f32x4*)(y + off) = v0; *(f32x4*)(y + off + 4) = v1; } if (yb) st8(yb + off, v0, v1);
                    s += sq4(v0) + sq4(v1); }
                s = fq_sum(s); if (fq == 0) ssq[(unsigned)row * 16 + pn * 4 + wc] = s; }
            asm volatile("" ::: "memory");
        }
    }
};

struct EpiUp {
    static constexpr bool PERM = true, AFTER_DRAIN = false;
    bf16_t* U; int ldu; const float* ssq;
    __device__ __forceinline__ void operator()(f32x4 (&acc)[2][2][4][2], const Unit& u, int wr, int wc, int fr, int fq) const {
        { const int l_ = lane_id_fresh(); fr = l_ & 15; fq = l_ >> 4; }
        const int pn = u.pn, row0 = u.pm * BM + wr * 64 + fr, cw = wc * 32 + 8 * fq;
#pragma unroll
        for (int ai = 0; ai < 2; ++ai)
#pragma unroll
            for (int m = 0; m < 4; ++m) { const int row = row0 + ai * HALF + m * 16;
                const f32x4* sp = (const f32x4*)(ssq + (size_t)row * 16); const f32x4 t = (sp[0] + sp[1]) + (sp[2] + sp[3]);
                const float rs = __builtin_amdgcn_rsqf(((t[0] + t[1]) + (t[2] + t[3])) * (1.0f / 1024.0f) + RMS_EPS);
#pragma unroll
                for (int bj = 0; bj < 2; ++bj) st8(U + (size_t)row * ldu + pn * 256 + bj * HALF + cw, acc[ai][bj][m][0] * rs, acc[ai][bj][m][1] * rs);
                asm volatile("" ::: "memory"); }
    }
};

__device__ __forceinline__ float dpp_prev(float x) { return __int_as_float(__builtin_amdgcn_update_dpp(__float_as_int(x), __float_as_int(x), 0x121, 0xf, 0xf, true)); }
__device__ __forceinline__ float dpp_next(float x) { return __int_as_float(__builtin_amdgcn_update_dpp(__float_as_int(x), __float_as_int(x), 0x12f, 0xf, 0xf, true)); }
struct EpiUpConv {
    static constexpr bool PERM = true, AFTER_DRAIN = false;
    bf16_t* act; float* halo; const float* ssq; const float* conv_w; const float* conv_b;
    __device__ __forceinline__ void operator()(f32x4 (&acc)[2][2][4][2], const Unit& u, int wr, int wc, int fr, int fq) const {
        { const int l_ = lane_id_fresh(); fr = l_ & 15; fq = l_ >> 4; }
        const int pn = u.pn, row0 = u.pm * BM + wr * 64 + fr, cw = wc * 32 + 8 * fq;
        { f32x4 tv[2][4];
#pragma unroll
        for (int ai = 0; ai < 2; ++ai)
#pragma unroll
            for (int m = 0; m < 4; ++m) tv[ai][m] = *(const f32x4*)(ssq + (unsigned)(row0 + ai * HALF + m * 16) * 16 + 4 * fq);
        asm volatile("" ::: "memory");
#pragma unroll
        for (int ai = 0; ai < 2; ++ai)
#pragma unroll
            for (int m = 0; m < 4; ++m) { const f32x4 t = tv[ai][m];
                const float rs = __builtin_amdgcn_rsqf(fq_sum((t[0] + t[1]) + (t[2] + t[3])) * (1.0f / 1024.0f) + RMS_EPS);
#pragma unroll
                for (int bj = 0; bj < 2; ++bj) { acc[ai][bj][m][0] = acc[ai][bj][m][0] * rs; acc[ai][bj][m][1] = acc[ai][bj][m][1] * rs; }
                if (m == 1 || m == 3) __builtin_amdgcn_sched_barrier(0); } }
        const bool first = fr == 0, last = fr == 15;
        u32x2 pk[2][4];
#pragma unroll
        for (int n = 0; n < 2; ++n) {
            const int c = pn * 128 + cw + 4 * n;
            const f32x4 wg0 = *(const f32x4*)(conv_w + c), wg1 = *(const f32x4*)(conv_w + 2 * DFF + c), wg2 = *(const f32x4*)(conv_w + 4 * DFF + c), bg = *(const f32x4*)(conv_b + c);
            const f32x4 wv0 = *(const f32x4*)(conv_w + DFF + c), wv1 = *(const f32x4*)(conv_w + 3 * DFF + c), wv2 = *(const f32x4*)(conv_w + 5 * DFF + c), bv = *(const f32x4*)(conv_b + DFF + c);
#pragma unroll
            for (int ai = 0; ai < 2; ++ai) {
                float* hb = halo + (unsigned)((4 * u.pm + 2 * ai + wr) * (4 * 2 * DFF) + pn * 256 + cw + 4 * n);
                f32x4 Apg = {0.f, 0.f, 0.f, 0.f}, Apv = Apg, Bcg, Bcv;
#pragma unroll
                for (int e = 0; e < 4; ++e) { Bcg[e] = dpp_next(acc[ai][0][0][n][e]); Bcv[e] = dpp_next(acc[ai][1][0][n][e]); }
#pragma unroll
                for (int m = 0; m < 4; ++m) { const int row = row0 + ai * HALF + m * 16;
                    const f32x4 ug = acc[ai][0][m][n], uv = acc[ai][1][m][n]; f32x4 G, V, Acg, Acv, Bng = {0.f, 0.f, 0.f, 0.f}, Bnv = Bng;
#pragma unroll
                    for (int e = 0; e < 4; ++e) { Acg[e] = dpp_prev(ug[e]); Acv[e] = dpp_prev(uv[e]);
                        if (m < 3) { Bng[e] = dpp_next(acc[ai][0][m < 3 ? m + 1 : 3][n][e]); Bnv[e] = dpp_next(acc[ai][1][m < 3 ? m + 1 : 3][n][e]); }
                        const float pg = first ? Apg[e] : Acg[e], pv = first ? Apv[e] : Acv[e], ng = last ? Bng[e] : Bcg[e], nv = last ? Bnv[e] : Bcv[e];
                        G[e] = wg0[e] * pg + wg1[e] * ug[e] + wg2[e] * ng + bg[e]; V[e] = wv0[e] * pv + wv1[e] * uv[e] + wv2[e] * nv + bv[e]; }
                    Apg = Acg; Apv = Acv; Bcg = Bng; Bcv = Bnv;
                    bool edge = false;
                    if (m == 0) { if (first) { edge = true; *(f32x4*)(hb) = ug; *(f32x4*)(hb + 128) = uv; *(f32x4*)(hb + 2 * 2 * DFF) = G; *(f32x4*)(hb + 2 * 2 * DFF + 128) = V; } }
                    if (m == 3) { if (last) { edge = true; *(f32x4*)(hb + 2 * DFF) = ug; *(f32x4*)(hb + 2 * DFF + 128) = uv; *(f32x4*)(hb + 3 * 2 * DFF) = G; *(f32x4*)(hb + 3 * 2 * DFF + 128) = V; } }
                    f32x4 o;
#pragma unroll
                    for (int e = 0; e < 4; ++e) o[e] = G[e] * fast_sigmoid(G[e]) * V[e];
                    u32x2 w; w.x = cvt_pk_bf16(o[0], o[1]); w.y = cvt_pk_bf16(o[2], o[3]);
                    if (n == 0) pk[ai][m] = w;
                    else if (!edge) { u32x4 w4; w4.x = pk[ai][m].x; w4.y = pk[ai][m].y; w4.z = w.x; w4.w = w.y; *(u32x4*)(act + ((unsigned)row * (unsigned)DFF + (unsigned)(c - 4))) = w4; }
                    __builtin_amdgcn_sched_barrier(0);
                }
                asm volatile("" ::: "memory");
            }
        }
    }
};

struct EpiFinal {
    static constexpr bool PERM = true, AFTER_DRAIN = false;
    const bf16_t* x1b; float* out; float* ssq; unsigned* cnt; const float* gf;
    __device__ __forceinline__ void operator()(f32x4 (&acc)[2][2][4][2], const Unit& u, int wr, int wc, int fr, int fq) const {
        const int l_ = lane_id_fresh(); fr = l_ & 15; fq = l_ >> 4;
        const int pn = u.pn, row0 = u.pm * BM + wr * 64 + fr, cw = wc * 32 + 8 * fq;
        const unsigned off0 = (unsigned)row0 * DM + pn * 256 + cw;
#pragma unroll
        for (int ai = 0; ai < 2; ++ai) {
            u32x4 xw[4][2];
#pragma unroll
            for (int m = 0; m < 4; ++m)
#pragma unroll
                for (int bj = 0; bj < 2; ++bj) xw[m][bj] = *(const u32x4*)(x1b + off0 + (unsigned)((ai * HALF + m * 16) * DM + bj * HALF));
            asm volatile("" ::: "memory");
#pragma unroll
            for (int m = 0; m < 4; ++m) { const int row = row0 + ai * HALF + m * 16; float s = 0.f;
#pragma unroll
                for (int bj = 0; bj < 2; ++bj) { const u32x4 w = xw[m][bj];
                    const f32x4 x0 = {__uint_as_float(w.x << 16), __uint_as_float(w.x & 0xffff0000u), __uint_as_float(w.y << 16), __uint_as_float(w.y & 0xffff0000u)};
                    const f32x4 x1v = {__uint_as_float(w.z << 16), __uint_as_float(w.z & 0xffff0000u), __uint_as_float(w.w << 16), __uint_as_float(w.w & 0xffff0000u)};
                    acc[ai][bj][m][0] = acc[ai][bj][m][0] + x0; acc[ai][bj][m][1] = acc[ai][bj][m][1] + x1v;
                    s += sq4(acc[ai][bj][m][0]) + sq4(acc[ai][bj][m][1]); }
                s = fq_sum(s); if (fq == 0) __hip_atomic_store(ssq + (unsigned)row * 16 + pn * 4 + wc, s, __ATOMIC_RELAXED, __HIP_MEMORY_SCOPE_AGENT); }
            asm volatile("" ::: "memory");
        }
        asm volatile("s_waitcnt vmcnt(0)" ::: "memory");
        __builtin_amdgcn_s_barrier(); asm volatile("" ::: "memory");
        if (wr == 0 && wc == 0) {
            unsigned* c = cnt + 64 * u.pm;
            if (l_ == 0) __hip_atomic_fetch_add(c, 1u, __ATOMIC_RELAXED, __HIP_MEMORY_SCOPE_AGENT);
            for (unsigned sp = 0; sp < (1u << 22); ++sp) {
                if ((unsigned)__builtin_amdgcn_readfirstlane(__hip_atomic_load(c, __ATOMIC_RELAXED, __HIP_MEMORY_SCOPE_AGENT)) >= 4u) break;
                __builtin_amdgcn_s_sleep(2); }
            __builtin_amdgcn_fence(__ATOMIC_ACQUIRE, "agent");
            asm volatile("s_waitcnt vmcnt(0)" ::: "memory");
        }
        __builtin_amdgcn_s_barrier(); asm volatile("" ::: "memory");
        f32x4 gv[2][2];
#pragma unroll
        for (int bj = 0; bj < 2; ++bj) { gv[bj][0] = *(const f32x4*)(gf + pn * 256 + bj * HALF + cw); gv[bj][1] = *(const f32x4*)(gf + pn * 256 + bj * HALF + cw + 4); }
        f32x4 tv[2][4];
#pragma unroll
        for (int ai = 0; ai < 2; ++ai)
#pragma unroll
            for (int m = 0; m < 4; ++m) tv[ai][m] = *(const f32x4*)(ssq + (unsigned)(row0 + ai * HALF + m * 16) * 16 + 4 * fq);
        asm volatile("" ::: "memory");
#pragma unroll
        for (int ai = 0; ai < 2; ++ai)
#pragma unroll
            for (int m = 0; m < 4; ++m) { const f32x4 t = tv[ai][m];
                const float rs = __builtin_amdgcn_rsqf(fq_sum((t[0] + t[1]) + (t[2] + t[3])) * (1.0f / 1024.0f) + RMS_EPS);
#pragma unroll
                for (int bj = 0; bj < 2; ++bj) { const unsigned off = off0 + (unsigned)((ai * HALF + m * 16) * DM + bj * HALF);
                    *(f32x4*)(out + off) = acc[ai][bj][m][0] * rs * gv[bj][0]; *(f32x4*)(out + off + 4) = acc[ai][bj][m][1] * rs * gv[bj][1]; }
                if (m == 1 || m == 3) __builtin_amdgcn_sched_barrier(0); }
    }
};
template <class Epi, class Sched, bool ALIGN_EPI = false, bool SP2 = false>
__device__ __forceinline__ void gemm_phase(PG8_LAS unsigned char* lds, const Gemm g, const Sched& S, const Epi& E, const int wave_id  ) {
    const int lane = lane_id_fresh(), wid = wave_id, tid = wid * 64 + lane,
              wr = wid >> 2, wc = wid & 3, fr = lane & 15, fq = lane >> 4;
    const int K = g.K, nt = K / BK;
    unsigned voffA[2], voffB[2]; int aoff, boff;
#define PG8_LANE_CONSTS() do { const int l_ = lane_id_fresh(), t_ = wid * 64 + l_, fr_ = l_ & 15, fq_ = l_ >> 4; \
        _Pragma("unroll") for (int i = 0; i < 2; ++i) { int R, C; stage_rc(t_ * 16 + i * 8192, R, C); const int Rb = Epi::PERM ? ((R & ~31) + perm32(R & 31)) : R; \
            voffA[i] = (unsigned)(R * K + C) * 2u; voffB[i] = (unsigned)(Rb * K + C) * 2u; } \
        aoff = lds_byte(wr * 64 + fr_, fq_ * 8); boff = lds_byte(wc * 32 + fr_, fq_ * 8); } while (0)
    PG8_LANE_CONSTS();
    const size_t kstep = (size_t)(BK * 2);
    const size_t hstep = (size_t)HALF * K * 2;
    const size_t tstep = 2 * hstep;
    const unsigned ldsw = (unsigned)wid * 1024u;
#define PG8_SA(b, h) (((b) * 2 + (h)) * HTB)
#define PG8_SB(b, h) ((4 + (b) * 2 + (h)) * HTB)
#define PG8_STAGE(bufoff, gbase, voff) do { _Pragma("unroll") for (int _i = 0; _i < 2; ++_i) \
        __builtin_amdgcn_global_load_lds((const unsigned*)((const char*)(gbase) + (voff)[_i]), (PG8_LAS unsigned*)(lds + (bufoff) + ldsw + _i * 8192), 16, 0, 0); } while (0)
#define PG8_LDA(dst, b, h) do { _Pragma("unroll") for (int m = 0; m < 4; ++m) _Pragma("unroll") for (int k = 0; k < 2; ++k) dst[m][k] = *(const PG8_LAS bf16x8*)(lds + PG8_SA(b, h) + aoff + m * 2048 + k * 1024); } while (0)
#define PG8_LDB(dst, b, h) do { _Pragma("unroll") for (int n = 0; n < 2; ++n) _Pragma("unroll") for (int k = 0; k < 2; ++k) dst[n][k] = *(const PG8_LAS bf16x8*)(lds + PG8_SB(b, h) + boff + n * 2048 + k * 1024); } while (0)
#define PG8_MMA(ai, bj, At, Bt) do { __builtin_amdgcn_s_setprio(1); _Pragma("unroll") for (int m = 0; m < 4; ++m) _Pragma("unroll") for (int n = 0; n < 2; ++n) _Pragma("unroll") for (int k = 0; k < 2; ++k) \
        acc[ai][bj][m][n] = __builtin_amdgcn_mfma_f32_16x16x32_bf16(Bt[n][k], At[m][k], acc[ai][bj][m][n], 0, 0, 0); __builtin_amdgcn_s_setprio(0); } while (0)
#define PG8_WAIT_V(n) asm volatile("s_waitcnt vmcnt(" #n ")" ::: "memory")
#define PG8_WAIT_L(n) asm volatile("s_waitcnt lgkmcnt(" #n ")" ::: "memory")
#define PG8_BAR __builtin_amdgcn_s_barrier()
#define PG8_SCHED __builtin_amdgcn_sched_barrier(0)
    Unit cur, nxt; int ui = 0;
    if (!S.next(0, cur)) return;
    f32x4 acc[2][2][4][2];
#pragma unroll
    for (int a = 0; a < 2; ++a)
#pragma unroll
        for (int b = 0; b < 2; ++b)
#pragma unroll
            for (int m = 0; m < 4; ++m)
#pragma unroll
                for (int n = 0; n < 2; ++n) acc[a][b][m][n] = (f32x4){0.f, 0.f, 0.f, 0.f};
    bf16x8 At[4][2], B0[2][2], B1[2][2];
    const char* cA = (const char*)g.A + (size_t)cur.pm * tstep; const char* cB = (const char*)g.Bt + (size_t)cur.pn * tstep;
    S.a_ready(cur);
    if constexpr (SP2) {
        PG8_STAGE(PG8_SB(0, 0), cB, voffB); PG8_STAGE(PG8_SB(0, 1), cB + hstep, voffB); PG8_STAGE(PG8_SA(0, 0), cA, voffA); PG8_STAGE(PG8_SA(0, 1), cA + hstep, voffA);
        if (wr == 1) PG8_BAR;
        PG8_WAIT_V(2); PG8_BAR;
        PG8_STAGE(PG8_SB(1, 0), cB + kstep, voffB); PG8_STAGE(PG8_SA(1, 0), cA + kstep, voffA); PG8_STAGE(PG8_SB(1, 1), cB + hstep + kstep, voffB);
        PG8_WAIT_V(6); PG8_BAR;
    } else {
        PG8_STAGE(PG8_SB(0, 0), cB, voffB); PG8_STAGE(PG8_SA(0, 0), cA, voffA); PG8_STAGE(PG8_SB(0, 1), cB + hstep, voffB); PG8_STAGE(PG8_SA(0, 1), cA + hstep, voffA);
        if (wr == 1) PG8_BAR;
        PG8_WAIT_V(4); PG8_BAR;
        PG8_STAGE(PG8_SB(1, 0), cB + kstep, voffB); PG8_STAGE(PG8_SA(1, 0), cA + kstep, voffA); PG8_STAGE(PG8_SB(1, 1), cB + hstep + kstep, voffB);
        PG8_WAIT_V(6); PG8_BAR;
    }
    for (;;) {
        const bool has_next = S.next(ui + 1, nxt);
        const char* nA = has_next ? (const char*)g.A + (size_t)nxt.pm * tstep : cA; const char* nB = has_next ? (const char*)g.Bt + (size_t)nxt.pn * tstep : cB;
        for (int t = 0; t < nt; t += 2) {
            const bool last = (t == nt - 2);
            const char* a1 = cA + (size_t)(t + 1) * kstep;
            const char* a2 = last ? nA : cA + (size_t)(t + 2) * kstep; const char* b2 = last ? nB : cB + (size_t)(t + 2) * kstep;
            const char* a3 = a2 + kstep; const char* b3 = b2 + kstep;
            if (last && has_next) S.a_ready(nxt);
            if constexpr (SP2) {
            PG8_LDB(B0, 0, 0); PG8_LDB(B1, 0, 1); PG8_SCHED; PG8_LDA(At, 0, 0); PG8_STAGE(PG8_SA(1, 1), a1 + hstep, voffA);
            PG8_WAIT_V(8); PG8_WAIT_L(0); PG8_BAR; PG8_MMA(0, 0, At, B0); PG8_MMA(0, 1, At, B1); PG8_BAR; PG8_SCHED;
            PG8_LDA(At, 0, 1); PG8_STAGE(PG8_SB(0, 0), b2, voffB); PG8_STAGE(PG8_SB(0, 1), b2 + hstep, voffB); PG8_STAGE(PG8_SA(0, 0), a2, voffA);
            PG8_WAIT_V(8); PG8_WAIT_L(0); PG8_BAR; PG8_MMA(1, 0, At, B0); PG8_MMA(1, 1, At, B1); PG8_BAR; PG8_SCHED;
            PG8_LDB(B0, 1, 0); PG8_LDB(B1, 1, 1); PG8_SCHED; PG8_LDA(At, 1, 0); PG8_STAGE(PG8_SA(0, 1), a2 + hstep, voffA);
            PG8_WAIT_V(8); PG8_WAIT_L(0); PG8_BAR; PG8_MMA(0, 0, At, B0); PG8_MMA(0, 1, At, B1); PG8_BAR; PG8_SCHED;
            PG8_LDA(At, 1, 1); PG8_STAGE(PG8_SB(1, 0), b3, voffB); PG8_STAGE(PG8_SB(1, 1), b3 + hstep, voffB); PG8_STAGE(PG8_SA(1, 0), a3, voffA);
            PG8_WAIT_V(8); PG8_WAIT_L(0); PG8_BAR; PG8_MMA(1, 0, At, B0); PG8_MMA(1, 1, At, B1); PG8_BAR; PG8_SCHED;
            } else {
            PG8_LDB(B0, 0, 0); PG8_SCHED; PG8_LDA(At, 0, 0); PG8_STAGE(PG8_SA(1, 1), a1 + hstep, voffA);
            PG8_WAIT_L(8); PG8_BAR; PG8_WAIT_L(0); PG8_MMA(0, 0, At, B0); PG8_BAR; PG8_SCHED;
            PG8_LDB(B1, 0, 1); PG8_STAGE(PG8_SB(0, 0), b2, voffB);
            PG8_BAR; PG8_WAIT_L(0); PG8_MMA(0, 1, At, B1); PG8_BAR;
            PG8_LDA(At, 0, 1); PG8_STAGE(PG8_SA(0, 0), a2, voffA);
            PG8_BAR; PG8_WAIT_L(0); PG8_MMA(1, 0, At, B0); PG8_BAR; PG8_SCHED;
            PG8_STAGE(PG8_SB(0, 1), b2 + hstep, voffB);
            PG8_WAIT_V(6); PG8_BAR; PG8_MMA(1, 1, At, B1); PG8_BAR;
            PG8_LDB(B0, 1, 0); PG8_SCHED; PG8_LDA(At, 1, 0); PG8_STAGE(PG8_SA(0, 1), a2 + hstep, voffA);
            PG8_WAIT_L(8); PG8_BAR; PG8_WAIT_L(0); PG8_MMA(0, 0, At, B0); PG8_BAR; PG8_SCHED;
            PG8_LDB(B1, 1, 1); PG8_STAGE(PG8_SB(1, 0), b3, voffB);
            PG8_BAR; PG8_WAIT_L(0); PG8_MMA(0, 1, At, B1); PG8_BAR;
            PG8_LDA(At, 1, 1); PG8_STAGE(PG8_SA(1, 0), a3, voffA);
            PG8_BAR; PG8_WAIT_L(0); PG8_MMA(1, 0, At, B0); PG8_BAR; PG8_SCHED;
            PG8_STAGE(PG8_SB(1, 1), b3 + hstep, voffB);
            PG8_WAIT_V(6); PG8_BAR; PG8_MMA(1, 1, At, B1); PG8_BAR;
            }
        }
        if constexpr (ALIGN_EPI) { if (wr == 0) PG8_BAR; }
        if constexpr (!Epi::AFTER_DRAIN) { E(acc, cur, wr, wc, fr, fq); S.done(cur); PG8_LANE_CONSTS(); }
        if (!has_next) break;
#pragma unroll
        for (int a = 0; a < 2; ++a)
#pragma unroll
            for (int b = 0; b < 2; ++b)
#pragma unroll
                for (int m = 0; m < 4; ++m)
#pragma unroll
                    for (int n = 0; n < 2; ++n) acc[a][b][m][n] = (f32x4){0.f, 0.f, 0.f, 0.f};
        cur = nxt; cA = nA; cB = nB; ++ui;
        if constexpr (ALIGN_EPI) { if (wr == 1) PG8_BAR; }
    }
    PG8_WAIT_V(0);
    if constexpr (!ALIGN_EPI) { if (wr == 0) PG8_BAR; }
    PG8_BAR;
    if constexpr (Epi::AFTER_DRAIN) { E.fused(acc, cur, wr, wc, fr, fq, lds, wid, lane); S.done(cur); }
#undef PG8_LANE_CONSTS
#undef PG8_SA
#undef PG8_SB
#undef PG8_STAGE
#undef PG8_LDA
#undef PG8_LDB
#undef PG8_MMA
#undef PG8_WAIT_V
#undef PG8_WAIT_L
#undef PG8_BAR
#undef PG8_SCHED
}
}
using pg8::SEQ; using pg8::NBATCH; using pg8::MTOK; using pg8::DM; using pg8::DFF; using pg8::RMS_EPS; using pg8::LOG2E;
#ifndef PG8_SP2
#define PG8_SP2 true
#endif
#ifndef PG8_ALIGN
#define PG8_ALIGN true
#endif
#ifndef MLA_OT
#define MLA_OT 1
#endif
namespace att {
using bf16x8 = __attribute__((ext_vector_type(8))) short;
using s16x4  = __attribute__((ext_vector_type(4))) short;
using f32x16 = __attribute__((ext_vector_type(16))) float;
using u32x4  = __attribute__((ext_vector_type(4))) unsigned;
typedef unsigned short bf16_t;
#define SBAR() __builtin_amdgcn_sched_barrier(0)
#define ATT_WAIT_BAR(N) asm volatile("s_waitcnt vmcnt(" #N ") lgkmcnt(0)\n\ts_barrier" ::: "memory")
__device__ __forceinline__ int crow(int r, int hi) { return (r & 3) + 8 * (r >> 2) + 4 * hi; }
__device__ __forceinline__ unsigned cvtpk(float lo, float hi) { unsigned r; asm volatile("v_cvt_pk_bf16_f32 %0, %1, %2" : "=v"(r) : "v"(lo), "v"(hi)); return r; }
__device__ __forceinline__ float bf2f(bf16_t b) { return __uint_as_float((unsigned)b << 16); }
typedef float f32x2_t __attribute__((ext_vector_type(2))); typedef __bf16 bf16x2_t __attribute__((ext_vector_type(2)));
__device__ __forceinline__ unsigned cvtpk2(float lo, float hi) { f32x2_t v = {lo, hi}; bf16x2_t r = __builtin_convertvector(v, bf16x2_t); return __builtin_bit_cast(unsigned, r); }
__device__ __forceinline__ bf16_t f2bf(float f) { return (bf16_t)(cvtpk(f, f) & 0xffffu); }
__device__ __forceinline__ void glds16(const void* gsrc, unsigned lds_dst) { unsigned keep;
    asm volatile("s_mov_b32 %0, m0\n\ts_mov_b32 m0, %2\n\ts_nop 0\n\tglobal_load_lds_dwordx4 %1, off\n\ts_mov_b32 m0, %0" : "=&s"(keep) : "v"(gsrc), "s"(lds_dst) : "memory"); }
template <int IMM> __device__ __forceinline__ void glds16s(const void* sbase, unsigned voff, unsigned lds_dst) { unsigned keep;
    asm volatile("s_mov_b32 %0, m0\n\ts_mov_b32 m0, %3\n\ts_nop 4\n\tglobal_load_lds_dwordx4 %1, %2 offset:%4\n\ts_mov_b32 m0, %0" : "=&s"(keep) : "v"(voff), "s"(sbase), "s"(lds_dst), "i"(IMM) : "memory"); }
__device__ __forceinline__ int swap23(int k) { return (k & ~0xC) | ((k & 4) << 1) | ((k & 8) >> 1); }
__device__ __forceinline__ int v_rd_base(int lane) { return ((lane & 3) << 3) | (((lane >> 2) & 3) << 6) | (((lane >> 4) & 1) << 5) | (((lane >> 5) & 1) << 8); }
template <int OFF> __device__ __forceinline__ s16x4 tr_read(int vb) { s16x4 r; asm volatile("ds_read_b64_tr_b16 %0, %1 offset:%2" : "=&v"(r) : "v"(vb), "i"(OFF) : "memory"); return r; }
__device__ __forceinline__ void pack_p(const f32x16& p0, const f32x16& p1, bf16x8& pa0, bf16x8& pa1, bf16x8& pa2, bf16x8& pa3) {
#define PK4(P, BASE, OUT) do { unsigned a0 = cvtpk(P[BASE + 0], P[BASE + 1]), a1 = cvtpk(P[BASE + 2], P[BASE + 3]);   \
    unsigned b0 = cvtpk(P[BASE + 4], P[BASE + 5]), b1 = cvtpk(P[BASE + 6], P[BASE + 7]);                              \
    auto r0 = __builtin_amdgcn_permlane32_swap(a0, b0, false, false); auto r1 = __builtin_amdgcn_permlane32_swap(a1, b1, false, false); \
    u32x4 w = {r0[0], r1[0], r0[1], r1[1]}; OUT = *reinterpret_cast<bf16x8*>(&w); } while (0)
    PK4(p0, 0, pa0); PK4(p0, 8, pa1); PK4(p1, 0, pa2); PK4(p1, 8, pa3);
#undef PK4
}
__device__ __forceinline__ float half_max(float v) { auto rr = __builtin_amdgcn_permlane32_swap(__float_as_uint(v), __float_as_uint(v), false, false); return fmaxf(__uint_as_float(rr[0]), __uint_as_float(rr[1])); }
__device__ __forceinline__ float half_sum(float v) { auto rr = __builtin_amdgcn_permlane32_swap(__float_as_uint(v), __float_as_uint(v), false, false); return __uint_as_float(rr[0]) + __uint_as_float(rr[1]); }
template <int ND0, int D0> __device__ __forceinline__ void pv_one(f32x16& od, int vb, bf16x8 pa0, bf16x8 pa1, bf16x8 pa2, bf16x8 pa3) {
    constexpr int KS = 1024 * ND0, HF = 512 * ND0;
    const s16x4 l0 = tr_read<D0 * 512 + 0 * KS>(vb), h0 = tr_read<D0 * 512 + 0 * KS + HF>(vb), l1 = tr_read<D0 * 512 + 1 * KS>(vb), h1 = tr_read<D0 * 512 + 1 * KS + HF>(vb);
    const s16x4 l2 = tr_read<D0 * 512 + 2 * KS>(vb), h2 = tr_read<D0 * 512 + 2 * KS + HF>(vb), l3 = tr_read<D0 * 512 + 3 * KS>(vb), h3 = tr_read<D0 * 512 + 3 * KS + HF>(vb);
    asm volatile("s_waitcnt lgkmcnt(0)" ::: "memory"); SBAR();
#define PK(L, H) (bf16x8){L[0], L[1], L[2], L[3], H[0], H[1], H[2], H[3]}
    od = __builtin_amdgcn_mfma_f32_32x32x16_bf16(pa0, PK(l0, h0), od, 0, 0, 0);
    od = __builtin_amdgcn_mfma_f32_32x32x16_bf16(pa1, PK(l1, h1), od, 0, 0, 0);
    od = __builtin_amdgcn_mfma_f32_32x32x16_bf16(pa2, PK(l2, h2), od, 0, 0, 0);
    od = __builtin_amdgcn_mfma_f32_32x32x16_bf16(pa3, PK(l3, h3), od, 0, 0, 0);
#undef PK
}
struct PvFrag { s16x4 l0, h0, l1, h1, l2, h2, l3, h3; };
template <int ND0, int D0> __device__ __forceinline__ void pv_issue(PvFrag& f, int vb) {
    constexpr int KS = 1024 * ND0, HF = 512 * ND0;
    f.l0 = tr_read<D0 * 512 + 0 * KS>(vb); f.h0 = tr_read<D0 * 512 + 0 * KS + HF>(vb); f.l1 = tr_read<D0 * 512 + 1 * KS>(vb); f.h1 = tr_read<D0 * 512 + 1 * KS + HF>(vb);
    f.l2 = tr_read<D0 * 512 + 2 * KS>(vb); f.h2 = tr_read<D0 * 512 + 2 * KS + HF>(vb); f.l3 = tr_read<D0 * 512 + 3 * KS>(vb); f.h3 = tr_read<D0 * 512 + 3 * KS + HF>(vb);
}
__device__ __forceinline__ void pv_mma(f32x16& od, const PvFrag& f, bf16x8 pa0, bf16x8 pa1, bf16x8 pa2, bf16x8 pa3) {
    asm volatile("s_waitcnt lgkmcnt(0)" ::: "memory"); SBAR();
#define PK(L, H) (bf16x8){L[0], L[1], L[2], L[3], H[0], H[1], H[2], H[3]}
    od = __builtin_amdgcn_mfma_f32_32x32x16_bf16(pa0, PK(f.l0, f.h0), od, 0, 0, 0);
    od = __builtin_amdgcn_mfma_f32_32x32x16_bf16(pa1, PK(f.l1, f.h1), od, 0, 0, 0);
    od = __builtin_amdgcn_mfma_f32_32x32x16_bf16(pa2, PK(f.l2, f.h2), od, 0, 0, 0);
    od = __builtin_amdgcn_mfma_f32_32x32x16_bf16(pa3, PK(f.l3, f.h3), od, 0, 0, 0);
#undef PK
}
template <int NK16, int RS, int CS> __device__ __forceinline__ void qkt(f32x16& p0, f32x16& p1, const char* Ks, const bf16x8* qr, int r32, int hi) {
    p0 = f32x16{}; p1 = f32x16{};
    const char* kb = Ks + hi * CS + r32 * RS;
#pragma unroll
    for (int d0 = 0; d0 < NK16; ++d0) {
        const bf16x8 b0 = *reinterpret_cast<const bf16x8*>(kb + d0 * 2 * CS), b1 = *reinterpret_cast<const bf16x8*>(kb + d0 * 2 * CS + 32 * RS);
        p0 = __builtin_amdgcn_mfma_f32_32x32x16_bf16(b0, qr[d0], p0, 0, 0, 0);
        p1 = __builtin_amdgcn_mfma_f32_32x32x16_bf16(b1, qr[d0], p1, 0, 0, 0); }
}

template <int NK16, int RS, int CS> __device__ __forceinline__ void qkt_c(f32x16& p0, f32x16& p1, const f32x16& c, const char* Ks, const bf16x8* qr, int r32, int hi) {
    const char* kb = Ks + hi * CS + r32 * RS;
    { const bf16x8 b0 = *reinterpret_cast<const bf16x8*>(kb), b1 = *reinterpret_cast<const bf16x8*>(kb + 32 * RS);
      p0 = __builtin_amdgcn_mfma_f32_32x32x16_bf16(b0, qr[0], c, 0, 0, 0);
      p1 = __builtin_amdgcn_mfma_f32_32x32x16_bf16(b1, qr[0], c, 0, 0, 0); }
#pragma unroll
    for (int d0 = 1; d0 < NK16; ++d0) {
        const bf16x8 b0 = *reinterpret_cast<const bf16x8*>(kb + d0 * 2 * CS), b1 = *reinterpret_cast<const bf16x8*>(kb + d0 * 2 * CS + 32 * RS);
        p0 = __builtin_amdgcn_mfma_f32_32x32x16_bf16(b0, qr[d0], p0, 0, 0, 0);
        p1 = __builtin_amdgcn_mfma_f32_32x32x16_bf16(b1, qr[d0], p1, 0, 0, 0); }
}
__device__ __forceinline__ float max3f(float a, float b, float c) { float r; asm("v_max3_f32 %0, %1, %2, %3" : "=v"(r) : "v"(a), "v"(b), "v"(c)); return r; }

namespace mla {
constexpr int NTILE = SEQ / 64;
constexpr int KPITCH = 400, KSLOT = 64 * KPITCH  , NSLOT = 4;
constexpr int LDS_K = 0, LDS_WS = NSLOT * KSLOT, LDS_BYTES = LDS_WS + 8 * 256;
constexpr int OST_PITCH = 272, OST_WAVE = 32 * OST_PITCH;
static_assert(8 * OST_WAVE <= NSLOT * KSLOT, "o_lat staging fits the ring");
#ifndef MLA_XVALU
#define MLA_XVALU 0
#endif
constexpr float THR = 8.f;
template <bool FIRST> __device__ __forceinline__ void partialSM(f32x16& p0, f32x16& p1, f32x16& negm, float& alpha) {
    float a = max3f(p0[0], p0[1], p0[2]), b = max3f(p0[9], p0[10], p0[11]), c = max3f(p1[0], p1[1], p1[2]), e = max3f(p1[9], p1[10], p1[11]);
    a = max3f(a, p0[3], p0[4]); b = max3f(b, p0[12], p0[13]); c = max3f(c, p1[3], p1[4]); e = max3f(e, p1[12], p1[13]);
    a = max3f(a, p0[5], p0[6]); b = max3f(b, p0[14], p0[15]); c = max3f(c, p1[5], p1[6]); e = max3f(e, p1[14], p1[15]);
    a = max3f(a, p0[7], p0[8]); c = max3f(c, p1[7], p1[8]);
    float pmax = max3f(a, b, c);
    pmax = max3f(pmax, e, e);
    { auto rr = __builtin_amdgcn_permlane32_swap(__float_as_uint(pmax), __float_as_uint(pmax), false, false); pmax = max3f(__uint_as_float(rr[0]), __uint_as_float(rr[1]), __uint_as_float(rr[1])); }
    alpha = 1.f;
    if (FIRST || !__builtin_expect(__all(pmax <= THR), 1)) {
        const float dl = FIRST ? pmax : fmaxf(pmax, 0.f);
        if (!FIRST) alpha = __builtin_amdgcn_exp2f(-dl);
#pragma unroll
        for (int r = 0; r < 16; ++r) { p0[r] -= dl; p1[r] -= dl; negm[r] -= dl; }
        asm volatile("" : "+v"(negm));
    }
#pragma unroll
    for (int r = 0; r < 16; ++r) p0[r] = __builtin_amdgcn_exp2f(p0[r]);
}
__device__ __forceinline__ void finishSM(f32x16& p0, f32x16& p1, float alpha, float& l_reg, bf16x8& pa0, bf16x8& pa1, bf16x8& pa2, bf16x8& pa3) {
#pragma unroll
    for (int r = 0; r < 16; ++r) p1[r] = __builtin_amdgcn_exp2f(p1[r]);
    float s0 = p0[0] + p0[1], s1 = p0[2] + p0[3], s2 = p1[0] + p1[1], s3 = p1[2] + p1[3];
#pragma unroll
    for (int r = 4; r < 16; r += 4) { s0 += p0[r]; s0 += p0[r + 1]; s1 += p0[r + 2]; s1 += p0[r + 3]; s2 += p1[r]; s2 += p1[r + 1]; s3 += p1[r + 2]; s3 += p1[r + 3]; }
    float ps = (s0 + s1) + (s2 + s3);
    ps = half_sum(ps);
    l_reg = l_reg * alpha + ps;
#if MLA_OT
#define MLA_PK(P, B) (u32x4){cvtpk2(P[B], P[B + 1]), cvtpk2(P[B + 2], P[B + 3]), cvtpk2(P[B + 4], P[B + 5]), cvtpk2(P[B + 6], P[B + 7])}
    { u32x4 w0 = MLA_PK(p0, 0), w1 = MLA_PK(p0, 8), w2 = MLA_PK(p1, 0), w3 = MLA_PK(p1, 8);
      pa0 = *reinterpret_cast<bf16x8*>(&w0); pa1 = *reinterpret_cast<bf16x8*>(&w1); pa2 = *reinterpret_cast<bf16x8*>(&w2); pa3 = *reinterpret_cast<bf16x8*>(&w3); }
#undef MLA_PK
#else
    pack_p(p0, p1, pa0, pa1, pa2, pa3);
#endif
}
__device__ __forceinline__ int v_rm_base(int lane) { return (8 * (lane >> 5) + ((lane >> 2) & 3)) * KPITCH + 32 * ((lane >> 4) & 1) + 8 * (lane & 3); }
template <int D0> __device__ __forceinline__ void pvr_issue(PvFrag& f, int vb) {
    constexpr int KS = 16 * KPITCH, HF = 4 * KPITCH;
    f.l0 = tr_read<D0 * 64 + 0 * KS>(vb); f.h0 = tr_read<D0 * 64 + 0 * KS + HF>(vb); f.l1 = tr_read<D0 * 64 + 1 * KS>(vb); f.h1 = tr_read<D0 * 64 + 1 * KS + HF>(vb);
    f.l2 = tr_read<D0 * 64 + 2 * KS>(vb); f.h2 = tr_read<D0 * 64 + 2 * KS + HF>(vb); f.l3 = tr_read<D0 * 64 + 3 * KS>(vb); f.h3 = tr_read<D0 * 64 + 3 * KS + HF>(vb);
}
template <int D0> __device__ __forceinline__ void pvr_one(f32x16& od, int vb, bf16x8 pa0, bf16x8 pa1, bf16x8 pa2, bf16x8 pa3) { PvFrag f; pvr_issue<D0>(f, vb); pv_mma(od, f, pa0, pa1, pa2, pa3); }
#if MLA_OT
__device__ __forceinline__ int vt_rm_base(int lane) { return (4 * (lane >> 5) + ((lane >> 2) & 3)) * KPITCH + 32 * ((lane >> 4) & 1) + 8 * (lane & 3); }
template <int D0> __device__ __forceinline__ void pvt_issue(PvFrag& f, int vb) {
    constexpr int KS = 16 * KPITCH, HF = 8 * KPITCH;
    f.l0 = tr_read<D0 * 64 + 0 * KS>(vb); f.h0 = tr_read<D0 * 64 + 0 * KS + HF>(vb); f.l1 = tr_read<D0 * 64 + 1 * KS>(vb); f.h1 = tr_read<D0 * 64 + 1 * KS + HF>(vb);
    f.l2 = tr_read<D0 * 64 + 2 * KS>(vb); f.h2 = tr_read<D0 * 64 + 2 * KS + HF>(vb); f.l3 = tr_read<D0 * 64 + 3 * KS>(vb); f.h3 = tr_read<D0 * 64 + 3 * KS + HF>(vb);
}
__device__ __forceinline__ void pvt_mma(f32x16& od, const PvFrag& f, bf16x8 pa0, bf16x8 pa1, bf16x8 pa2, bf16x8 pa3) {
    asm volatile("s_waitcnt lgkmcnt(0)" ::: "memory"); SBAR();
#define PK(L, H) (bf16x8){L[0], L[1], L[2], L[3], H[0], H[1], H[2], H[3]}
    od = __builtin_amdgcn_mfma_f32_32x32x16_bf16(PK(f.l0, f.h0), pa0, od, 0, 0, 0);
    od = __builtin_amdgcn_mfma_f32_32x32x16_bf16(PK(f.l1, f.h1), pa1, od, 0, 0, 0);
    od = __builtin_amdgcn_mfma_f32_32x32x16_bf16(PK(f.l2, f.h2), pa2, od, 0, 0, 0);
    od = __builtin_amdgcn_mfma_f32_32x32x16_bf16(PK(f.l3, f.h3), pa3, od, 0, 0, 0);
#undef PK
}
template <int D0> __device__ __forceinline__ void pvt_one(f32x16& od, int vb, bf16x8 pa0, bf16x8 pa1, bf16x8 pa2, bf16x8 pa3) { PvFrag f; pvt_issue<D0>(f, vb); pvt_mma(od, f, pa0, pa1, pa2, pa3); }
#define MLA_PV_ISSUE pvt_issue
#define MLA_PV_MMA pvt_mma
#define MLA_PV_ONE pvt_one
#define MLA_V_BASE vt_rm_base
#else
#define MLA_PV_ISSUE pvr_issue
#define MLA_PV_MMA pv_mma
#define MLA_PV_ONE pvr_one
#define MLA_V_BASE v_rm_base
#endif
__device__ __forceinline__ void h1_qk_finish(f32x16& C0, f32x16& C1, f32x16& P0, f32x16& P1, const f32x16& negm, const char* Ks, const bf16x8* qr, int r32, int hi,
                                             float alP, float& l_reg, bf16x8& pa0, bf16x8& pa1, bf16x8& pa2, bf16x8& pa3) {
    const char* kb = Ks + hi * 16 + r32 * KPITCH;
    bf16x8 b0 = *reinterpret_cast<const bf16x8*>(kb), b1 = *reinterpret_cast<const bf16x8*>(kb + 32 * KPITCH);
    float a0 = 0.f, a1 = 0.f, c0 = 0.f, c1 = 0.f; unsigned w[16];
#pragma unroll
    for (int k = 0; k < 12; ++k) {
        bf16x8 n0 = b0, n1 = b1;
        if (k < 11) { n0 = *reinterpret_cast<const bf16x8*>(kb + (k + 1) * 32); n1 = *reinterpret_cast<const bf16x8*>(kb + (k + 1) * 32 + 32 * KPITCH); }
        if (k == 0) { C0 = __builtin_amdgcn_mfma_f32_32x32x16_bf16(b0, qr[0], negm, 0, 0, 0); C1 = __builtin_amdgcn_mfma_f32_32x32x16_bf16(b1, qr[0], negm, 0, 0, 0); }
        else { C0 = __builtin_amdgcn_mfma_f32_32x32x16_bf16(b0, qr[k], C0, 0, 0, 0); C1 = __builtin_amdgcn_mfma_f32_32x32x16_bf16(b1, qr[k], C1, 0, 0, 0); }
        if (k < 8) { float e0 = __builtin_amdgcn_exp2f(P1[2 * k]), e1 = __builtin_amdgcn_exp2f(P1[2 * k + 1]);
            if (k == 0) { a0 = P0[0]; a1 = P0[1]; } else { a0 += P0[2 * k]; a1 += P0[2 * k + 1]; }
            w[k] = cvtpk2(P0[2 * k], P0[2 * k + 1]);
            asm volatile("" : "+v"(e0), "+v"(e1), "+v"(a0), "+v"(a1), "+v"(w[k]));
            P1[2 * k] = e0; P1[2 * k + 1] = e1; }
        else { const int e = 4 * (k - 8);
            if (k == 8) { c0 = P1[0] + P1[2]; c1 = P1[1] + P1[3]; } else { c0 += P1[e]; c1 += P1[e + 1]; c0 += P1[e + 2]; c1 += P1[e + 3]; }
            w[8 + 2 * (k - 8)] = cvtpk2(P1[e], P1[e + 1]); w[9 + 2 * (k - 8)] = cvtpk2(P1[e + 2], P1[e + 3]);
            asm volatile("" : "+v"(c0), "+v"(c1), "+v"(w[8 + 2 * (k - 8)]), "+v"(w[9 + 2 * (k - 8)])); }
        SBAR();
        b0 = n0; b1 = n1;
    }
    l_reg = l_reg * alP + half_sum((a0 + a1) + (c0 + c1));
    { u32x4 w0 = {w[0], w[1], w[2], w[3]}, w1 = {w[4], w[5], w[6], w[7]}, w2 = {w[8], w[9], w[10], w[11]}, w3 = {w[12], w[13], w[14], w[15]};
      pa0 = *reinterpret_cast<bf16x8*>(&w0); pa1 = *reinterpret_cast<bf16x8*>(&w1); pa2 = *reinterpret_cast<bf16x8*>(&w2); pa3 = *reinterpret_cast<bf16x8*>(&w3); }
}
__device__ __forceinline__ void max_head(const f32x16& p0, const f32x16& p1, float& a, float& b, float& c, float& e) {
    a = max3f(p0[0], p0[1], p0[2]); b = max3f(p0[9], p0[10], p0[11]); c = max3f(p1[0], p1[1], p1[2]); e = max3f(p1[9], p1[10], p1[11]);
    a = max3f(a, p0[3], p0[4]); b = max3f(b, p0[12], p0[13]); c = max3f(c, p1[3], p1[4]); e = max3f(e, p1[12], p1[13]);
}
__device__ __forceinline__ float max_tail(const f32x16& p0, const f32x16& p1, float a, float b, float c, float e) {
    a = max3f(a, p0[5], p0[6]); b = max3f(b, p0[14], p0[15]); c = max3f(c, p1[5], p1[6]); e = max3f(e, p1[14], p1[15]);
    a = max3f(a, p0[7], p0[8]); c = max3f(c, p1[7], p1[8]);
    float pmax = max3f(a, b, c); pmax = max3f(pmax, e, e);
    auto rr = __builtin_amdgcn_permlane32_swap(__float_as_uint(pmax), __float_as_uint(pmax), false, false);
    return max3f(__uint_as_float(rr[0]), __uint_as_float(rr[1]), __uint_as_float(rr[1]));
}
struct Tensors { const bf16_t* QA; const bf16_t* KL; const bf16_t* WV; const bf16_t* GA; const bf16_t* OB; bf16_t* MIX; };
#ifdef TP_MLA
#define MLA_TSARG , unsigned long long (&ts)[6], bool tson
#define MLA_TS(slot) do { if (tson) ts[slot] = __builtin_amdgcn_s_memrealtime(); } while (0)
#else
#define MLA_TSARG
#define MLA_TS(slot) do { } while (0)
#endif
__device__ __forceinline__ void unit(int b, int h, int qb, const Tensors& T, char* shm, const int wave_id MLA_TSARG) {
    const int lane = pg8::lane_id_fresh(), wid = wave_id, r32 = lane & 31, hi = lane >> 5;
    const long rowbase = (long)b * SEQ; const int q0 = qb * 256;
    MLA_TS(0);
    const unsigned lds0 = (unsigned)(uintptr_t)shm;
    float* wsf = (float*)(shm + LDS_WS) + wid * 64; float* al_l = wsf; float* li_l = wsf + 32;
    const char* klb = (const char*)(T.KL + rowbase * 192);
    unsigned koff0, koff1, koff2;
    { int s = 64 * wid + lane, row = s / 25, pos = s - 25 * row; koff0 = (unsigned)(row * 384 + (pos < 24 ? pos : 23) * 16);
      s += 512; row = s / 25; pos = s - 25 * row; koff1 = (unsigned)(row * 384 + (pos < 24 ? pos : 23) * 16);
      s += 512; row = s / 25; pos = s - 25 * row; koff2 = (unsigned)(row * 384 + (pos < 24 ? pos : 23) * 16); }
#define MLA_DMA(t) do { const unsigned kd_ = (unsigned)__builtin_amdgcn_readfirstlane(lds0 + LDS_K + ((t) & 3) * KSLOT + wid * 1024); const char* kb_ = klb + (size_t)(t) * 24576; \
        glds16s<0>(kb_, koff0, kd_); glds16s<0>(kb_, koff1, kd_ + 8192); glds16s<0>(kb_, koff2, kd_ + 16384); \
        if (wid == 0) { const int s_ = 1536 + lane, row_ = 61 + (lane >= 14) + (lane >= 39), pos_ = s_ - 25 * row_; glds16s<0>(kb_, (unsigned)(row_ * 384 + (pos_ < 24 ? pos_ : 23) * 16), kd_ + 24576); } } while (0)
    MLA_DMA(0); MLA_DMA(1);
    bf16x8 qr[12];
    { const bf16_t* Qw = T.QA + (rowbase + q0 + wid * 32 + r32) * 1536 + h * 192 + hi * 8;
#pragma unroll
      for (int d0 = 0; d0 < 12; ++d0) qr[d0] = *reinterpret_cast<const bf16x8*>(Qw + d0 * 16); }
    const int vb0 = (int)(lds0 + LDS_K) + MLA_V_BASE(lane);
    float l_reg = 0.f; f32x16 o[4] = {};
    f32x16 negm = {}; asm volatile("" : "+v"(negm));
    f32x16 pA0, pA1, pB0, pB1; float alA, alB; bf16x8 pa0, pa1, pa2, pa3;
#if MLA_OT
#define MLA_RESC(a) do { if (__any((a) < 1.f)) { _Pragma("unroll") for (int d = 0; d < 4; ++d) _Pragma("unroll") for (int r = 0; r < 16; ++r) o[d][r] *= (a); } } while (0)
#else
#define MLA_RESC(a) do { if (__any((a) < 1.f)) { if (hi == 0) al_l[r32] = (a); asm volatile("s_waitcnt lgkmcnt(0)" ::: "memory"); \
        _Pragma("unroll") for (int d = 0; d < 4; ++d) _Pragma("unroll") for (int r = 0; r < 16; ++r) o[d][r] *= al_l[crow(r, hi)]; } } while (0)
#endif
#define ATT_BAR_L() asm volatile("s_waitcnt lgkmcnt(0)\n\ts_barrier" ::: "memory")
    ATT_WAIT_BAR(0);
    MLA_TS(1);
    if (wid >= 4) ATT_BAR_L();
    qkt<12, KPITCH, 16>(pA0, pA1, shm + LDS_K, qr, r32, hi); ATT_WAIT_BAR(0);
    MLA_DMA(2); partialSM<true>(pA0, pA1, negm, alA); ATT_BAR_L();
#define MLA_STEP(C0, C1, P0, P1, alC, alP, t, HASN) do { \
        h1_qk_finish(C0, C1, P0, P1, negm, shm + LDS_K + ((t) & 3) * KSLOT, qr, r32, hi, alP, l_reg, pa0, pa1, pa2, pa3); SBAR(); ATT_WAIT_BAR(0); \
        { const int vb_ = vb0 + (((t) - 1) & 3) * KSLOT; float ma_, mb_, mc_, me_, pmx_; \
          { PvFrag f_; MLA_PV_ISSUE<0>(f_, vb_); if (HASN) { MLA_DMA((t) + 2); } max_head(C0, C1, ma_, mb_, mc_, me_); SBAR(); MLA_PV_MMA(o[0], f_, pa0, pa1, pa2, pa3); } \
          { PvFrag f_; MLA_PV_ISSUE<1>(f_, vb_); pmx_ = max_tail(C0, C1, ma_, mb_, mc_, me_); SBAR(); MLA_PV_MMA(o[1], f_, pa0, pa1, pa2, pa3); } \
          alC = 1.f; \
          if (!__builtin_expect(__all(pmx_ <= THR), 1)) { const float dl_ = fmaxf(pmx_, 0.f); alC = __builtin_amdgcn_exp2f(-dl_); \
              _Pragma("unroll") for (int r_ = 0; r_ < 16; ++r_) { C0[r_] -= dl_; C1[r_] -= dl_; negm[r_] -= dl_; } asm volatile("" : "+v"(negm)); } \
          { PvFrag f_; MLA_PV_ISSUE<2>(f_, vb_); _Pragma("unroll") for (int r_ = 0; r_ < 8; ++r_) C0[r_] = __builtin_amdgcn_exp2f(C0[r_]); asm volatile("" : "+v"(C0)); SBAR(); MLA_PV_MMA(o[2], f_, pa0, pa1, pa2, pa3); } \
          { PvFrag f_; MLA_PV_ISSUE<3>(f_, vb_); _Pragma("unroll") for (int r_ = 8; r_ < 16; ++r_) C0[r_] = __builtin_amdgcn_exp2f(C0[r_]); asm volatile("" : "+v"(C0)); SBAR(); MLA_PV_MMA(o[3], f_, pa0, pa1, pa2, pa3); } } \
        SBAR(); ATT_BAR_L(); MLA_RESC(alC); } while (0)
    for (int t = 1; t + 1 < NTILE; t += 2) {
        MLA_STEP(pB0, pB1, pA0, pA1, alB, alA, t, true);
        MLA_STEP(pA0, pA1, pB0, pB1, alA, alB, t + 1, (t + 3 < NTILE));
    }
    { qkt_c<12, KPITCH, 16>(pB0, pB1, negm, shm + LDS_K + ((NTILE - 1) & 3) * KSLOT, qr, r32, hi);
      finishSM(pA0, pA1, alA, l_reg, pa0, pa1, pa2, pa3); SBAR(); ATT_WAIT_BAR(0);
      { const int vb_ = vb0 + ((NTILE - 2) & 3) * KSLOT; MLA_PV_ONE<0>(o[0], vb_, pa0, pa1, pa2, pa3); MLA_PV_ONE<1>(o[1], vb_, pa0, pa1, pa2, pa3); MLA_PV_ONE<2>(o[2], vb_, pa0, pa1, pa2, pa3); MLA_PV_ONE<3>(o[3], vb_, pa0, pa1, pa2, pa3); }
      partialSM<false>(pB0, pB1, negm, alB);
      ATT_BAR_L(); MLA_RESC(alB);
      finishSM(pB0, pB1, alB, l_reg, pa0, pa1, pa2, pa3); SBAR();
      { const int vb_ = vb0 + ((NTILE - 1) & 3) * KSLOT; MLA_PV_ONE<0>(o[0], vb_, pa0, pa1, pa2, pa3); MLA_PV_ONE<1>(o[1], vb_, pa0, pa1, pa2, pa3); MLA_PV_ONE<2>(o[2], vb_, pa0, pa1, pa2, pa3); MLA_PV_ONE<3>(o[3], vb_, pa0, pa1, pa2, pa3); } }
    if (wid < 4) ATT_BAR_L();
    MLA_TS(2);
#if MLA_OT
    { const float rl = __builtin_amdgcn_rcpf(l_reg);
      bf16x8 pb[8];
#pragma unroll
      for (int ks = 0; ks < 8; ++ks) { const int bl = ks >> 1, b8 = (ks & 1) * 8;
          u32x4 w = {cvtpk(o[bl][b8 + 0] * rl, o[bl][b8 + 1] * rl), cvtpk(o[bl][b8 + 2] * rl, o[bl][b8 + 3] * rl), cvtpk(o[bl][b8 + 4] * rl, o[bl][b8 + 5] * rl), cvtpk(o[bl][b8 + 6] * rl, o[bl][b8 + 7] * rl)};
          pb[ks] = *reinterpret_cast<bf16x8*>(&w); }
      const bf16_t* wv = T.WV + ((size_t)h * 32 * 64 + lane) * 8;
      char* stg = shm + LDS_K + wid * (32 * 272);
      const int srow = lane >> 3, sc8 = (lane & 7) * 8;
      const size_t off0 = (size_t)(rowbase + q0 + wid * 32 + srow) * 1024 + h * 128 + sc8;
      u32x4 ga[8], ob[8]; bf16x8 bw[16], bn[16];
#pragma unroll
      for (int x = 0; x < 8; ++x) { const size_t off = off0 + (size_t)(x & 3) * 8 * 1024 + (x >> 2) * 64; ga[x] = *reinterpret_cast<const u32x4*>(T.GA + off); ob[x] = *reinterpret_cast<const u32x4*>(T.OB + off); }
#pragma unroll
      for (int x = 0; x < 16; ++x) bw[x] = *reinterpret_cast<const bf16x8*>(wv + x * 512);
      SBAR();
#pragma unroll
      for (int half = 0; half < 2; ++half) {
          if (half == 0) {
#pragma unroll
              for (int x = 0; x < 16; ++x) bn[x] = *reinterpret_cast<const bf16x8*>(wv + (16 + x) * 512); }
#pragma unroll
          for (int db2 = 0; db2 < 2; ++db2) { f32x16 oa = f32x16{};
#pragma unroll
              for (int ks = 0; ks < 8; ++ks) oa = __builtin_amdgcn_mfma_f32_32x32x16_bf16(half == 0 ? bw[db2 * 8 + ks] : bn[db2 * 8 + ks], pb[ks], oa, 0, 0, 0);
#pragma unroll
              for (int g = 0; g < 4; ++g) *reinterpret_cast<pg8::f32x4*>(stg + r32 * 272 + (db2 * 32 + 8 * g + 4 * hi) * 4) = pg8::f32x4{oa[4 * g], oa[4 * g + 1], oa[4 * g + 2], oa[4 * g + 3]}; }
          if (half == 0) MLA_TS(4); else MLA_TS(5);
#pragma unroll
          for (int it = 0; it < 4; ++it) { const int row = it * 8 + srow, x = half * 4 + it;
              const pg8::f32x4 x0 = *reinterpret_cast<const pg8::f32x4*>(stg + row * 272 + sc8 * 4), x1 = *reinterpret_cast<const pg8::f32x4*>(stg + row * 272 + sc8 * 4 + 16);
              u32x4 w;
#define MIX2(X, A, B, GW, OW) cvtpk2(X[A] * __uint_as_float((GW) << 16) + __uint_as_float((OW) << 16), X[B] * __uint_as_float((GW) & 0xffff0000u) + __uint_as_float((OW) & 0xffff0000u))
              w[0] = MIX2(x0, 0, 1, ga[x][0], ob[x][0]); w[1] = MIX2(x0, 2, 3, ga[x][1], ob[x][1]); w[2] = MIX2(x1, 0, 1, ga[x][2], ob[x][2]); w[3] = MIX2(x1, 2, 3, ga[x][3], ob[x][3]);
#undef MIX2
              *reinterpret_cast<u32x4*>(T.MIX + off0 + (size_t)it * 8 * 1024 + half * 64) = w; } } }
#else
    if (hi == 0) li_l[r32] = l_reg; asm volatile("s_waitcnt lgkmcnt(0)" ::: "memory");
    ATT_BAR_L();
    { char* stg = shm + LDS_K + wid * OST_WAVE;
#if MLA_OT
#pragma unroll
      for (int r = 0; r < 16; ++r) { const float rl = __builtin_amdgcn_rcpf(l_reg);
#pragma unroll
          for (int d0 = 0; d0 < 4; ++d0) *(bf16_t*)(stg + r32 * OST_PITCH + (d0 * 32 + crow(r, hi)) * 2) = f2bf(o[d0][r] * rl); }
#else
#pragma unroll
      for (int r = 0; r < 16; ++r) { const float rl = __builtin_amdgcn_rcpf(li_l[crow(r, hi)]);
#pragma unroll
          for (int d0 = 0; d0 < 4; ++d0) *(bf16_t*)(stg + crow(r, hi) * OST_PITCH + (d0 * 32 + r32) * 2) = f2bf(o[d0][r] * rl); }
#endif
      asm volatile("s_waitcnt lgkmcnt(0)" ::: "memory");
      bf16x8 af[8];
#pragma unroll
      for (int ks = 0; ks < 8; ++ks) af[ks] = *reinterpret_cast<const bf16x8*>(stg + r32 * OST_PITCH + ks * 32 + hi * 16);
      const bf16_t* wv = T.WV + ((size_t)(h * 128 + r32) * 128 + hi * 8);
#pragma unroll
      for (int d0 = 0; d0 < 4; ++d0) { o[d0] = f32x16{};
#pragma unroll
          for (int ks = 0; ks < 8; ++ks) { const bf16x8 bw = *reinterpret_cast<const bf16x8*>(wv + (size_t)d0 * 32 * 128 + ks * 16);
              o[d0] = __builtin_amdgcn_mfma_f32_32x32x16_bf16(af[ks], bw, o[d0], 0, 0, 0); } } }
    const long orow0 = rowbase + q0 + wid * 32;
#pragma unroll
    for (int r = 0; r < 16; ++r) { const long off = (orow0 + crow(r, hi)) * 1024 + h * 128 + r32;
#pragma unroll
        for (int d0 = 0; d0 < 4; ++d0) { const float v = o[d0][r] * bf2f(T.GA[off + d0 * 32]) + bf2f(T.OB[off + d0 * 32]); T.MIX[off + d0 * 32] = f2bf(v); } }
#endif
    asm volatile("s_waitcnt lgkmcnt(0)\n\ts_barrier" ::: "memory");
    MLA_TS(3);
#undef MLA_TS
#undef MLA_DMA
#undef MLA_RESC
#undef ATT_BAR_L
#undef MLA_STEP
#undef MLA_PV_ISSUE
#undef MLA_PV_MMA
#undef MLA_PV_ONE
#undef MLA_V_BASE
}
}

namespace mla2 {
using mla::NTILE; using mla::KPITCH; using mla::KSLOT; using mla::THR; using mla::OST_PITCH; using mla::OST_WAVE;
constexpr int NSLOT = 3;
constexpr int LDS_K = 0, LDS_P = NSLOT * KSLOT  , LDS_X = LDS_P + 65536  , LDS_BYTES = LDS_X + 4096;
static_assert(8 * OST_WAVE <= NSLOT * KSLOT, "o_lat staging fits the ring");
using mla::Tensors;
__device__ __forceinline__ void softmax_block(f32x16& p0, f32x16& p1, float& m_reg, float& l_reg, float& alpha, bf16x8& pa0, bf16x8& pa1, bf16x8& pa2, bf16x8& pa3) {
    float pm0 = fmaxf(p0[0], p0[1]), pm1 = fmaxf(p0[2], p0[3]), pm2 = fmaxf(p1[0], p1[1]), pm3 = fmaxf(p1[2], p1[3]);
#pragma unroll
    for (int r = 4; r < 16; r += 4) { pm0 = fmaxf(fmaxf(pm0, p0[r]), p0[r + 1]); pm1 = fmaxf(fmaxf(pm1, p0[r + 2]), p0[r + 3]); pm2 = fmaxf(fmaxf(pm2, p1[r]), p1[r + 1]); pm3 = fmaxf(fmaxf(pm3, p1[r + 2]), p1[r + 3]); }
    const float pmax = half_max(fmaxf(fmaxf(pm0, pm1), fmaxf(pm2, pm3)));
    const bool keep = __all(pmax - m_reg <= THR);
    const float mn = keep ? m_reg : fmaxf(m_reg, pmax); alpha = __builtin_amdgcn_exp2f(m_reg - mn); m_reg = mn;
#pragma unroll
    for (int r = 0; r < 16; ++r) { p0[r] = __builtin_amdgcn_exp2f(p0[r] - mn); p1[r] = __builtin_amdgcn_exp2f(p1[r] - mn); }
    float s0 = p0[0] + p0[1], s1 = p0[2] + p0[3], s2 = p1[0] + p1[1], s3 = p1[2] + p1[3];
#pragma unroll
    for (int r = 4; r < 16; r += 4) { s0 += p0[r]; s0 += p0[r + 1]; s1 += p0[r + 2]; s1 += p0[r + 3]; s2 += p1[r]; s2 += p1[r + 1]; s3 += p1[r + 2]; s3 += p1[r + 3]; }
    l_reg = l_reg * alpha + half_sum((s0 + s1) + (s2 + s3));
    pack_p(p0, p1, pa0, pa1, pa2, pa3);
}
__device__ __forceinline__ void out_block(const char* stg, const Tensors& T, int h, long orow0, int r32, int hi) {
    bf16x8 af[8];
#pragma unroll
    for (int ks = 0; ks < 8; ++ks) af[ks] = *reinterpret_cast<const bf16x8*>(stg + r32 * OST_PITCH + ks * 32 + hi * 16);
    const bf16_t* wv = T.WV + ((size_t)(h * 128 + r32) * 128 + hi * 8);
    f32x16 oa[4];
#pragma unroll
    for (int d0 = 0; d0 < 4; ++d0) { oa[d0] = f32x16{};
#pragma unroll
        for (int ks = 0; ks < 8; ++ks) { const bf16x8 bw = *reinterpret_cast<const bf16x8*>(wv + (size_t)d0 * 32 * 128 + ks * 16);
            oa[d0] = __builtin_amdgcn_mfma_f32_32x32x16_bf16(af[ks], bw, oa[d0], 0, 0, 0); } }
#pragma unroll
    for (int r = 0; r < 16; ++r) { const long off = (orow0 + crow(r, hi)) * 1024 + h * 128 + r32;
#pragma unroll
        for (int d0 = 0; d0 < 4; ++d0) { const float v = oa[d0][r] * bf2f(T.GA[off + d0 * 32]) + bf2f(T.OB[off + d0 * 32]); T.MIX[off + d0 * 32] = f2bf(v); } }
}
__device__ __forceinline__ void unit(int b, int h, int qb, const Tensors& T, char* shm, const int wave_id) {
    const int lane = pg8::lane_id_fresh(), wid = wave_id, r32 = lane & 31, hi = lane >> 5;
    const bool is_qk = wid < 4; const int pair = wid & 3;
    const long rowbase = (long)b * SEQ; const int q0 = qb * 256;
    const unsigned lds0 = (unsigned)(uintptr_t)shm;
    char* Pp = shm + LDS_P + pair * 8192; char* Xp = shm + LDS_X + pair * 1024;
    float* alx = (float*)Xp; float* lx = (float*)(Xp + 512); unsigned* fx = (unsigned*)(Xp + 768);
#define M2_BAR() asm volatile("s_waitcnt vmcnt(0) lgkmcnt(0)\n\ts_barrier" ::: "memory")
    const char* klb = (const char*)(T.KL + rowbase * 192);
#define M2_PIECE(kb_, p_, dst_) do { const int s_ = 64 * (p_) + lane, row_ = (s_ * 1311) >> 15, pos_ = s_ - 25 * row_; \
        glds16s<0>(kb_, (unsigned)(row_ * 384 + (pos_ < 24 ? pos_ : 23) * 16), (unsigned)__builtin_amdgcn_readfirstlane(dst_ + (p_) * 1024)); } while (0)
#define M2_DMA(t) do { const unsigned sd_ = lds0 + LDS_K + ((t) % 3) * KSLOT; const char* kb_ = klb + (size_t)(t) * 24576; \
        _Pragma("unroll") for (int i_ = 0; i_ < 6; ++i_) M2_PIECE(kb_, pair + 4 * i_, sd_); if (pair == 0) M2_PIECE(kb_, 24, sd_); } while (0)
    const int vb0 = (int)(lds0 + LDS_K) + mla::v_rm_base(lane);
#define M2_BAR_L() asm volatile("s_waitcnt lgkmcnt(0)\n\ts_barrier" ::: "memory")
    if (is_qk) {
        bf16x8 qA[12], qB[12]; float mA = -1e30f, mB = -1e30f, lA = 0.f, lB = 0.f;
        { const bf16_t* Qw = T.QA + (rowbase + q0 + pair * 64 + r32) * 1536 + h * 192 + hi * 8;
#pragma unroll
          for (int d0 = 0; d0 < 12; ++d0) { qA[d0] = *reinterpret_cast<const bf16x8*>(Qw + d0 * 16); qB[d0] = *reinterpret_cast<const bf16x8*>(Qw + 32 * 1536 + d0 * 16); } }
        f32x16 pA0, pA1, pB0, pB1;
        char* pw = Pp + lane * 16;
#define M2_QK(P0, P1, Q, t) do { P0 = f32x16{}; P1 = f32x16{}; const char* kb_ = shm + LDS_K + ((t) % 3) * KSLOT + hi * 16 + r32 * KPITCH; \
        _Pragma("unroll") for (int d0 = 0; d0 < 12; ++d0) { const bf16x8 b0_ = *reinterpret_cast<const bf16x8*>(kb_ + d0 * 32), b1_ = *reinterpret_cast<const bf16x8*>(kb_ + d0 * 32 + 32 * KPITCH); \
            P0 = __builtin_amdgcn_mfma_f32_32x32x16_bf16(b0_, Q[d0], P0, 0, 0, 0); P1 = __builtin_amdgcn_mfma_f32_32x32x16_bf16(b1_, Q[d0], P1, 0, 0, 0); } } while (0)
#define M2_SM(P0, P1, M, L, BLK) do { bf16x8 a0_, a1_, a2_, a3_; float al_; softmax_block(P0, P1, M, L, al_, a0_, a1_, a2_, a3_); \
        *reinterpret_cast<bf16x8*>(pw + (BLK) * 4096) = a0_; *reinterpret_cast<bf16x8*>(pw + (BLK) * 4096 + 1024) = a1_; *reinterpret_cast<bf16x8*>(pw + (BLK) * 4096 + 2048) = a2_; *reinterpret_cast<bf16x8*>(pw + (BLK) * 4096 + 3072) = a3_; \
        const bool f_ = __any(al_ < 1.f); if (hi == 0) alx[(BLK) * 32 + r32] = al_; if (lane == 0) fx[BLK] = f_ ? 1u : 0u; } while (0)
        M2_BAR();
        M2_QK(pA0, pA1, qA, 0); M2_BAR_L();
        M2_QK(pB0, pB1, qB, 0); M2_SM(pA0, pA1, mA, lA, 0); M2_BAR_L();
        for (int t = 1; t < NTILE; ++t) {
            M2_QK(pA0, pA1, qA, t); M2_SM(pB0, pB1, mB, lB, 1); M2_BAR_L();
            M2_QK(pB0, pB1, qB, t); M2_SM(pA0, pA1, mA, lA, 0); M2_BAR_L();
        }
        M2_SM(pB0, pB1, mB, lB, 1); M2_BAR_L();
        M2_BAR_L();
        if (hi == 0) { lx[r32] = lA; lx[32 + r32] = lB; }
        M2_BAR();
        M2_BAR();
#undef M2_QK
#undef M2_SM
    } else {
        f32x16 oA[4] = {}, oB[4] = {};
        const char* pr = Pp + lane * 16;
#define M2_PVB(O, BLK, t1) do { const int vb_ = vb0 + ((t1) % 3) * KSLOT; \
        const bf16x8 a0_ = *reinterpret_cast<const bf16x8*>(pr + (BLK) * 4096), a1_ = *reinterpret_cast<const bf16x8*>(pr + (BLK) * 4096 + 1024), a2_ = *reinterpret_cast<const bf16x8*>(pr + (BLK) * 4096 + 2048), a3_ = *reinterpret_cast<const bf16x8*>(pr + (BLK) * 4096 + 3072); \
        if (fx[BLK] != 0u) { _Pragma("unroll") for (int d = 0; d < 4; ++d) _Pragma("unroll") for (int r = 0; r < 16; ++r) O[d][r] *= alx[(BLK) * 32 + crow(r, hi)]; } \
        mla::pvr_one<0>(O[0], vb_, a0_, a1_, a2_, a3_); mla::pvr_one<1>(O[1], vb_, a0_, a1_, a2_, a3_); mla::pvr_one<2>(O[2], vb_, a0_, a1_, a2_, a3_); mla::pvr_one<3>(O[3], vb_, a0_, a1_, a2_, a3_); } while (0)
        M2_DMA(0);
        M2_BAR();
        M2_DMA(1); M2_BAR_L();
        M2_BAR();
        for (int t = 1; t < NTILE; ++t) {
            if (t + 1 < NTILE) M2_DMA(t + 1);
            M2_PVB(oA, 0, t - 1); M2_BAR_L();
            M2_PVB(oB, 1, t - 1); M2_BAR();
        }
        M2_PVB(oA, 0, NTILE - 1); M2_BAR_L();
        M2_PVB(oB, 1, NTILE - 1); M2_BAR_L();
#undef M2_PVB
        M2_BAR();
        { char* stgA = shm + LDS_K + (2 * pair) * OST_WAVE; char* stgB = stgA + OST_WAVE;
#pragma unroll
          for (int r = 0; r < 16; ++r) { const float ra = __builtin_amdgcn_rcpf(lx[crow(r, hi)]), rb = __builtin_amdgcn_rcpf(lx[32 + crow(r, hi)]);
#pragma unroll
              for (int d0 = 0; d0 < 4; ++d0) { *(bf16_t*)(stgA + crow(r, hi) * OST_PITCH + (d0 * 32 + r32) * 2) = f2bf(oA[d0][r] * ra); *(bf16_t*)(stgB + crow(r, hi) * OST_PITCH + (d0 * 32 + r32) * 2) = f2bf(oB[d0][r] * rb); } } }
        M2_BAR();
    }
#undef M2_BAR_L
    { const char* stg = shm + LDS_K + (2 * pair + (is_qk ? 1 : 0)) * OST_WAVE;
      out_block(stg, T, h, rowbase + q0 + pair * 64 + (is_qk ? 32 : 0), r32, hi); }
    asm volatile("s_waitcnt lgkmcnt(0)\n\ts_barrier" ::: "memory");
#undef M2_BAR
#undef M2_PIECE
#undef M2_DMA
}
}

namespace swa {
constexpr int KP = 144  , KT = 64 * KP  ;
constexpr int LDS_K = 0;
struct Tensors { const bf16_t* QB; const bf16_t* KB; const bf16_t* VB; bf16_t* GOB; const float* BT2; const float* SINK2; };
__device__ __forceinline__ int vt_base64(int lane) { return ((lane & 3) << 3) | (((lane >> 2) & 3) << 6) | (((lane >> 4) & 1) << 5) | ((lane >> 5) << 10); }
template <int D0> __device__ __forceinline__ void pvt64(f32x16& od, int vb, bf16x8 pa0, bf16x8 pa1, bf16x8 pa2, bf16x8 pa3) {
    const s16x4 l0 = tr_read<D0 * 512 + 0 * 2048>(vb), h0 = tr_read<D0 * 512 + 0 * 2048 + 256>(vb), l1 = tr_read<D0 * 512 + 1 * 2048>(vb), h1 = tr_read<D0 * 512 + 1 * 2048 + 256>(vb);
    const s16x4 l2 = tr_read<D0 * 512 + 2 * 2048>(vb), h2 = tr_read<D0 * 512 + 2 * 2048 + 256>(vb), l3 = tr_read<D0 * 512 + 3 * 2048>(vb), h3 = tr_read<D0 * 512 + 3 * 2048 + 256>(vb);
    asm volatile("s_waitcnt lgkmcnt(0)" ::: "memory"); SBAR();
#define PK(L, H) (bf16x8){L[0], L[1], L[2], L[3], H[0], H[1], H[2], H[3]}
    od = __builtin_amdgcn_mfma_f32_32x32x16_bf16(PK(l0, h0), pa0, od, 0, 0, 0);
    od = __builtin_amdgcn_mfma_f32_32x32x16_bf16(PK(l1, h1), pa1, od, 0, 0, 0);
    od = __builtin_amdgcn_mfma_f32_32x32x16_bf16(PK(l2, h2), pa2, od, 0, 0, 0);
    od = __builtin_amdgcn_mfma_f32_32x32x16_bf16(PK(l3, h3), pa3, od, 0, 0, 0);
#undef PK
}
constexpr int NQB = 8, RING = 6;
constexpr int LDS_V = RING * KT, LDS_TAB = LDS_V + RING * 8192, LDS_BYTES = LDS_TAB + 4 * 4 * 384 * 4;
constexpr float THR = 8.f;
typedef float f32x8_t __attribute__((ext_vector_type(8)));
__device__ __forceinline__ f32x16 cat4(pg8::f32x4 a, pg8::f32x4 b, pg8::f32x4 c, pg8::f32x4 e) {
    const f32x8_t lo = __builtin_shufflevector(a, b, 0, 1, 2, 3, 4, 5, 6, 7), hi = __builtin_shufflevector(c, e, 0, 1, 2, 3, 4, 5, 6, 7);
    return __builtin_shufflevector(lo, hi, 0, 1, 2, 3, 4, 5, 6, 7, 8, 9, 10, 11, 12, 13, 14, 15); }
__device__ __forceinline__ void bias_init(f32x16& n0, f32x16& n1, const float* tb) { const pg8::f32x4* q = reinterpret_cast<const pg8::f32x4*>(tb);
    n0 = cat4(q[0], q[2], q[4], q[6]); n1 = cat4(q[8], q[10], q[12], q[14]); }
__device__ __forceinline__ void qk_acc(f32x16& n0, f32x16& n1, const char* Ks, const bf16x8* qr, int r32, int hi) {
    const char* kb = Ks + hi * 16 + r32 * KP;
#pragma unroll
    for (int d0 = 0; d0 < 4; ++d0) { const bf16x8 b0 = *reinterpret_cast<const bf16x8*>(kb + d0 * 32), b1 = *reinterpret_cast<const bf16x8*>(kb + d0 * 32 + 32 * KP);
        n0 = __builtin_amdgcn_mfma_f32_32x32x16_bf16(b0, qr[d0], n0, 0, 0, 0); n1 = __builtin_amdgcn_mfma_f32_32x32x16_bf16(b1, qr[d0], n1, 0, 0, 0); }
}
#ifdef TP_SWA
#define SWA_TSARG , unsigned long long (&ts)[6]
#else
#define SWA_TSARG
#endif
__device__ __forceinline__ void run(int b, int kvh, int j, const Tensors& T, char* shm, const int wave_id SWA_TSARG) {
    const int lane = pg8::lane_id_fresh(), wid = wave_id, tid = wid * 64 + lane, r32 = lane & 31, hi = lane >> 5;
    const int g = wid >> 1, rh = wid & 1, head = kvh * 4 + g;
    const long rowbase = (long)b * SEQ; const int qb0 = j * NQB;
    const unsigned lds0 = (unsigned)(uintptr_t)shm;
    unsigned vvoff, kvoff, kvoff8;
    { const int st = 2 * wid + (lane >> 5), kk = (st >> 1) * 8 + ((lane & 31) >> 2), k = swap23(kk), c = (st & 1) * 32 + (lane & 3) * 8;
      vvoff = (unsigned)((k * 256 + c) * 2);
      int s = 64 * wid + lane, row = s / 9, pos = s - 9 * row; kvoff = (unsigned)(row * 512 + (pos < 8 ? pos : 7) * 16); s = 512 + lane; row = s / 9; pos = s - 9 * row; kvoff8 = (unsigned)(row * 512 + (pos < 8 ? pos : 7) * 16); }
#define SWA_DMA(TT) do { const int s_ = (TT) % RING; const long kb_ = rowbase + 64 * (TT); \
        glds16s<0>((const char*)(T.KB + kb_ * 256 + kvh * 64), kvoff, (unsigned)__builtin_amdgcn_readfirstlane(lds0 + LDS_K + s_ * KT + wid * 1024)); \
        if (wid == 0) glds16s<0>((const char*)(T.KB + kb_ * 256 + kvh * 64), kvoff8, (unsigned)__builtin_amdgcn_readfirstlane(lds0 + LDS_K + s_ * KT + 8192)); \
        glds16s<0>((const char*)(T.VB + kb_ * 256 + kvh * 64), vvoff, (unsigned)__builtin_amdgcn_readfirstlane(lds0 + LDS_V + s_ * 8192 + wid * 1024)); } while (0)
#ifdef TP_SWA
#define SWA_TS(slot) do { ts[slot] = __builtin_amdgcn_s_memrealtime(); } while (0)
#else
#define SWA_TS(slot) do { } while (0)
#endif
    SWA_TS(0);
    for (int TT = qb0 - 2; TT <= qb0 + 2; ++TT) if (TT >= 0 && TT < SEQ / 64) SWA_DMA(TT);
    { float* tab = (float*)(shm + LDS_TAB); float tv[12];
#pragma unroll
      for (int x = 0; x < 12; ++x) { const int i = tid + 512 * x, gg = i / 1536, rel = i % 384 + ((i / 384) & 3) - 192; const int rc = rel < -128 ? -128 : (rel > 128 ? 128 : rel);
          tv[x] = T.BT2[(kvh * 4 + gg) * 264 + rc + 128]; }
#pragma unroll
      for (int x = 0; x < 12; ++x) { const int i = tid + 512 * x, rel = i % 384 + ((i / 384) & 3) - 192; tab[i] = (rel >= -128 && rel <= 128) ? tv[x] : -1e30f; } }
    bf16x8 qr[4];
    const bf16_t* Qw = T.QB + (rowbase + qb0 * 64 + rh * 32 + r32) * 1024 + head * 64 + hi * 8;
#pragma unroll
    for (int d0 = 0; d0 < 4; ++d0) qr[d0] = *reinterpret_cast<const bf16x8*>(Qw + d0 * 16);
    const float sink = T.SINK2[head];
    const int vb0 = (int)(lds0 + LDS_V) + vt_base64(lane);
    const float* tbl;
    { const int base = 64 - 32 * rh - r32 + 4 * hi, s = base & 3; tbl = (const float*)(shm + LDS_TAB) + (g * 4 + s) * 384 + (base - s); }
    ATT_WAIT_BAR(0);
    SWA_TS(1);
    for (int i = 0; i < NQB; ++i) {
        const int qb = qb0 + i;
        if (i == 4) SWA_TS(2);
        if (i + 1 < NQB && qb + 3 < SEQ / 64) SWA_DMA(qb + 3);
        bf16x8 qn[4];
        if (i + 1 < NQB) {
#pragma unroll
            for (int d0 = 0; d0 < 4; ++d0) qn[d0] = *reinterpret_cast<const bf16x8*>(Qw + (size_t)(i + 1) * 64 * 1024 + d0 * 16); }
        else {
#pragma unroll
            for (int d0 = 0; d0 < 4; ++d0) qn[d0] = qr[d0]; }
        bf16_t* orow = T.GOB + (size_t)(rowbase + qb * 64 + rh * 32 + r32) * 1024 + head * 64 + 4 * hi;
        pg8::u32x2 gt[8];
#pragma unroll
        for (int x = 0; x < 8; ++x) gt[x] = *reinterpret_cast<const pg8::u32x2*>(orow + (x >> 2) * 32 + 8 * (x & 3));
        float m_reg = sink, l_reg = 1.0f; f32x16 o[2] = {};
        const int t_lo = qb < 2 ? 2 - qb : 0, nt = (qb + 2 >= SEQ / 64 ? SEQ / 64 + 2 - qb : 5) - t_lo;
        f32x16 sa0, sa1, sb0, sb1;
        bias_init(sa0, sa1, tbl + 64 * t_lo); qk_acc(sa0, sa1, shm + LDS_K + ((qb - 2 + t_lo) % RING) * KT, qr, r32, hi);
#define SWA_TILE(C0, C1, N0, N1, k, HASN) do { const int t_ = t_lo + (k), sl_ = (qb - 2 + t_) % RING; const bool hasn_ = (HASN); \
            if (hasn_) bias_init(N0, N1, tbl + 64 * (t_ + 1)); \
            float pmax; { float a = max3f(C0[0], C0[1], C0[2]), b2 = max3f(C0[9], C0[10], C0[11]), c = max3f(C1[0], C1[1], C1[2]), e = max3f(C1[9], C1[10], C1[11]); \
              a = max3f(a, C0[3], C0[4]); b2 = max3f(b2, C0[12], C0[13]); c = max3f(c, C1[3], C1[4]); e = max3f(e, C1[12], C1[13]); \
              a = max3f(a, C0[5], C0[6]); b2 = max3f(b2, C0[14], C0[15]); c = max3f(c, C1[5], C1[6]); e = max3f(e, C1[14], C1[15]); \
              a = max3f(a, C0[7], C0[8]); c = max3f(c, C1[7], C1[8]); pmax = max3f(a, b2, c); pmax = max3f(pmax, e, e); \
              auto rr = __builtin_amdgcn_permlane32_swap(__float_as_uint(pmax), __float_as_uint(pmax), false, false); pmax = max3f(__uint_as_float(rr[0]), __uint_as_float(rr[1]), __uint_as_float(rr[1])); } \
            asm volatile("" : "+v"(pmax)); SBAR(); \
            if (hasn_) qk_acc(N0, N1, shm + LDS_K + ((qb - 1 + t_) % RING) * KT, qr, r32, hi); \
            SBAR(); \
            if (!__builtin_expect(__all(pmax - m_reg <= THR), 1)) { const float mn = fmaxf(m_reg, pmax), alpha = __builtin_amdgcn_exp2f(m_reg - mn); m_reg = mn; l_reg *= alpha; \
                _Pragma("unroll") for (int d_ = 0; d_ < 2; ++d_) _Pragma("unroll") for (int r_ = 0; r_ < 16; ++r_) o[d_][r_] *= alpha; } \
            bf16x8 pa0, pa1, pa2, pa3; \
            { float s0, s1, s2, s3; \
              _Pragma("unroll") for (int r_ = 0; r_ < 16; ++r_) { C0[r_] = __builtin_amdgcn_exp2f(C0[r_] - m_reg); C1[r_] = __builtin_amdgcn_exp2f(C1[r_] - m_reg); } \
              s0 = C0[0] + C0[1]; s1 = C0[2] + C0[3]; s2 = C1[0] + C1[1]; s3 = C1[2] + C1[3]; \
              _Pragma("unroll") for (int r_ = 4; r_ < 16; r_ += 4) { s0 += C0[r_]; s0 += C0[r_ + 1]; s1 += C0[r_ + 2]; s1 += C0[r_ + 3]; s2 += C1[r_]; s2 += C1[r_ + 1]; s3 += C1[r_ + 2]; s3 += C1[r_ + 3]; } \
              l_reg += half_sum((s0 + s1) + (s2 + s3)); } \
            { u32x4 w0 = SWA_PK(C0, 0), w1 = SWA_PK(C0, 8), w2 = SWA_PK(C1, 0), w3 = SWA_PK(C1, 8); \
              pa0 = *reinterpret_cast<bf16x8*>(&w0); pa1 = *reinterpret_cast<bf16x8*>(&w1); pa2 = *reinterpret_cast<bf16x8*>(&w2); pa3 = *reinterpret_cast<bf16x8*>(&w3); } \
            asm volatile("" : "+v"(pa0), "+v"(pa1), "+v"(pa2), "+v"(pa3), "+v"(l_reg)); SBAR(); \
            pvt64<0>(o[0], vb0 + sl_ * 8192, pa0, pa1, pa2, pa3); pvt64<1>(o[1], vb0 + sl_ * 8192, pa0, pa1, pa2, pa3); } while (0)
#define SWA_PK(P, B) (u32x4){cvtpk2(P[B], P[B + 1]), cvtpk2(P[B + 2], P[B + 3]), cvtpk2(P[B + 4], P[B + 5]), cvtpk2(P[B + 6], P[B + 7])}
        SWA_TILE(sa0, sa1, sb0, sb1, 0, true);
        SWA_TILE(sb0, sb1, sa0, sa1, 1, true);
        SWA_TILE(sa0, sa1, sb0, sb1, 2, nt > 3);
        if (nt > 3) { SWA_TILE(sb0, sb1, sa0, sa1, 3, nt > 4);
            if (nt > 4) SWA_TILE(sa0, sa1, sb0, sb1, 4, false); }
#undef SWA_PK
#undef SWA_TILE
        if (i == 4) SWA_TS(3);
        { const float rl = __builtin_amdgcn_rcpf(l_reg);
#pragma unroll
          for (int x = 0; x < 8; ++x) { const int d0 = x >> 2, gq = x & 3;
              const float v0 = o[d0][4 * gq + 0] * rl * __uint_as_float(gt[x].x << 16), v1 = o[d0][4 * gq + 1] * rl * __uint_as_float(gt[x].x & 0xffff0000u);
              const float v2 = o[d0][4 * gq + 2] * rl * __uint_as_float(gt[x].y << 16), v3 = o[d0][4 * gq + 3] * rl * __uint_as_float(gt[x].y & 0xffff0000u);
              pg8::u32x2 w; w.x = cvtpk(v0, v1); w.y = cvtpk(v2, v3); *reinterpret_cast<pg8::u32x2*>(orow + d0 * 32 + 8 * gq) = w; } }
#pragma unroll
        for (int d0 = 0; d0 < 4; ++d0) qr[d0] = qn[d0];
        asm volatile("s_waitcnt vmcnt(8) lgkmcnt(0)\n\ts_barrier" ::: "memory");
        if (i == 4) SWA_TS(4);
    }
    SWA_TS(5);
#undef SWA_DMA
#undef SWA_TS
}
}
#undef SBAR
#undef ATT_WAIT_BAR
}
constexpr int NWAVES = 8;
#ifndef MK_PER_PHASE
#define MK_PER_PHASE 0
#endif
constexpr int N_PHASES = 8;

constexpr size_t MiB = 1u << 20;
constexpr size_t WS_CTL = 0, CTL_ZERO_BYTES = 128 * 1024;
constexpr size_t WS_COS = 1 * MiB, WS_SIN = WS_COS + 512 * 1024;
constexpr size_t WS_BT2 = 2 * MiB, WS_SINK2 = WS_BT2 + 16 * 264 * 4;
constexpr size_t WS_SSQQ = 3 * MiB, WS_SSQKV = WS_SSQQ + 512 * 1024;
constexpr size_t WS_SSQ2 = 4 * MiB, WS_SSQ3 = 6 * MiB;
constexpr size_t WS_WIN = 8 * MiB, WS_WQB = 16 * MiB, WS_WVT = 17 * MiB, WS_WOUT = 18 * MiB, WS_WUP = 20 * MiB, WS_WDN = 31 * MiB;
constexpr size_t WS_A0 = 40 * MiB;
constexpr size_t WS_XN = WS_A0;
constexpr size_t WS_X1B = WS_A0;
constexpr size_t WS_QLAT = 104 * MiB, WS_KL = 120 * MiB  , WS_QB = 132 * MiB, WS_KB = 196 * MiB, WS_VB = 212 * MiB, WS_GA = 228 * MiB, WS_GB = 292 * MiB;
constexpr size_t WS_MIX = WS_QB;
constexpr size_t WS_HALO = 104 * MiB;
constexpr size_t WS_ACT = 296 * MiB;
constexpr size_t WS_END = 472 * MiB;
static_assert(WS_ACT + (size_t)MTOK * DFF * 2 <= WS_END && WS_HALO + (size_t)(MTOK / 64) * 4 * 5632 * 4 <= WS_ACT && WS_KL + (size_t)MTOK * 192 * 2 <= WS_QB, "d_ws map");
constexpr int CW_BAR = 4096;
static_assert((CW_BAR + 3456) * 4 <= 65536, "barrier words below the panel counters");
constexpr int CW_PANEL = 16384;

constexpr int RING_OFF = 0, RING_BYTES = 146432;
constexpr int LDSCTL_OFF = RING_BYTES, MISC_OFF = LDSCTL_OFF + 320;
constexpr int LDS_BYTES = 147456;
static_assert(att::mla::LDS_BYTES <= RING_BYTES && att::mla2::LDS_BYTES <= RING_BYTES && att::swa::LDS_BYTES <= RING_BYTES && pg8::STAGE_BYTES <= RING_BYTES && MISC_OFF + 64 <= LDS_BYTES, "LDS map");

#define GAS __attribute__((address_space(1)))
#define LAS __attribute__((address_space(3)))
typedef unsigned short bf16;
typedef unsigned v4u __attribute__((ext_vector_type(4)));
typedef float f32x4 __attribute__((ext_vector_type(4)));
typedef short bf16x8 __attribute__((ext_vector_type(8)));
typedef GAS unsigned gu32;
typedef GAS unsigned long long gu64;
#define RLX_AGENT __ATOMIC_RELAXED, __HIP_MEMORY_SCOPE_AGENT
#define LDS_WAIT() asm volatile("s_waitcnt lgkmcnt(0)" ::: "memory")
#define VM_WAIT() asm volatile("s_waitcnt vmcnt(0)" ::: "memory")
__device__ __forceinline__ unsigned long long rt() { return __builtin_amdgcn_s_memrealtime(); }
__device__ __forceinline__ unsigned f2bf(float f) { unsigned u = __builtin_bit_cast(unsigned, f); return (u + 0x7fffu + ((u >> 16) & 1u)) >> 16; }
__device__ __forceinline__ unsigned pk2(float lo, float hi) { return f2bf(lo) | (f2bf(hi) << 16); }

#define XB_TMO      128
#define XB_XCNT(j)  (256  + 64 * (j))
#define XB_XSUB(j)  (1280 + 64 * (j))
#define XB_XGEN(j)  (2304 + 64 * (j))
#define XB_TOP      3328
#define XB_TOPGEN   3392
#define XCD_BAR_WORDS 3456
#define XB_SPIN_CAP (1u << 18)

__device__ __forceinline__ unsigned xb_ld(unsigned* p)              { return __hip_atomic_load(p, __ATOMIC_RELAXED, __HIP_MEMORY_SCOPE_AGENT); }
__device__ __forceinline__ unsigned xb_add(unsigned* p, unsigned v) { return __hip_atomic_fetch_add(p, v, __ATOMIC_RELAXED, __HIP_MEMORY_SCOPE_AGENT); }
__device__ __forceinline__ unsigned xb_xcc_id() { return (unsigned)__builtin_amdgcn_s_getreg((3 << 11) | 20) & 0xFu; }
#define XB_SPIN(cond, bar) do { unsigned _sp = 0; while (cond) { __builtin_amdgcn_s_sleep(1); \
    if ((++_sp & 255u) == 0u) { if (xb_ld(&(bar)[XB_TMO])) break; if (_sp > XB_SPIN_CAP) { atomicAdd(&(bar)[XB_TMO], 1u); break; } } } } while (0)

struct XcdBarrier {
    unsigned* bar; unsigned x; int w;
    volatile LAS unsigned* st;
};

__device__ __forceinline__ XcdBarrier xcd_barrier_post(unsigned* bar, volatile LAS unsigned* st) {
    XcdBarrier b; b.bar = bar; b.x = xb_xcc_id(); b.st = st;
    if (threadIdx.x == 0) (void)xb_add(&bar[XB_XCNT(b.x)], 1u);
    return b;
}
__device__ __forceinline__ void xcd_barrier_complete(unsigned* bar, unsigned x, unsigned& nloc, unsigned& nx) {
    const unsigned G = gridDim.x * gridDim.y * gridDim.z;
    unsigned sum, cnt, mine, sp = 0u;
    for (;;) {
        sum = 0u; cnt = 0u; mine = 0u;
#pragma unroll
        for (unsigned j = 0; j < 16; ++j) { const unsigned c = xb_ld(&bar[XB_XCNT(j)]); sum += c; cnt += (c > 0u) ? 1u : 0u; mine = (j == x) ? c : mine; }
        if (sum == G) break;
        __builtin_amdgcn_s_sleep(1);
        if ((++sp & 255u) == 0u) { if (xb_ld(&bar[XB_TMO])) break; if (sp > XB_SPIN_CAP) { atomicAdd(&bar[XB_TMO], 1u); break; } }
    }
    nloc = mine > 0u ? mine : 1u; nx = cnt > 0u ? cnt : 1u;
}

__device__ __forceinline__ void xcd_barrier(const XcdBarrier& b) {
    asm volatile("s_waitcnt vmcnt(0)" ::: "memory");
    __syncthreads();
    if (b.w == 0 && pg8::lane_id_fresh() == 0) {
        unsigned* bar = b.bar;
        __builtin_amdgcn_s_waitcnt(0);
        unsigned nloc = b.st[0], nx = b.st[1];
        if (nloc == 0u) { xcd_barrier_complete(bar, b.x, nloc, nx); b.st[0] = nloc; b.st[1] = nx; }
        const unsigned old = xb_add(&bar[XB_XSUB(b.x)], 1u);
        const unsigned gen = old / nloc;
        if (old + 1u == (gen + 1u) * nloc) {
            __builtin_amdgcn_fence(__ATOMIC_RELEASE, "agent");
            asm volatile("s_waitcnt vmcnt(0)" ::: "memory");
            const unsigned og = xb_add(&bar[XB_TOP], 1u);
            const unsigned tg = og / nx;
            if (og + 1u == (tg + 1u) * nx) xb_add(&bar[XB_TOPGEN], 1u);
            else XB_SPIN(xb_ld(&bar[XB_TOPGEN]) == tg, bar);
            __builtin_amdgcn_fence(__ATOMIC_ACQUIRE, "agent");
            xb_add(&bar[XB_XGEN(b.x)], 1u);
            asm volatile("s_waitcnt vmcnt(0)" ::: "memory");
        } else {
            XB_SPIN(xb_ld(&bar[XB_XGEN(b.x)]) == gen, bar);
            __builtin_amdgcn_fence(__ATOMIC_ACQUIRE, "agent");
            asm volatile("s_waitcnt vmcnt(0)" ::: "memory");
        }
    }
    __syncthreads();
}

struct Frame {
    LAS unsigned char* lds; volatile LAS unsigned* MISC; gu32* ctl;
    int wave, vcu, G;
};
__device__ __forceinline__ float wave_sum(float v) {
#pragma unroll
    for (int o = 1; o < 64; o <<= 1) v += __shfl_xor(v, o);
    return v;
}
template <class RowMap>
__device__ __forceinline__ void p0_transpose_item(const float* W, int K, int N, bf16* WT, const float* kscale, const RowMap& rm, LAS float* scr, int item, int lane) {
    const int nblk = N / 32, kb = item / nblk, nb = item % nblk, k0 = 64 * kb, n0 = 32 * nb;
    float tv[32];
#pragma unroll
    for (int i = 0; i < 32; ++i) { const int kk = 2 * i + (lane >> 5); tv[i] = W[(size_t)(k0 + kk) * N + n0 + (lane & 31)]; }
#pragma unroll
    for (int i = 0; i < 32; ++i) { const int kk = 2 * i + (lane >> 5); const float sc = kscale ? kscale[k0 + kk] : 1.0f; scr[kk * 33 + (lane & 31)] = tv[i] * sc; }
    LDS_WAIT(); asm volatile("" ::: "memory");
    const int c = lane & 7;
#pragma unroll
    for (int j = 0; j < 4; ++j) { const int n = (lane >> 3) + 8 * j; const LAS float* s = scr + (8 * c) * 33 + n;
        v4u o; o.x = pk2(s[0 * 33], s[1 * 33]); o.y = pk2(s[2 * 33], s[3 * 33]); o.z = pk2(s[4 * 33], s[5 * 33]); o.w = pk2(s[6 * 33], s[7 * 33]);
        const int rr = rm(n0 + n); if (rr >= 0) *(GAS v4u*)(WT + (size_t)rr * K + k0 + 8 * c) = o; }
    LDS_WAIT(); asm volatile("" ::: "memory");
}
struct MapIdent { __device__ __forceinline__ int operator()(int n) const { return n; } };
struct MapWin { __device__ __forceinline__ int operator()(int n) const {
    if (n < 256) return n; if (n >= 448) return n + 64; const int j = n - 256; if (j < 128) return 256 + j; const int d = j - 128; return 384 + (d < 32 ? 2 * d : 2 * (d - 32) + 1); } };
struct MapWqb { __device__ __forceinline__ int operator()(int n) const {
    const int h = n / 192, d = n % 192; if (d < 128) return -1  ; const int r = d - 128; return 1024 + h * 64 + (r < 32 ? 2 * r : 2 * (r - 32) + 1); } };
struct MapWup { __device__ __forceinline__ int operator()(int n) const {
    const int v = n >= DFF, c = v ? n - DFF : n; return 256 * (c >> 7) + 128 * v + (c & 127); } };

__device__ __forceinline__ int t5_bucket(int rel) {
    const int n = rel < 0 ? -rel : rel; int bk;
    if (n < 8) bk = n; else { const int e = (31 - __builtin_clz((unsigned)(n * n))) - 6; bk = 8 + e; if (bk > 15) bk = 15; }
    return (rel > 0 ? 16 : 0) + bk;
}
#ifndef MLA_SPLIT
#define MLA_SPLIT 0
#endif
struct Args {
    const float* x; const int* positions; const float* norm1_g; const float* w_in; const float* q_a_norm_g; const float* w_q_b; const float* kv_a_norm_g; const float* w_kv_b;
    const float* rel_bias; const float* sinks; const float* w_out; const float* norm2_g; const float* w_up; const float* conv_w; const float* conv_b; const float* w_down; const float* final_norm_g;
    float* out; unsigned char* ws; int ph_lo, ph_hi;
};

__device__ __forceinline__ void p0_prologue(Frame& F, const Args& a) {
    unsigned char* ws = a.ws;
    LAS float* scr = (LAS float*)(F.lds + RING_OFF + F.wave * 16384);
    const int lane = pg8::lane_id_fresh();
    const int gw = F.vcu * NWAVES + F.wave, NGW = F.G * NWAVES;
    constexpr int I_IN = (1024 / 64) * (4032 / 32), I_QB = (256 / 64) * (1536 / 32), I_OUT = (1024 / 64) * (1024 / 32), I_UP = (1024 / 64) * (5632 / 32), I_DN = (DFF / 64) * (1024 / 32);
    constexpr int NITEMS = I_IN + I_QB + I_OUT + I_UP + I_DN;
#ifndef P0DUP
#define P0DUP 0
#endif
    for (int rp_ = 0; rp_ <= (P0DUP & 1); ++rp_)
    for (int it = gw; it < NITEMS; it += NGW) {
        int r = it;
        if (r < I_IN) { p0_transpose_item(a.w_in, 1024, 4032, (bf16*)(ws + WS_WIN), nullptr, MapWin(), scr, r, lane); continue; } r -= I_IN;
        if (r < I_QB) { p0_transpose_item(a.w_q_b, 256, 1536, (bf16*)(ws + WS_WQB), a.q_a_norm_g, MapWqb(), scr, r, lane); continue; } r -= I_QB;
        if (r < I_OUT) { p0_transpose_item(a.w_out, 1024, 1024, (bf16*)(ws + WS_WOUT), nullptr, MapIdent(), scr, r, lane); continue; } r -= I_OUT;
        if (r < I_UP) { p0_transpose_item(a.w_up, 1024, 5632, (bf16*)(ws + WS_WUP), a.norm2_g, MapWup(), scr, r, lane); continue; } r -= I_UP;
        p0_transpose_item(a.w_down, DFF, 1024, (bf16*)(ws + WS_WDN), nullptr, MapIdent(), scr, r, lane);
    }
    const int gt = gw * 64 + lane, NGT = NGW * 64;
    for (int rp_ = 0; rp_ <= ((P0DUP >> 2) & 1); ++rp_)
    if (F.wave == 0) for (int blk = F.vcu; blk < 256; blk += F.G) { const int hh = blk >> 5, cb = (blk >> 3) & 3, jb = blk & 7, r32 = lane & 31, hi = lane >> 5;
        const f32x4* qp = (const f32x4*)(a.w_q_b + (size_t)(jb * 32 + r32) * 1536 + hh * 192) + hi; const f32x4* kp = (const f32x4*)(a.w_kv_b + (size_t)(cb * 32 + r32) * 2048 + hh * 256) + hi;
        att::f32x16 acc = {};
#pragma unroll 8
        for (int s = 0; s < 16; ++s) { const f32x4 x = qp[2 * s], y = kp[2 * s];
            acc = __builtin_amdgcn_mfma_f32_32x32x2f32(x[0], y[0], acc, 0, 0, 0); acc = __builtin_amdgcn_mfma_f32_32x32x2f32(x[1], y[1], acc, 0, 0, 0);
            acc = __builtin_amdgcn_mfma_f32_32x32x2f32(x[2], y[2], acc, 0, 0, 0); acc = __builtin_amdgcn_mfma_f32_32x32x2f32(x[3], y[3], acc, 0, 0, 0); }
        const float gk = a.kv_a_norm_g[cb * 32 + r32];
        bf16* dst = (bf16*)(ws + WS_WQB) + (size_t)(hh * 128 + cb * 32 + r32) * 256 + jb * 32 + 4 * hi;
#pragma unroll
        for (int g = 0; g < 4; ++g) { const f32x4 gq = *(const f32x4*)(a.q_a_norm_g + jb * 32 + 8 * g + 4 * hi);
            *(GAS unsigned long long*)(dst + 8 * g) = (unsigned long long)pk2(acc[4 * g] * gq[0] * gk, acc[4 * g + 1] * gq[1] * gk) | ((unsigned long long)pk2(acc[4 * g + 2] * gq[2] * gk, acc[4 * g + 3] * gq[3] * gk) << 32); } }
    for (int i = gt; i < 8 * 128 * 128; i += NGT) { const int hh = i >> 14, dd = (i >> 7) & 127, cp = i & 127, c = MLA_OT ? ((cp & ~0xC) | ((cp & 4) << 1) | ((cp & 8) >> 1)) : cp;
        ((bf16*)(ws + WS_WVT))[((((size_t)hh * 4 + (dd >> 5)) * 8 + (cp >> 4)) * 64 + ((cp >> 3) & 1) * 32 + (dd & 31)) * 8 + (cp & 7)] = (bf16)f2bf(a.w_kv_b[(size_t)c * 2048 + hh * 256 + 128 + dd] * a.kv_a_norm_g[c]); }
    for (int i = gt; i < 64 * 1024 / 8; i += NGT) *(GAS v4u*)((bf16*)(ws + WS_WIN) + (size_t)448 * 1024 + (size_t)i * 8) = (v4u){0u, 0u, 0u, 0u};
    for (int rp_ = 0; rp_ <= ((P0DUP >> 3) & 1); ++rp_)
    for (int i = gt; i < SEQ * 32; i += NGT) { const int s = i >> 5, d = i & 31;
        const float invf = __builtin_amdgcn_exp2f(-(float)d * (13.287712379549449f / 32.0f));
        const float ang = (float)a.positions[s] * invf;
        const double rev = (double)ang * 0.15915494309189535; const float fr = (float)(rev - __builtin_rint(rev));
        ((float*)(ws + WS_COS))[i] = __builtin_amdgcn_cosf(fr); ((float*)(ws + WS_SIN))[i] = __builtin_amdgcn_sinf(fr); }
    for (int i = gt; i < 16 * 264; i += NGT) { const int h = i / 264, j = i % 264; float v = 0.f; if (j <= 256) v = a.rel_bias[t5_bucket(j - 128) * 16 + h] * LOG2E; ((float*)(ws + WS_BT2))[i] = v; }
    if (gt < 16) ((float*)(ws + WS_SINK2))[gt] = a.sinks[gt] * LOG2E;
    for (int rp_ = 0; rp_ <= ((P0DUP >> 1) & 1); ++rp_)
    for (int m = gw; m < MTOK; m += 2 * NGW) {
        const GAS f32x4* xr = (const GAS f32x4*)(a.x + (size_t)m * DM) + lane; const GAS f32x4* xr2 = xr + (size_t)NGW * (DM / 4); const GAS f32x4* gr = (const GAS f32x4*)a.norm1_g + lane;
        f32x4 v[4], u[4]; float s = 0.f, s2 = 0.f;
#pragma unroll
        for (int j = 0; j < 4; ++j) { v[j] = xr[64 * j]; u[j] = xr2[64 * j]; }
#pragma unroll
        for (int j = 0; j < 4; ++j) { s += (v[j].x * v[j].x + v[j].y * v[j].y) + (v[j].z * v[j].z + v[j].w * v[j].w); s2 += (u[j].x * u[j].x + u[j].y * u[j].y) + (u[j].z * u[j].z + u[j].w * u[j].w); }
        const float rs = 1.0f / sqrtf(wave_sum(s) * (1.0f / DM) + RMS_EPS), rs2 = 1.0f / sqrtf(wave_sum(s2) * (1.0f / DM) + RMS_EPS);
        GAS unsigned long long* o8 = (GAS unsigned long long*)((bf16*)(ws + WS_XN) + (size_t)m * DM) + lane; GAS unsigned long long* o82 = o8 + (size_t)NGW * (DM / 4);
#pragma unroll
        for (int j = 0; j < 4; ++j) { const f32x4 g = gr[64 * j];
            o8[64 * j] = (unsigned long long)pk2(v[j].x * rs * g.x, v[j].y * rs * g.y) | ((unsigned long long)pk2(v[j].z * rs * g.z, v[j].w * rs * g.w) << 32);
            o82[64 * j] = (unsigned long long)pk2(u[j].x * rs2 * g.x, u[j].y * rs2 * g.y) | ((unsigned long long)pk2(u[j].z * rs2 * g.z, u[j].w * rs2 * g.w) << 32); }
    }
}

__device__ __forceinline__ void p6_fixup(Frame& F, const Args& a) {
    const int lane = pg8::lane_id_fresh();
    const int gw = F.vcu * NWAVES + F.wave, NGW = F.G * NWAVES;
    const float* halo = (const float*)(a.ws + WS_HALO); bf16* ACT = (bf16*)(a.ws + WS_ACT);
    constexpr int NBLK = MTOK / 64, HROW = 2 * DFF, HBLK = 4 * HROW;
    for (int it = gw; it < NBLK * 2 * 11; it += NGW) {
        const int cg = it % 11, which = (it / 11) & 1, blk = it / 22;
        const int c = cg * 256 + lane * 4, cu = 256 * (c >> 7) + (c & 127);
        const int r = 64 * blk + (which ? 63 : 0);
        const float* hp = halo + (size_t)blk * HBLK + (2 + which) * HROW + cu;
        f32x4 G = *(const f32x4*)hp, V = *(const f32x4*)(hp + 128);
        const bool has = which ? (((r + 1) & (SEQ - 1)) != 0) : ((r & (SEQ - 1)) != 0);
        if (has) { const float* np = halo + (size_t)(which ? blk + 1 : blk - 1) * HBLK + (which ? 0 : 1) * HROW + cu;
            const f32x4 rg = *(const f32x4*)np, rv = *(const f32x4*)(np + 128);
            const f32x4 wg = *(const f32x4*)(a.conv_w + (which ? 4 : 0) * DFF + c), wv = *(const f32x4*)(a.conv_w + (which ? 5 : 1) * DFF + c);
            G = G + wg * rg; V = V + wv * rv; }
        f32x4 o;
#pragma unroll
        for (int e = 0; e < 4; ++e) o[e] = G[e] * pg8::fast_sigmoid(G[e]) * V[e];
        pg8::st4((pg8::bf16_t*)(ACT + (size_t)r * DFF + c), o);
    }
}

__device__ __forceinline__ void p8_final_norm(Frame& F, const Args& a) {
    const int gw = F.vcu * NWAVES + F.wave, NGW = F.G * NWAVES;
    const int lane = pg8::lane_id_fresh();
    const float* ssq = (const float*)(a.ws + WS_SSQ3);
    for (int m = gw; m < MTOK; m += NGW) {
        const f32x4* sp = (const f32x4*)(ssq + (size_t)m * 16); const f32x4 t = (sp[0] + sp[1]) + (sp[2] + sp[3]);
        const float rs = 1.0f / sqrtf(((t[0] + t[1]) + (t[2] + t[3])) * (1.0f / DM) + RMS_EPS);
        GAS f32x4* xr = (GAS f32x4*)(a.out + (size_t)m * DM) + lane; const GAS f32x4* gr = (const GAS f32x4*)a.final_norm_g + lane;
#pragma unroll
        for (int j = 0; j < 4; ++j) { const f32x4 v = xr[64 * j], g = gr[64 * j]; xr[64 * j] = v * rs * g; }
    }
}

__global__ void __launch_bounds__(NWAVES * 64, 2) enc_fwd(Args args) {
    extern __shared__ __attribute__((aligned(16))) unsigned char lds[];
    Frame F;
    F.lds = (LAS unsigned char*)lds; F.MISC = (volatile LAS unsigned*)(F.lds + MISC_OFF);
    F.wave = __builtin_amdgcn_readfirstlane(threadIdx.x >> 6);
    F.G = gridDim.x; { const int bx = blockIdx.x; F.vcu = (F.G % 8 == 0) ? (bx % 8) * (F.G / 8) + bx / 8 : bx; }
    unsigned char* ws = args.ws;
    F.ctl = (gu32*)(ws + WS_CTL);
    for (int u = threadIdx.x; u < (LDS_BYTES - LDSCTL_OFF) / 4; u += NWAVES * 64) ((LAS unsigned*)(F.lds + LDSCTL_OFF))[u] = 0u;
    __syncthreads();
    XcdBarrier bar; bar.bar = (unsigned*)(F.ctl + CW_BAR); bar.x = 0; bar.st = nullptr;
    if (!MK_PER_PHASE) bar = xcd_barrier_post((unsigned*)(F.ctl + CW_BAR), F.MISC + 8);
    bar.w = F.wave;
    const int lo = args.ph_lo, hi = args.ph_hi;
#ifndef PHMASK
#define PHMASK 0xff
#endif
#define IN(k) (((PHMASK >> (k)) & 1) && lo <= (k) && (k) < hi)
#ifndef DUPMASK
#define DUPMASK 0
#endif
#define REP(k) for (int rep_ = 0; rep_ <= ((DUPMASK >> (k)) & 1); ++rep_)
#define SEAM(k) do { if (IN(k) && IN((k) + 1)) xcd_barrier(bar); } while (0)
    bf16* const WIN = (bf16*)(ws + WS_WIN); bf16* const WQB = (bf16*)(ws + WS_WQB); bf16* const WOUT = (bf16*)(ws + WS_WOUT);
    bf16* const WUP = (bf16*)(ws + WS_WUP); bf16* const WDN = (bf16*)(ws + WS_WDN);
    const float* const COS = (const float*)(ws + WS_COS); const float* const SIN = (const float*)(ws + WS_SIN);
    bf16* const QA = (bf16*)args.out;

#ifdef TP_PHASE
    unsigned long long tp_r0 = 0, tp_r1 = 0, tp_c0 = 0, tp_c1 = 0;
#ifndef TP_END
#define TP_END (TP_PHASE + 1)
#endif
#if defined(TP_SWA) || defined(TP_MLA)
#define TP_MARK(k)
#else
#define TP_MARK(k) do { if ((k) == TP_PHASE) { tp_r0 = __builtin_amdgcn_s_memrealtime(); tp_c0 = __builtin_amdgcn_s_memtime(); } if ((k) == TP_END) { tp_r1 = __builtin_amdgcn_s_memrealtime(); tp_c1 = __builtin_amdgcn_s_memtime(); } } while (0)
#endif
#else
#define TP_MARK(k)
#endif
#ifdef TP_SWA
    unsigned long long tp_ts[6] = {};
#define TP_TSPASS , tp_ts
#else
#define TP_TSPASS
#endif
#ifdef TP_MLA
    unsigned long long tp_ts[6] = {};
#define TP_MLAPASS , tp_ts, (u == F.vcu + F.G)
#else
#define TP_MLAPASS
#endif
    TP_MARK(0);
    if (IN(0)) REP(0) { p0_prologue(F, args); } SEAM(0);
    TP_MARK(1);

    if (IN(1)) REP(1) {
        pg8::Gemm g{(bf16*)(ws + WS_XN), WIN, MTOK, 4096, 1024}; pg8::StaticOrder S; S.init(MTOK, 4096, F.G, (int)blockIdx.x);
        pg8::EpiInProj E{(bf16*)(ws + WS_QLAT), (bf16*)(ws + WS_KL), (bf16*)(ws + WS_QB), (bf16*)(ws + WS_KB), (bf16*)(ws + WS_VB), (bf16*)(ws + WS_GA), (bf16*)(ws + WS_GB),
                         (float*)(ws + WS_SSQQ), (float*)(ws + WS_SSQKV), COS, SIN};
        pg8::gemm_phase<pg8::EpiInProj, pg8::StaticOrder, PG8_ALIGN, PG8_SP2>(F.lds + RING_OFF, g, S, E, F.wave);
    } SEAM(1);

    TP_MARK(2);
    if (IN(2)) REP(2) {
#ifndef P2SUB
#define P2SUB 7
#endif
#ifndef P2DUPG
#define P2DUPG 0
#endif
        for (int rg_ = 0; rg_ <= P2DUPG; ++rg_) {
        if (P2SUB & 1) { pg8::Gemm g{(bf16*)(ws + WS_QLAT), WQB, MTOK, 1536, 256}; pg8::StaticOrder S; S.init(MTOK, 1536, F.G, (int)blockIdx.x);
          pg8::EpiQProj E{QA, (const float*)(ws + WS_SSQQ), COS, SIN};
          pg8::gemm_phase<pg8::EpiQProj, pg8::StaticOrder, PG8_ALIGN, PG8_SP2>(F.lds + RING_OFF, g, S, E, F.wave); }
        }
        TP_MARK(20);
        if (P2SUB & 4) { const att::swa::Tensors T{(const bf16*)(ws + WS_QB), (const bf16*)(ws + WS_KB), (const bf16*)(ws + WS_VB), (bf16*)(ws + WS_GB), (const float*)(ws + WS_BT2), (const float*)(ws + WS_SINK2)};
          for (int u = F.vcu; u < NBATCH * 4 * (SEQ / 64 / att::swa::NQB); u += F.G) { const int j = u % (SEQ / 64 / att::swa::NQB), bk = u / (SEQ / 64 / att::swa::NQB); att::swa::run(bk >> 2, bk & 3, j, T, (char*)lds + RING_OFF, F.wave TP_TSPASS); } }
#ifdef TP_SWA
        tp_r0 = tp_ts[TP_A]; tp_r1 = tp_ts[TP_B];
#endif
    } SEAM(2);

    TP_MARK(3);
    if (IN(3)) REP(3) {
        const att::mla::Tensors T{QA, (const bf16*)(ws + WS_KL), (const bf16*)(ws + WS_WVT), (const bf16*)(ws + WS_GA), (const bf16*)(ws + WS_GB), (bf16*)(ws + WS_MIX)};
        for (int u = F.vcu; u < NBATCH * 8 * (SEQ / 256); u += F.G) { const int qb = u & 15, bh = u >> 4;
#if MLA_SPLIT
            att::mla2::unit(bh >> 3, bh & 7, qb, T, (char*)lds + RING_OFF, F.wave);
#else
            att::mla::unit(bh >> 3, bh & 7, qb, T, (char*)lds + RING_OFF, F.wave TP_MLAPASS);
#endif
        }
#ifdef TP_MLA
        tp_r0 = tp_ts[TP_A]; tp_r1 = tp_ts[TP_B];
#endif
    } SEAM(3);

    TP_MARK(4);
    if (IN(4)) REP(4) {
        pg8::Gemm g{(bf16*)(ws + WS_MIX), WOUT, MTOK, 1024, 1024}; pg8::StaticOrder S; S.init(MTOK, 1024, F.G, (int)blockIdx.x);
        pg8::EpiResidual E{args.x, nullptr, (bf16*)(ws + WS_X1B), (float*)(ws + WS_SSQ2)};
        pg8::gemm_phase<pg8::EpiResidual, pg8::StaticOrder, PG8_ALIGN, PG8_SP2>(F.lds + RING_OFF, g, S, E, F.wave);
    } SEAM(4);

    TP_MARK(5);
    if (IN(5)) REP(5) {
        pg8::Gemm g{(bf16*)(ws + WS_X1B), WUP, MTOK, 2 * DFF, 1024}; pg8::StaticOrder S; S.init(MTOK, 2 * DFF, F.G, (int)blockIdx.x);
        pg8::EpiUpConv E{(bf16*)(ws + WS_ACT), (float*)(ws + WS_HALO), (const float*)(ws + WS_SSQ2), args.conv_w, args.conv_b};
        pg8::gemm_phase<pg8::EpiUpConv, pg8::StaticOrder, PG8_ALIGN, PG8_SP2>(F.lds + RING_OFF, g, S, E, F.wave);
    } SEAM(5);
    TP_MARK(6);
    if (IN(6)) REP(6) { p6_fixup(F, args); } SEAM(6);

    TP_MARK(7);
    if (IN(7)) REP(7) {
        pg8::Gemm g{(bf16*)(ws + WS_ACT), WDN, MTOK, 1024, DFF}; pg8::StaticOrder S; S.init(MTOK, 1024, F.G, (int)blockIdx.x);
        pg8::EpiFinal E{(const bf16*)(ws + WS_X1B), args.out, (float*)(ws + WS_SSQ3), (unsigned*)(F.ctl + CW_PANEL), args.final_norm_g};
        pg8::gemm_phase<pg8::EpiFinal, pg8::StaticOrder, PG8_ALIGN, PG8_SP2>(F.lds + RING_OFF, g, S, E, F.wave);
    }
#ifdef TP_PHASE
    TP_MARK(8);
#ifndef TP_CLK
#define TP_CLK 0
#endif
#ifndef TP_GAIN
#define TP_GAIN 4
#endif
    if (blockIdx.x == 0 && F.wave == 0) {
        const unsigned long long dr = tp_r1 - tp_r0, dc = tp_c1 - tp_c0;
        const unsigned long long ticks = (TP_CLK ? dc * 100ull / dr : dr) * (unsigned long long)TP_GAIN;
        const unsigned long long t0 = __builtin_amdgcn_s_memrealtime();
        while (__builtin_amdgcn_s_memrealtime() - t0 < ticks) __builtin_amdgcn_s_sleep(8); }
#endif
#undef IN
#undef SEAM
}

extern "C" void kernel_launch(void* const* d_in, const int* in_sizes, int n_in, void* d_out, int out_size, void* d_ws, size_t ws_size, hipStream_t stream) {
    static int grid = 0;
    if (grid == 0) {
        if (n_in != 17 || in_sizes[0] != MTOK * DM || out_size != MTOK * DM || ws_size < WS_END) { fprintf(stderr, "kernel_launch: unexpected shapes (n_in %d, in0 %d, out %d, ws %zu; need ws >= %zu); nothing launched\n", n_in, n_in > 0 ? in_sizes[0] : -1, out_size, ws_size, (size_t)WS_END); grid = -1; return; }
        int dev = 0, cus = 0, per_cu = 0;
        if (hipGetDevice(&dev) != hipSuccess || hipDeviceGetAttribute(&cus, hipDeviceAttributeMultiprocessorCount, dev) != hipSuccess) { fprintf(stderr, "kernel_launch: device query failed\n"); grid = -1; return; }
        if (hipFuncSetAttribute((const void*)enc_fwd, hipFuncAttributeMaxDynamicSharedMemorySize, LDS_BYTES) != hipSuccess) { fprintf(stderr, "kernel_launch: hipFuncSetAttribute failed\n"); grid = -1; return; }
        if (hipOccupancyMaxActiveBlocksPerMultiprocessor(&per_cu, (const void*)enc_fwd, NWAVES * 64, LDS_BYTES) != hipSuccess || per_cu < 1) { fprintf(stderr, "kernel_launch: occupancy query reports %d workgroups per CU\n", per_cu); }
        (void)hipGetLastError();
        grid = cus;
    }
    if (grid < 0) return;
    if (hipMemsetAsync((char*)d_ws + WS_CTL, 0, CTL_ZERO_BYTES, stream) != hipSuccess) { fprintf(stderr, "kernel_launch: hipMemsetAsync failed\n"); return; }
    Args a{};
    a.x = (const float*)d_in[0]; a.positions = (const int*)d_in[1]; a.norm1_g = (const float*)d_in[2]; a.w_in = (const float*)d_in[3]; a.q_a_norm_g = (const float*)d_in[4]; a.w_q_b = (const float*)d_in[5];
    a.kv_a_norm_g = (const float*)d_in[6]; a.w_kv_b = (const float*)d_in[7]; a.rel_bias = (const float*)d_in[8]; a.sinks = (const float*)d_in[9]; a.w_out = (const float*)d_in[10]; a.norm2_g = (const float*)d_in[11];
    a.w_up = (const float*)d_in[12]; a.conv_w = (const float*)d_in[13]; a.conv_b = (const float*)d_in[14]; a.w_down = (const float*)d_in[15]; a.final_norm_g = (const float*)d_in[16];
    a.out = (float*)d_out; a.ws = (unsigned char*)d_ws;
#if MK_PER_PHASE
    for (int p = 0; p < N_PHASES; ++p) { a.ph_lo = p; a.ph_hi = p + 1; hipLaunchKernelGGL(enc_fwd, dim3(grid), dim3(NWAVES * 64), LDS_BYTES, stream, a); }
#else
    a.ph_lo = 0; a.ph_hi = N_PHASES; hipLaunchKernelGGL(enc_fwd, dim3(grid), dim3(NWAVES * 64), LDS_BYTES, stream, a);
#endif
    const hipError_t le = hipPeekAtLastError();
    if (le != hipSuccess) fprintf(stderr, "kernel_launch: launch failed: %s (grid %d)\n", hipGetErrorName(le), grid);
}
```
